# Optimizing an MI355X kernel written in HIP

```python
import math
import jax, jax.numpy as jnp
from jax import lax
import numpy as np

D_MODEL = 1024
BATCH = 16
SEQ = 2048
DEPTH = 2

CHUNK = 64
N_META = 16
N_MIXERS = 2
D_FF = 4 * D_MODEL
EPS = 1e-6

M_HEADS = 8
M_DQK = D_MODEL // (2 * M_HEADS)
M_DV = D_MODEL // M_HEADS
M_QK = M_HEADS * M_DQK
M_V = M_HEADS * M_DV
M_IN = 2 * M_QK + 2 * M_V + 2 * M_HEADS
M_CHUNK = 64

A_HEADS = 8
A_DH = D_MODEL // (2 * A_HEADS)
A_DV = 2 * A_DH
Q_BLOCK = 128
SUBLN_EPS = 1e-5

N_MLSTM = (DEPTH + 1) // 2
N_DIFF = DEPTH // 2

kernel_name = "hybrid_mlstm_diffattn_stream_encoder"


def rmsnorm(x, g, eps=EPS):
    xf = x.astype(jnp.float32)
    y = xf * lax.rsqrt(jnp.mean(xf * xf, axis=-1, keepdims=True) + eps)
    return (y * g.astype(jnp.float32)).astype(x.dtype)


def chunk_end(p):
    if p < N_META:
        return N_META
    return N_META + ((p - N_META) // CHUNK + 1) * CHUNK


def mlstm_mixer(h, w_in, b_gate, head_gain, w_out):
    B, L, _ = h.shape
    f32 = jnp.float32
    proj = (h @ w_in).astype(f32)
    q, k, v, o, gates = jnp.split(proj, [M_QK, 2 * M_QK, 2 * M_QK + M_V, 2 * M_QK + 2 * M_V], axis=-1)
    gates = gates + b_gate.astype(f32)
    ig, fg = gates[..., :M_HEADS], gates[..., M_HEADS:]

    pad = (-L) % M_CHUNK
    Lp = L + pad
    nc = Lp // M_CHUNK

    def to_chunks(t, d):
        t = jnp.pad(t, ((0, 0), (0, pad), (0, 0)))
        return t.reshape(B, nc, M_CHUNK, M_HEADS, d).transpose(0, 3, 1, 2, 4)

    def gate_chunks(g):
        g = jnp.pad(g, ((0, 0), (0, pad), (0, 0)))
        return g.reshape(B, nc, M_CHUNK, M_HEADS).transpose(0, 3, 1, 2)

    qc = to_chunks(q, M_DQK) * (M_DQK ** -0.5)
    kc = to_chunks(k, M_DQK)
    vc = to_chunks(v, M_DV)
    igc = gate_chunks(ig)
    lfc = gate_chunks(jax.nn.log_sigmoid(fg))

    b = jnp.cumsum(lfc, axis=-1)
    b_end = b[..., -1]
    a = b_end[..., None] - b + igc

    def step(carry, inp):
        C, n, m = carry
        k_s, v_s, a_s, be = inp
        m_new = jnp.maximum(be + m, jnp.max(a_s, axis=-1))
        decay = jnp.exp(be + m - m_new)
        w = jnp.exp(a_s - m_new[..., None])
        C_new = decay[..., None, None] * C + jnp.einsum('bhs,bhsd,bhse->bhde', w, k_s, v_s)
        n_new = decay[..., None] * n + jnp.einsum('bhs,bhsd->bhd', w, k_s)
        return (C_new, n_new, m_new), (C, n, m)

    init = (jnp.zeros((B, M_HEADS, M_DQK, M_DV), f32),
            jnp.zeros((B, M_HEADS, M_DQK), f32),
            jnp.zeros((B, M_HEADS), f32))
    xs = (kc.transpose(2, 0, 1, 3, 4), vc.transpose(2, 0, 1, 3, 4),
          a.transpose(2, 0, 1, 3), b_end.transpose(2, 0, 1))
    _, (C_prev, n_prev, m_prev) = lax.scan(step, init, xs)
    C_prev = C_prev.transpose(1, 2, 0, 3, 4)
    n_prev = n_prev.transpose(1, 2, 0, 3)
    m_prev = m_prev.transpose(1, 2, 0)

    causal = np.tril(np.ones((M_CHUNK, M_CHUNK), dtype=bool))
    log_d = jnp.where(causal, b[..., :, None] - b[..., None, :] + igc[..., None, :], -jnp.inf)
    m_inter = b + m_prev[..., None]
    m_t = jnp.maximum(m_inter, jnp.max(log_d, axis=-1))
    d_mat = jnp.exp(log_d - m_t[..., None])
    s = jnp.einsum('bhctd,bhcsd->bhcts', qc, kc) * d_mat
    inter = jnp.exp(m_inter - m_t)
    num = (inter[..., None] * jnp.einsum('bhctd,bhcde->bhcte', qc, C_prev)
           + jnp.einsum('bhcts,bhcse->bhcte', s, vc))
    den = inter * jnp.einsum('bhctd,bhcd->bhct', qc, n_prev) + jnp.sum(s, axis=-1)
    hh = num / jnp.maximum(jnp.abs(den), jnp.exp(-m_t))[..., None]

    hh = hh.transpose(0, 2, 3, 1, 4).reshape(B, Lp, M_HEADS, M_DV)[:, :L]
    hh = hh * lax.rsqrt(jnp.mean(hh * hh, axis=-1, keepdims=True) + EPS)
    hh = hh * head_gain.astype(f32).reshape(M_HEADS, M_DV)
    out = (jax.nn.sigmoid(o) * hh.reshape(B, L, M_V)).astype(h.dtype)
    return out @ w_out


def diff_attention(h, w_in, lam_vecs, head_gain, w_out, layer_idx):
    B, L, _ = h.shape
    f32 = jnp.float32
    lambda_init = 0.8 - 0.6 * math.exp(-0.3 * layer_idx)
    proj = h @ w_in
    q, k, v = jnp.split(proj, 3, axis=-1)
    q = (q.astype(f32) * (A_DH ** -0.5)).reshape(B, L, A_HEADS, 2, A_DH)
    k = k.astype(f32).reshape(B, L, A_HEADS, 2, A_DH)
    v = v.astype(f32).reshape(B, L, A_HEADS, A_DV)
    lv = lam_vecs.astype(f32)
    lam = jnp.exp(jnp.sum(lv[0] * lv[1])) - jnp.exp(jnp.sum(lv[2] * lv[3])) + lambda_init

    pos = np.arange(L)
    cid = np.where(pos < N_META, 0, 1 + (pos - N_META) // CHUNK)
    outs = []
    for s0 in range(0, L, Q_BLOCK):
        e0 = min(s0 + Q_BLOCK, L)
        ke = min(L, chunk_end(e0 - 1))
        mask = cid[None, :ke] <= cid[s0:e0, None]
        sc = jnp.einsum('bqhcd,bkhcd->bhcqk', q[:, s0:e0], k[:, :ke])
        p = jax.nn.softmax(jnp.where(mask, sc, -jnp.inf), axis=-1)
        attn = p[:, :, 0] - lam * p[:, :, 1]
        outs.append(jnp.einsum('bhqk,bkhe->bqhe', attn, v[:, :ke]))
    o = jnp.concatenate(outs, axis=1)
    o = o * lax.rsqrt(jnp.mean(o * o, axis=-1, keepdims=True) + SUBLN_EPS)
    o = o * head_gain.astype(f32).reshape(A_HEADS, A_DV) * (1.0 - lambda_init)
    return o.reshape(B, L, A_HEADS * A_DV).astype(h.dtype) @ w_out


def sq_relu_mlp(y, w_up, w_down):
    u = y @ w_up
    return jnp.square(jax.nn.relu(u)) @ w_down


def setup_inputs(seed: int = 0) -> dict:
    key = jax.random.key(seed)
    ks = jax.random.split(key, 16)
    nrm = jax.random.normal
    f32 = jnp.float32
    x = nrm(ks[0], (BATCH, SEQ, D_MODEL), f32)
    meta_tokens = nrm(ks[1], (N_META, D_MODEL), f32)
    norm_gains = 1.0 + 0.02 * nrm(ks[2], (DEPTH, 2, D_MODEL), f32)
    mlstm_w_in = nrm(ks[3], (N_MLSTM, D_MODEL, M_IN), f32) * D_MODEL ** -0.5
    ig_bias = 0.1 * nrm(ks[4], (N_MLSTM, M_HEADS), f32)
    fg_bias = jnp.linspace(3.0, 6.0, M_HEADS, dtype=f32)[None, :] + 0.1 * nrm(ks[5], (N_MLSTM, M_HEADS), f32)
    mlstm_b_gate = jnp.concatenate([ig_bias, fg_bias], axis=-1)
    mlstm_head_gain = 1.0 + 0.02 * nrm(ks[6], (N_MLSTM, M_V), f32)
    mlstm_w_out = nrm(ks[7], (N_MLSTM, M_V, D_MODEL), f32) * M_V ** -0.5
    diff_w_in = nrm(ks[8], (N_DIFF, D_MODEL, 3 * D_MODEL), f32) * D_MODEL ** -0.5
    diff_lambda = 0.1 * nrm(ks[9], (N_DIFF, 4, A_DH), f32)
    diff_head_gain = 1.0 + 0.02 * nrm(ks[10], (N_DIFF, A_HEADS * A_DV), f32)
    diff_w_out = nrm(ks[11], (N_DIFF, A_HEADS * A_DV, D_MODEL), f32) * (A_HEADS * A_DV) ** -0.5
    mlp_w_up = nrm(ks[12], (DEPTH, D_MODEL, D_FF), f32) * D_MODEL ** -0.5
    mlp_w_down = nrm(ks[13], (DEPTH, D_FF, D_MODEL), f32) * D_FF ** -0.5
    final_gain = 1.0 + 0.02 * nrm(ks[14], (D_MODEL,), f32)
    return {"x": x, "meta_tokens": meta_tokens, "norm_gains": norm_gains,
            "mlstm_w_in": mlstm_w_in, "mlstm_b_gate": mlstm_b_gate,
            "mlstm_head_gain": mlstm_head_gain, "mlstm_w_out": mlstm_w_out,
            "diff_w_in": diff_w_in, "diff_lambda": diff_lambda,
            "diff_head_gain": diff_head_gain, "diff_w_out": diff_w_out,
            "mlp_w_up": mlp_w_up, "mlp_w_down": mlp_w_down, "final_gain": final_gain}


def reference(x, meta_tokens, norm_gains, mlstm_w_in, mlstm_b_gate, mlstm_head_gain, mlstm_w_out,
              diff_w_in, diff_lambda, diff_head_gain, diff_w_out, mlp_w_up, mlp_w_down, final_gain):
    B = x.shape[0]
    meta = jnp.broadcast_to(meta_tokens.astype(x.dtype)[None], (B, N_META, D_MODEL))
    h = jnp.concatenate([meta, x], axis=1)
    for i in range(DEPTH):
        j = i // N_MIXERS
        y = rmsnorm(h, norm_gains[i, 0])
        if i % N_MIXERS == 0:
            y = mlstm_mixer(y, mlstm_w_in[j], mlstm_b_gate[j], mlstm_head_gain[j], mlstm_w_out[j])
        else:
            y = diff_attention(y, diff_w_in[j], diff_lambda[j], diff_head_gain[j], diff_w_out[j], i)
        h = h + y
        h = h + sq_relu_mlp(rmsnorm(h, norm_gains[i, 1]), mlp_w_up[i], mlp_w_down[i])
    h = rmsnorm(h, final_gain)
    return h[:, N_META:]
```

```cpp
#include <hip/hip_runtime.h>
#include <cstdio>
#include <cstdint>
namespace pg8 {
#define PG8_LAS __attribute__((address_space(3)))
typedef unsigned short bf16_t;
typedef short bf16x8 __attribute__((ext_vector_type(8)));
typedef float f32x4 __attribute__((ext_vector_type(4)));
typedef unsigned u32x4 __attribute__((ext_vector_type(4)));
constexpr int BM = 256, BK = 64, HALF = 128, HTB = HALF * BK * 2  , STAGE_BYTES = 8 * HTB, NXCD = 8, WGM = 8;

__host__ __device__ __forceinline__ int lds_byte(int r, int c) { const int st = (r >> 4) * 2 + (c >> 5), rr = r & 15, cc = c & 31, ob = rr * 64 + cc * 2; return st * 1024 + (ob ^ (((ob >> 9) & 1) << 5)); }
__host__ __device__ __forceinline__ void stage_rc(int b, int& R, int& C) { const int st = b / 1024, sb = b % 1024, swz = sb ^ (((sb >> 9) & 1) << 5); R = (st >> 1) * 16 + swz / 64; C = (st & 1) * 32 + (swz % 64) / 2; }
__host__ __device__ __forceinline__ int perm32(int rho) { const int n = rho >> 4, i = rho & 15; return 8 * (i >> 2) + 4 * n + (i & 3); }

struct Unit { int pm, pn; };
struct Gemm { const bf16_t* A; const bf16_t* Bt; int M, N, K; };

struct StaticOrder {
    int nM, nN, nwg, G, c;
    __host__ __device__ void init(int M, int N, int G_, int c_) { nM = M / BM; nN = N / BM; nwg = nM * nN; G = G_; c = c_; }
    __host__ __device__ bool next(int i, Unit& u) const {
        const long L = (long)i * G + c; if (L >= nwg) return false;
        int wgid = (int)L; { const int q = nwg / NXCD, r = nwg % NXCD, xcd = wgid % NXCD, off = wgid / NXCD; wgid = (xcd < r ? xcd * (q + 1) : r * (q + 1) + (xcd - r) * q) + off; }
        const int nig = WGM * nN, gid = wgid / nig, fm = gid * WGM, gsz = (nM - fm) < WGM ? (nM - fm) : WGM;
        u.pm = fm + ((wgid % nig) % gsz); u.pn = (wgid % nig) / gsz; return true;
    }
    __device__ __forceinline__ void a_ready(const Unit&) const {}
    __device__ __forceinline__ void done(const Unit&) const {}
};

__device__ __forceinline__ unsigned cvt_pk_bf16(float lo, float hi) { unsigned r; asm volatile("v_cvt_pk_bf16_f32 %0, %1, %2" : "=v"(r) : "v"(lo), "v"(hi)); return r; }
typedef unsigned u32x2 __attribute__((ext_vector_type(2)));

template <int NS> __device__ __forceinline__ float row_rstd(const float* ss, int row, float eps) {
    const float* sp = ss + (size_t)row * 16; float s;
    if (NS == 1) s = sp[0];
    else { const f32x4 a = *(const f32x4*)sp, b = *(const f32x4*)(sp + 4), c = *(const f32x4*)(sp + 8), d = *(const f32x4*)(sp + 12);
           s = ((a[0] + a[1]) + (a[2] + a[3])) + ((b[0] + b[1]) + (b[2] + b[3])) + ((c[0] + c[1]) + (c[2] + c[3])) + ((d[0] + d[1]) + (d[2] + d[3])); }
    return __builtin_amdgcn_rsqf(s * (1.0f / 1024.0f) + eps);
}
template <int ACT, int NS> struct EpiScale {
    static constexpr bool PERM = true, AFTER_DRAIN = false;
    bf16_t* O; int ldc; const float* ss; float eps;
    __device__ __forceinline__ void operator()(const f32x4 (&acc)[2][2][4][2], const Unit& u, int wr, int wc, int fr, int fq) const {
        const int row0 = u.pm * BM + wr * 64 + fr, col0 = u.pn * BM + wc * 32 + 8 * fq;
#pragma unroll
        for (int ai = 0; ai < 2; ++ai)
#pragma unroll
            for (int m = 0; m < 4; ++m) { const int row = row0 + ai * HALF + m * 16; const float rs = row_rstd<NS>(ss, row, eps);
                bf16_t* rowp = O + (size_t)row * ldc + col0;
#pragma unroll
                for (int bj = 0; bj < 2; ++bj) { f32x4 v0 = acc[ai][bj][m][0] * rs, v1 = acc[ai][bj][m][1] * rs;
                    if (ACT == 1) {
#pragma unroll
                        for (int i = 0; i < 4; ++i) { const float a = fmaxf(v0[i], 0.f), b = fmaxf(v1[i], 0.f); v0[i] = a * a; v1[i] = b * b; } }
                    u32x4 w; w.x = cvt_pk_bf16(v0[0], v0[1]); w.y = cvt_pk_bf16(v0[2], v0[3]); w.z = cvt_pk_bf16(v1[0], v1[1]); w.w = cvt_pk_bf16(v1[2], v1[3]);
                    *(u32x4*)(rowp + bj * HALF) = w; } }
    }
};
struct EpiRes {
    static constexpr bool PERM = false, AFTER_DRAIN = false;
    float* Hm; float* Hr; bf16_t* HB; float* ss;
    __device__ __forceinline__ void operator()(const f32x4 (&acc)[2][2][4][2], const Unit& u, int wr, int wc, int fr, int fq) const {
        const int row0 = u.pm * BM + wr * 64 + fr, col0 = u.pn * BM + wc * 32 + 4 * fq;
#pragma unroll
        for (int ai = 0; ai < 2; ++ai)
#pragma unroll
            for (int m = 0; m < 4; ++m) { const int row = row0 + ai * HALF + m * 16;
                float* hp = (u.pm == 0 ? Hm + (size_t)row * 1024 : Hr + (size_t)(row - 256) * 1024) + col0; float q = 0.f;
#pragma unroll
                for (int bj = 0; bj < 2; ++bj)
#pragma unroll
                    for (int n = 0; n < 2; ++n) { const int off = bj * HALF + n * 16; const f32x4 hv = *(const f32x4*)(hp + off) + acc[ai][bj][m][n]; *(f32x4*)(hp + off) = hv;
                        q += (hv[0] * hv[0] + hv[1] * hv[1]) + (hv[2] * hv[2] + hv[3] * hv[3]);
                        if (HB) { u32x2 w; w.x = cvt_pk_bf16(hv[0], hv[1]); w.y = cvt_pk_bf16(hv[2], hv[3]); *(u32x2*)(HB + (size_t)row * 1024 + col0 + off) = w; } }
                q += __shfl_xor(q, 16); q += __shfl_xor(q, 32);
                if (fq == 0) ss[(size_t)row * 16 + u.pn * 4 + wc] = q; }
    }
};

template <class Epi, class Sched, bool ALIGN_EPI = false, bool SP2 = false>
__device__ __forceinline__ void gemm_phase(PG8_LAS unsigned char* lds, const Gemm g, const Sched& S, const Epi& E) {
    const int tid = threadIdx.x, wid = __builtin_amdgcn_readfirstlane(tid >> 6), lane = tid & 63, wr = wid >> 2, wc = wid & 3, fr = lane & 15, fq = lane >> 4;
    const int K = g.K, nt = K / BK;
    unsigned voffA[2], voffB[2];
#pragma unroll
    for (int i = 0; i < 2; ++i) { int R, C; stage_rc(tid * 16 + i * 8192, R, C); const int Rb = Epi::PERM ? ((R & ~31) + perm32(R & 31)) : R;
        voffA[i] = (unsigned)(R * K + C) * 2u; voffB[i] = (unsigned)(Rb * K + C) * 2u; }
    const size_t kstep = (size_t)(BK * 2);
    const size_t hstep = (size_t)HALF * K * 2;
    const size_t tstep = 2 * hstep;
    const unsigned ldsw = (unsigned)wid * 1024u;
    const int aoff = lds_byte(wr * 64 + fr, fq * 8), boff = lds_byte(wc * 32 + fr, fq * 8);
#define PG8_SA(b, h) (((b) * 2 + (h)) * HTB)
#define PG8_SB(b, h) ((4 + (b) * 2 + (h)) * HTB)
#define PG8_STAGE(bufoff, gbase, voff) do { _Pragma("unroll") for (int _i = 0; _i < 2; ++_i) \
        __builtin_amdgcn_global_load_lds((const unsigned*)((const char*)(gbase) + (voff)[_i]), (PG8_LAS unsigned*)(lds + (bufoff) + ldsw + _i * 8192), 16, 0, 0); } while (0)
#define PG8_LDA(dst, b, h) do { _Pragma("unroll") for (int m = 0; m < 4; ++m) _Pragma("unroll") for (int k = 0; k < 2; ++k) dst[m][k] = *(const PG8_LAS bf16x8*)(lds + PG8_SA(b, h) + aoff + m * 2048 + k * 1024); } while (0)
#define PG8_LDB(dst, b, h) do { _Pragma("unroll") for (int n = 0; n < 2; ++n) _Pragma("unroll") for (int k = 0; k < 2; ++k) dst[n][k] = *(const PG8_LAS bf16x8*)(lds + PG8_SB(b, h) + boff + n * 2048 + k * 1024); } while (0)
#define PG8_MMA(ai, bj, At, Bt) do { __builtin_amdgcn_s_setprio(1); _Pragma("unroll") for (int m = 0; m < 4; ++m) _Pragma("unroll") for (int n = 0; n < 2; ++n) _Pragma("unroll") for (int k = 0; k < 2; ++k) \
        acc[ai][bj][m][n] = __builtin_amdgcn_mfma_f32_16x16x32_bf16(Bt[n][k], At[m][k], acc[ai][bj][m][n], 0, 0, 0); __builtin_amdgcn_s_setprio(0); } while (0)
#define PG8_WAIT_V(n) asm volatile("s_waitcnt vmcnt(" #n ")" ::: "memory")
#define PG8_WAIT_L(n) asm volatile("s_waitcnt lgkmcnt(" #n ")" ::: "memory")
#define PG8_BAR __builtin_amdgcn_s_barrier()
#define PG8_SCHED __builtin_amdgcn_sched_barrier(0)
    Unit cur, nxt; int ui = 0;
    if (!S.next(0, cur)) return;
    f32x4 acc[2][2][4][2];
#pragma unroll
    for (int a = 0; a < 2; ++a)
#pragma unroll
        for (int b = 0; b < 2; ++b)
#pragma unroll
            for (int m = 0; m < 4; ++m)
#pragma unroll
                for (int n = 0; n < 2; ++n) acc[a][b][m][n] = (f32x4){0.f, 0.f, 0.f, 0.f};
    bf16x8 At[4][2], B0[2][2], B1[2][2];
    const char* cA = (const char*)g.A + (size_t)cur.pm * tstep; const char* cB = (const char*)g.Bt + (size_t)cur.pn * tstep;
    S.a_ready(cur);
    if constexpr (SP2) {
        PG8_STAGE(PG8_SB(0, 0), cB, voffB); PG8_STAGE(PG8_SB(0, 1), cB + hstep, voffB); PG8_STAGE(PG8_SA(0, 0), cA, voffA); PG8_STAGE(PG8_SA(0, 1), cA + hstep, voffA);
        if (wr == 1) PG8_BAR;
        PG8_WAIT_V(2); PG8_BAR;
        PG8_STAGE(PG8_SB(1, 0), cB + kstep, voffB); PG8_STAGE(PG8_SA(1, 0), cA + kstep, voffA); PG8_STAGE(PG8_SB(1, 1), cB + hstep + kstep, voffB);
        PG8_WAIT_V(6); PG8_BAR;
    } else {
        PG8_STAGE(PG8_SB(0, 0), cB, voffB); PG8_STAGE(PG8_SA(0, 0), cA, voffA); PG8_STAGE(PG8_SB(0, 1), cB + hstep, voffB); PG8_STAGE(PG8_SA(0, 1), cA + hstep, voffA);
        if (wr == 1) PG8_BAR;
        PG8_WAIT_V(4); PG8_BAR;
        PG8_STAGE(PG8_SB(1, 0), cB + kstep, voffB); PG8_STAGE(PG8_SA(1, 0), cA + kstep, voffA); PG8_STAGE(PG8_SB(1, 1), cB + hstep + kstep, voffB);
        PG8_WAIT_V(6); PG8_BAR;
    }
    for (;;) {
        const bool has_next = S.next(ui + 1, nxt);
        const char* nA = has_next ? (const char*)g.A + (size_t)nxt.pm * tstep : cA; const char* nB = has_next ? (const char*)g.Bt + (size_t)nxt.pn * tstep : cB;
        for (int t = 0; t < nt; t += 2) {
            const bool last = (t == nt - 2);
            const char* a1 = cA + (size_t)(t + 1) * kstep;
            const char* a2 = last ? nA : cA + (size_t)(t + 2) * kstep; const char* b2 = last ? nB : cB + (size_t)(t + 2) * kstep;
            const char* a3 = a2 + kstep; const char* b3 = b2 + kstep;
            if (last && has_next) S.a_ready(nxt);
            if constexpr (SP2) {
            PG8_LDB(B0, 0, 0); PG8_LDB(B1, 0, 1); PG8_SCHED; PG8_LDA(At, 0, 0); PG8_STAGE(PG8_SA(1, 1), a1 + hstep, voffA);
            PG8_WAIT_V(8); PG8_WAIT_L(0); PG8_BAR; PG8_MMA(0, 0, At, B0); PG8_MMA(0, 1, At, B1); PG8_BAR; PG8_SCHED;
            PG8_LDA(At, 0, 1); PG8_STAGE(PG8_SB(0, 0), b2, voffB); PG8_STAGE(PG8_SB(0, 1), b2 + hstep, voffB); PG8_STAGE(PG8_SA(0, 0), a2, voffA);
            PG8_WAIT_V(8); PG8_WAIT_L(0); PG8_BAR; PG8_MMA(1, 0, At, B0); PG8_MMA(1, 1, At, B1); PG8_BAR; PG8_SCHED;
            PG8_LDB(B0, 1, 0); PG8_LDB(B1, 1, 1); PG8_SCHED; PG8_LDA(At, 1, 0); PG8_STAGE(PG8_SA(0, 1), a2 + hstep, voffA);
            PG8_WAIT_V(8); PG8_WAIT_L(0); PG8_BAR; PG8_MMA(0, 0, At, B0); PG8_MMA(0, 1, At, B1); PG8_BAR; PG8_SCHED;
            PG8_LDA(At, 1, 1); PG8_STAGE(PG8_SB(1, 0), b3, voffB); PG8_STAGE(PG8_SB(1, 1), b3 + hstep, voffB); PG8_STAGE(PG8_SA(1, 0), a3, voffA);
            PG8_WAIT_V(8); PG8_WAIT_L(0); PG8_BAR; PG8_MMA(1, 0, At, B0); PG8_MMA(1, 1, At, B1); PG8_BAR; PG8_SCHED;
            } else {
            PG8_LDB(B0, 0, 0); PG8_SCHED; PG8_LDA(At, 0, 0); PG8_STAGE(PG8_SA(1, 1), a1 + hstep, voffA);
            PG8_WAIT_L(8); PG8_BAR; PG8_WAIT_L(0); PG8_MMA(0, 0, At, B0); PG8_BAR; PG8_SCHED;
            PG8_LDB(B1, 0, 1); PG8_STAGE(PG8_SB(0, 0), b2, voffB);
            PG8_BAR; PG8_WAIT_L(0); PG8_MMA(0, 1, At, B1); PG8_BAR;
            PG8_LDA(At, 0, 1); PG8_STAGE(PG8_SA(0, 0), a2, voffA);
            PG8_BAR; PG8_WAIT_L(0); PG8_MMA(1, 0, At, B0); PG8_BAR; PG8_SCHED;
            PG8_STAGE(PG8_SB(0, 1), b2 + hstep, voffB);
            PG8_WAIT_V(6); PG8_BAR; PG8_MMA(1, 1, At, B1); PG8_BAR;
            PG8_LDB(B0, 1, 0); PG8_SCHED; PG8_LDA(At, 1, 0); PG8_STAGE(PG8_SA(0, 1), a2 + hstep, voffA);
            PG8_WAIT_L(8); PG8_BAR; PG8_WAIT_L(0); PG8_MMA(0, 0, At, B0); PG8_BAR; PG8_SCHED;
            PG8_LDB(B1, 1, 1); PG8_STAGE(PG8_SB(1, 0), b3, voffB);
            PG8_BAR; PG8_WAIT_L(0); PG8_MMA(0, 1, At, B1); PG8_BAR;
            PG8_LDA(At, 1, 1); PG8_STAGE(PG8_SA(1, 0), a3, voffA);
            PG8_BAR; PG8_WAIT_L(0); PG8_MMA(1, 0, At, B0); PG8_BAR; PG8_SCHED;
            PG8_STAGE(PG8_SB(1, 1), b3 + hstep, voffB);
            PG8_WAIT_V(6); PG8_BAR; PG8_MMA(1, 1, At, B1); PG8_BAR;
            }
        }
        if constexpr (ALIGN_EPI) { if (wr == 0) PG8_BAR; }
        if constexpr (!Epi::AFTER_DRAIN) { E(acc, cur, wr, wc, fr, fq); S.done(cur); }
        if (!has_next) break;
#pragma unroll
        for (int a = 0; a < 2; ++a)
#pragma unroll
            for (int b = 0; b < 2; ++b)
#pragma unroll
                for (int m = 0; m < 4; ++m)
#pragma unroll
                    for (int n = 0; n < 2; ++n) acc[a][b][m][n] = (f32x4){0.f, 0.f, 0.f, 0.f};
        cur = nxt; cA = nA; cB = nB; ++ui;
        if constexpr (ALIGN_EPI) { if (wr == 1) PG8_BAR; }
    }
    PG8_WAIT_V(0);
    if constexpr (!ALIGN_EPI) { if (wr == 0) PG8_BAR; }
    PG8_BAR;
    if constexpr (Epi::AFTER_DRAIN) { E.fused(acc, cur, wr, wc, fr, fq, lds, wid, lane); S.done(cur); }
#undef PG8_SA
#undef PG8_SB
#undef PG8_STAGE
#undef PG8_LDA
#undef PG8_LDB
#undef PG8_MMA
#undef PG8_WAIT_V
#undef PG8_WAIT_L
#undef PG8_BAR
#undef PG8_SCHED
}
}

#ifndef PG8_SP2
#define PG8_SP2 true
#endif
#ifndef PG8_ALIGN
#define PG8_ALIGN true
#endif
constexpr int NB = 16, SEQ = 2048, NMETA = 16, D = 1024, FF = 4096;
constexpr int MROWS = NB * (SEQ + NMETA);
constexpr int META_ROWS = NB * NMETA;
constexpr int NH = 8, DQK = 64, DV = 128;
constexpr int NPROJ = 3072;
constexpr float EPS = 1e-6f, SUBLN_EPS = 1e-5f;
constexpr int NWAVES = 8;
#ifndef MK_N_LAUNCHES
#define MK_N_LAUNCHES 12
#endif
constexpr int NPHASE = 12;

constexpr size_t MiB = 1u << 20;
constexpr size_t WS_CTL = 0, CTL_ZERO_BYTES = 1 * MiB;
constexpr size_t WS_WIN0 = 1 * MiB, WS_WOUT0 = 7 * MiB, WS_WUP0 = 9 * MiB, WS_WDN0 = 17 * MiB;
constexpr size_t WS_WIN1 = 25 * MiB, WS_WOUT1 = 31 * MiB, WS_WUP1 = 33 * MiB, WS_WDN1 = 41 * MiB;
constexpr size_t WS_WG = 49 * MiB;
constexpr size_t WS_HMETA = 50 * MiB;
constexpr size_t WS_SS = 51 * MiB;
constexpr size_t WS_GATES = 54 * MiB;
constexpr size_t WS_HB = 57 * MiB;
constexpr size_t WS_P = 122 * MiB;
constexpr size_t WS_MIX = WS_P + (size_t)MROWS * NPROJ * 2;
constexpr size_t WS_U = WS_P;
constexpr size_t WS_END = WS_MIX + (size_t)MROWS * D * 2;
static_assert(WS_HB + (size_t)MROWS * D * 2 <= WS_P && WS_U + (size_t)MROWS * FF * 2 <= WS_END && WS_SS + (size_t)MROWS * 64 <= WS_GATES && WS_GATES + (size_t)MROWS * 64 <= WS_HB, "d_ws map");
constexpr int CW_BAR = 4096;

constexpr int RING_OFF = 0, RING_BYTES = 131072;
constexpr int LDSCTL_OFF = RING_BYTES, MISC_OFF = LDSCTL_OFF + 320;
constexpr int LDS_BYTES = 147456;

#define GAS __attribute__((address_space(1)))
#define LAS __attribute__((address_space(3)))
typedef unsigned short bf16;
typedef unsigned v4u __attribute__((ext_vector_type(4)));
typedef float f32x4 __attribute__((ext_vector_type(4)));
typedef GAS unsigned gu32;
#define RLX_AGENT __ATOMIC_RELAXED, __HIP_MEMORY_SCOPE_AGENT
#define LDS_WAIT() asm volatile("s_waitcnt lgkmcnt(0)" ::: "memory")
__device__ __forceinline__ unsigned f2bf(float f) { unsigned u = __builtin_bit_cast(unsigned, f); return (u + 0x7fffu + ((u >> 16) & 1u)) >> 16; }
__device__ __forceinline__ unsigned pk2(float lo, float hi) { return f2bf(lo) | (f2bf(hi) << 16); }
__device__ __forceinline__ float bf2f(unsigned short v) { return __builtin_bit_cast(float, (unsigned)v << 16); }
__device__ __forceinline__ float bflo(unsigned w) { return __builtin_bit_cast(float, w << 16); }
__device__ __forceinline__ float bfhi(unsigned w) { return __builtin_bit_cast(float, w & 0xffff0000u); }

#define XB_TMO      128
#define XB_XCNT(j)  (256  + 64 * (j))
#define XB_XSUB(j)  (1280 + 64 * (j))
#define XB_XGEN(j)  (2304 + 64 * (j))
#define XB_TOP      3328
#define XB_TOPGEN   3392
#define XCD_BAR_WORDS 3456
#define XB_SPIN_CAP (1u << 18)
__device__ __forceinline__ unsigned xb_ld(unsigned* p)              { return __hip_atomic_load(p, __ATOMIC_RELAXED, __HIP_MEMORY_SCOPE_AGENT); }
__device__ __forceinline__ unsigned xb_add(unsigned* p, unsigned v) { return __hip_atomic_fetch_add(p, v, __ATOMIC_RELAXED, __HIP_MEMORY_SCOPE_AGENT); }
__device__ __forceinline__ unsigned xb_xcc_id() { return (unsigned)__builtin_amdgcn_s_getreg((3 << 11) | 20) & 0xFu; }
#define XB_SPIN(cond, bar) do { unsigned _sp = 0; while (cond) { __builtin_amdgcn_s_sleep(1); \
    if ((++_sp & 255u) == 0u) { if (xb_ld(&(bar)[XB_TMO])) break; if (_sp > XB_SPIN_CAP) { atomicAdd(&(bar)[XB_TMO], 1u); break; } } } } while (0)
struct XcdBarrier { unsigned* bar; unsigned x; volatile LAS unsigned* st; };
__device__ __forceinline__ XcdBarrier xcd_barrier_post(unsigned* bar, volatile LAS unsigned* st) {
    XcdBarrier b; b.bar = bar; b.x = xb_xcc_id(); b.st = st;
    if (threadIdx.x == 0) (void)xb_add(&bar[XB_XCNT(b.x)], 1u);
    return b;
}
__device__ __forceinline__ void xcd_barrier_complete(unsigned* bar, unsigned x, unsigned& nloc, unsigned& nx) {
    const unsigned G = gridDim.x * gridDim.y * gridDim.z;
    unsigned sum, cnt, mine, sp = 0u;
    for (;;) {
        sum = 0u; cnt = 0u; mine = 0u;
#pragma unroll
        for (unsigned j = 0; j < 16; ++j) { const unsigned c = xb_ld(&bar[XB_XCNT(j)]); sum += c; cnt += (c > 0u) ? 1u : 0u; mine = (j == x) ? c : mine; }
        if (sum == G) break;
        __builtin_amdgcn_s_sleep(1);
        if ((++sp & 255u) == 0u) { if (xb_ld(&bar[XB_TMO])) break; if (sp > XB_SPIN_CAP) { atomicAdd(&bar[XB_TMO], 1u); break; } }
    }
    nloc = mine > 0u ? mine : 1u; nx = cnt > 0u ? cnt : 1u;
}
__device__ __forceinline__ void xcd_barrier(const XcdBarrier& b) {
    asm volatile("s_waitcnt vmcnt(0)" ::: "memory");
    __syncthreads();
    if (threadIdx.x == 0) {
        unsigned* bar = b.bar;
        __builtin_amdgcn_s_waitcnt(0);
        unsigned nloc = b.st[0], nx = b.st[1];
        if (nloc == 0u) { xcd_barrier_complete(bar, b.x, nloc, nx); b.st[0] = nloc; b.st[1] = nx; }
        const unsigned old = xb_add(&bar[XB_XSUB(b.x)], 1u);
        const unsigned gen = old / nloc;
        if (old + 1u == (gen + 1u) * nloc) {
            __builtin_amdgcn_fence(__ATOMIC_RELEASE, "agent");
            asm volatile("s_waitcnt vmcnt(0)" ::: "memory");
            const unsigned og = xb_add(&bar[XB_TOP], 1u);
            const unsigned tg = og / nx;
            if (og + 1u == (tg + 1u) * nx) xb_add(&bar[XB_TOPGEN], 1u);
            else XB_SPIN(xb_ld(&bar[XB_TOPGEN]) == tg, bar);
            __builtin_amdgcn_fence(__ATOMIC_ACQUIRE, "agent");
            xb_add(&bar[XB_XGEN(b.x)], 1u);
            asm volatile("s_waitcnt vmcnt(0)" ::: "memory");
        } else {
            XB_SPIN(xb_ld(&bar[XB_XGEN(b.x)]) == gen, bar);
            __builtin_amdgcn_fence(__ATOMIC_ACQUIRE, "agent");
            asm volatile("s_waitcnt vmcnt(0)" ::: "memory");
        }
    }
    __syncthreads();
}

struct Frame {
    LAS unsigned char* lds;
    volatile LAS unsigned* MISC;
    gu32* ctl;
    int tid, lane, wave, vcu, G;
    const float *x, *meta, *ngain, *m_win, *m_bgate, *m_hgain, *m_wout, *d_win, *d_lam, *d_hgain, *d_wout, *w_up, *w_dn, *fgain;
    float* out; unsigned char* ws;
    bf16 *WIN0, *WOUT0, *WUP0, *WDN0, *WIN1, *WOUT1, *WUP1, *WDN1, *HB, *P, *MIX, *U;
    float *WG, *HMETA, *SS, *GATES;
};
__device__ __forceinline__ float wave_sum(float v) {
#pragma unroll
    for (int o = 1; o < 64; o <<= 1) v += __shfl_xor(v, o);
    return v;
}
__device__ __forceinline__ void p0_transpose_item(const float* W, int K, int ldw, int Nuse, const float* gk, int nscale, bf16* WT, LAS float* scr, int item, int lane) {
    const int nblk = Nuse / 32, kb = item / nblk, nb = item % nblk, k0 = 64 * kb, n0 = 32 * nb;
    const float cs = (n0 < nscale) ? 0.125f : 1.f;
#pragma unroll 8
    for (int i = 0; i < 32; ++i) { const int kk = 2 * i + (lane >> 5); const float g = gk ? gk[k0 + kk] * cs : cs; scr[kk * 33 + (lane & 31)] = W[(size_t)(k0 + kk) * ldw + n0 + (lane & 31)] * g; }
    LDS_WAIT(); asm volatile("" ::: "memory");
    const int c = lane & 7;
#pragma unroll
    for (int j = 0; j < 4; ++j) { const int n = (lane >> 3) + 8 * j; const LAS float* s = scr + (8 * c) * 33 + n;
        v4u o; o.x = pk2(s[0 * 33], s[1 * 33]); o.y = pk2(s[2 * 33], s[3 * 33]); o.z = pk2(s[4 * 33], s[5 * 33]); o.w = pk2(s[6 * 33], s[7 * 33]);
        *(GAS v4u*)(WT + (size_t)(n0 + n) * K + k0 + 8 * c) = o; }
    LDS_WAIT(); asm volatile("" ::: "memory");
}
__device__ __forceinline__ void p0_prologue(Frame& F) {
    LAS float* scr = (LAS float*)(F.lds + RING_OFF + F.wave * 16384);
    const int gw = F.vcu * NWAVES + F.wave, NGW = F.G * NWAVES;
    constexpr int I_IN = (D / 64) * (NPROJ / 32), I_OUT = (D / 64) * (D / 32), I_UP = (D / 64) * (FF / 32), I_DN = (FF / 64) * (D / 32);
    constexpr int I_LAYER = I_IN + I_OUT + I_UP + I_DN, NITEMS = 2 * I_LAYER;
    for (int it = gw; it < NITEMS; it += NGW) {
        const int layer = it / I_LAYER; int r = it % I_LAYER;
        const float* g0 = F.ngain + (layer * 2 + 0) * D; const float* g1 = F.ngain + (layer * 2 + 1) * D;
        if (r < I_IN) { if (layer == 0) p0_transpose_item(F.m_win, D, 3088, NPROJ, g0, 512, F.WIN0, scr, r, F.lane); else p0_transpose_item(F.d_win, D, NPROJ, NPROJ, g0, 1024, F.WIN1, scr, r, F.lane); continue; } r -= I_IN;
        if (r < I_OUT) { p0_transpose_item(layer == 0 ? F.m_wout : F.d_wout, D, D, D, nullptr, 0, layer == 0 ? F.WOUT0 : F.WOUT1, scr, r, F.lane); continue; } r -= I_OUT;
        if (r < I_UP) { p0_transpose_item(F.w_up + (size_t)layer * D * FF, D, FF, FF, g1, 0, layer == 0 ? F.WUP0 : F.WUP1, scr, r, F.lane); continue; } r -= I_UP;
        p0_transpose_item(F.w_dn + (size_t)layer * FF * D, FF, D, D, nullptr, 0, layer == 0 ? F.WDN0 : F.WDN1, scr, r, F.lane);
    }
    __syncthreads();
    LAS float* wg = (LAS float*)(F.lds + RING_OFF);
    for (int i = F.tid; i < 16 * D; i += NWAVES * 64) { const int k = i >> 4, j = i & 15; wg[j * D + k] = F.m_win[(size_t)k * 3088 + NPROJ + j] * F.ngain[k]; }
    __syncthreads();
    for (int row = gw; row < MROWS; row += NGW) {
        const float* src = row < META_ROWS ? F.meta + (size_t)(row & 15) * D : F.x + (size_t)(row - META_ROWS) * D;
        float* dst = row < META_ROWS ? F.HMETA + (size_t)row * D : F.out + (size_t)(row - META_ROWS) * D;
        f32x4 v[4]; float s = 0.f;
#pragma unroll
        for (int j = 0; j < 4; ++j) { v[j] = ((const GAS f32x4*)src)[64 * j + F.lane]; s += (v[j].x * v[j].x + v[j].y * v[j].y) + (v[j].z * v[j].z + v[j].w * v[j].w); }
        s = wave_sum(s);
        const float rstd = 1.0f / sqrtf(s * (1.0f / D) + EPS);
#pragma unroll
        for (int j = 0; j < 4; ++j) { ((GAS f32x4*)dst)[64 * j + F.lane] = v[j];
            ((GAS unsigned long long*)(F.HB + (size_t)row * D))[64 * j + F.lane] = (unsigned long long)pk2(v[j].x, v[j].y) | ((unsigned long long)pk2(v[j].z, v[j].w) << 32); }
        if (F.lane == 0) F.SS[(size_t)row * 16] = s;
        float keep = 0.f;
#pragma unroll 4
        for (int g = 0; g < 16; ++g) { float p = 0.f;
#pragma unroll
            for (int j = 0; j < 4; ++j) { const f32x4 w = *(const LAS f32x4*)(wg + g * D + 256 * j + 4 * F.lane); p += (v[j].x * w.x + v[j].y * w.y) + (v[j].z * w.z + v[j].w * w.w); }
            p = wave_sum(p); if (F.lane == g) keep = p; }
        if (F.lane < 16) F.GATES[(size_t)row * 16 + F.lane] = keep * rstd + F.m_bgate[F.lane];
    }
}

__device__ __forceinline__ void mlstm_simple_phase(Frame& F) {
    LAS bf16* qs = (LAS bf16*)(F.lds);
    LAS bf16* ks = qs + 64 * 64;
    LAS bf16* vs = ks + 64 * 64;
    LAS bf16* os = vs + 64 * 128;
    LAS float* lfs = (LAS float*)(os + 64 * 128);
    LAS float* igs = lfs + 64;
    LAS float* red = igs + 64;
    LAS float* hbuf = red + 2 * 4 * 132;
    const int tid = F.tid, e = tid & 127, dq = tid >> 7;
    for (int unit = blockIdx.x; unit < NB * NH; unit += F.G) {
        const int b = unit >> 3, h = unit & 7;
        float C[16], nn[16]; float m = 0.f;
#pragma unroll
        for (int i = 0; i < 16; ++i) { C[i] = 0.f; nn[i] = 0.f; }
        for (int seg = 0; seg <= 32; ++seg) {
            const int nrows = seg == 0 ? 16 : 64; const int row0 = seg == 0 ? b * 16 : META_ROWS + b * SEQ + (seg - 1) * 64;
            __syncthreads();
            for (int i = tid; i < nrows * 8; i += 512) { const int r = i >> 3, c8 = i & 7; const bf16* src = F.P + (size_t)(row0 + r) * NPROJ + h * 64 + c8 * 8;
                *(LAS v4u*)(qs + r * 64 + c8 * 8) = *(const GAS v4u*)src; *(LAS v4u*)(ks + r * 64 + c8 * 8) = *(const GAS v4u*)(src + 512); }
            for (int i = tid; i < nrows * 16; i += 512) { const int r = i >> 4, c8 = i & 15; const bf16* src = F.P + (size_t)(row0 + r) * NPROJ + 1024 + h * 128 + c8 * 8;
                *(LAS v4u*)(vs + r * 128 + c8 * 8) = *(const GAS v4u*)src; *(LAS v4u*)(os + r * 128 + c8 * 8) = *(const GAS v4u*)(src + 1024); }
            if (tid < nrows) { const float ig = F.GATES[(size_t)(row0 + tid) * 16 + h], fg = F.GATES[(size_t)(row0 + tid) * 16 + 8 + h];
                lfs[tid] = fminf(fg, 0.f) - log1pf(expf(-fabsf(fg))); igs[tid] = ig; }
            __syncthreads();
            for (int s = 0; s < nrows; ++s) {
                const float lf = lfs[s], ig = igs[s]; const float mn = fmaxf(lf + m, ig); const float fdec = expf(lf + m - mn), iw = expf(ig - mn); m = mn;
                const float ve = bf2f(vs[s * 128 + e]); float pnum = 0.f, pden = 0.f;
#pragma unroll
                for (int dd = 0; dd < 16; ++dd) { const int d = dq * 16 + dd; const float kd = iw * bf2f(ks[s * 64 + d]), qd = bf2f(qs[s * 64 + d]);
                    C[dd] = fdec * C[dd] + kd * ve; nn[dd] = fdec * nn[dd] + kd; pnum += C[dd] * qd; pden += nn[dd] * qd; }
                LAS float* rb = red + (s & 1) * 4 * 132;
                rb[dq * 132 + e] = pnum; if (e == 0) rb[dq * 132 + 128] = pden;
                __syncthreads();
                if (dq == 0) { const float num = (rb[e] + rb[132 + e]) + (rb[264 + e] + rb[396 + e]); const float den = (rb[128] + rb[132 + 128]) + (rb[264 + 128] + rb[396 + 128]);
                    hbuf[s * 128 + e] = num / fmaxf(fabsf(den), expf(-m)); }
            }
            __syncthreads();
            for (int s = F.wave; s < nrows; s += NWAVES) {
                const float a0 = hbuf[s * 128 + F.lane], a1 = hbuf[s * 128 + 64 + F.lane];
                const float r = 1.0f / sqrtf(wave_sum(a0 * a0 + a1 * a1) * (1.0f / DV) + EPS);
                const float o0 = bf2f(os[s * 128 + F.lane]), o1 = bf2f(os[s * 128 + 64 + F.lane]);
                const float g0 = F.m_hgain[h * DV + F.lane], g1 = F.m_hgain[h * DV + 64 + F.lane];
                bf16* dst = F.MIX + (size_t)(row0 + s) * D + h * DV;
                dst[F.lane] = (bf16)f2bf(a0 * r * g0 / (1.0f + expf(-o0))); dst[64 + F.lane] = (bf16)f2bf(a1 * r * g1 / (1.0f + expf(-o1)));
            }
        }
    }
}

__device__ __forceinline__ void attn_simple_phase(Frame& F) {
    LAS bf16* Ks = (LAS bf16*)(F.lds);
    LAS bf16* Vs = Ks + 64 * 128;
    LAS float* ob = (LAS float*)(Vs + 64 * 128);
    LAS float* ssb = ob + 64 * 2 * 128;
    const int tid = F.tid, qi = tid & 63, comp = (tid >> 6) & 1, vq = tid >> 7;
    const float lambda_init = 0.8f - 0.6f * expf(-0.3f * 1.0f);
    float lam; { float s01 = 0.f, s23 = 0.f; for (int i = 0; i < 64; ++i) { s01 += F.d_lam[i] * F.d_lam[64 + i]; s23 += F.d_lam[128 + i] * F.d_lam[192 + i]; } lam = expf(s01) - expf(s23) + lambda_init; }
    for (int u = blockIdx.x; u < NB * NH * 33; u += F.G) {
        const int c = 32 - u / (NB * NH), bh = u % (NB * NH), b = bh >> 3, h = bh & 7;
        const int nq = c == 0 ? 16 : 64; const int qrow0 = c == 0 ? b * 16 : META_ROWS + b * SEQ + (c - 1) * 64;
        float q[64];
        { const bf16* qp = F.P + (size_t)(qrow0 + (qi < nq ? qi : 0)) * NPROJ + h * 128 + comp * 64;
#pragma unroll
          for (int i = 0; i < 8; ++i) { const v4u w = *(const GAS v4u*)(qp + 8 * i); q[8 * i] = bflo(w.x); q[8 * i + 1] = bfhi(w.x); q[8 * i + 2] = bflo(w.y); q[8 * i + 3] = bfhi(w.y); q[8 * i + 4] = bflo(w.z); q[8 * i + 5] = bfhi(w.z); q[8 * i + 6] = bflo(w.w); q[8 * i + 7] = bfhi(w.w); } }
        float acc[32]; float m = -INFINITY, l = 0.f;
#pragma unroll
        for (int i = 0; i < 32; ++i) acc[i] = 0.f;
        for (int t = 0; t <= c; ++t) {
            const int nk = t == 0 ? 16 : 64; const int krow0 = t == 0 ? b * 16 : META_ROWS + b * SEQ + (t - 1) * 64;
            __syncthreads();
            for (int i = tid; i < nk * 16; i += 512) { const int r = i >> 4, c8 = i & 15; const bf16* src = F.P + (size_t)(krow0 + r) * NPROJ + 1024 + h * 128 + c8 * 8;
                *(LAS v4u*)(Ks + r * 128 + c8 * 8) = *(const GAS v4u*)src; *(LAS v4u*)(Vs + r * 128 + c8 * 8) = *(const GAS v4u*)(src + 1024); }
            __syncthreads();
            for (int j = 0; j < nk; ++j) {
                const LAS v4u* kp = (const LAS v4u*)(Ks + j * 128 + comp * 64); float s = 0.f;
#pragma unroll
                for (int i = 0; i < 8; ++i) { const v4u w = kp[i]; s += q[8 * i] * bflo(w.x) + q[8 * i + 1] * bfhi(w.x) + q[8 * i + 2] * bflo(w.y) + q[8 * i + 3] * bfhi(w.y) + q[8 * i + 4] * bflo(w.z) + q[8 * i + 5] * bfhi(w.z) + q[8 * i + 6] * bflo(w.w) + q[8 * i + 7] * bfhi(w.w); }
                const float mn = fmaxf(m, s), sc = expf(m - mn), p = expf(s - mn); l = l * sc + p; m = mn;
                const LAS v4u* vp = (const LAS v4u*)(Vs + j * 128 + vq * 32);
#pragma unroll
                for (int i = 0; i < 4; ++i) { const v4u w = vp[i];
                    acc[8 * i] = acc[8 * i] * sc + p * bflo(w.x); acc[8 * i + 1] = acc[8 * i + 1] * sc + p * bfhi(w.x); acc[8 * i + 2] = acc[8 * i + 2] * sc + p * bflo(w.y); acc[8 * i + 3] = acc[8 * i + 3] * sc + p * bfhi(w.y);
                    acc[8 * i + 4] = acc[8 * i + 4] * sc + p * bflo(w.z); acc[8 * i + 5] = acc[8 * i + 5] * sc + p * bfhi(w.z); acc[8 * i + 6] = acc[8 * i + 6] * sc + p * bflo(w.w); acc[8 * i + 7] = acc[8 * i + 7] * sc + p * bfhi(w.w); }
            }
        }
        __syncthreads();
        { const float il = 1.0f / l;
#pragma unroll
          for (int i = 0; i < 32; ++i) ob[(qi * 2 + comp) * 128 + vq * 32 + i] = acc[i] * il; }
        __syncthreads();
        const int part = tid >> 6; float dvv[16]; float sq = 0.f;
#pragma unroll
        for (int i = 0; i < 16; ++i) { const int e = part * 16 + i; dvv[i] = ob[(qi * 2 + 0) * 128 + e] - lam * ob[(qi * 2 + 1) * 128 + e]; sq += dvv[i] * dvv[i]; }
        ssb[part * 64 + qi] = sq;
        __syncthreads();
        float tot = 0.f;
#pragma unroll
        for (int i = 0; i < 8; ++i) tot += ssb[i * 64 + qi];
        const float r = (1.0f - lambda_init) / sqrtf(tot * (1.0f / DV) + SUBLN_EPS);
        if (qi < nq) { bf16* dst = F.MIX + (size_t)(qrow0 + qi) * D + h * DV + part * 16; unsigned w[8];
#pragma unroll
            for (int i = 0; i < 8; ++i) w[i] = pk2(dvv[2 * i] * r * F.d_hgain[h * DV + part * 16 + 2 * i], dvv[2 * i + 1] * r * F.d_hgain[h * DV + part * 16 + 2 * i + 1]);
            *(GAS v4u*)dst = (v4u){w[0], w[1], w[2], w[3]}; *(GAS v4u*)(dst + 8) = (v4u){w[4], w[5], w[6], w[7]}; }
    }
}

__device__ __forceinline__ void final_norm_phase(Frame& F) {
    const int gw = F.vcu * NWAVES + F.wave, NGW = F.G * NWAVES;
    for (int row = META_ROWS + gw; row < MROWS; row += NGW) {
        const float rs = pg8::row_rstd<16>(F.SS, row, EPS);
        GAS f32x4* p = (GAS f32x4*)(F.out + (size_t)(row - META_ROWS) * D);
#pragma unroll
        for (int j = 0; j < 4; ++j) { f32x4 v = p[64 * j + F.lane]; const f32x4 g = ((const GAS f32x4*)F.fgain)[64 * j + F.lane]; v = v * rs * g; p[64 * j + F.lane] = v; }
    }
}
struct Args { const float* in[14]; float* out; unsigned char* ws; int ph_lo, ph_hi; };
__global__ void __launch_bounds__(NWAVES * 64, 2) fwd_kernel(Args args) {
    extern __shared__ __attribute__((aligned(16))) unsigned char lds[];
    Frame F;
    F.lds = (LAS unsigned char*)lds;
    F.MISC = (volatile LAS unsigned*)(F.lds + MISC_OFF);
    F.tid = threadIdx.x; F.lane = F.tid & 63; F.wave = __builtin_amdgcn_readfirstlane(F.tid >> 6);
    F.G = gridDim.x; { const int bx = blockIdx.x; F.vcu = (F.G % 8 == 0) ? (bx % 8) * (F.G / 8) + bx / 8 : bx; }
    unsigned char* ws = args.ws; F.ws = ws;
    F.ctl = (gu32*)(ws + WS_CTL);
    F.x = args.in[0]; F.meta = args.in[1]; F.ngain = args.in[2]; F.m_win = args.in[3]; F.m_bgate = args.in[4]; F.m_hgain = args.in[5]; F.m_wout = args.in[6];
    F.d_win = args.in[7]; F.d_lam = args.in[8]; F.d_hgain = args.in[9]; F.d_wout = args.in[10]; F.w_up = args.in[11]; F.w_dn = args.in[12]; F.fgain = args.in[13];
    F.out = args.out;
    F.WIN0 = (bf16*)(ws + WS_WIN0); F.WOUT0 = (bf16*)(ws + WS_WOUT0); F.WUP0 = (bf16*)(ws + WS_WUP0); F.WDN0 = (bf16*)(ws + WS_WDN0);
    F.WIN1 = (bf16*)(ws + WS_WIN1); F.WOUT1 = (bf16*)(ws + WS_WOUT1); F.WUP1 = (bf16*)(ws + WS_WUP1); F.WDN1 = (bf16*)(ws + WS_WDN1);
    F.HB = (bf16*)(ws + WS_HB); F.P = (bf16*)(ws + WS_P); F.MIX = (bf16*)(ws + WS_MIX); F.U = (bf16*)(ws + WS_U);
    F.WG = (float*)(ws + WS_WG); F.HMETA = (float*)(ws + WS_HMETA); F.SS = (float*)(ws + WS_SS); F.GATES = (float*)(ws + WS_GATES);
    for (int u = F.tid; u < (LDS_BYTES - LDSCTL_OFF) / 4; u += NWAVES * 64) ((LAS unsigned*)(F.lds + LDSCTL_OFF))[u] = 0u;
    __syncthreads();
    const int lo = args.ph_lo, hi = args.ph_hi;
    const bool use_bar = (hi - lo) > 1;
    XcdBarrier bar; bar.bar = (unsigned*)(F.ctl + CW_BAR); bar.x = 0; bar.st = nullptr;
    if (use_bar) bar = xcd_barrier_post((unsigned*)(F.ctl + CW_BAR), F.MISC + 8);
#define IN(k) (lo <= (k) && (k) < hi)
#define SEAM(k) do { if (IN(k) && IN((k) + 1)) xcd_barrier(bar); } while (0)
#define GEMM_PHASE(k, EPI, Aptr, Bptr, NN, KK, ...) if (IN(k)) { pg8::Gemm g{Aptr, Bptr, MROWS, NN, KK}; pg8::StaticOrder S; S.init(MROWS, NN, F.G, (int)blockIdx.x); \
        EPI E{__VA_ARGS__}; pg8::gemm_phase<EPI, pg8::StaticOrder, PG8_ALIGN, PG8_SP2>(F.lds + RING_OFF, g, S, E); SEAM(k); }
    typedef pg8::EpiScale<0, 1> EpiIn0; typedef pg8::EpiScale<0, 16> EpiIn1; typedef pg8::EpiScale<1, 16> EpiUp;
    if (IN(0)) { p0_prologue(F); SEAM(0); }
    GEMM_PHASE(1, EpiIn0, F.HB, F.WIN0, NPROJ, D, F.P, NPROJ, F.SS, EPS)
    if (IN(2)) { mlstm_simple_phase(F); SEAM(2); }
    GEMM_PHASE(3, pg8::EpiRes, F.MIX, F.WOUT0, D, D, F.HMETA, F.out, F.HB, F.SS)
    GEMM_PHASE(4, EpiUp, F.HB, F.WUP0, FF, D, F.U, FF, F.SS, EPS)
    GEMM_PHASE(5, pg8::EpiRes, F.U, F.WDN0, D, FF, F.HMETA, F.out, F.HB, F.SS)
    GEMM_PHASE(6, EpiIn1, F.HB, F.WIN1, NPROJ, D, F.P, NPROJ, F.SS, EPS)
    if (IN(7)) { attn_simple_phase(F); SEAM(7); }
    GEMM_PHASE(8, pg8::EpiRes, F.MIX, F.WOUT1, D, D, F.HMETA, F.out, F.HB, F.SS)
    GEMM_PHASE(9, EpiUp, F.HB, F.WUP1, FF, D, F.U, FF, F.SS, EPS)
    GEMM_PHASE(10, pg8::EpiRes, F.U, F.WDN1, D, FF, F.HMETA, F.out, (bf16*)nullptr, F.SS)
    if (IN(11)) { final_norm_phase(F); }
#undef IN
#undef SEAM
#undef GEMM_PHASE
}

extern "C" void kernel_launch(void* const* d_in, const int* in_sizes, int n_in, void* d_out, int out_size, void* d_ws, size_t ws_size, hipStream_t stream) {
    static int grid = 0;
    if (grid == 0) {
        if (n_in != 14 || in_sizes[0] != NB * SEQ * D || out_size != NB * SEQ * D || ws_size < WS_END) { fprintf(stderr, "kernel_launch: unexpected shapes (n_in %d, in0 %d, out %d, ws %zu)\n", n_in, n_in > 0 ? in_sizes[0] : -1, out_size, ws_size); grid = -1; return; }
        int dev = 0, cus = 0, per_cu = 0;
        if (hipGetDevice(&dev) != hipSuccess || hipDeviceGetAttribute(&cus, hipDeviceAttributeMultiprocessorCount, dev) != hipSuccess) { grid = -1; return; }
        if (hipFuncSetAttribute((const void*)fwd_kernel, hipFuncAttributeMaxDynamicSharedMemorySize, LDS_BYTES) != hipSuccess) { fprintf(stderr, "kernel_launch: hipFuncSetAttribute failed\n"); grid = -1; return; }
        if (hipOccupancyMaxActiveBlocksPerMultiprocessor(&per_cu, (const void*)fwd_kernel, NWAVES * 64, LDS_BYTES) != hipSuccess || per_cu < 1) { fprintf(stderr, "kernel_launch: occupancy query reports %d blocks per CU\n", per_cu); (void)hipGetLastError(); grid = -1; return; }
        grid = cus;
    }
    if (grid < 0) return;
    if (hipMemsetAsync((char*)d_ws + WS_CTL, 0, CTL_ZERO_BYTES, stream) != hipSuccess) return;
    Args a{};
    for (int i = 0; i < 14; ++i) a.in[i] = (const float*)d_in[i];
    a.out = (float*)d_out; a.ws = (unsigned char*)d_ws;
    if (MK_N_LAUNCHES == 1) { a.ph_lo = 0; a.ph_hi = NPHASE; hipLaunchKernelGGL(fwd_kernel, dim3(grid), dim3(NWAVES * 64), LDS_BYTES, stream, a); }
    else for (int p = 0; p < NPHASE; ++p) { a.ph_lo = p; a.ph_hi = p + 1; hipLaunchKernelGGL(fwd_kernel, dim3(grid), dim3(NWAVES * 64), LDS_BYTES, stream, a); }
}
```

```cpp
#include <hip/hip_runtime.h>
#include <cstdio>
#include <cstdint>
namespace pg8 {
#define PG8_LAS __attribute__((address_space(3)))
typedef unsigned short bf16_t;
typedef short bf16x8 __attribute__((ext_vector_type(8)));
typedef float f32x4 __attribute__((ext_vector_type(4)));
typedef unsigned u32x4 __attribute__((ext_vector_type(4)));
constexpr int BM = 256, BK = 64, HALF = 128, HTB = HALF * BK * 2  , STAGE_BYTES = 8 * HTB, NXCD = 8, WGM = 8;

__host__ __device__ __forceinline__ int lds_byte(int r, int c) { const int st = (r >> 4) * 2 + (c >> 5), rr = r & 15, cc = c & 31, ob = rr * 64 + cc * 2; return st * 1024 + (ob ^ (((ob >> 9) & 1) << 5)); }
__host__ __device__ __forceinline__ void stage_rc(int b, int& R, int& C) { const int st = b / 1024, sb = b % 1024, swz = sb ^ (((sb >> 9) & 1) << 5); R = (st >> 1) * 16 + swz / 64; C = (st & 1) * 32 + (swz % 64) / 2; }
__host__ __device__ __forceinline__ int perm32(int rho) { const int n = rho >> 4, i = rho & 15; return 8 * (i >> 2) + 4 * n + (i & 3); }

struct Unit { int pm, pn; };
struct Gemm { const bf16_t* A; const bf16_t* Bt; int M, N, K; };

struct StaticOrder {
    int nM, nN, nwg, G, c;
    __host__ __device__ void init(int M, int N, int G_, int c_) { nM = M / BM; nN = N / BM; nwg = nM * nN; G = G_; c = c_; }
    __host__ __device__ bool next(int i, Unit& u) const {
        const long L = (long)i * G + c; if (L >= nwg) return false;
        int wgid = (int)L; { const int q = nwg / NXCD, r = nwg % NXCD, xcd = wgid % NXCD, off = wgid / NXCD; wgid = (xcd < r ? xcd * (q + 1) : r * (q + 1) + (xcd - r) * q) + off; }
        const int nig = WGM * nN, gid = wgid / nig, fm = gid * WGM, gsz = (nM - fm) < WGM ? (nM - fm) : WGM;
        u.pm = fm + ((wgid % nig) % gsz); u.pn = (wgid % nig) / gsz; return true;
    }
    __device__ __forceinline__ void a_ready(const Unit&) const {}
    __device__ __forceinline__ void done(const Unit&) const {}
};

__device__ __forceinline__ unsigned cvt_pk_bf16(float lo, float hi) { unsigned r; asm volatile("v_cvt_pk_bf16_f32 %0, %1, %2" : "=v"(r) : "v"(lo), "v"(hi)); return r; }
typedef unsigned u32x2 __attribute__((ext_vector_type(2)));

template <int NS> __device__ __forceinline__ float row_rstd(const float* ss, int row, float eps) {
    const float* sp = ss + (size_t)row * 16; float s;
    if (NS == 1) s = sp[0];
    else { const f32x4 a = *(const f32x4*)sp, b = *(const f32x4*)(sp + 4), c = *(const f32x4*)(sp + 8), d = *(const f32x4*)(sp + 12);
           s = ((a[0] + a[1]) + (a[2] + a[3])) + ((b[0] + b[1]) + (b[2] + b[3])) + ((c[0] + c[1]) + (c[2] + c[3])) + ((d[0] + d[1]) + (d[2] + d[3])); }
    return __builtin_amdgcn_rsqf(s * (1.0f / 1024.0f) + eps);
}
template <int ACT, int NS> struct EpiScale {
    static constexpr bool PERM = true, AFTER_DRAIN = false;
    bf16_t* O; int ldc; const float* ss; float eps;
    __device__ __forceinline__ void operator()(const f32x4 (&acc)[2][2][4][2], const Unit& u, int wr, int wc, int fr, int fq) const {
        const int row0 = u.pm * BM + wr * 64 + fr, col0 = u.pn * BM + wc * 32 + 8 * fq;
#pragma unroll
        for (int ai = 0; ai < 2; ++ai)
#pragma unroll
            for (int m = 0; m < 4; ++m) { const int row = row0 + ai * HALF + m * 16; const float rs = row_rstd<NS>(ss, row, eps);
                bf16_t* rowp = O + (size_t)row * ldc + col0;
#pragma unroll
                for (int bj = 0; bj < 2; ++bj) { f32x4 v0 = acc[ai][bj][m][0] * rs, v1 = acc[ai][bj][m][1] * rs;
                    if (ACT == 1) {
#pragma unroll
                        for (int i = 0; i < 4; ++i) { const float a = fmaxf(v0[i], 0.f), b = fmaxf(v1[i], 0.f); v0[i] = a * a; v1[i] = b * b; } }
                    u32x4 w; w.x = cvt_pk_bf16(v0[0], v0[1]); w.y = cvt_pk_bf16(v0[2], v0[3]); w.z = cvt_pk_bf16(v1[0], v1[1]); w.w = cvt_pk_bf16(v1[2], v1[3]);
                    *(u32x4*)(rowp + bj * HALF) = w; } }
    }
};
struct EpiRes {
    static constexpr bool PERM = false, AFTER_DRAIN = false;
    float* Hm; float* Hr; bf16_t* HB; float* ss;
    __device__ __forceinline__ void operator()(const f32x4 (&acc)[2][2][4][2], const Unit& u, int wr, int wc, int fr, int fq) const {
        const int row0 = u.pm * BM + wr * 64 + fr, col0 = u.pn * BM + wc * 32 + 4 * fq;
#pragma unroll
        for (int ai = 0; ai < 2; ++ai)
#pragma unroll
            for (int m = 0; m < 4; ++m) { const int row = row0 + ai * HALF + m * 16;
                float* hp = (u.pm == 0 ? Hm + (size_t)row * 1024 : Hr + (size_t)(row - 256) * 1024) + col0; float q = 0.f;
#pragma unroll
                for (int bj = 0; bj < 2; ++bj)
#pragma unroll
                    for (int n = 0; n < 2; ++n) { const int off = bj * HALF + n * 16; const f32x4 hv = *(const f32x4*)(hp + off) + acc[ai][bj][m][n]; *(f32x4*)(hp + off) = hv;
                        q += (hv[0] * hv[0] + hv[1] * hv[1]) + (hv[2] * hv[2] + hv[3] * hv[3]);
                        if (HB) { u32x2 w; w.x = cvt_pk_bf16(hv[0], hv[1]); w.y = cvt_pk_bf16(hv[2], hv[3]); *(u32x2*)(HB + (size_t)row * 1024 + col0 + off) = w; } }
                q += __shfl_xor(q, 16); q += __shfl_xor(q, 32);
                if (fq == 0) ss[(size_t)row * 16 + u.pn * 4 + wc] = q; }
    }
};

template <class Epi, class Sched, bool ALIGN_EPI = false, bool SP2 = false>
__device__ __forceinline__ void gemm_phase(PG8_LAS unsigned char* lds, const Gemm g, const Sched& S, const Epi& E) {
    const int tid = threadIdx.x, wid = __builtin_amdgcn_readfirstlane(tid >> 6), lane = tid & 63, wr = wid >> 2, wc = wid & 3, fr = lane & 15, fq = lane >> 4;
    const int K = g.K, nt = K / BK;
    unsigned voffA[2], voffB[2];
#pragma unroll
    for (int i = 0; i < 2; ++i) { int R, C; stage_rc(tid * 16 + i * 8192, R, C); const int Rb = Epi::PERM ? ((R & ~31) + perm32(R & 31)) : R;
        voffA[i] = (unsigned)(R * K + C) * 2u; voffB[i] = (unsigned)(Rb * K + C) * 2u; }
    const size_t kstep = (size_t)(BK * 2);
    const size_t hstep = (size_t)HALF * K * 2;
    const size_t tstep = 2 * hstep;
    const unsigned ldsw = (unsigned)wid * 1024u;
    const int aoff = lds_byte(wr * 64 + fr, fq * 8), boff = lds_byte(wc * 32 + fr, fq * 8);
#define PG8_SA(b, h) (((b) * 2 + (h)) * HTB)
#define PG8_SB(b, h) ((4 + (b) * 2 + (h)) * HTB)
#define PG8_STAGE(bufoff, gbase, voff) do { _Pragma("unroll") for (int _i = 0; _i < 2; ++_i) \
        __builtin_amdgcn_global_load_lds((const unsigned*)((const char*)(gbase) + (voff)[_i]), (PG8_LAS unsigned*)(lds + (bufoff) + ldsw + _i * 8192), 16, 0, 0); } while (0)
#define PG8_LDA(dst, b, h) do { _Pragma("unroll") for (int m = 0; m < 4; ++m) _Pragma("unroll") for (int k = 0; k < 2; ++k) dst[m][k] = *(const PG8_LAS bf16x8*)(lds + PG8_SA(b, h) + aoff + m * 2048 + k * 1024); } while (0)
#define PG8_LDB(dst, b, h) do { _Pragma("unroll") for (int n = 0; n < 2; ++n) _Pragma("unroll") for (int k = 0; k < 2; ++k) dst[n][k] = *(const PG8_LAS bf16x8*)(lds + PG8_SB(b, h) + boff + n * 2048 + k * 1024); } while (0)
#define PG8_MMA(ai, bj, At, Bt) do { __builtin_amdgcn_s_setprio(1); _Pragma("unroll") for (int m = 0; m < 4; ++m) _Pragma("unroll") for (int n = 0; n < 2; ++n) _Pragma("unroll") for (int k = 0; k < 2; ++k) \
        acc[ai][bj][m][n] = __builtin_amdgcn_mfma_f32_16x16x32_bf16(Bt[n][k], At[m][k], acc[ai][bj][m][n], 0, 0, 0); __builtin_amdgcn_s_setprio(0); } while (0)
#define PG8_WAIT_V(n) asm volatile("s_waitcnt vmcnt(" #n ")" ::: "memory")
#define PG8_WAIT_L(n) asm volatile("s_waitcnt lgkmcnt(" #n ")" ::: "memory")
#define PG8_BAR __builtin_amdgcn_s_barrier()
#define PG8_SCHED __builtin_amdgcn_sched_barrier(0)
    Unit cur, nxt; int ui = 0;
    if (!S.next(0, cur)) return;
    f32x4 acc[2][2][4][2];
#pragma unroll
    for (int a = 0; a < 2; ++a)
#pragma unroll
        for (int b = 0; b < 2; ++b)
#pragma unroll
            for (int m = 0; m < 4; ++m)
#pragma unroll
                for (int n = 0; n < 2; ++n) acc[a][b][m][n] = (f32x4){0.f, 0.f, 0.f, 0.f};
    bf16x8 At[4][2], B0[2][2], B1[2][2];
    const char* cA = (const char*)g.A + (size_t)cur.pm * tstep; const char* cB = (const char*)g.Bt + (size_t)cur.pn * tstep;
    S.a_ready(cur);
    if constexpr (SP2) {
        PG8_STAGE(PG8_SB(0, 0), cB, voffB); PG8_STAGE(PG8_SB(0, 1), cB + hstep, voffB); PG8_STAGE(PG8_SA(0, 0), cA, voffA); PG8_STAGE(PG8_SA(0, 1), cA + hstep, voffA);
        if (wr == 1) PG8_BAR;
        PG8_WAIT_V(2); PG8_BAR;
        PG8_STAGE(PG8_SB(1, 0), cB + kstep, voffB); PG8_STAGE(PG8_SA(1, 0), cA + kstep, voffA); PG8_STAGE(PG8_SB(1, 1), cB + hstep + kstep, voffB);
        PG8_WAIT_V(6); PG8_BAR;
    } else {
        PG8_STAGE(PG8_SB(0, 0), cB, voffB); PG8_STAGE(PG8_SA(0, 0), cA, voffA); PG8_STAGE(PG8_SB(0, 1), cB + hstep, voffB); PG8_STAGE(PG8_SA(0, 1), cA + hstep, voffA);
        if (wr == 1) PG8_BAR;
        PG8_WAIT_V(4); PG8_BAR;
        PG8_STAGE(PG8_SB(1, 0), cB + kstep, voffB); PG8_STAGE(PG8_SA(1, 0), cA + kstep, voffA); PG8_STAGE(PG8_SB(1, 1), cB + hstep + kstep, voffB);
        PG8_WAIT_V(6); PG8_BAR;
    }
    for (;;) {
        const bool has_next = S.next(ui + 1, nxt);
        const char* nA = has_next ? (const char*)g.A + (size_t)nxt.pm * tstep : cA; const char* nB = has_next ? (const char*)g.Bt + (size_t)nxt.pn * tstep : cB;
        for (int t = 0; t < nt; t += 2) {
            const bool last = (t == nt - 2);
            const char* a1 = cA + (size_t)(t + 1) * kstep;
            const char* a2 = last ? nA : cA + (size_t)(t + 2) * kstep; const char* b2 = last ? nB : cB + (size_t)(t + 2) * kstep;
            const char* a3 = a2 + kstep; const char* b3 = b2 + kstep;
            if (last && has_next) S.a_ready(nxt);
            if constexpr (SP2) {
            PG8_LDB(B0, 0, 0); PG8_LDB(B1, 0, 1); PG8_SCHED; PG8_LDA(At, 0, 0); PG8_STAGE(PG8_SA(1, 1), a1 + hstep, voffA);
            PG8_WAIT_V(8); PG8_WAIT_L(0); PG8_BAR; PG8_MMA(0, 0, At, B0); PG8_MMA(0, 1, At, B1); PG8_BAR; PG8_SCHED;
            PG8_LDA(At, 0, 1); PG8_STAGE(PG8_SB(0, 0), b2, voffB); PG8_STAGE(PG8_SB(0, 1), b2 + hstep, voffB); PG8_STAGE(PG8_SA(0, 0), a2, voffA);
            PG8_WAIT_V(8); PG8_WAIT_L(0); PG8_BAR; PG8_MMA(1, 0, At, B0); PG8_MMA(1, 1, At, B1); PG8_BAR; PG8_SCHED;
            PG8_LDB(B0, 1, 0); PG8_LDB(B1, 1, 1); PG8_SCHED; PG8_LDA(At, 1, 0); PG8_STAGE(PG8_SA(0, 1), a2 + hstep, voffA);
            PG8_WAIT_V(8); PG8_WAIT_L(0); PG8_BAR; PG8_MMA(0, 0, At, B0); PG8_MMA(0, 1, At, B1); PG8_BAR; PG8_SCHED;
            PG8_LDA(At, 1, 1); PG8_STAGE(PG8_SB(1, 0), b3, voffB); PG8_STAGE(PG8_SB(1, 1), b3 + hstep, voffB); PG8_STAGE(PG8_SA(1, 0), a3, voffA);
            PG8_WAIT_V(8); PG8_WAIT_L(0); PG8_BAR; PG8_MMA(1, 0, At, B0); PG8_MMA(1, 1, At, B1); PG8_BAR; PG8_SCHED;
            } else {
            PG8_LDB(B0, 0, 0); PG8_SCHED; PG8_LDA(At, 0, 0); PG8_STAGE(PG8_SA(1, 1), a1 + hstep, voffA);
            PG8_WAIT_L(8); PG8_BAR; PG8_WAIT_L(0); PG8_MMA(0, 0, At, B0); PG8_BAR; PG8_SCHED;
            PG8_LDB(B1, 0, 1); PG8_STAGE(PG8_SB(0, 0), b2, voffB);
            PG8_BAR; PG8_WAIT_L(0); PG8_MMA(0, 1, At, B1); PG8_BAR;
            PG8_LDA(At, 0, 1); PG8_STAGE(PG8_SA(0, 0), a2, voffA);
            PG8_BAR; PG8_WAIT_L(0); PG8_MMA(1, 0, At, B0); PG8_BAR; PG8_SCHED;
            PG8_STAGE(PG8_SB(0, 1), b2 + hstep, voffB);
            PG8_WAIT_V(6); PG8_BAR; PG8_MMA(1, 1, At, B1); PG8_BAR;
            PG8_LDB(B0, 1, 0); PG8_SCHED; PG8_LDA(At, 1, 0); PG8_STAGE(PG8_SA(0, 1), a2 + hstep, voffA);
            PG8_WAIT_L(8); PG8_BAR; PG8_WAIT_L(0); PG8_MMA(0, 0, At, B0); PG8_BAR; PG8_SCHED;
            PG8_LDB(B1, 1, 1); PG8_STAGE(PG8_SB(1, 0), b3, voffB);
            PG8_BAR; PG8_WAIT_L(0); PG8_MMA(0, 1, At, B1); PG8_BAR;
            PG8_LDA(At, 1, 1); PG8_STAGE(PG8_SA(1, 0), a3, voffA);
            PG8_BAR; PG8_WAIT_L(0); PG8_MMA(1, 0, At, B0); PG8_BAR; PG8_SCHED;
            PG8_STAGE(PG8_SB(1, 1), b3 + hstep, voffB);
            PG8_WAIT_V(6); PG8_BAR; PG8_MMA(1, 1, At, B1); PG8_BAR;
            }
        }
        if constexpr (ALIGN_EPI) { if (wr == 0) PG8_BAR; }
        if constexpr (!Epi::AFTER_DRAIN) { E(acc, cur, wr, wc, fr, fq); S.done(cur); }
        if (!has_next) break;
#pragma unroll
        for (int a = 0; a < 2; ++a)
#pragma unroll
            for (int b = 0; b < 2; ++b)
#pragma unroll
                for (int m = 0; m < 4; ++m)
#pragma unroll
                    for (int n = 0; n < 2; ++n) acc[a][b][m][n] = (f32x4){0.f, 0.f, 0.f, 0.f};
        cur = nxt; cA = nA; cB = nB; ++ui;
        if constexpr (ALIGN_EPI) { if (wr == 1) PG8_BAR; }
    }
    PG8_WAIT_V(0);
    if constexpr (!ALIGN_EPI) { if (wr == 0) PG8_BAR; }
    PG8_BAR;
    if constexpr (Epi::AFTER_DRAIN) { E.fused(acc, cur, wr, wc, fr, fq, lds, wid, lane); S.done(cur); }
#undef PG8_SA
#undef PG8_SB
#undef PG8_STAGE
#undef PG8_LDA
#undef PG8_LDB
#undef PG8_MMA
#undef PG8_WAIT_V
#undef PG8_WAIT_L
#undef PG8_BAR
#undef PG8_SCHED
}
}

#ifndef PG8_SP2
#define PG8_SP2 true
#endif
#ifndef PG8_ALIGN
#define PG8_ALIGN true
#endif
constexpr int NB = 16, SEQ = 2048, NMETA = 16, D = 1024, FF = 4096;
constexpr int MROWS = NB * (SEQ + NMETA);
constexpr int META_ROWS = NB * NMETA;
constexpr int NH = 8, DQK = 64, DV = 128;
constexpr int NPROJ = 3072;
constexpr float EPS = 1e-6f, SUBLN_EPS = 1e-5f;
constexpr int NWAVES = 8;
#ifndef MK_N_LAUNCHES
#define MK_N_LAUNCHES 1
#endif
constexpr int NPHASE = 12;

constexpr size_t MiB = 1u << 20;
constexpr size_t WS_CTL = 0, CTL_ZERO_BYTES = 1 * MiB;
constexpr size_t WS_WIN0 = 1 * MiB, WS_WOUT0 = 7 * MiB, WS_WUP0 = 9 * MiB, WS_WDN0 = 17 * MiB;
constexpr size_t WS_WIN1 = 25 * MiB, WS_WOUT1 = 31 * MiB, WS_WUP1 = 33 * MiB, WS_WDN1 = 41 * MiB;
constexpr size_t WS_WG = 49 * MiB;
constexpr size_t WS_HMETA = 50 * MiB;
constexpr size_t WS_SS = 51 * MiB;
constexpr size_t WS_GATES = 54 * MiB;
constexpr size_t WS_HB = 57 * MiB;
constexpr size_t WS_P = 122 * MiB;
constexpr size_t WS_MIX = WS_P + (size_t)MROWS * NPROJ * 2;
constexpr size_t WS_U = WS_P;
constexpr size_t WS_END = WS_MIX + (size_t)MROWS * D * 2;
static_assert(WS_HB + (size_t)MROWS * D * 2 <= WS_P && WS_U + (size_t)MROWS * FF * 2 <= WS_END && WS_SS + (size_t)MROWS * 64 <= WS_GATES && WS_GATES + (size_t)MROWS * 64 <= WS_HB, "d_ws map");
constexpr int CW_BAR = 4096;

constexpr int RING_OFF = 0, RING_BYTES = 131072;
constexpr int LDSCTL_OFF = RING_BYTES, MISC_OFF = LDSCTL_OFF + 320;
constexpr int LDS_BYTES = 147456;

#define GAS __attribute__((address_space(1)))
#define LAS __attribute__((address_space(3)))
typedef unsigned short bf16;
typedef unsigned v4u __attribute__((ext_vector_type(4)));
typedef float f32x4 __attribute__((ext_vector_type(4)));
typedef GAS unsigned gu32;
#define RLX_AGENT __ATOMIC_RELAXED, __HIP_MEMORY_SCOPE_AGENT
#define LDS_WAIT() asm volatile("s_waitcnt lgkmcnt(0)" ::: "memory")
__device__ __forceinline__ unsigned f2bf(float f) { unsigned u = __builtin_bit_cast(unsigned, f); return (u + 0x7fffu + ((u >> 16) & 1u)) >> 16; }
__device__ __forceinline__ unsigned pk2(float lo, float hi) { return f2bf(lo) | (f2bf(hi) << 16); }
__device__ __forceinline__ float bf2f(unsigned short v) { return __builtin_bit_cast(float, (unsigned)v << 16); }
__device__ __forceinline__ float bflo(unsigned w) { return __builtin_bit_cast(float, w << 16); }
__device__ __forceinline__ float bfhi(unsigned w) { return __builtin_bit_cast(float, w & 0xffff0000u); }

#define XB_TMO      128
#define XB_XCNT(j)  (256  + 64 * (j))
#define XB_XSUB(j)  (1280 + 64 * (j))
#define XB_XGEN(j)  (2304 + 64 * (j))
#define XB_TOP      3328
#define XB_TOPGEN   3392
#define XCD_BAR_WORDS 3456
#define XB_SPIN_CAP (1u << 18)
__device__ __forceinline__ unsigned xb_ld(unsigned* p)              { return __hip_atomic_load(p, __ATOMIC_RELAXED, __HIP_MEMORY_SCOPE_AGENT); }
__device__ __forceinline__ unsigned xb_add(unsigned* p, unsigned v) { return __hip_atomic_fetch_add(p, v, __ATOMIC_RELAXED, __HIP_MEMORY_SCOPE_AGENT); }
__device__ __forceinline__ unsigned xb_xcc_id() { return (unsigned)__builtin_amdgcn_s_getreg((3 << 11) | 20) & 0xFu; }
#define XB_SPIN(cond, bar) do { unsigned _sp = 0; while (cond) { __builtin_amdgcn_s_sleep(1); \
    if ((++_sp & 255u) == 0u) { if (xb_ld(&(bar)[XB_TMO])) break; if (_sp > XB_SPIN_CAP) { atomicAdd(&(bar)[XB_TMO], 1u); break; } } } } while (0)
struct XcdBarrier { unsigned* bar; unsigned x; volatile LAS unsigned* st; };
__device__ __forceinline__ XcdBarrier xcd_barrier_post(unsigned* bar, volatile LAS unsigned* st) {
    XcdBarrier b; b.bar = bar; b.x = xb_xcc_id(); b.st = st;
    if (threadIdx.x == 0) (void)xb_add(&bar[XB_XCNT(b.x)], 1u);
    return b;
}
__device__ __forceinline__ void xcd_barrier_complete(unsigned* bar, unsigned x, unsigned& nloc, unsigned& nx) {
    const unsigned G = gridDim.x * gridDim.y * gridDim.z;
    unsigned sum, cnt, mine, sp = 0u;
    for (;;) {
        sum = 0u; cnt = 0u; mine = 0u;
#pragma unroll
        for (unsigned j = 0; j < 16; ++j) { const unsigned c = xb_ld(&bar[XB_XCNT(j)]); sum += c; cnt += (c > 0u) ? 1u : 0u; mine = (j == x) ? c : mine; }
        if (sum == G) break;
        __builtin_amdgcn_s_sleep(1);
        if ((++sp & 255u) == 0u) { if (xb_ld(&bar[XB_TMO])) break; if (sp > XB_SPIN_CAP) { atomicAdd(&bar[XB_TMO], 1u); break; } }
    }
    nloc = mine > 0u ? mine : 1u; nx = cnt > 0u ? cnt : 1u;
}
__device__ __forceinline__ void xcd_barrier(const XcdBarrier& b) {
    asm volatile("s_waitcnt vmcnt(0)" ::: "memory");
    __syncthreads();
    if (threadIdx.x == 0) {
        unsigned* bar = b.bar;
        __builtin_amdgcn_s_waitcnt(0);
        unsigned nloc = b.st[0], nx = b.st[1];
        if (nloc == 0u) { xcd_barrier_complete(bar, b.x, nloc, nx); b.st[0] = nloc; b.st[1] = nx; }
        const unsigned old = xb_add(&bar[XB_XSUB(b.x)], 1u);
        const unsigned gen = old / nloc;
        if (old + 1u == (gen + 1u) * nloc) {
            __builtin_amdgcn_fence(__ATOMIC_RELEASE, "agent");
            asm volatile("s_waitcnt vmcnt(0)" ::: "memory");
            const unsigned og = xb_add(&bar[XB_TOP], 1u);
            const unsigned tg = og / nx;
            if (og + 1u == (tg + 1u) * nx) xb_add(&bar[XB_TOPGEN], 1u);
            else XB_SPIN(xb_ld(&bar[XB_TOPGEN]) == tg, bar);
            __builtin_amdgcn_fence(__ATOMIC_ACQUIRE, "agent");
            xb_add(&bar[XB_XGEN(b.x)], 1u);
            asm volatile("s_waitcnt vmcnt(0)" ::: "memory");
        } else {
            XB_SPIN(xb_ld(&bar[XB_XGEN(b.x)]) == gen, bar);
            __builtin_amdgcn_fence(__ATOMIC_ACQUIRE, "agent");
            asm volatile("s_waitcnt vmcnt(0)" ::: "memory");
        }
    }
    __syncthreads();
}

struct Frame {
    LAS unsigned char* lds;
    volatile LAS unsigned* MISC;
    gu32* ctl;
    int tid, lane, wave, vcu, G;
    const float *x, *meta, *ngain, *m_win, *m_bgate, *m_hgain, *m_wout, *d_win, *d_lam, *d_hgain, *d_wout, *w_up, *w_dn, *fgain;
    float* out; unsigned char* ws;
    bf16 *WIN0, *WOUT0, *WUP0, *WDN0, *WIN1, *WOUT1, *WUP1, *WDN1, *HB, *P, *MIX, *U;
    float *WG, *HMETA, *SS, *GATES;
};
__device__ __forceinline__ float wave_sum(float v) {
#pragma unroll
    for (int o = 1; o < 64; o <<= 1) v += __shfl_xor(v, o);
    return v;
}
__device__ __forceinline__ void p0_transpose_item(const float* W, int K, int ldw, int Nuse, const float* gk, int nscale, bf16* WT, LAS float* scr, int item, int lane) {
    const int nblk = Nuse / 32, kb = item / nblk, nb = item % nblk, k0 = 64 * kb, n0 = 32 * nb;
    const float cs = (n0 < nscale) ? 0.125f : 1.f;
#pragma unroll 8
    for (int i = 0; i < 32; ++i) { const int kk = 2 * i + (lane >> 5); const float g = gk ? gk[k0 + kk] * cs : cs; scr[kk * 33 + (lane & 31)] = W[(size_t)(k0 + kk) * ldw + n0 + (lane & 31)] * g; }
    LDS_WAIT(); asm volatile("" ::: "memory");
    const int c = lane & 7;
#pragma unroll
    for (int j = 0; j < 4; ++j) { const int n = (lane >> 3) + 8 * j; const LAS float* s = scr + (8 * c) * 33 + n;
        v4u o; o.x = pk2(s[0 * 33], s[1 * 33]); o.y = pk2(s[2 * 33], s[3 * 33]); o.z = pk2(s[4 * 33], s[5 * 33]); o.w = pk2(s[6 * 33], s[7 * 33]);
        *(GAS v4u*)(WT + (size_t)(n0 + n) * K + k0 + 8 * c) = o; }
    LDS_WAIT(); asm volatile("" ::: "memory");
}
__device__ __forceinline__ void p0_prologue(Frame& F) {
    LAS float* scr = (LAS float*)(F.lds + RING_OFF + F.wave * 16384);
    const int gw = F.vcu * NWAVES + F.wave, NGW = F.G * NWAVES;
    constexpr int I_IN = (D / 64) * (NPROJ / 32), I_OUT = (D / 64) * (D / 32), I_UP = (D / 64) * (FF / 32), I_DN = (FF / 64) * (D / 32);
    constexpr int I_LAYER = I_IN + I_OUT + I_UP + I_DN, NITEMS = 2 * I_LAYER;
    for (int it = gw; it < NITEMS; it += NGW) {
        const int layer = it / I_LAYER; int r = it % I_LAYER;
        const float* g0 = F.ngain + (layer * 2 + 0) * D; const float* g1 = F.ngain + (layer * 2 + 1) * D;
        if (r < I_IN) { if (layer == 0) p0_transpose_item(F.m_win, D, 3088, NPROJ, g0, 512, F.WIN0, scr, r, F.lane); else p0_transpose_item(F.d_win, D, NPROJ, NPROJ, g0, 1024, F.WIN1, scr, r, F.lane); continue; } r -= I_IN;
        if (r < I_OUT) { p0_transpose_item(layer == 0 ? F.m_wout : F.d_wout, D, D, D, nullptr, 0, layer == 0 ? F.WOUT0 : F.WOUT1, scr, r, F.lane); continue; } r -= I_OUT;
        if (r < I_UP) { p0_transpose_item(F.w_up + (size_t)layer * D * FF, D, FF, FF, g1, 0, layer == 0 ? F.WUP0 : F.WUP1, scr, r, F.lane); continue; } r -= I_UP;
        p0_transpose_item(F.w_dn + (size_t)layer * FF * D, FF, D, D, nullptr, 0, layer == 0 ? F.WDN0 : F.WDN1, scr, r, F.lane);
    }
    __syncthreads();
    LAS float* wg = (LAS float*)(F.lds + RING_OFF);
    for (int i = F.tid; i < 16 * D; i += NWAVES * 64) { const int k = i >> 4, j = i & 15; wg[j * D + k] = F.m_win[(size_t)k * 3088 + NPROJ + j] * F.ngain[k]; }
    __syncthreads();
    for (int row = gw; row < MROWS; row += NGW) {
        const float* src = row < META_ROWS ? F.meta + (size_t)(row & 15) * D : F.x + (size_t)(row - META_ROWS) * D;
        float* dst = row < META_ROWS ? F.HMETA + (size_t)row * D : F.out + (size_t)(row - META_ROWS) * D;
        f32x4 v[4]; float s = 0.f;
#pragma unroll
        for (int j = 0; j < 4; ++j) { v[j] = ((const GAS f32x4*)src)[64 * j + F.lane]; s += (v[j].x * v[j].x + v[j].y * v[j].y) + (v[j].z * v[j].z + v[j].w * v[j].w); }
        s = wave_sum(s);
        const float rstd = 1.0f / sqrtf(s * (1.0f / D) + EPS);
#pragma unroll
        for (int j = 0; j < 4; ++j) { ((GAS f32x4*)dst)[64 * j + F.lane] = v[j];
            ((GAS unsigned long long*)(F.HB + (size_t)row * D))[64 * j + F.lane] = (unsigned long long)pk2(v[j].x, v[j].y) | ((unsigned long long)pk2(v[j].z, v[j].w) << 32); }
        if (F.lane == 0) F.SS[(size_t)row * 16] = s;
        float keep = 0.f;
#pragma unroll 4
        for (int g = 0; g < 16; ++g) { float p = 0.f;
#pragma unroll
            for (int j = 0; j < 4; ++j) { const f32x4 w = *(const LAS f32x4*)(wg + g * D + 256 * j + 4 * F.lane); p += (v[j].x * w.x + v[j].y * w.y) + (v[j].z * w.z + v[j].w * w.w); }
            p = wave_sum(p); if (F.lane == g) keep = p; }
        if (F.lane < 16) F.GATES[(size_t)row * 16 + F.lane] = keep * rstd + F.m_bgate[F.lane];
    }
}

__device__ __forceinline__ void mlstm_simple_phase(Frame& F) {
    LAS bf16* qs = (LAS bf16*)(F.lds);
    LAS bf16* ks = qs + 64 * 64;
    LAS bf16* vs = ks + 64 * 64;
    LAS bf16* os = vs + 64 * 128;
    LAS float* lfs = (LAS float*)(os + 64 * 128);
    LAS float* igs = lfs + 64;
    LAS float* red = igs + 64;
    LAS float* hbuf = red + 2 * 4 * 132;
    const int tid = F.tid, e = tid & 127, dq = tid >> 7;
    for (int unit = blockIdx.x; unit < NB * NH; unit += F.G) {
        const int b = unit >> 3, h = unit & 7;
        float C[16], nn[16]; float m = 0.f;
#pragma unroll
        for (int i = 0; i < 16; ++i) { C[i] = 0.f; nn[i] = 0.f; }
        for (int seg = 0; seg <= 32; ++seg) {
            const int nrows = seg == 0 ? 16 : 64; const int row0 = seg == 0 ? b * 16 : META_ROWS + b * SEQ + (seg - 1) * 64;
            __syncthreads();
            for (int i = tid; i < nrows * 8; i += 512) { const int r = i >> 3, c8 = i & 7; const bf16* src = F.P + (size_t)(row0 + r) * NPROJ + h * 64 + c8 * 8;
                *(LAS v4u*)(qs + r * 64 + c8 * 8) = *(const GAS v4u*)src; *(LAS v4u*)(ks + r * 64 + c8 * 8) = *(const GAS v4u*)(src + 512); }
            for (int i = tid; i < nrows * 16; i += 512) { const int r = i >> 4, c8 = i & 15; const bf16* src = F.P + (size_t)(row0 + r) * NPROJ + 1024 + h * 128 + c8 * 8;
                *(LAS v4u*)(vs + r * 128 + c8 * 8) = *(const GAS v4u*)src; *(LAS v4u*)(os + r * 128 + c8 * 8) = *(const GAS v4u*)(src + 1024); }
            if (tid < nrows) { const float ig = F.GATES[(size_t)(row0 + tid) * 16 + h], fg = F.GATES[(size_t)(row0 + tid) * 16 + 8 + h];
                lfs[tid] = fminf(fg, 0.f) - log1pf(expf(-fabsf(fg))); igs[tid] = ig; }
            __syncthreads();
            for (int s = 0; s < nrows; ++s) {
                const float lf = lfs[s], ig = igs[s]; const float mn = fmaxf(lf + m, ig); const float fdec = expf(lf + m - mn), iw = expf(ig - mn); m = mn;
                const float ve = bf2f(vs[s * 128 + e]); float pnum = 0.f, pden = 0.f;
#pragma unroll
                for (int dd = 0; dd < 16; ++dd) { const int d = dq * 16 + dd; const float kd = iw * bf2f(ks[s * 64 + d]), qd = bf2f(qs[s * 64 + d]);
                    C[dd] = fdec * C[dd] + kd * ve; nn[dd] = fdec * nn[dd] + kd; pnum += C[dd] * qd; pden += nn[dd] * qd; }
                LAS float* rb = red + (s & 1) * 4 * 132;
                rb[dq * 132 + e] = pnum; if (e == 0) rb[dq * 132 + 128] = pden;
                __syncthreads();
                if (dq == 0) { const float num = (rb[e] + rb[132 + e]) + (rb[264 + e] + rb[396 + e]); const float den = (rb[128] + rb[132 + 128]) + (rb[264 + 128] + rb[396 + 128]);
                    hbuf[s * 128 + e] = num / fmaxf(fabsf(den), expf(-m)); }
            }
            __syncthreads();
            for (int s = F.wave; s < nrows; s += NWAVES) {
                const float a0 = hbuf[s * 128 + F.lane], a1 = hbuf[s * 128 + 64 + F.lane];
                const float r = 1.0f / sqrtf(wave_sum(a0 * a0 + a1 * a1) * (1.0f / DV) + EPS);
                const float o0 = bf2f(os[s * 128 + F.lane]), o1 = bf2f(os[s * 128 + 64 + F.lane]);
                const float g0 = F.m_hgain[h * DV + F.lane], g1 = F.m_hgain[h * DV + 64 + F.lane];
                bf16* dst = F.MIX + (size_t)(row0 + s) * D + h * DV;
                dst[F.lane] = (bf16)f2bf(a0 * r * g0 / (1.0f + expf(-o0))); dst[64 + F.lane] = (bf16)f2bf(a1 * r * g1 / (1.0f + expf(-o1)));
            }
        }
    }
}

__device__ __forceinline__ void attn_simple_phase(Frame& F) {
    LAS bf16* Ks = (LAS bf16*)(F.lds);
    LAS bf16* Vs = Ks + 64 * 128;
    LAS float* ob = (LAS float*)(Vs + 64 * 128);
    LAS float* ssb = ob + 64 * 2 * 128;
    const int tid = F.tid, qi = tid & 63, comp = (tid >> 6) & 1, vq = tid >> 7;
    const float lambda_init = 0.8f - 0.6f * expf(-0.3f * 1.0f);
    float lam; { float s01 = 0.f, s23 = 0.f; for (int i = 0; i < 64; ++i) { s01 += F.d_lam[i] * F.d_lam[64 + i]; s23 += F.d_lam[128 + i] * F.d_lam[192 + i]; } lam = expf(s01) - expf(s23) + lambda_init; }
    for (int u = blockIdx.x; u < NB * NH * 33; u += F.G) {
        const int c = 32 - u / (NB * NH), bh = u % (NB * NH), b = bh >> 3, h = bh & 7;
        const int nq = c == 0 ? 16 : 64; const int qrow0 = c == 0 ? b * 16 : META_ROWS + b * SEQ + (c - 1) * 64;
        float q[64];
        { const bf16* qp = F.P + (size_t)(qrow0 + (qi < nq ? qi : 0)) * NPROJ + h * 128 + comp * 64;
#pragma unroll
          for (int i = 0; i < 8; ++i) { const v4u w = *(const GAS v4u*)(qp + 8 * i); q[8 * i] = bflo(w.x); q[8 * i + 1] = bfhi(w.x); q[8 * i + 2] = bflo(w.y); q[8 * i + 3] = bfhi(w.y); q[8 * i + 4] = bflo(w.z); q[8 * i + 5] = bfhi(w.z); q[8 * i + 6] = bflo(w.w); q[8 * i + 7] = bfhi(w.w); } }
        float acc[32]; float m = -INFINITY, l = 0.f;
#pragma unroll
        for (int i = 0; i < 32; ++i) acc[i] = 0.f;
        for (int t = 0; t <= c; ++t) {
            const int nk = t == 0 ? 16 : 64; const int krow0 = t == 0 ? b * 16 : META_ROWS + b * SEQ + (t - 1) * 64;
            __syncthreads();
            for (int i = tid; i < nk * 16; i += 512) { const int r = i >> 4, c8 = i & 15; const bf16* src = F.P + (size_t)(krow0 + r) * NPROJ + 1024 + h * 128 + c8 * 8;
                *(LAS v4u*)(Ks + r * 128 + c8 * 8) = *(const GAS v4u*)src; *(LAS v4u*)(Vs + r * 128 + c8 * 8) = *(const GAS v4u*)(src + 1024); }
            __syncthreads();
            for (int j = 0; j < nk; ++j) {
                const LAS v4u* kp = (const LAS v4u*)(Ks + j * 128 + comp * 64); float s = 0.f;
#pragma unroll
                for (int i = 0; i < 8; ++i) { const v4u w = kp[i]; s += q[8 * i] * bflo(w.x) + q[8 * i + 1] * bfhi(w.x) + q[8 * i + 2] * bflo(w.y) + q[8 * i + 3] * bfhi(w.y) + q[8 * i + 4] * bflo(w.z) + q[8 * i + 5] * bfhi(w.z) + q[8 * i + 6] * bflo(w.w) + q[8 * i + 7] * bfhi(w.w); }
                const float mn = fmaxf(m, s), sc = expf(m - mn), p = expf(s - mn); l = l * sc + p; m = mn;
                const LAS v4u* vp = (const LAS v4u*)(Vs + j * 128 + vq * 32);
#pragma unroll
                for (int i = 0; i < 4; ++i) { const v4u w = vp[i];
                    acc[8 * i] = acc[8 * i] * sc + p * bflo(w.x); acc[8 * i + 1] = acc[8 * i + 1] * sc + p * bfhi(w.x); acc[8 * i + 2] = acc[8 * i + 2] * sc + p * bflo(w.y); acc[8 * i + 3] = acc[8 * i + 3] * sc + p * bfhi(w.y);
                    acc[8 * i + 4] = acc[8 * i + 4] * sc + p * bflo(w.z); acc[8 * i + 5] = acc[8 * i + 5] * sc + p * bfhi(w.z); acc[8 * i + 6] = acc[8 * i + 6] * sc + p * bflo(w.w); acc[8 * i + 7] = acc[8 * i + 7] * sc + p * bfhi(w.w); }
            }
        }
        __syncthreads();
        { const float il = 1.0f / l;
#pragma unroll
          for (int i = 0; i < 32; ++i) ob[(qi * 2 + comp) * 128 + vq * 32 + i] = acc[i] * il; }
        __syncthreads();
        const int part = tid >> 6; float dvv[16]; float sq = 0.f;
#pragma unroll
        for (int i = 0; i < 16; ++i) { const int e = part * 16 + i; dvv[i] = ob[(qi * 2 + 0) * 128 + e] - lam * ob[(qi * 2 + 1) * 128 + e]; sq += dvv[i] * dvv[i]; }
        ssb[part * 64 + qi] = sq;
        __syncthreads();
        float tot = 0.f;
#pragma unroll
        for (int i = 0; i < 8; ++i) tot += ssb[i * 64 + qi];
        const float r = (1.0f - lambda_init) / sqrtf(tot * (1.0f / DV) + SUBLN_EPS);
        if (qi < nq) { bf16* dst = F.MIX + (size_t)(qrow0 + qi) * D + h * DV + part * 16; unsigned w[8];
#pragma unroll
            for (int i = 0; i < 8; ++i) w[i] = pk2(dvv[2 * i] * r * F.d_hgain[h * DV + part * 16 + 2 * i], dvv[2 * i + 1] * r * F.d_hgain[h * DV + part * 16 + 2 * i + 1]);
            *(GAS v4u*)dst = (v4u){w[0], w[1], w[2], w[3]}; *(GAS v4u*)(dst + 8) = (v4u){w[4], w[5], w[6], w[7]}; }
    }
}

__device__ __forceinline__ void final_norm_phase(Frame& F) {
    const int gw = F.vcu * NWAVES + F.wave, NGW = F.G * NWAVES;
    for (int row = META_ROWS + gw; row < MROWS; row += NGW) {
        const float rs = pg8::row_rstd<16>(F.SS, row, EPS);
        GAS f32x4* p = (GAS f32x4*)(F.out + (size_t)(row - META_ROWS) * D);
#pragma unroll
        for (int j = 0; j < 4; ++j) { f32x4 v = p[64 * j + F.lane]; const f32x4 g = ((const GAS f32x4*)F.fgain)[64 * j + F.lane]; v = v * rs * g; p[64 * j + F.lane] = v; }
    }
}
struct Args { const float* in[14]; float* out; unsigned char* ws; int ph_lo, ph_hi; };
__global__ void __launch_bounds__(NWAVES * 64, 2) fwd_kernel(Args args) {
    extern __shared__ __attribute__((aligned(16))) unsigned char lds[];
    Frame F;
    F.lds = (LAS unsigned char*)lds;
    F.MISC = (volatile LAS unsigned*)(F.lds + MISC_OFF);
    F.tid = threadIdx.x; F.lane = F.tid & 63; F.wave = __builtin_amdgcn_readfirstlane(F.tid >> 6);
    F.G = gridDim.x; { const int bx = blockIdx.x; F.vcu = (F.G % 8 == 0) ? (bx % 8) * (F.G / 8) + bx / 8 : bx; }
    unsigned char* ws = args.ws; F.ws = ws;
    F.ctl = (gu32*)(ws + WS_CTL);
    F.x = args.in[0]; F.meta = args.in[1]; F.ngain = args.in[2]; F.m_win = args.in[3]; F.m_bgate = args.in[4]; F.m_hgain = args.in[5]; F.m_wout = args.in[6];
    F.d_win = args.in[7]; F.d_lam = args.in[8]; F.d_hgain = args.in[9]; F.d_wout = args.in[10]; F.w_up = args.in[11]; F.w_dn = args.in[12]; F.fgain = args.in[13];
    F.out = args.out;
    F.WIN0 = (bf16*)(ws + WS_WIN0); F.WOUT0 = (bf16*)(ws + WS_WOUT0); F.WUP0 = (bf16*)(ws + WS_WUP0); F.WDN0 = (bf16*)(ws + WS_WDN0);
    F.WIN1 = (bf16*)(ws + WS_WIN1); F.WOUT1 = (bf16*)(ws + WS_WOUT1); F.WUP1 = (bf16*)(ws + WS_WUP1); F.WDN1 = (bf16*)(ws + WS_WDN1);
    F.HB = (bf16*)(ws + WS_HB); F.P = (bf16*)(ws + WS_P); F.MIX = (bf16*)(ws + WS_MIX); F.U = (bf16*)(ws + WS_U);
    F.WG = (float*)(ws + WS_WG); F.HMETA = (float*)(ws + WS_HMETA); F.SS = (float*)(ws + WS_SS); F.GATES = (float*)(ws + WS_GATES);
    for (int u = F.tid; u < (LDS_BYTES - LDSCTL_OFF) / 4; u += NWAVES * 64) ((LAS unsigned*)(F.lds + LDSCTL_OFF))[u] = 0u;
    __syncthreads();
    const int lo = args.ph_lo, hi = args.ph_hi;
    const bool use_bar = (hi - lo) > 1;
    XcdBarrier bar; bar.bar = (unsigned*)(F.ctl + CW_BAR); bar.x = 0; bar.st = nullptr;
    if (use_bar) bar = xcd_barrier_post((unsigned*)(F.ctl + CW_BAR), F.MISC + 8);
#define IN(k) (lo <= (k) && (k) < hi)
#define SEAM(k) do { if (IN(k) && IN((k) + 1)) xcd_barrier(bar); } while (0)
#define GEMM_PHASE(k, EPI, Aptr, Bptr, NN, KK, ...) if (IN(k)) { pg8::Gemm g{Aptr, Bptr, MROWS, NN, KK}; pg8::StaticOrder S; S.init(MROWS, NN, F.G, (int)blockIdx.x); \
        EPI E{__VA_ARGS__}; pg8::gemm_phase<EPI, pg8::StaticOrder, PG8_ALIGN, PG8_SP2>(F.lds + RING_OFF, g, S, E); SEAM(k); }
    typedef pg8::EpiScale<0, 1> EpiIn0; typedef pg8::EpiScale<0, 16> EpiIn1; typedef pg8::EpiScale<1, 16> EpiUp;
    if (IN(0)) { p0_prologue(F); SEAM(0); }
    GEMM_PHASE(1, EpiIn0, F.HB, F.WIN0, NPROJ, D, F.P, NPROJ, F.SS, EPS)
    if (IN(2)) { mlstm_simple_phase(F); SEAM(2); }
    GEMM_PHASE(3, pg8::EpiRes, F.MIX, F.WOUT0, D, D, F.HMETA, F.out, F.HB, F.SS)
    GEMM_PHASE(4, EpiUp, F.HB, F.WUP0, FF, D, F.U, FF, F.SS, EPS)
    GEMM_PHASE(5, pg8::EpiRes, F.U, F.WDN0, D, FF, F.HMETA, F.out, F.HB, F.SS)
    GEMM_PHASE(6, EpiIn1, F.HB, F.WIN1, NPROJ, D, F.P, NPROJ, F.SS, EPS)
    if (IN(7)) { attn_simple_phase(F); SEAM(7); }
    GEMM_PHASE(8, pg8::EpiRes, F.MIX, F.WOUT1, D, D, F.HMETA, F.out, F.HB, F.SS)
    GEMM_PHASE(9, EpiUp, F.HB, F.WUP1, FF, D, F.U, FF, F.SS, EPS)
    GEMM_PHASE(10, pg8::EpiRes, F.U, F.WDN1, D, FF, F.HMETA, F.out, (bf16*)nullptr, F.SS)
    if (IN(11)) { final_norm_phase(F); }
#undef IN
#undef SEAM
#undef GEMM_PHASE
}

extern "C" void kernel_launch(void* const* d_in, const int* in_sizes, int n_in, void* d_out, int out_size, void* d_ws, size_t ws_size, hipStream_t stream) {
    static int grid = 0;
    if (grid == 0) {
        if (n_in != 14 || in_sizes[0] != NB * SEQ * D || out_size != NB * SEQ * D || ws_size < WS_END) { fprintf(stderr, "kernel_launch: unexpected shapes (n_in %d, in0 %d, out %d, ws %zu)\n", n_in, n_in > 0 ? in_sizes[0] : -1, out_size, ws_size); grid = -1; return; }
        int dev = 0, cus = 0, per_cu = 0;
        if (hipGetDevice(&dev) != hipSuccess || hipDeviceGetAttribute(&cus, hipDeviceAttributeMultiprocessorCount, dev) != hipSuccess) { grid = -1; return; }
        if (hipFuncSetAttribute((const void*)fwd_kernel, hipFuncAttributeMaxDynamicSharedMemorySize, LDS_BYTES) != hipSuccess) { fprintf(stderr, "kernel_launch: hipFuncSetAttribute failed\n"); grid = -1; return; }
        if (hipOccupancyMaxActiveBlocksPerMultiprocessor(&per_cu, (const void*)fwd_kernel, NWAVES * 64, LDS_BYTES) != hipSuccess || per_cu < 1) { fprintf(stderr, "kernel_launch: occupancy query reports %d blocks per CU\n", per_cu); (void)hipGetLastError(); grid = -1; return; }
        grid = cus;
    }
    if (grid < 0) return;
    if (hipMemsetAsync((char*)d_ws + WS_CTL, 0, CTL_ZERO_BYTES, stream) != hipSuccess) return;
    Args a{};
    for (int i = 0; i < 14; ++i) a.in[i] = (const float*)d_in[i];
    a.out = (float*)d_out; a.ws = (unsigned char*)d_ws;
    if (MK_N_LAUNCHES == 1) { a.ph_lo = 0; a.ph_hi = NPHASE; hipLaunchKernelGGL(fwd_kernel, dim3(grid), dim3(NWAVES * 64), LDS_BYTES, stream, a); }
    else for (int p = 0; p < NPHASE; ++p) { a.ph_lo = p; a.ph_hi = p + 1; hipLaunchKernelGGL(fwd_kernel, dim3(grid), dim3(NWAVES * 64), LDS_BYTES, stream, a); }
}
```

```cpp
#include <hip/hip_runtime.h>
#include <cstdio>
#include <cstdint>
namespace pg8 {
#define PG8_LAS __attribute__((address_space(3)))
typedef unsigned short bf16_t;
typedef short bf16x8 __attribute__((ext_vector_type(8)));
typedef float f32x4 __attribute__((ext_vector_type(4)));
typedef unsigned u32x4 __attribute__((ext_vector_type(4)));
constexpr int BM = 256, BK = 64, HALF = 128, HTB = HALF * BK * 2  , STAGE_BYTES = 8 * HTB, NXCD = 8, WGM = 8;

__host__ __device__ __forceinline__ int lds_byte(int r, int c) { const int st = (r >> 4) * 2 + (c >> 5), rr = r & 15, cc = c & 31, ob = rr * 64 + cc * 2; return st * 1024 + (ob ^ (((ob >> 9) & 1) << 5)); }
__host__ __device__ __forceinline__ void stage_rc(int b, int& R, int& C) { const int st = b / 1024, sb = b % 1024, swz = sb ^ (((sb >> 9) & 1) << 5); R = (st >> 1) * 16 + swz / 64; C = (st & 1) * 32 + (swz % 64) / 2; }
__host__ __device__ __forceinline__ int perm32(int rho) { const int n = rho >> 4, i = rho & 15; return 8 * (i >> 2) + 4 * n + (i & 3); }

struct Unit { int pm, pn; };
struct Gemm { const bf16_t* A; const bf16_t* Bt; int M, N, K; };

struct StaticOrder {
    int nM, nN, nwg, G, c;
    __host__ __device__ void init(int M, int N, int G_, int c_) { nM = M / BM; nN = N / BM; nwg = nM * nN; G = G_; c = c_; }
    __host__ __device__ bool next(int i, Unit& u) const {
        const long L = (long)i * G + c; if (L >= nwg) return false;
        int wgid = (int)L; { const int q = nwg / NXCD, r = nwg % NXCD, xcd = wgid % NXCD, off = wgid / NXCD; wgid = (xcd < r ? xcd * (q + 1) : r * (q + 1) + (xcd - r) * q) + off; }
        const int nig = WGM * nN, gid = wgid / nig, fm = gid * WGM, gsz = (nM - fm) < WGM ? (nM - fm) : WGM;
        u.pm = fm + ((wgid % nig) % gsz); u.pn = (wgid % nig) / gsz; return true;
    }
    __device__ __forceinline__ void a_ready(const Unit&) const {}
    __device__ __forceinline__ void done(const Unit&) const {}
};

__device__ __forceinline__ unsigned cvt_pk_bf16(float lo, float hi) { unsigned r; asm volatile("v_cvt_pk_bf16_f32 %0, %1, %2" : "=v"(r) : "v"(lo), "v"(hi)); return r; }
typedef unsigned u32x2 __attribute__((ext_vector_type(2)));

template <int NS> __device__ __forceinline__ float row_rstd(const float* ss, int row, float eps) {
    const float* sp = ss + (size_t)row * 16; float s;
    if (NS == 1) s = sp[0];
    else { const f32x4 a = *(const f32x4*)sp, b = *(const f32x4*)(sp + 4), c = *(const f32x4*)(sp + 8), d = *(const f32x4*)(sp + 12);
           s = ((a[0] + a[1]) + (a[2] + a[3])) + ((b[0] + b[1]) + (b[2] + b[3])) + ((c[0] + c[1]) + (c[2] + c[3])) + ((d[0] + d[1]) + (d[2] + d[3])); }
    return __builtin_amdgcn_rsqf(s * (1.0f / 1024.0f) + eps);
}
template <int ACT, int NS> struct EpiScale {
    static constexpr bool PERM = true, AFTER_DRAIN = false;
    bf16_t* O; int ldc; const float* ss; float eps;
    __device__ __forceinline__ void operator()(const f32x4 (&acc)[2][2][4][2], const Unit& u, int wr, int wc, int fr, int fq) const {
        const int row0 = u.pm * BM + wr * 64 + fr, col0 = u.pn * BM + wc * 32 + 8 * fq;
#pragma unroll
        for (int ai = 0; ai < 2; ++ai)
#pragma unroll
            for (int m = 0; m < 4; ++m) { const int row = row0 + ai * HALF + m * 16; const float rs = row_rstd<NS>(ss, row, eps);
                bf16_t* rowp = O + (size_t)row * ldc + col0;
#pragma unroll
                for (int bj = 0; bj < 2; ++bj) { f32x4 v0 = acc[ai][bj][m][0] * rs, v1 = acc[ai][bj][m][1] * rs;
                    if (ACT == 1) {
#pragma unroll
                        for (int i = 0; i < 4; ++i) { const float a = fmaxf(v0[i], 0.f), b = fmaxf(v1[i], 0.f); v0[i] = a * a; v1[i] = b * b; } }
                    u32x4 w; w.x = cvt_pk_bf16(v0[0], v0[1]); w.y = cvt_pk_bf16(v0[2], v0[3]); w.z = cvt_pk_bf16(v1[0], v1[1]); w.w = cvt_pk_bf16(v1[2], v1[3]);
                    *(u32x4*)(rowp + bj * HALF) = w; } }
    }
};
struct EpiRes {
    static constexpr bool PERM = false, AFTER_DRAIN = false;
    float* Hm; float* Hr; bf16_t* HB; float* ss; int meta_first;
    __device__ __forceinline__ void operator()(const f32x4 (&acc)[2][2][4][2], const Unit& u, int wr, int wc, int fr, int fq) const {
        const int row0 = u.pm * BM + wr * 64 + fr, col0 = u.pn * BM + wc * 32 + 4 * fq;
#pragma unroll
        for (int ai = 0; ai < 2; ++ai)
#pragma unroll
            for (int m = 0; m < 4; ++m) { const int row = row0 + ai * HALF + m * 16;
                float* hp = (meta_first ? (u.pm == 0 ? Hm + (size_t)row * 1024 : Hr + (size_t)(row - 256) * 1024) : Hr + (size_t)row * 1024) + col0; float q = 0.f;
#pragma unroll
                for (int bj = 0; bj < 2; ++bj)
#pragma unroll
                    for (int n = 0; n < 2; ++n) { const int off = bj * HALF + n * 16; const f32x4 hv = *(const f32x4*)(hp + off) + acc[ai][bj][m][n]; *(f32x4*)(hp + off) = hv;
                        q += (hv[0] * hv[0] + hv[1] * hv[1]) + (hv[2] * hv[2] + hv[3] * hv[3]);
                        if (HB) { u32x2 w; w.x = cvt_pk_bf16(hv[0], hv[1]); w.y = cvt_pk_bf16(hv[2], hv[3]); *(u32x2*)(HB + (size_t)row * 1024 + col0 + off) = w; } }
                q += __shfl_xor(q, 16); q += __shfl_xor(q, 32);
                if (fq == 0) ss[(size_t)row * 16 + u.pn * 4 + wc] = q; }
    }
};

template <class Epi, class Sched, bool ALIGN_EPI = false, bool SP2 = false>
__device__ __forceinline__ void gemm_phase(PG8_LAS unsigned char* lds, const Gemm g, const Sched& S, const Epi& E) {
    const int tid = threadIdx.x, wid = __builtin_amdgcn_readfirstlane(tid >> 6), lane = tid & 63, wr = wid >> 2, wc = wid & 3, fr = lane & 15, fq = lane >> 4;
    const int K = g.K, nt = K / BK;
    unsigned voffA[2], voffB[2];
#pragma unroll
    for (int i = 0; i < 2; ++i) { int R, C; stage_rc(tid * 16 + i * 8192, R, C); const int Rb = Epi::PERM ? ((R & ~31) + perm32(R & 31)) : R;
        voffA[i] = (unsigned)(R * K + C) * 2u; voffB[i] = (unsigned)(Rb * K + C) * 2u; }
    const size_t kstep = (size_t)(BK * 2);
    const size_t hstep = (size_t)HALF * K * 2;
    const size_t tstep = 2 * hstep;
    const unsigned ldsw = (unsigned)wid * 1024u;
    const int aoff = lds_byte(wr * 64 + fr, fq * 8), boff = lds_byte(wc * 32 + fr, fq * 8);
#define PG8_SA(b, h) (((b) * 2 + (h)) * HTB)
#define PG8_SB(b, h) ((4 + (b) * 2 + (h)) * HTB)
#define PG8_STAGE(bufoff, gbase, voff) do { _Pragma("unroll") for (int _i = 0; _i < 2; ++_i) \
        __builtin_amdgcn_global_load_lds((const unsigned*)((const char*)(gbase) + (voff)[_i]), (PG8_LAS unsigned*)(lds + (bufoff) + ldsw + _i * 8192), 16, 0, 0); } while (0)
#define PG8_LDA(dst, b, h) do { _Pragma("unroll") for (int m = 0; m < 4; ++m) _Pragma("unroll") for (int k = 0; k < 2; ++k) dst[m][k] = *(const PG8_LAS bf16x8*)(lds + PG8_SA(b, h) + aoff + m * 2048 + k * 1024); } while (0)
#define PG8_LDB(dst, b, h) do { _Pragma("unroll") for (int n = 0; n < 2; ++n) _Pragma("unroll") for (int k = 0; k < 2; ++k) dst[n][k] = *(const PG8_LAS bf16x8*)(lds + PG8_SB(b, h) + boff + n * 2048 + k * 1024); } while (0)
#define PG8_MMA(ai, bj, At, Bt) do { __builtin_amdgcn_s_setprio(1); _Pragma("unroll") for (int m = 0; m < 4; ++m) _Pragma("unroll") for (int n = 0; n < 2; ++n) _Pragma("unroll") for (int k = 0; k < 2; ++k) \
        acc[ai][bj][m][n] = __builtin_amdgcn_mfma_f32_16x16x32_bf16(Bt[n][k], At[m][k], acc[ai][bj][m][n], 0, 0, 0); __builtin_amdgcn_s_setprio(0); } while (0)
#define PG8_WAIT_V(n) asm volatile("s_waitcnt vmcnt(" #n ")" ::: "memory")
#define PG8_WAIT_L(n) asm volatile("s_waitcnt lgkmcnt(" #n ")" ::: "memory")
#define PG8_BAR __builtin_amdgcn_s_barrier()
#define PG8_SCHED __builtin_amdgcn_sched_barrier(0)
    Unit cur, nxt; int ui = 0;
    if (!S.next(0, cur)) return;
    f32x4 acc[2][2][4][2];
#pragma unroll
    for (int a = 0; a < 2; ++a)
#pragma unroll
        for (int b = 0; b < 2; ++b)
#pragma unroll
            for (int m = 0; m < 4; ++m)
#pragma unroll
                for (int n = 0; n < 2; ++n) acc[a][b][m][n] = (f32x4){0.f, 0.f, 0.f, 0.f};
    bf16x8 At[4][2], B0[2][2], B1[2][2];
    const char* cA = (const char*)g.A + (size_t)cur.pm * tstep; const char* cB = (const char*)g.Bt + (size_t)cur.pn * tstep;
    S.a_ready(cur);
    if constexpr (SP2) {
        PG8_STAGE(PG8_SB(0, 0), cB, voffB); PG8_STAGE(PG8_SB(0, 1), cB + hstep, voffB); PG8_STAGE(PG8_SA(0, 0), cA, voffA); PG8_STAGE(PG8_SA(0, 1), cA + hstep, voffA);
        if (wr == 1) PG8_BAR;
        PG8_WAIT_V(2); PG8_BAR;
        PG8_STAGE(PG8_SB(1, 0), cB + kstep, voffB); PG8_STAGE(PG8_SA(1, 0), cA + kstep, voffA); PG8_STAGE(PG8_SB(1, 1), cB + hstep + kstep, voffB);
        PG8_WAIT_V(6); PG8_BAR;
    } else {
        PG8_STAGE(PG8_SB(0, 0), cB, voffB); PG8_STAGE(PG8_SA(0, 0), cA, voffA); PG8_STAGE(PG8_SB(0, 1), cB + hstep, voffB); PG8_STAGE(PG8_SA(0, 1), cA + hstep, voffA);
        if (wr == 1) PG8_BAR;
        PG8_WAIT_V(4); PG8_BAR;
        PG8_STAGE(PG8_SB(1, 0), cB + kstep, voffB); PG8_STAGE(PG8_SA(1, 0), cA + kstep, voffA); PG8_STAGE(PG8_SB(1, 1), cB + hstep + kstep, voffB);
        PG8_WAIT_V(6); PG8_BAR;
    }
    for (;;) {
        const bool has_next = S.next(ui + 1, nxt);
        const char* nA = has_next ? (const char*)g.A + (size_t)nxt.pm * tstep : cA; const char* nB = has_next ? (const char*)g.Bt + (size_t)nxt.pn * tstep : cB;
        for (int t = 0; t < nt; t += 2) {
            const bool last = (t == nt - 2);
            const char* a1 = cA + (size_t)(t + 1) * kstep;
            const char* a2 = last ? nA : cA + (size_t)(t + 2) * kstep; const char* b2 = last ? nB : cB + (size_t)(t + 2) * kstep;
            const char* a3 = a2 + kstep; const char* b3 = b2 + kstep;
            if (last && has_next) S.a_ready(nxt);
            if constexpr (SP2) {
            PG8_LDB(B0, 0, 0); PG8_LDB(B1, 0, 1); PG8_SCHED; PG8_LDA(At, 0, 0); PG8_STAGE(PG8_SA(1, 1), a1 + hstep, voffA);
            PG8_WAIT_V(8); PG8_WAIT_L(0); PG8_BAR; PG8_MMA(0, 0, At, B0); PG8_MMA(0, 1, At, B1); PG8_BAR; PG8_SCHED;
            PG8_LDA(At, 0, 1); PG8_STAGE(PG8_SB(0, 0), b2, voffB); PG8_STAGE(PG8_SB(0, 1), b2 + hstep, voffB); PG8_STAGE(PG8_SA(0, 0), a2, voffA);
            PG8_WAIT_V(8); PG8_WAIT_L(0); PG8_BAR; PG8_MMA(1, 0, At, B0); PG8_MMA(1, 1, At, B1); PG8_BAR; PG8_SCHED;
            PG8_LDB(B0, 1, 0); PG8_LDB(B1, 1, 1); PG8_SCHED; PG8_LDA(At, 1, 0); PG8_STAGE(PG8_SA(0, 1), a2 + hstep, voffA);
            PG8_WAIT_V(8); PG8_WAIT_L(0); PG8_BAR; PG8_MMA(0, 0, At, B0); PG8_MMA(0, 1, At, B1); PG8_BAR; PG8_SCHED;
            PG8_LDA(At, 1, 1); PG8_STAGE(PG8_SB(1, 0), b3, voffB); PG8_STAGE(PG8_SB(1, 1), b3 + hstep, voffB); PG8_STAGE(PG8_SA(1, 0), a3, voffA);
            PG8_WAIT_V(8); PG8_WAIT_L(0); PG8_BAR; PG8_MMA(1, 0, At, B0); PG8_MMA(1, 1, At, B1); PG8_BAR; PG8_SCHED;
            } else {
            PG8_LDB(B0, 0, 0); PG8_SCHED; PG8_LDA(At, 0, 0); PG8_STAGE(PG8_SA(1, 1), a1 + hstep, voffA);
            PG8_WAIT_L(8); PG8_BAR; PG8_WAIT_L(0); PG8_MMA(0, 0, At, B0); PG8_BAR; PG8_SCHED;
            PG8_LDB(B1, 0, 1); PG8_STAGE(PG8_SB(0, 0), b2, voffB);
            PG8_BAR; PG8_WAIT_L(0); PG8_MMA(0, 1, At, B1); PG8_BAR;
            PG8_LDA(At, 0, 1); PG8_STAGE(PG8_SA(0, 0), a2, voffA);
            PG8_BAR; PG8_WAIT_L(0); PG8_MMA(1, 0, At, B0); PG8_BAR; PG8_SCHED;
            PG8_STAGE(PG8_SB(0, 1), b2 + hstep, voffB);
            PG8_WAIT_V(6); PG8_BAR; PG8_MMA(1, 1, At, B1); PG8_BAR;
            PG8_LDB(B0, 1, 0); PG8_SCHED; PG8_LDA(At, 1, 0); PG8_STAGE(PG8_SA(0, 1), a2 + hstep, voffA);
            PG8_WAIT_L(8); PG8_BAR; PG8_WAIT_L(0); PG8_MMA(0, 0, At, B0); PG8_BAR; PG8_SCHED;
            PG8_LDB(B1, 1, 1); PG8_STAGE(PG8_SB(1, 0), b3, voffB);
            PG8_BAR; PG8_WAIT_L(0); PG8_MMA(0, 1, At, B1); PG8_BAR;
            PG8_LDA(At, 1, 1); PG8_STAGE(PG8_SA(1, 0), a3, voffA);
            PG8_BAR; PG8_WAIT_L(0); PG8_MMA(1, 0, At, B0); PG8_BAR; PG8_SCHED;
            PG8_STAGE(PG8_SB(1, 1), b3 + hstep, voffB);
            PG8_WAIT_V(6); PG8_BAR; PG8_MMA(1, 1, At, B1); PG8_BAR;
            }
        }
        if constexpr (ALIGN_EPI) { if (wr == 0) PG8_BAR; }
        if constexpr (!Epi::AFTER_DRAIN) { E(acc, cur, wr, wc, fr, fq); S.done(cur); }
        if (!has_next) break;
#pragma unroll
        for (int a = 0; a < 2; ++a)
#pragma unroll
            for (int b = 0; b < 2; ++b)
#pragma unroll
                for (int m = 0; m < 4; ++m)
#pragma unroll
                    for (int n = 0; n < 2; ++n) acc[a][b][m][n] = (f32x4){0.f, 0.f, 0.f, 0.f};
        cur = nxt; cA = nA; cB = nB; ++ui;
        if constexpr (ALIGN_EPI) { if (wr == 1) PG8_BAR; }
    }
    PG8_WAIT_V(0);
    if constexpr (!ALIGN_EPI) { if (wr == 0) PG8_BAR; }
    PG8_BAR;
    if constexpr (Epi::AFTER_DRAIN) { E.fused(acc, cur, wr, wc, fr, fq, lds, wid, lane); S.done(cur); }
#undef PG8_SA
#undef PG8_SB
#undef PG8_STAGE
#undef PG8_LDA
#undef PG8_LDB
#undef PG8_MMA
#undef PG8_WAIT_V
#undef PG8_WAIT_L
#undef PG8_BAR
#undef PG8_SCHED
}
}

#ifndef PG8_SP2
#define PG8_SP2 true
#endif
#ifndef PG8_ALIGN
#define PG8_ALIGN true
#endif
constexpr int NB = 16, SEQ = 2048, NMETA = 16, D = 1024, FF = 4096;
constexpr int MROWS = NB * (SEQ + NMETA);
constexpr int META_ROWS = NB * NMETA;
constexpr int NH = 8, DQK = 64, DV = 128;
constexpr int NPROJ = 3072;
constexpr float EPS = 1e-6f, SUBLN_EPS = 1e-5f;
constexpr int NWAVES = 8;
#ifndef MK_N_LAUNCHES
#define MK_N_LAUNCHES 1
#endif
constexpr int NPHASE = 12;

constexpr size_t MiB = 1u << 20;
constexpr size_t WS_CTL = 0, CTL_ZERO_BYTES = 1 * MiB;
constexpr size_t WS_WIN0 = 1 * MiB, WS_WOUT0 = 7 * MiB, WS_WUP0 = 9 * MiB, WS_WDN0 = 17 * MiB;
constexpr size_t WS_WIN1 = 25 * MiB, WS_WOUT1 = 31 * MiB, WS_WUP1 = 33 * MiB, WS_WDN1 = 41 * MiB;
constexpr size_t WS_WG = 49 * MiB;
constexpr size_t WS_HMETA = 50 * MiB;
constexpr size_t WS_SS = 51 * MiB;
constexpr size_t WS_GATES = 54 * MiB;
constexpr size_t WS_HB = 57 * MiB;
constexpr size_t WS_P = 122 * MiB;
constexpr size_t WS_MIX = WS_P + (size_t)MROWS * NPROJ * 2;
constexpr size_t WS_U = WS_P;
constexpr size_t WS_END = WS_MIX + (size_t)MROWS * D * 2;
static_assert(WS_HB + (size_t)MROWS * D * 2 <= WS_P && WS_U + (size_t)MROWS * FF * 2 <= WS_END && WS_SS + (size_t)MROWS * 64 <= WS_GATES && WS_GATES + (size_t)MROWS * 64 <= WS_HB, "d_ws map");
constexpr int CW_BAR = 4096;

constexpr int RING_OFF = 0, RING_BYTES = 131072;
constexpr int LDSCTL_OFF = RING_BYTES, MISC_OFF = LDSCTL_OFF + 320;
constexpr int LDS_BYTES = 147456;

#define GAS __attribute__((address_space(1)))
#define LAS __attribute__((address_space(3)))
typedef unsigned short bf16;
typedef unsigned v4u __attribute__((ext_vector_type(4)));
typedef float f32x4 __attribute__((ext_vector_type(4)));
typedef GAS unsigned gu32;
#define RLX_AGENT __ATOMIC_RELAXED, __HIP_MEMORY_SCOPE_AGENT
#define LDS_WAIT() asm volatile("s_waitcnt lgkmcnt(0)" ::: "memory")
__device__ __forceinline__ unsigned f2bf(float f) { unsigned u = __builtin_bit_cast(unsigned, f); return (u + 0x7fffu + ((u >> 16) & 1u)) >> 16; }
__device__ __forceinline__ unsigned pk2(float lo, float hi) { return f2bf(lo) | (f2bf(hi) << 16); }
__device__ __forceinline__ float bf2f(unsigned short v) { return __builtin_bit_cast(float, (unsigned)v << 16); }
__device__ __forceinline__ float bflo(unsigned w) { return __builtin_bit_cast(float, w << 16); }
__device__ __forceinline__ float bfhi(unsigned w) { return __builtin_bit_cast(float, w & 0xffff0000u); }

#define XB_TMO      128
#define XB_XCNT(j)  (256  + 64 * (j))
#define XB_XSUB(j)  (1280 + 64 * (j))
#define XB_XGEN(j)  (2304 + 64 * (j))
#define XB_TOP      3328
#define XB_TOPGEN   3392
#define XCD_BAR_WORDS 3456
#define XB_SPIN_CAP (1u << 18)
__device__ __forceinline__ unsigned xb_ld(unsigned* p)              { return __hip_atomic_load(p, __ATOMIC_RELAXED, __HIP_MEMORY_SCOPE_AGENT); }
__device__ __forceinline__ unsigned xb_add(unsigned* p, unsigned v) { return __hip_atomic_fetch_add(p, v, __ATOMIC_RELAXED, __HIP_MEMORY_SCOPE_AGENT); }
__device__ __forceinline__ unsigned xb_xcc_id() { return (unsigned)__builtin_amdgcn_s_getreg((3 << 11) | 20) & 0xFu; }
#define XB_SPIN(cond, bar) do { unsigned _sp = 0; while (cond) { __builtin_amdgcn_s_sleep(1); \
    if ((++_sp & 255u) == 0u) { if (xb_ld(&(bar)[XB_TMO])) break; if (_sp > XB_SPIN_CAP) { atomicAdd(&(bar)[XB_TMO], 1u); break; } } } } while (0)
struct XcdBarrier { unsigned* bar; unsigned x; volatile LAS unsigned* st; };
__device__ __forceinline__ XcdBarrier xcd_barrier_post(unsigned* bar, volatile LAS unsigned* st) {
    XcdBarrier b; b.bar = bar; b.x = xb_xcc_id(); b.st = st;
    if (threadIdx.x == 0) (void)xb_add(&bar[XB_XCNT(b.x)], 1u);
    return b;
}
__device__ __forceinline__ void xcd_barrier_complete(unsigned* bar, unsigned x, unsigned& nloc, unsigned& nx) {
    const unsigned G = gridDim.x * gridDim.y * gridDim.z;
    unsigned sum, cnt, mine, sp = 0u;
    for (;;) {
        sum = 0u; cnt = 0u; mine = 0u;
#pragma unroll
        for (unsigned j = 0; j < 16; ++j) { const unsigned c = xb_ld(&bar[XB_XCNT(j)]); sum += c; cnt += (c > 0u) ? 1u : 0u; mine = (j == x) ? c : mine; }
        if (sum == G) break;
        __builtin_amdgcn_s_sleep(1);
        if ((++sp & 255u) == 0u) { if (xb_ld(&bar[XB_TMO])) break; if (sp > XB_SPIN_CAP) { atomicAdd(&bar[XB_TMO], 1u); break; } }
    }
    nloc = mine > 0u ? mine : 1u; nx = cnt > 0u ? cnt : 1u;
}
__device__ __forceinline__ void xcd_barrier(const XcdBarrier& b) {
    asm volatile("s_waitcnt vmcnt(0)" ::: "memory");
    __syncthreads();
    if (threadIdx.x == 0) {
        unsigned* bar = b.bar;
        __builtin_amdgcn_s_waitcnt(0);
        unsigned nloc = b.st[0], nx = b.st[1];
        if (nloc == 0u) { xcd_barrier_complete(bar, b.x, nloc, nx); b.st[0] = nloc; b.st[1] = nx; }
        const unsigned old = xb_add(&bar[XB_XSUB(b.x)], 1u);
        const unsigned gen = old / nloc;
        if (old + 1u == (gen + 1u) * nloc) {
            __builtin_amdgcn_fence(__ATOMIC_RELEASE, "agent");
            asm volatile("s_waitcnt vmcnt(0)" ::: "memory");
            const unsigned og = xb_add(&bar[XB_TOP], 1u);
            const unsigned tg = og / nx;
            if (og + 1u == (tg + 1u) * nx) xb_add(&bar[XB_TOPGEN], 1u);
            else XB_SPIN(xb_ld(&bar[XB_TOPGEN]) == tg, bar);
            __builtin_amdgcn_fence(__ATOMIC_ACQUIRE, "agent");
            xb_add(&bar[XB_XGEN(b.x)], 1u);
            asm volatile("s_waitcnt vmcnt(0)" ::: "memory");
        } else {
            XB_SPIN(xb_ld(&bar[XB_XGEN(b.x)]) == gen, bar);
            __builtin_amdgcn_fence(__ATOMIC_ACQUIRE, "agent");
            asm volatile("s_waitcnt vmcnt(0)" ::: "memory");
        }
    }
    __syncthreads();
}

struct Frame {
    LAS unsigned char* lds;
    volatile LAS unsigned* MISC;
    gu32* ctl;
    int tid, lane, wave, vcu, G;
    const float *x, *meta, *ngain, *m_win, *m_bgate, *m_hgain, *m_wout, *d_win, *d_lam, *d_hgain, *d_wout, *w_up, *w_dn, *fgain;
    float* out; unsigned char* ws;
    bf16 *WIN0, *WOUT0, *WUP0, *WDN0, *WIN1, *WOUT1, *WUP1, *WDN1, *HB, *P, *MIX, *U;
    float *WG, *HMETA, *SS, *GATES;
};
__device__ __forceinline__ float wave_sum(float v) {
#pragma unroll
    for (int o = 1; o < 64; o <<= 1) v += __shfl_xor(v, o);
    return v;
}
__device__ __forceinline__ void p0_transpose_item(const float* W, int K, int ldw, int Nuse, const float* gk, int nscale, bf16* WT, LAS float* scr, int item, int lane) {
    const int nblk = Nuse / 32, kb = item / nblk, nb = item % nblk, k0 = 64 * kb, n0 = 32 * nb;
    const float cs = (n0 < nscale) ? 0.125f : 1.f;
#pragma unroll 8
    for (int i = 0; i < 32; ++i) { const int kk = 2 * i + (lane >> 5); const float g = gk ? gk[k0 + kk] * cs : cs; scr[kk * 33 + (lane & 31)] = W[(size_t)(k0 + kk) * ldw + n0 + (lane & 31)] * g; }
    LDS_WAIT(); asm volatile("" ::: "memory");
    const int c = lane & 7;
#pragma unroll
    for (int j = 0; j < 4; ++j) { const int n = (lane >> 3) + 8 * j; const LAS float* s = scr + (8 * c) * 33 + n;
        v4u o; o.x = pk2(s[0 * 33], s[1 * 33]); o.y = pk2(s[2 * 33], s[3 * 33]); o.z = pk2(s[4 * 33], s[5 * 33]); o.w = pk2(s[6 * 33], s[7 * 33]);
        *(GAS v4u*)(WT + (size_t)(n0 + n) * K + k0 + 8 * c) = o; }
    LDS_WAIT(); asm volatile("" ::: "memory");
}
__device__ __forceinline__ void p0_prologue(Frame& F) {
    LAS float* scr = (LAS float*)(F.lds + RING_OFF + F.wave * 16384);
    const int gw = F.vcu * NWAVES + F.wave, NGW = F.G * NWAVES;
    constexpr int I_IN = (D / 64) * (NPROJ / 32), I_OUT = (D / 64) * (D / 32), I_UP = (D / 64) * (FF / 32), I_DN = (FF / 64) * (D / 32);
    constexpr int I_LAYER = I_IN + I_OUT + I_UP + I_DN, NITEMS = 2 * I_LAYER;
    for (int it = gw; it < NITEMS; it += NGW) {
        const int layer = it / I_LAYER; int r = it % I_LAYER;
        const float* g0 = F.ngain + (layer * 2 + 0) * D; const float* g1 = F.ngain + (layer * 2 + 1) * D;
        if (r < I_IN) { if (layer == 0) p0_transpose_item(F.m_win, D, 3088, NPROJ, g0, 512, F.WIN0, scr, r, F.lane); else p0_transpose_item(F.d_win, D, NPROJ, NPROJ, g0, 1024, F.WIN1, scr, r, F.lane); continue; } r -= I_IN;
        if (r < I_OUT) { p0_transpose_item(layer == 0 ? F.m_wout : F.d_wout, D, D, D, nullptr, 0, layer == 0 ? F.WOUT0 : F.WOUT1, scr, r, F.lane); continue; } r -= I_OUT;
        if (r < I_UP) { p0_transpose_item(F.w_up + (size_t)layer * D * FF, D, FF, FF, g1, 0, layer == 0 ? F.WUP0 : F.WUP1, scr, r, F.lane); continue; } r -= I_UP;
        p0_transpose_item(F.w_dn + (size_t)layer * FF * D, FF, D, D, nullptr, 0, layer == 0 ? F.WDN0 : F.WDN1, scr, r, F.lane);
    }
    __syncthreads();
    LAS float* wg = (LAS float*)(F.lds + RING_OFF);
    for (int i = F.tid; i < 16 * D; i += NWAVES * 64) { const int k = i >> 4, j = i & 15; wg[j * D + k] = F.m_win[(size_t)k * 3088 + NPROJ + j] * F.ngain[k]; }
    __syncthreads();
    for (int row = gw; row < MROWS; row += NGW) {
        const float* src = row < META_ROWS ? F.meta + (size_t)(row & 15) * D : F.x + (size_t)(row - META_ROWS) * D;
        float* dst = row < META_ROWS ? F.HMETA + (size_t)row * D : F.out + (size_t)(row - META_ROWS) * D;
        f32x4 v[4]; float s = 0.f;
#pragma unroll
        for (int j = 0; j < 4; ++j) { v[j] = ((const GAS f32x4*)src)[64 * j + F.lane]; s += (v[j].x * v[j].x + v[j].y * v[j].y) + (v[j].z * v[j].z + v[j].w * v[j].w); }
        s = wave_sum(s);
        const float rstd = 1.0f / sqrtf(s * (1.0f / D) + EPS);
#pragma unroll
        for (int j = 0; j < 4; ++j) { ((GAS f32x4*)dst)[64 * j + F.lane] = v[j];
            ((GAS unsigned long long*)(F.HB + (size_t)row * D))[64 * j + F.lane] = (unsigned long long)pk2(v[j].x, v[j].y) | ((unsigned long long)pk2(v[j].z, v[j].w) << 32); }
        if (F.lane == 0) F.SS[(size_t)row * 16] = s;
        float keep = 0.f;
#pragma unroll 4
        for (int g = 0; g < 16; ++g) { float p = 0.f;
#pragma unroll
            for (int j = 0; j < 4; ++j) { const f32x4 w = *(const LAS f32x4*)(wg + g * D + 256 * j + 4 * F.lane); p += (v[j].x * w.x + v[j].y * w.y) + (v[j].z * w.z + v[j].w * w.w); }
            p = wave_sum(p); if (F.lane == g) keep = p; }
        if (F.lane < 16) F.GATES[(size_t)row * 16 + F.lane] = keep * rstd + F.m_bgate[F.lane];
    }
}

__device__ __forceinline__ void mlstm_simple_phase(Frame& F) {
    LAS bf16* qs = (LAS bf16*)(F.lds);
    LAS bf16* ks = qs + 64 * 64;
    LAS bf16* vs = ks + 64 * 64;
    LAS bf16* os = vs + 64 * 128;
    LAS float* lfs = (LAS float*)(os + 64 * 128);
    LAS float* igs = lfs + 64;
    LAS float* red = igs + 64;
    LAS float* hbuf = red + 2 * 4 * 132;
    const int tid = F.tid, e = tid & 127, dq = tid >> 7;
    for (int unit = blockIdx.x; unit < NB * NH; unit += F.G) {
        const int b = unit >> 3, h = unit & 7;
        float C[16], nn[16]; float m = 0.f;
#pragma unroll
        for (int i = 0; i < 16; ++i) { C[i] = 0.f; nn[i] = 0.f; }
        for (int seg = 0; seg <= 32; ++seg) {
            const int nrows = seg == 0 ? 16 : 64; const int row0 = seg == 0 ? b * 16 : META_ROWS + b * SEQ + (seg - 1) * 64;
            __syncthreads();
            for (int i = tid; i < nrows * 8; i += 512) { const int r = i >> 3, c8 = i & 7; const bf16* src = F.P + (size_t)(row0 + r) * NPROJ + h * 64 + c8 * 8;
                *(LAS v4u*)(qs + r * 64 + c8 * 8) = *(const GAS v4u*)src; *(LAS v4u*)(ks + r * 64 + c8 * 8) = *(const GAS v4u*)(src + 512); }
            for (int i = tid; i < nrows * 16; i += 512) { const int r = i >> 4, c8 = i & 15; const bf16* src = F.P + (size_t)(row0 + r) * NPROJ + 1024 + h * 128 + c8 * 8;
                *(LAS v4u*)(vs + r * 128 + c8 * 8) = *(const GAS v4u*)src; *(LAS v4u*)(os + r * 128 + c8 * 8) = *(const GAS v4u*)(src + 1024); }
            if (tid < nrows) { const float ig = F.GATES[(size_t)(row0 + tid) * 16 + h], fg = F.GATES[(size_t)(row0 + tid) * 16 + 8 + h];
                lfs[tid] = fminf(fg, 0.f) - log1pf(expf(-fabsf(fg))); igs[tid] = ig; }
            __syncthreads();
            for (int s = 0; s < nrows; ++s) {
                const float lf = lfs[s], ig = igs[s]; const float mn = fmaxf(lf + m, ig); const float fdec = expf(lf + m - mn), iw = expf(ig - mn); m = mn;
                const float ve = bf2f(vs[s * 128 + e]); float pnum = 0.f, pden = 0.f;
#pragma unroll
                for (int dd = 0; dd < 16; ++dd) { const int d = dq * 16 + dd; const float kd = iw * bf2f(ks[s * 64 + d]), qd = bf2f(qs[s * 64 + d]);
                    C[dd] = fdec * C[dd] + kd * ve; nn[dd] = fdec * nn[dd] + kd; pnum += C[dd] * qd; pden += nn[dd] * qd; }
                LAS float* rb = red + (s & 1) * 4 * 132;
                rb[dq * 132 + e] = pnum; if (e == 0) rb[dq * 132 + 128] = pden;
                __syncthreads();
                if (dq == 0) { const float num = (rb[e] + rb[132 + e]) + (rb[264 + e] + rb[396 + e]); const float den = (rb[128] + rb[132 + 128]) + (rb[264 + 128] + rb[396 + 128]);
                    hbuf[s * 128 + e] = num / fmaxf(fabsf(den), expf(-m)); }
            }
            __syncthreads();
            for (int s = F.wave; s < nrows; s += NWAVES) {
                const float a0 = hbuf[s * 128 + F.lane], a1 = hbuf[s * 128 + 64 + F.lane];
                const float r = 1.0f / sqrtf(wave_sum(a0 * a0 + a1 * a1) * (1.0f / DV) + EPS);
                const float o0 = bf2f(os[s * 128 + F.lane]), o1 = bf2f(os[s * 128 + 64 + F.lane]);
                const float g0 = F.m_hgain[h * DV + F.lane], g1 = F.m_hgain[h * DV + 64 + F.lane];
                bf16* dst = F.MIX + (size_t)(row0 + s) * D + h * DV;
                dst[F.lane] = (bf16)f2bf(a0 * r * g0 / (1.0f + expf(-o0))); dst[64 + F.lane] = (bf16)f2bf(a1 * r * g1 / (1.0f + expf(-o1)));
            }
        }
    }
}

__device__ __forceinline__ void attn_simple_phase(Frame& F) {
    LAS bf16* Ks = (LAS bf16*)(F.lds);
    LAS bf16* Vs = Ks + 64 * 128;
    LAS float* ob = (LAS float*)(Vs + 64 * 128);
    LAS float* ssb = ob + 64 * 2 * 128;
    const int tid = F.tid, qi = tid & 63, comp = (tid >> 6) & 1, vq = tid >> 7;
    const float lambda_init = 0.8f - 0.6f * expf(-0.3f * 1.0f);
    float lam; { float s01 = 0.f, s23 = 0.f; for (int i = 0; i < 64; ++i) { s01 += F.d_lam[i] * F.d_lam[64 + i]; s23 += F.d_lam[128 + i] * F.d_lam[192 + i]; } lam = expf(s01) - expf(s23) + lambda_init; }
    for (int u = blockIdx.x; u < NB * NH * 33; u += F.G) {
        const int c = 32 - u / (NB * NH), bh = u % (NB * NH), b = bh >> 3, h = bh & 7;
        const int nq = c == 0 ? 16 : 64; const int qrow0 = c == 0 ? b * 16 : META_ROWS + b * SEQ + (c - 1) * 64;
        float q[64];
        { const bf16* qp = F.P + (size_t)(qrow0 + (qi < nq ? qi : 0)) * NPROJ + h * 128 + comp * 64;
#pragma unroll
          for (int i = 0; i < 8; ++i) { const v4u w = *(const GAS v4u*)(qp + 8 * i); q[8 * i] = bflo(w.x); q[8 * i + 1] = bfhi(w.x); q[8 * i + 2] = bflo(w.y); q[8 * i + 3] = bfhi(w.y); q[8 * i + 4] = bflo(w.z); q[8 * i + 5] = bfhi(w.z); q[8 * i + 6] = bflo(w.w); q[8 * i + 7] = bfhi(w.w); } }
        float acc[32]; float m = -INFINITY, l = 0.f;
#pragma unroll
        for (int i = 0; i < 32; ++i) acc[i] = 0.f;
        for (int t = 0; t <= c; ++t) {
            const int nk = t == 0 ? 16 : 64; const int krow0 = t == 0 ? b * 16 : META_ROWS + b * SEQ + (t - 1) * 64;
            __syncthreads();
            for (int i = tid; i < nk * 16; i += 512) { const int r = i >> 4, c8 = i & 15; const bf16* src = F.P + (size_t)(krow0 + r) * NPROJ + 1024 + h * 128 + c8 * 8;
                *(LAS v4u*)(Ks + r * 128 + c8 * 8) = *(const GAS v4u*)src; *(LAS v4u*)(Vs + r * 128 + c8 * 8) = *(const GAS v4u*)(src + 1024); }
            __syncthreads();
            for (int j = 0; j < nk; ++j) {
                const LAS v4u* kp = (const LAS v4u*)(Ks + j * 128 + comp * 64); float s = 0.f;
#pragma unroll
                for (int i = 0; i < 8; ++i) { const v4u w = kp[i]; s += q[8 * i] * bflo(w.x) + q[8 * i + 1] * bfhi(w.x) + q[8 * i + 2] * bflo(w.y) + q[8 * i + 3] * bfhi(w.y) + q[8 * i + 4] * bflo(w.z) + q[8 * i + 5] * bfhi(w.z) + q[8 * i + 6] * bflo(w.w) + q[8 * i + 7] * bfhi(w.w); }
                const float mn = fmaxf(m, s), sc = expf(m - mn), p = expf(s - mn); l = l * sc + p; m = mn;
                const LAS v4u* vp = (const LAS v4u*)(Vs + j * 128 + vq * 32);
#pragma unroll
                for (int i = 0; i < 4; ++i) { const v4u w = vp[i];
                    acc[8 * i] = acc[8 * i] * sc + p * bflo(w.x); acc[8 * i + 1] = acc[8 * i + 1] * sc + p * bfhi(w.x); acc[8 * i + 2] = acc[8 * i + 2] * sc + p * bflo(w.y); acc[8 * i + 3] = acc[8 * i + 3] * sc + p * bfhi(w.y);
                    acc[8 * i + 4] = acc[8 * i + 4] * sc + p * bflo(w.z); acc[8 * i + 5] = acc[8 * i + 5] * sc + p * bfhi(w.z); acc[8 * i + 6] = acc[8 * i + 6] * sc + p * bflo(w.w); acc[8 * i + 7] = acc[8 * i + 7] * sc + p * bfhi(w.w); }
            }
        }
        __syncthreads();
        { const float il = 1.0f / l;
#pragma unroll
          for (int i = 0; i < 32; ++i) ob[(qi * 2 + comp) * 128 + vq * 32 + i] = acc[i] * il; }
        __syncthreads();
        const int part = tid >> 6; float dvv[16]; float sq = 0.f;
#pragma unroll
        for (int i = 0; i < 16; ++i) { const int e = part * 16 + i; dvv[i] = ob[(qi * 2 + 0) * 128 + e] - lam * ob[(qi * 2 + 1) * 128 + e]; sq += dvv[i] * dvv[i]; }
        ssb[part * 64 + qi] = sq;
        __syncthreads();
        float tot = 0.f;
#pragma unroll
        for (int i = 0; i < 8; ++i) tot += ssb[i * 64 + qi];
        const float r = (1.0f - lambda_init) / sqrtf(tot * (1.0f / DV) + SUBLN_EPS);
        if (qi < nq) { bf16* dst = F.MIX + (size_t)(qrow0 + qi) * D + h * DV + part * 16; unsigned w[8];
#pragma unroll
            for (int i = 0; i < 8; ++i) w[i] = pk2(dvv[2 * i] * r * F.d_hgain[h * DV + part * 16 + 2 * i], dvv[2 * i + 1] * r * F.d_hgain[h * DV + part * 16 + 2 * i + 1]);
            *(GAS v4u*)dst = (v4u){w[0], w[1], w[2], w[3]}; *(GAS v4u*)(dst + 8) = (v4u){w[4], w[5], w[6], w[7]}; }
    }
}

__device__ __forceinline__ void final_norm_phase(Frame& F) {
    const int gw = F.vcu * NWAVES + F.wave, NGW = F.G * NWAVES;
    for (int row = META_ROWS + gw; row < MROWS; row += NGW) {
        const float rs = pg8::row_rstd<16>(F.SS, row, EPS);
        GAS f32x4* p = (GAS f32x4*)(F.out + (size_t)(row - META_ROWS) * D);
#pragma unroll
        for (int j = 0; j < 4; ++j) { f32x4 v = p[64 * j + F.lane]; const f32x4 g = ((const GAS f32x4*)F.fgain)[64 * j + F.lane]; v = v * rs * g; p[64 * j + F.lane] = v; }
    }
}
namespace attn2 {
typedef short bf16x8 __attribute__((ext_vector_type(8)));
typedef short s16x4 __attribute__((ext_vector_type(4)));
typedef float f32x16 __attribute__((ext_vector_type(16)));
constexpr int KSTR = 272, VSTR = 320, KBYTES = 64 * KSTR, VBYTES = 64 * VSTR, BUFB = KBYTES + VBYTES;
constexpr int CBS = 129;
constexpr float LOG2E = 1.4426950408889634f;
__device__ __forceinline__ int crow(int r, int hi) { return (r & 3) + 8 * (r >> 2) + 4 * hi; }
__device__ __forceinline__ s16x4 vtr(const LAS unsigned char* p) { return __builtin_bit_cast(s16x4, __builtin_amdgcn_ds_read_tr16_b64_v4i16((LAS s16x4*)p)); }
__device__ __forceinline__ bf16x8 pack8(const f32x16& p, int b0) {
    v4u w; w.x = pg8::cvt_pk_bf16(p[b0], p[b0 + 1]); w.y = pg8::cvt_pk_bf16(p[b0 + 2], p[b0 + 3]); w.z = pg8::cvt_pk_bf16(p[b0 + 4], p[b0 + 5]); w.w = pg8::cvt_pk_bf16(p[b0 + 6], p[b0 + 7]);
    return __builtin_bit_cast(bf16x8, w);
}
}
__device__ __forceinline__ void attn_mfma_phase(Frame& F) {
    using namespace attn2;
    const int tid = F.tid, lane = F.lane, wave = F.wave, r32 = lane & 31, hi = lane >> 5, rb = wave >> 1, comp = wave & 1;
    const float lambda_init = 0.8f - 0.6f * expf(-0.3f * 1.0f);
    float lam; { float s01 = 0.f, s23 = 0.f; for (int i = 0; i < 64; ++i) { s01 += F.d_lam[i] * F.d_lam[64 + i]; s23 += F.d_lam[128 + i] * F.d_lam[192 + i]; } lam = expf(s01) - expf(s23) + lambda_init; }
    const int npw = (1024 + F.G - 1) / F.G;
    LAS unsigned char* lds = F.lds;
    LAS float* cb = (LAS float*)lds;
    const int li = lane & 15, q4 = li >> 2, p4 = li & 3, g1 = (lane >> 4) & 1;
    for (int it = 0; it < 2 * npw; ++it) {
        const int pi = F.vcu * npw + (it >> 1); if (pi >= 1024) break;
        const int bh = pi >> 3, s = pi & 7, b = bh >> 3, h = bh & 7, jq = (it & 1) ? 15 - s : s;
        const int qrow = META_ROWS + b * SEQ + 128 * jq + 32 * rb + r32;
        const int cw = 2 * jq + 1 + (rb >> 1), NT = 2 * jq + 3;
        bf16x8 qf[4];
        { const bf16* qp = F.P + (size_t)qrow * NPROJ + h * 128 + comp * 64 + hi * 8;
#pragma unroll
          for (int d0 = 0; d0 < 4; ++d0) qf[d0] = *(const GAS bf16x8*)(qp + 16 * d0); }
        f32x16 o[4];
#pragma unroll
        for (int k = 0; k < 4; ++k)
#pragma unroll
            for (int r = 0; r < 16; ++r) o[k][r] = 0.f;
        float m = -1e30f, l = 0.f;
        v4u sv[4];
#define ATT_LOAD(t) do { _Pragma("unroll") for (int i_ = 0; i_ < 4; ++i_) { const int id_ = i_ * 512 + tid, row_ = id_ >> 5, pc_ = id_ & 31; \
            const int col_ = (pc_ < 16 ? 1024 + pc_ * 8 : 2048 + (pc_ - 16) * 8) + h * 128; \
            if ((t) == 0) { if (row_ < 16) sv[i_] = *(const GAS v4u*)(F.P + (size_t)(b * 16 + row_) * NPROJ + col_); else sv[i_] = (v4u){0u, 0u, 0u, 0u}; } \
            else sv[i_] = *(const GAS v4u*)(F.P + (size_t)(META_ROWS + b * SEQ + ((t) - 1) * 64 + row_) * NPROJ + col_); } } while (0)
#define ATT_STORE(buf) do { _Pragma("unroll") for (int i_ = 0; i_ < 4; ++i_) { const int id_ = i_ * 512 + tid, row_ = id_ >> 5, pc_ = id_ & 31; \
            LAS unsigned char* d_ = lds + (buf) * BUFB + (pc_ < 16 ? row_ * KSTR + pc_ * 16 : KBYTES + row_ * VSTR + (pc_ - 16) * 16); *(LAS v4u*)d_ = sv[i_]; } } while (0)
        __syncthreads();
        ATT_LOAD(0); ATT_STORE(0);
        __syncthreads();
        for (int t = 0; t < NT; ++t) {
            if (t + 1 < NT) ATT_LOAD(t + 1);
            if (t <= cw) {
                const LAS unsigned char* Kb = lds + (t & 1) * BUFB; const LAS unsigned char* Vb = Kb + KBYTES;
                bf16x8 kf[2][4];
#pragma unroll
                for (int kh = 0; kh < 2; ++kh)
#pragma unroll
                    for (int d0 = 0; d0 < 4; ++d0) kf[kh][d0] = *(const LAS bf16x8*)(Kb + (32 * kh + r32) * KSTR + comp * 128 + d0 * 32 + hi * 16);
                f32x16 p0, p1;
#pragma unroll
                for (int r = 0; r < 16; ++r) { p0[r] = 0.f; p1[r] = 0.f; }
#pragma unroll
                for (int d0 = 0; d0 < 4; ++d0) { p0 = __builtin_amdgcn_mfma_f32_32x32x16_bf16(kf[0][d0], qf[d0], p0, 0, 0, 0); p1 = __builtin_amdgcn_mfma_f32_32x32x16_bf16(kf[1][d0], qf[d0], p1, 0, 0, 0); }
                if (t == 0) {
#pragma unroll
                    for (int r = 0; r < 16; ++r) { if (r >= 8) p0[r] = -INFINITY; p1[r] = -INFINITY; } }
                float rm = fmaxf(p0[0], p1[0]);
#pragma unroll
                for (int r = 1; r < 16; ++r) rm = fmaxf(rm, fmaxf(p0[r], p1[r]));
                rm = fmaxf(rm, __shfl_xor(rm, 32));
                const float mn = fmaxf(m, rm), alpha = __builtin_amdgcn_exp2f((m - mn) * LOG2E), mL = mn * LOG2E; m = mn;
                float ls = 0.f;
#pragma unroll
                for (int r = 0; r < 16; ++r) { p0[r] = __builtin_amdgcn_exp2f(fmaf(p0[r], LOG2E, -mL)); p1[r] = __builtin_amdgcn_exp2f(fmaf(p1[r], LOG2E, -mL)); ls += p0[r] + p1[r]; }
                l = l * alpha + ls;
#pragma unroll
                for (int k = 0; k < 4; ++k)
#pragma unroll
                    for (int r = 0; r < 16; ++r) o[k][r] *= alpha;
                bf16x8 pf[4]; pf[0] = pack8(p0, 0); pf[1] = pack8(p0, 8); pf[2] = pack8(p1, 0); pf[3] = pack8(p1, 8);
                const LAS unsigned char* vbase = Vb + (4 * hi + q4) * VSTR + (16 * g1 + 4 * p4) * 2;
#pragma unroll
                for (int blk = 0; blk < 4; ++blk)
#pragma unroll
                    for (int ks = 0; ks < 4; ++ks) {
                        const s16x4 lo = vtr(vbase + (16 * ks) * VSTR + blk * 64), hh = vtr(vbase + (16 * ks + 8) * VSTR + blk * 64);
                        const bf16x8 vf = (bf16x8){lo[0], lo[1], lo[2], lo[3], hh[0], hh[1], hh[2], hh[3]};
                        o[blk] = __builtin_amdgcn_mfma_f32_32x32x16_bf16(vf, pf[ks], o[blk], 0, 0, 0);
                    }
            }
            if (t + 1 < NT) ATT_STORE((t + 1) & 1);
            __syncthreads();
        }
#undef ATT_LOAD
#undef ATT_STORE
        l += __shfl_xor(l, 32);
        const float inv = 1.0f / l;
        LAS float* cbw = cb + (rb * 32 + r32) * CBS;
        if (comp == 1) {
#pragma unroll
            for (int blk = 0; blk < 4; ++blk)
#pragma unroll
                for (int r = 0; r < 16; ++r) cbw[32 * blk + crow(r, hi)] = o[blk][r] * inv;
        }
        __syncthreads();
        if (comp == 0) {
            float ssq = 0.f;
#pragma unroll
            for (int blk = 0; blk < 4; ++blk)
#pragma unroll
                for (int r = 0; r < 16; ++r) { const float d = o[blk][r] * inv - lam * cbw[32 * blk + crow(r, hi)]; o[blk][r] = d; ssq += d * d; }
            ssq += __shfl_xor(ssq, 32);
            const float rr = (1.0f - lambda_init) / sqrtf(ssq * (1.0f / DV) + SUBLN_EPS);
            bf16* dst = F.MIX + (size_t)qrow * D + h * DV; const float* gp = F.d_hgain + h * DV;
#pragma unroll
            for (int blk = 0; blk < 4; ++blk)
#pragma unroll
                for (int r = 0; r < 16; ++r) { const int dv = 32 * blk + crow(r, hi); dst[dv] = (bf16)f2bf(o[blk][r] * rr * gp[dv]); }
        }
    }
}
struct Args { const float* in[14]; float* out; unsigned char* ws; int ph_lo, ph_hi; };
__global__ void __launch_bounds__(NWAVES * 64, 2) fwd_kernel(Args args) {
    extern __shared__ __attribute__((aligned(16))) unsigned char lds[];
    Frame F;
    F.lds = (LAS unsigned char*)lds;
    F.MISC = (volatile LAS unsigned*)(F.lds + MISC_OFF);
    F.tid = threadIdx.x; F.lane = F.tid & 63; F.wave = __builtin_amdgcn_readfirstlane(F.tid >> 6);
    F.G = gridDim.x; { const int bx = blockIdx.x; F.vcu = (F.G % 8 == 0) ? (bx % 8) * (F.G / 8) + bx / 8 : bx; }
    unsigned char* ws = args.ws; F.ws = ws;
    F.ctl = (gu32*)(ws + WS_CTL);
    F.x = args.in[0]; F.meta = args.in[1]; F.ngain = args.in[2]; F.m_win = args.in[3]; F.m_bgate = args.in[4]; F.m_hgain = args.in[5]; F.m_wout = args.in[6];
    F.d_win = args.in[7]; F.d_lam = args.in[8]; F.d_hgain = args.in[9]; F.d_wout = args.in[10]; F.w_up = args.in[11]; F.w_dn = args.in[12]; F.fgain = args.in[13];
    F.out = args.out;
    F.WIN0 = (bf16*)(ws + WS_WIN0); F.WOUT0 = (bf16*)(ws + WS_WOUT0); F.WUP0 = (bf16*)(ws + WS_WUP0); F.WDN0 = (bf16*)(ws + WS_WDN0);
    F.WIN1 = (bf16*)(ws + WS_WIN1); F.WOUT1 = (bf16*)(ws + WS_WOUT1); F.WUP1 = (bf16*)(ws + WS_WUP1); F.WDN1 = (bf16*)(ws + WS_WDN1);
    F.HB = (bf16*)(ws + WS_HB); F.P = (bf16*)(ws + WS_P); F.MIX = (bf16*)(ws + WS_MIX); F.U = (bf16*)(ws + WS_U);
    F.WG = (float*)(ws + WS_WG); F.HMETA = (float*)(ws + WS_HMETA); F.SS = (float*)(ws + WS_SS); F.GATES = (float*)(ws + WS_GATES);
    for (int u = F.tid; u < (LDS_BYTES - LDSCTL_OFF) / 4; u += NWAVES * 64) ((LAS unsigned*)(F.lds + LDSCTL_OFF))[u] = 0u;
    __syncthreads();
    const int lo = args.ph_lo, hi = args.ph_hi;
    const bool use_bar = (hi - lo) > 1;
    XcdBarrier bar; bar.bar = (unsigned*)(F.ctl + CW_BAR); bar.x = 0; bar.st = nullptr;
    if (use_bar) bar = xcd_barrier_post((unsigned*)(F.ctl + CW_BAR), F.MISC + 8);
#define IN(k) (lo <= (k) && (k) < hi)
#define SEAM(k) do { if (IN(k) && IN((k) + 1)) xcd_barrier(bar); } while (0)
#define GEMM_PHASE(k, EPI, MM, Aptr, Bptr, NN, KK, ...) if (IN(k)) { pg8::Gemm g{Aptr, Bptr, MM, NN, KK}; pg8::StaticOrder S; S.init(MM, NN, F.G, (int)blockIdx.x); \
        EPI E{__VA_ARGS__}; pg8::gemm_phase<EPI, pg8::StaticOrder, PG8_ALIGN, PG8_SP2>(F.lds + RING_OFF, g, S, E); SEAM(k); }
    typedef pg8::EpiScale<0, 1> EpiIn0; typedef pg8::EpiScale<0, 16> EpiIn1; typedef pg8::EpiScale<1, 16> EpiUp;
    if (IN(0)) { p0_prologue(F); SEAM(0); }
    GEMM_PHASE(1, EpiIn0, MROWS, F.HB, F.WIN0, NPROJ, D, F.P, NPROJ, F.SS, EPS)
    if (IN(2)) { mlstm_simple_phase(F); SEAM(2); }
    GEMM_PHASE(3, pg8::EpiRes, MROWS, F.MIX, F.WOUT0, D, D, F.HMETA, F.out, F.HB, F.SS, 1)
    GEMM_PHASE(4, EpiUp, MROWS, F.HB, F.WUP0, FF, D, F.U, FF, F.SS, EPS)
    GEMM_PHASE(5, pg8::EpiRes, MROWS, F.U, F.WDN0, D, FF, F.HMETA, F.out, F.HB, F.SS, 1)
    GEMM_PHASE(6, EpiIn1, MROWS, F.HB, F.WIN1, NPROJ, D, F.P, NPROJ, F.SS, EPS)
#ifdef ATTN_SIMPLE
    if (IN(7)) { attn_simple_phase(F); SEAM(7); }
#else
    if (IN(7)) { attn_mfma_phase(F); SEAM(7); }
#endif
    constexpr int MR = MROWS - META_ROWS;
    GEMM_PHASE(8, pg8::EpiRes, MR, F.MIX + (size_t)META_ROWS * D, F.WOUT1, D, D, F.HMETA, F.out, F.HB + (size_t)META_ROWS * D, F.SS + (size_t)META_ROWS * 16, 0)
    GEMM_PHASE(9, EpiUp, MR, F.HB + (size_t)META_ROWS * D, F.WUP1, FF, D, F.U + (size_t)META_ROWS * FF, FF, F.SS + (size_t)META_ROWS * 16, EPS)
    GEMM_PHASE(10, pg8::EpiRes, MR, F.U + (size_t)META_ROWS * FF, F.WDN1, D, FF, F.HMETA, F.out, (bf16*)nullptr, F.SS + (size_t)META_ROWS * 16, 0)
    if (IN(11)) { final_norm_phase(F); }
#undef IN
#undef SEAM
#undef GEMM_PHASE
}

extern "C" void kernel_launch(void* const* d_in, const int* in_sizes, int n_in, void* d_out, int out_size, void* d_ws, size_t ws_size, hipStream_t stream) {
    static int grid = 0;
    if (grid == 0) {
        if (n_in != 14 || in_sizes[0] != NB * SEQ * D || out_size != NB * SEQ * D || ws_size < WS_END) { fprintf(stderr, "kernel_launch: unexpected shapes (n_in %d, in0 %d, out %d, ws %zu)\n", n_in, n_in > 0 ? in_sizes[0] : -1, out_size, ws_size); grid = -1; return; }
        int dev = 0, cus = 0, per_cu = 0;
        if (hipGetDevice(&dev) != hipSuccess || hipDeviceGetAttribute(&cus, hipDeviceAttributeMultiprocessorCount, dev) != hipSuccess) { grid = -1; return; }
        if (hipFuncSetAttribute((const void*)fwd_kernel, hipFuncAttributeMaxDynamicSharedMemorySize, LDS_BYTES) != hipSuccess) { fprintf(stderr, "kernel_launch: hipFuncSetAttribute failed\n"); grid = -1; return; }
        if (hipOccupancyMaxActiveBlocksPerMultiprocessor(&per_cu, (const void*)fwd_kernel, NWAVES * 64, LDS_BYTES) != hipSuccess || per_cu < 1) { fprintf(stderr, "kernel_launch: occupancy query reports %d blocks per CU\n", per_cu); (void)hipGetLastError(); grid = -1; return; }
        grid = cus;
    }
    if (grid < 0) return;
    if (hipMemsetAsync((char*)d_ws + WS_CTL, 0, CTL_ZERO_BYTES, stream) != hipSuccess) return;
    Args a{};
    for (int i = 0; i < 14; ++i) a.in[i] = (const float*)d_in[i];
    a.out = (float*)d_out; a.ws = (unsigned char*)d_ws;
    if (MK_N_LAUNCHES == 1) { a.ph_lo = 0; a.ph_hi = NPHASE; hipLaunchKernelGGL(fwd_kernel, dim3(grid), dim3(NWAVES * 64), LDS_BYTES, stream, a); }
    else for (int p = 0; p < NPHASE; ++p) { a.ph_lo = p; a.ph_hi = p + 1; hipLaunchKernelGGL(fwd_kernel, dim3(grid), dim3(NWAVES * 64), LDS_BYTES, stream, a); }
}
```

```cpp
#include <hip/hip_runtime.h>
#include <cstdio>
#include <cstdint>
namespace pg8 {
#define PG8_LAS __attribute__((address_space(3)))
typedef unsigned short bf16_t;
typedef short bf16x8 __attribute__((ext_vector_type(8)));
typedef float f32x4 __attribute__((ext_vector_type(4)));
typedef unsigned u32x4 __attribute__((ext_vector_type(4)));
constexpr int BM = 256, BK = 64, HALF = 128, HTB = HALF * BK * 2  , STAGE_BYTES = 8 * HTB, NXCD = 8, WGM = 8;

__host__ __device__ __forceinline__ int lds_byte(int r, int c) { const int st = (r >> 4) * 2 + (c >> 5), rr = r & 15, cc = c & 31, ob = rr * 64 + cc * 2; return st * 1024 + (ob ^ (((ob >> 9) & 1) << 5)); }
__host__ __device__ __forceinline__ void stage_rc(int b, int& R, int& C) { const int st = b / 1024, sb = b % 1024, swz = sb ^ (((sb >> 9) & 1) << 5); R = (st >> 1) * 16 + swz / 64; C = (st & 1) * 32 + (swz % 64) / 2; }
__host__ __device__ __forceinline__ int perm32(int rho) { const int n = rho >> 4, i = rho & 15; return 8 * (i >> 2) + 4 * n + (i & 3); }

struct Unit { int pm, pn; };
struct Gemm { const bf16_t* A; const bf16_t* Bt; int M, N, K; };

struct StaticOrder {
    int nM, nN, nwg, G, c;
    __host__ __device__ void init(int M, int N, int G_, int c_) { nM = M / BM; nN = N / BM; nwg = nM * nN; G = G_; c = c_; }
    __host__ __device__ bool next(int i, Unit& u) const {
        const long L = (long)i * G + c; if (L >= nwg) return false;
        int wgid = (int)L; { const int q = nwg / NXCD, r = nwg % NXCD, xcd = wgid % NXCD, off = wgid / NXCD; wgid = (xcd < r ? xcd * (q + 1) : r * (q + 1) + (xcd - r) * q) + off; }
        const int nig = WGM * nN, gid = wgid / nig, fm = gid * WGM, gsz = (nM - fm) < WGM ? (nM - fm) : WGM;
        u.pm = fm + ((wgid % nig) % gsz); u.pn = (wgid % nig) / gsz; return true;
    }
    __device__ __forceinline__ void a_ready(const Unit&) const {}
    __device__ __forceinline__ void done(const Unit&) const {}
};

__device__ __forceinline__ unsigned cvt_pk_bf16(float lo, float hi) { unsigned r; asm volatile("v_cvt_pk_bf16_f32 %0, %1, %2" : "=v"(r) : "v"(lo), "v"(hi)); return r; }
typedef unsigned u32x2 __attribute__((ext_vector_type(2)));

template <int NS> __device__ __forceinline__ float row_rstd(const float* ss, int row, float eps) {
    const float* sp = ss + (size_t)row * 16; float s;
    if (NS == 1) s = sp[0];
    else { const f32x4 a = *(const f32x4*)sp, b = *(const f32x4*)(sp + 4), c = *(const f32x4*)(sp + 8), d = *(const f32x4*)(sp + 12);
           s = ((a[0] + a[1]) + (a[2] + a[3])) + ((b[0] + b[1]) + (b[2] + b[3])) + ((c[0] + c[1]) + (c[2] + c[3])) + ((d[0] + d[1]) + (d[2] + d[3])); }
    return __builtin_amdgcn_rsqf(s * (1.0f / 1024.0f) + eps);
}
template <int ACT, int NS> struct EpiScale {
    static constexpr bool PERM = true, AFTER_DRAIN = false;
    bf16_t* O; int ldc; const float* ss; float eps;
    __device__ __forceinline__ void operator()(const f32x4 (&acc)[2][2][4][2], const Unit& u, int wr, int wc, int fr, int fq) const {
        const int row0 = u.pm * BM + wr * 64 + fr, col0 = u.pn * BM + wc * 32 + 8 * fq;
#pragma unroll
        for (int ai = 0; ai < 2; ++ai)
#pragma unroll
            for (int m = 0; m < 4; ++m) { const int row = row0 + ai * HALF + m * 16; const float rs = row_rstd<NS>(ss, row, eps);
                bf16_t* rowp = O + (size_t)row * ldc + col0;
#pragma unroll
                for (int bj = 0; bj < 2; ++bj) { f32x4 v0 = acc[ai][bj][m][0] * rs, v1 = acc[ai][bj][m][1] * rs;
                    if (ACT == 1) {
#pragma unroll
                        for (int i = 0; i < 4; ++i) { const float a = fmaxf(v0[i], 0.f), b = fmaxf(v1[i], 0.f); v0[i] = a * a; v1[i] = b * b; } }
                    u32x4 w; w.x = cvt_pk_bf16(v0[0], v0[1]); w.y = cvt_pk_bf16(v0[2], v0[3]); w.z = cvt_pk_bf16(v1[0], v1[1]); w.w = cvt_pk_bf16(v1[2], v1[3]);
                    *(u32x4*)(rowp + bj * HALF) = w; } }
    }
};
struct EpiRes {
    static constexpr bool PERM = false, AFTER_DRAIN = false;
    float* Hm; float* Hr; bf16_t* HB; float* ss; int meta_first;
    __device__ __forceinline__ void operator()(const f32x4 (&acc)[2][2][4][2], const Unit& u, int wr, int wc, int fr, int fq) const {
        const int row0 = u.pm * BM + wr * 64 + fr, col0 = u.pn * BM + wc * 32 + 4 * fq;
#pragma unroll
        for (int ai = 0; ai < 2; ++ai)
#pragma unroll
            for (int m = 0; m < 4; ++m) { const int row = row0 + ai * HALF + m * 16;
                float* hp = (meta_first ? (u.pm == 0 ? Hm + (size_t)row * 1024 : Hr + (size_t)(row - 256) * 1024) : Hr + (size_t)row * 1024) + col0; float q = 0.f;
#pragma unroll
                for (int bj = 0; bj < 2; ++bj)
#pragma unroll
                    for (int n = 0; n < 2; ++n) { const int off = bj * HALF + n * 16; const f32x4 hv = *(const f32x4*)(hp + off) + acc[ai][bj][m][n]; *(f32x4*)(hp + off) = hv;
                        q += (hv[0] * hv[0] + hv[1] * hv[1]) + (hv[2] * hv[2] + hv[3] * hv[3]);
                        if (HB) { u32x2 w; w.x = cvt_pk_bf16(hv[0], hv[1]); w.y = cvt_pk_bf16(hv[2], hv[3]); *(u32x2*)(HB + (size_t)row * 1024 + col0 + off) = w; } }
                q += __shfl_xor(q, 16); q += __shfl_xor(q, 32);
                if (fq == 0) ss[(size_t)row * 16 + u.pn * 4 + wc] = q; }
    }
};

template <class Epi, class Sched, bool ALIGN_EPI = false, bool SP2 = false>
__device__ __forceinline__ void gemm_phase(PG8_LAS unsigned char* lds, const Gemm g, const Sched& S, const Epi& E) {
    const int tid = threadIdx.x, wid = __builtin_amdgcn_readfirstlane(tid >> 6), lane = tid & 63, wr = wid >> 2, wc = wid & 3, fr = lane & 15, fq = lane >> 4;
    const int K = g.K, nt = K / BK;
    unsigned voffA[2], voffB[2];
#pragma unroll
    for (int i = 0; i < 2; ++i) { int R, C; stage_rc(tid * 16 + i * 8192, R, C); const int Rb = Epi::PERM ? ((R & ~31) + perm32(R & 31)) : R;
        voffA[i] = (unsigned)(R * K + C) * 2u; voffB[i] = (unsigned)(Rb * K + C) * 2u; }
    const size_t kstep = (size_t)(BK * 2);
    const size_t hstep = (size_t)HALF * K * 2;
    const size_t tstep = 2 * hstep;
    const unsigned ldsw = (unsigned)wid * 1024u;
    const int aoff = lds_byte(wr * 64 + fr, fq * 8), boff = lds_byte(wc * 32 + fr, fq * 8);
#define PG8_SA(b, h) (((b) * 2 + (h)) * HTB)
#define PG8_SB(b, h) ((4 + (b) * 2 + (h)) * HTB)
#define PG8_STAGE(bufoff, gbase, voff) do { _Pragma("unroll") for (int _i = 0; _i < 2; ++_i) \
        __builtin_amdgcn_global_load_lds((const unsigned*)((const char*)(gbase) + (voff)[_i]), (PG8_LAS unsigned*)(lds + (bufoff) + ldsw + _i * 8192), 16, 0, 0); } while (0)
#define PG8_LDA(dst, b, h) do { _Pragma("unroll") for (int m = 0; m < 4; ++m) _Pragma("unroll") for (int k = 0; k < 2; ++k) dst[m][k] = *(const PG8_LAS bf16x8*)(lds + PG8_SA(b, h) + aoff + m * 2048 + k * 1024); } while (0)
#define PG8_LDB(dst, b, h) do { _Pragma("unroll") for (int n = 0; n < 2; ++n) _Pragma("unroll") for (int k = 0; k < 2; ++k) dst[n][k] = *(const PG8_LAS bf16x8*)(lds + PG8_SB(b, h) + boff + n * 2048 + k * 1024); } while (0)
#define PG8_MMA(ai, bj, At, Bt) do { __builtin_amdgcn_s_setprio(1); _Pragma("unroll") for (int m = 0; m < 4; ++m) _Pragma("unroll") for (int n = 0; n < 2; ++n) _Pragma("unroll") for (int k = 0; k < 2; ++k) \
        acc[ai][bj][m][n] = __builtin_amdgcn_mfma_f32_16x16x32_bf16(Bt[n][k], At[m][k], acc[ai][bj][m][n], 0, 0, 0); __builtin_amdgcn_s_setprio(0); } while (0)
#define PG8_WAIT_V(n) asm volatile("s_waitcnt vmcnt(" #n ")" ::: "memory")
#define PG8_WAIT_L(n) asm volatile("s_waitcnt lgkmcnt(" #n ")" ::: "memory")
#define PG8_BAR __builtin_amdgcn_s_barrier()
#define PG8_SCHED __builtin_amdgcn_sched_barrier(0)
    Unit cur, nxt; int ui = 0;
    if (!S.next(0, cur)) return;
    f32x4 acc[2][2][4][2];
#pragma unroll
    for (int a = 0; a < 2; ++a)
#pragma unroll
        for (int b = 0; b < 2; ++b)
#pragma unroll
            for (int m = 0; m < 4; ++m)
#pragma unroll
                for (int n = 0; n < 2; ++n) acc[a][b][m][n] = (f32x4){0.f, 0.f, 0.f, 0.f};
    bf16x8 At[4][2], B0[2][2], B1[2][2];
    const char* cA = (const char*)g.A + (size_t)cur.pm * tstep; const char* cB = (const char*)g.Bt + (size_t)cur.pn * tstep;
    S.a_ready(cur);
    if constexpr (SP2) {
        PG8_STAGE(PG8_SB(0, 0), cB, voffB); PG8_STAGE(PG8_SB(0, 1), cB + hstep, voffB); PG8_STAGE(PG8_SA(0, 0), cA, voffA); PG8_STAGE(PG8_SA(0, 1), cA + hstep, voffA);
        if (wr == 1) PG8_BAR;
        PG8_WAIT_V(2); PG8_BAR;
        PG8_STAGE(PG8_SB(1, 0), cB + kstep, voffB); PG8_STAGE(PG8_SA(1, 0), cA + kstep, voffA); PG8_STAGE(PG8_SB(1, 1), cB + hstep + kstep, voffB);
        PG8_WAIT_V(6); PG8_BAR;
    } else {
        PG8_STAGE(PG8_SB(0, 0), cB, voffB); PG8_STAGE(PG8_SA(0, 0), cA, voffA); PG8_STAGE(PG8_SB(0, 1), cB + hstep, voffB); PG8_STAGE(PG8_SA(0, 1), cA + hstep, voffA);
        if (wr == 1) PG8_BAR;
        PG8_WAIT_V(4); PG8_BAR;
        PG8_STAGE(PG8_SB(1, 0), cB + kstep, voffB); PG8_STAGE(PG8_SA(1, 0), cA + kstep, voffA); PG8_STAGE(PG8_SB(1, 1), cB + hstep + kstep, voffB);
        PG8_WAIT_V(6); PG8_BAR;
    }
    for (;;) {
        const bool has_next = S.next(ui + 1, nxt);
        const char* nA = has_next ? (const char*)g.A + (size_t)nxt.pm * tstep : cA; const char* nB = has_next ? (const char*)g.Bt + (size_t)nxt.pn * tstep : cB;
        for (int t = 0; t < nt; t += 2) {
            const bool last = (t == nt - 2);
            const char* a1 = cA + (size_t)(t + 1) * kstep;
            const char* a2 = last ? nA : cA + (size_t)(t + 2) * kstep; const char* b2 = last ? nB : cB + (size_t)(t + 2) * kstep;
            const char* a3 = a2 + kstep; const char* b3 = b2 + kstep;
            if (last && has_next) S.a_ready(nxt);
            if constexpr (SP2) {
            PG8_LDB(B0, 0, 0); PG8_LDB(B1, 0, 1); PG8_SCHED; PG8_LDA(At, 0, 0); PG8_STAGE(PG8_SA(1, 1), a1 + hstep, voffA);
            PG8_WAIT_V(8); PG8_WAIT_L(0); PG8_BAR; PG8_MMA(0, 0, At, B0); PG8_MMA(0, 1, At, B1); PG8_BAR; PG8_SCHED;
            PG8_LDA(At, 0, 1); PG8_STAGE(PG8_SB(0, 0), b2, voffB); PG8_STAGE(PG8_SB(0, 1), b2 + hstep, voffB); PG8_STAGE(PG8_SA(0, 0), a2, voffA);
            PG8_WAIT_V(8); PG8_WAIT_L(0); PG8_BAR; PG8_MMA(1, 0, At, B0); PG8_MMA(1, 1, At, B1); PG8_BAR; PG8_SCHED;
            PG8_LDB(B0, 1, 0); PG8_LDB(B1, 1, 1); PG8_SCHED; PG8_LDA(At, 1, 0); PG8_STAGE(PG8_SA(0, 1), a2 + hstep, voffA);
            PG8_WAIT_V(8); PG8_WAIT_L(0); PG8_BAR; PG8_MMA(0, 0, At, B0); PG8_MMA(0, 1, At, B1); PG8_BAR; PG8_SCHED;
            PG8_LDA(At, 1, 1); PG8_STAGE(PG8_SB(1, 0), b3, voffB); PG8_STAGE(PG8_SB(1, 1), b3 + hstep, voffB); PG8_STAGE(PG8_SA(1, 0), a3, voffA);
            PG8_WAIT_V(8); PG8_WAIT_L(0); PG8_BAR; PG8_MMA(1, 0, At, B0); PG8_MMA(1, 1, At, B1); PG8_BAR; PG8_SCHED;
            } else {
            PG8_LDB(B0, 0, 0); PG8_SCHED; PG8_LDA(At, 0, 0); PG8_STAGE(PG8_SA(1, 1), a1 + hstep, voffA);
            PG8_WAIT_L(8); PG8_BAR; PG8_WAIT_L(0); PG8_MMA(0, 0, At, B0); PG8_BAR; PG8_SCHED;
            PG8_LDB(B1, 0, 1); PG8_STAGE(PG8_SB(0, 0), b2, voffB);
            PG8_BAR; PG8_WAIT_L(0); PG8_MMA(0, 1, At, B1); PG8_BAR;
            PG8_LDA(At, 0, 1); PG8_STAGE(PG8_SA(0, 0), a2, voffA);
            PG8_BAR; PG8_WAIT_L(0); PG8_MMA(1, 0, At, B0); PG8_BAR; PG8_SCHED;
            PG8_STAGE(PG8_SB(0, 1), b2 + hstep, voffB);
            PG8_WAIT_V(6); PG8_BAR; PG8_MMA(1, 1, At, B1); PG8_BAR;
            PG8_LDB(B0, 1, 0); PG8_SCHED; PG8_LDA(At, 1, 0); PG8_STAGE(PG8_SA(0, 1), a2 + hstep, voffA);
            PG8_WAIT_L(8); PG8_BAR; PG8_WAIT_L(0); PG8_MMA(0, 0, At, B0); PG8_BAR; PG8_SCHED;
            PG8_LDB(B1, 1, 1); PG8_STAGE(PG8_SB(1, 0), b3, voffB);
            PG8_BAR; PG8_WAIT_L(0); PG8_MMA(0, 1, At, B1); PG8_BAR;
            PG8_LDA(At, 1, 1); PG8_STAGE(PG8_SA(1, 0), a3, voffA);
            PG8_BAR; PG8_WAIT_L(0); PG8_MMA(1, 0, At, B0); PG8_BAR; PG8_SCHED;
            PG8_STAGE(PG8_SB(1, 1), b3 + hstep, voffB);
            PG8_WAIT_V(6); PG8_BAR; PG8_MMA(1, 1, At, B1); PG8_BAR;
            }
        }
        if constexpr (ALIGN_EPI) { if (wr == 0) PG8_BAR; }
        if constexpr (!Epi::AFTER_DRAIN) { E(acc, cur, wr, wc, fr, fq); S.done(cur); }
        if (!has_next) break;
#pragma unroll
        for (int a = 0; a < 2; ++a)
#pragma unroll
            for (int b = 0; b < 2; ++b)
#pragma unroll
                for (int m = 0; m < 4; ++m)
#pragma unroll
                    for (int n = 0; n < 2; ++n) acc[a][b][m][n] = (f32x4){0.f, 0.f, 0.f, 0.f};
        cur = nxt; cA = nA; cB = nB; ++ui;
        if constexpr (ALIGN_EPI) { if (wr == 1) PG8_BAR; }
    }
    PG8_WAIT_V(0);
    if constexpr (!ALIGN_EPI) { if (wr == 0) PG8_BAR; }
    PG8_BAR;
    if constexpr (Epi::AFTER_DRAIN) { E.fused(acc, cur, wr, wc, fr, fq, lds, wid, lane); S.done(cur); }
#undef PG8_SA
#undef PG8_SB
#undef PG8_STAGE
#undef PG8_LDA
#undef PG8_LDB
#undef PG8_MMA
#undef PG8_WAIT_V
#undef PG8_WAIT_L
#undef PG8_BAR
#undef PG8_SCHED
}
}

#ifndef PG8_SP2
#define PG8_SP2 true
#endif
#ifndef PG8_ALIGN
#define PG8_ALIGN true
#endif
constexpr int NB = 16, SEQ = 2048, NMETA = 16, D = 1024, FF = 4096;
constexpr int MROWS = NB * (SEQ + NMETA);
constexpr int META_ROWS = NB * NMETA;
constexpr int NH = 8, DQK = 64, DV = 128;
constexpr int NPROJ = 3072;
constexpr float EPS = 1e-6f, SUBLN_EPS = 1e-5f;
constexpr int NWAVES = 8;
#ifndef MK_N_LAUNCHES
#define MK_N_LAUNCHES 1
#endif
constexpr int NPHASE = 12;

constexpr size_t MiB = 1u << 20;
constexpr size_t WS_CTL = 0, CTL_ZERO_BYTES = 1 * MiB;
constexpr size_t WS_WIN0 = 1 * MiB, WS_WOUT0 = 7 * MiB, WS_WUP0 = 9 * MiB, WS_WDN0 = 17 * MiB;
constexpr size_t WS_WIN1 = 25 * MiB, WS_WOUT1 = 31 * MiB, WS_WUP1 = 33 * MiB, WS_WDN1 = 41 * MiB;
constexpr size_t WS_WG = 49 * MiB;
constexpr size_t WS_HMETA = 50 * MiB;
constexpr size_t WS_SS = 51 * MiB;
constexpr size_t WS_GATES = 54 * MiB;
constexpr size_t WS_HB = 57 * MiB;
constexpr size_t WS_P = 122 * MiB;
constexpr size_t WS_MIX = WS_P + (size_t)MROWS * NPROJ * 2;
constexpr size_t WS_U = WS_P;
constexpr size_t WS_END = WS_MIX + (size_t)MROWS * D * 2;
static_assert(WS_HB + (size_t)MROWS * D * 2 <= WS_P && WS_U + (size_t)MROWS * FF * 2 <= WS_END && WS_SS + (size_t)MROWS * 64 <= WS_GATES && WS_GATES + (size_t)MROWS * 64 <= WS_HB, "d_ws map");
constexpr int CW_BAR = 4096;

constexpr int RING_OFF = 0, RING_BYTES = 131072;
constexpr int LDSCTL_OFF = RING_BYTES, MISC_OFF = LDSCTL_OFF + 320;
constexpr int LDS_BYTES = 147456;

#define GAS __attribute__((address_space(1)))
#define LAS __attribute__((address_space(3)))
typedef unsigned short bf16;
typedef unsigned v4u __attribute__((ext_vector_type(4)));
typedef float f32x4 __attribute__((ext_vector_type(4)));
typedef GAS unsigned gu32;
#define RLX_AGENT __ATOMIC_RELAXED, __HIP_MEMORY_SCOPE_AGENT
#define LDS_WAIT() asm volatile("s_waitcnt lgkmcnt(0)" ::: "memory")
__device__ __forceinline__ unsigned f2bf(float f) { unsigned u = __builtin_bit_cast(unsigned, f); return (u + 0x7fffu + ((u >> 16) & 1u)) >> 16; }
__device__ __forceinline__ unsigned pk2(float lo, float hi) { return f2bf(lo) | (f2bf(hi) << 16); }
__device__ __forceinline__ float bf2f(unsigned short v) { return __builtin_bit_cast(float, (unsigned)v << 16); }
__device__ __forceinline__ float bflo(unsigned w) { return __builtin_bit_cast(float, w << 16); }
__device__ __forceinline__ float bfhi(unsigned w) { return __builtin_bit_cast(float, w & 0xffff0000u); }

#define XB_TMO      128
#define XB_XCNT(j)  (256  + 64 * (j))
#define XB_XSUB(j)  (1280 + 64 * (j))
#define XB_XGEN(j)  (2304 + 64 * (j))
#define XB_TOP      3328
#define XB_TOPGEN   3392
#define XCD_BAR_WORDS 3456
#define XB_SPIN_CAP (1u << 18)
__device__ __forceinline__ unsigned xb_ld(unsigned* p)              { return __hip_atomic_load(p, __ATOMIC_RELAXED, __HIP_MEMORY_SCOPE_AGENT); }
__device__ __forceinline__ unsigned xb_add(unsigned* p, unsigned v) { return __hip_atomic_fetch_add(p, v, __ATOMIC_RELAXED, __HIP_MEMORY_SCOPE_AGENT); }
__device__ __forceinline__ unsigned xb_xcc_id() { return (unsigned)__builtin_amdgcn_s_getreg((3 << 11) | 20) & 0xFu; }
#define XB_SPIN(cond, bar) do { unsigned _sp = 0; while (cond) { __builtin_amdgcn_s_sleep(1); \
    if ((++_sp & 255u) == 0u) { if (xb_ld(&(bar)[XB_TMO])) break; if (_sp > XB_SPIN_CAP) { atomicAdd(&(bar)[XB_TMO], 1u); break; } } } } while (0)
struct XcdBarrier { unsigned* bar; unsigned x; volatile LAS unsigned* st; };
__device__ __forceinline__ XcdBarrier xcd_barrier_post(unsigned* bar, volatile LAS unsigned* st) {
    XcdBarrier b; b.bar = bar; b.x = xb_xcc_id(); b.st = st;
    if (threadIdx.x == 0) (void)xb_add(&bar[XB_XCNT(b.x)], 1u);
    return b;
}
__device__ __forceinline__ void xcd_barrier_complete(unsigned* bar, unsigned x, unsigned& nloc, unsigned& nx) {
    const unsigned G = gridDim.x * gridDim.y * gridDim.z;
    unsigned sum, cnt, mine, sp = 0u;
    for (;;) {
        sum = 0u; cnt = 0u; mine = 0u;
#pragma unroll
        for (unsigned j = 0; j < 16; ++j) { const unsigned c = xb_ld(&bar[XB_XCNT(j)]); sum += c; cnt += (c > 0u) ? 1u : 0u; mine = (j == x) ? c : mine; }
        if (sum == G) break;
        __builtin_amdgcn_s_sleep(1);
        if ((++sp & 255u) == 0u) { if (xb_ld(&bar[XB_TMO])) break; if (sp > XB_SPIN_CAP) { atomicAdd(&bar[XB_TMO], 1u); break; } }
    }
    nloc = mine > 0u ? mine : 1u; nx = cnt > 0u ? cnt : 1u;
}
__device__ __forceinline__ void xcd_barrier(const XcdBarrier& b) {
    asm volatile("s_waitcnt vmcnt(0)" ::: "memory");
    __syncthreads();
    if (threadIdx.x == 0) {
        unsigned* bar = b.bar;
        __builtin_amdgcn_s_waitcnt(0);
        unsigned nloc = b.st[0], nx = b.st[1];
        if (nloc == 0u) { xcd_barrier_complete(bar, b.x, nloc, nx); b.st[0] = nloc; b.st[1] = nx; }
        const unsigned old = xb_add(&bar[XB_XSUB(b.x)], 1u);
        const unsigned gen = old / nloc;
        if (old + 1u == (gen + 1u) * nloc) {
            __builtin_amdgcn_fence(__ATOMIC_RELEASE, "agent");
            asm volatile("s_waitcnt vmcnt(0)" ::: "memory");
            const unsigned og = xb_add(&bar[XB_TOP], 1u);
            const unsigned tg = og / nx;
            if (og + 1u == (tg + 1u) * nx) xb_add(&bar[XB_TOPGEN], 1u);
            else XB_SPIN(xb_ld(&bar[XB_TOPGEN]) == tg, bar);
            __builtin_amdgcn_fence(__ATOMIC_ACQUIRE, "agent");
            xb_add(&bar[XB_XGEN(b.x)], 1u);
            asm volatile("s_waitcnt vmcnt(0)" ::: "memory");
        } else {
            XB_SPIN(xb_ld(&bar[XB_XGEN(b.x)]) == gen, bar);
            __builtin_amdgcn_fence(__ATOMIC_ACQUIRE, "agent");
            asm volatile("s_waitcnt vmcnt(0)" ::: "memory");
        }
    }
    __syncthreads();
}

struct Frame {
    LAS unsigned char* lds;
    volatile LAS unsigned* MISC;
    gu32* ctl;
    int tid, lane, wave, vcu, G;
    const float *x, *meta, *ngain, *m_win, *m_bgate, *m_hgain, *m_wout, *d_win, *d_lam, *d_hgain, *d_wout, *w_up, *w_dn, *fgain;
    float* out; unsigned char* ws;
    bf16 *WIN0, *WOUT0, *WUP0, *WDN0, *WIN1, *WOUT1, *WUP1, *WDN1, *HB, *P, *MIX, *U;
    float *WG, *HMETA, *SS, *GATES;
};
__device__ __forceinline__ float wave_sum(float v) {
#pragma unroll
    for (int o = 1; o < 64; o <<= 1) v += __shfl_xor(v, o);
    return v;
}
__device__ __forceinline__ void p0_transpose_item(const float* W, int K, int ldw, int Nuse, const float* gk, int nscale, bf16* WT, LAS float* scr, int item, int lane) {
    const int nblk = Nuse / 32, kb = item / nblk, nb = item % nblk, k0 = 64 * kb, n0 = 32 * nb;
    const float cs = (n0 < nscale) ? 0.125f : 1.f;
#pragma unroll 8
    for (int i = 0; i < 32; ++i) { const int kk = 2 * i + (lane >> 5); const float g = gk ? gk[k0 + kk] * cs : cs; scr[kk * 33 + (lane & 31)] = W[(size_t)(k0 + kk) * ldw + n0 + (lane & 31)] * g; }
    LDS_WAIT(); asm volatile("" ::: "memory");
    const int c = lane & 7;
#pragma unroll
    for (int j = 0; j < 4; ++j) { const int n = (lane >> 3) + 8 * j; const LAS float* s = scr + (8 * c) * 33 + n;
        v4u o; o.x = pk2(s[0 * 33], s[1 * 33]); o.y = pk2(s[2 * 33], s[3 * 33]); o.z = pk2(s[4 * 33], s[5 * 33]); o.w = pk2(s[6 * 33], s[7 * 33]);
        *(GAS v4u*)(WT + (size_t)(n0 + n) * K + k0 + 8 * c) = o; }
    LDS_WAIT(); asm volatile("" ::: "memory");
}
__device__ __forceinline__ void p0_prologue(Frame& F) {
    LAS float* scr = (LAS float*)(F.lds + RING_OFF + F.wave * 16384);
    const int gw = F.vcu * NWAVES + F.wave, NGW = F.G * NWAVES;
    constexpr int I_IN = (D / 64) * (NPROJ / 32), I_OUT = (D / 64) * (D / 32), I_UP = (D / 64) * (FF / 32), I_DN = (FF / 64) * (D / 32);
    constexpr int I_LAYER = I_IN + I_OUT + I_UP + I_DN, NITEMS = 2 * I_LAYER;
    for (int it = gw; it < NITEMS; it += NGW) {
        const int layer = it / I_LAYER; int r = it % I_LAYER;
        const float* g0 = F.ngain + (layer * 2 + 0) * D; const float* g1 = F.ngain + (layer * 2 + 1) * D;
        if (r < I_IN) { if (layer == 0) p0_transpose_item(F.m_win, D, 3088, NPROJ, g0, 512, F.WIN0, scr, r, F.lane); else p0_transpose_item(F.d_win, D, NPROJ, NPROJ, g0, 1024, F.WIN1, scr, r, F.lane); continue; } r -= I_IN;
        if (r < I_OUT) { p0_transpose_item(layer == 0 ? F.m_wout : F.d_wout, D, D, D, nullptr, 0, layer == 0 ? F.WOUT0 : F.WOUT1, scr, r, F.lane); continue; } r -= I_OUT;
        if (r < I_UP) { p0_transpose_item(F.w_up + (size_t)layer * D * FF, D, FF, FF, g1, 0, layer == 0 ? F.WUP0 : F.WUP1, scr, r, F.lane); continue; } r -= I_UP;
        p0_transpose_item(F.w_dn + (size_t)layer * FF * D, FF, D, D, nullptr, 0, layer == 0 ? F.WDN0 : F.WDN1, scr, r, F.lane);
    }
    __syncthreads();
    LAS float* wg = (LAS float*)(F.lds + RING_OFF);
    for (int i = F.tid; i < 16 * D; i += NWAVES * 64) { const int k = i >> 4, j = i & 15; wg[j * D + k] = F.m_win[(size_t)k * 3088 + NPROJ + j] * F.ngain[k]; }
    __syncthreads();
    for (int row = gw; row < MROWS; row += NGW) {
        const float* src = row < META_ROWS ? F.meta + (size_t)(row & 15) * D : F.x + (size_t)(row - META_ROWS) * D;
        float* dst = row < META_ROWS ? F.HMETA + (size_t)row * D : F.out + (size_t)(row - META_ROWS) * D;
        f32x4 v[4]; float s = 0.f;
#pragma unroll
        for (int j = 0; j < 4; ++j) { v[j] = ((const GAS f32x4*)src)[64 * j + F.lane]; s += (v[j].x * v[j].x + v[j].y * v[j].y) + (v[j].z * v[j].z + v[j].w * v[j].w); }
        s = wave_sum(s);
        const float rstd = 1.0f / sqrtf(s * (1.0f / D) + EPS);
#pragma unroll
        for (int j = 0; j < 4; ++j) { ((GAS f32x4*)dst)[64 * j + F.lane] = v[j];
            ((GAS unsigned long long*)(F.HB + (size_t)row * D))[64 * j + F.lane] = (unsigned long long)pk2(v[j].x, v[j].y) | ((unsigned long long)pk2(v[j].z, v[j].w) << 32); }
        if (F.lane == 0) F.SS[(size_t)row * 16] = s;
        float keep = 0.f;
#pragma unroll 4
        for (int g = 0; g < 16; ++g) { float p = 0.f;
#pragma unroll
            for (int j = 0; j < 4; ++j) { const f32x4 w = *(const LAS f32x4*)(wg + g * D + 256 * j + 4 * F.lane); p += (v[j].x * w.x + v[j].y * w.y) + (v[j].z * w.z + v[j].w * w.w); }
            p = wave_sum(p); if (F.lane == g) keep = p; }
        if (F.lane < 16) F.GATES[(size_t)row * 16 + F.lane] = keep * rstd + F.m_bgate[F.lane];
    }
}

__device__ __forceinline__ void mlstm_simple_phase(Frame& F) {
    LAS bf16* qs = (LAS bf16*)(F.lds);
    LAS bf16* ks = qs + 64 * 64;
    LAS bf16* vs = ks + 64 * 64;
    LAS bf16* os = vs + 64 * 128;
    LAS float* lfs = (LAS float*)(os + 64 * 128);
    LAS float* igs = lfs + 64;
    LAS float* red = igs + 64;
    LAS float* hbuf = red + 2 * 4 * 132;
    const int tid = F.tid, e = tid & 127, dq = tid >> 7;
    for (int unit = blockIdx.x; unit < NB * NH; unit += F.G) {
        const int b = unit >> 3, h = unit & 7;
        float C[16], nn[16]; float m = 0.f;
#pragma unroll
        for (int i = 0; i < 16; ++i) { C[i] = 0.f; nn[i] = 0.f; }
        for (int seg = 0; seg <= 32; ++seg) {
            const int nrows = seg == 0 ? 16 : 64; const int row0 = seg == 0 ? b * 16 : META_ROWS + b * SEQ + (seg - 1) * 64;
            __syncthreads();
            for (int i = tid; i < nrows * 8; i += 512) { const int r = i >> 3, c8 = i & 7; const bf16* src = F.P + (size_t)(row0 + r) * NPROJ + h * 64 + c8 * 8;
                *(LAS v4u*)(qs + r * 64 + c8 * 8) = *(const GAS v4u*)src; *(LAS v4u*)(ks + r * 64 + c8 * 8) = *(const GAS v4u*)(src + 512); }
            for (int i = tid; i < nrows * 16; i += 512) { const int r = i >> 4, c8 = i & 15; const bf16* src = F.P + (size_t)(row0 + r) * NPROJ + 1024 + h * 128 + c8 * 8;
                *(LAS v4u*)(vs + r * 128 + c8 * 8) = *(const GAS v4u*)src; *(LAS v4u*)(os + r * 128 + c8 * 8) = *(const GAS v4u*)(src + 1024); }
            if (tid < nrows) { const float ig = F.GATES[(size_t)(row0 + tid) * 16 + h], fg = F.GATES[(size_t)(row0 + tid) * 16 + 8 + h];
                lfs[tid] = fminf(fg, 0.f) - log1pf(expf(-fabsf(fg))); igs[tid] = ig; }
            __syncthreads();
            for (int s = 0; s < nrows; ++s) {
                const float lf = lfs[s], ig = igs[s]; const float mn = fmaxf(lf + m, ig); const float fdec = expf(lf + m - mn), iw = expf(ig - mn); m = mn;
                const float ve = bf2f(vs[s * 128 + e]); float pnum = 0.f, pden = 0.f;
#pragma unroll
                for (int dd = 0; dd < 16; ++dd) { const int d = dq * 16 + dd; const float kd = iw * bf2f(ks[s * 64 + d]), qd = bf2f(qs[s * 64 + d]);
                    C[dd] = fdec * C[dd] + kd * ve; nn[dd] = fdec * nn[dd] + kd; pnum += C[dd] * qd; pden += nn[dd] * qd; }
                LAS float* rb = red + (s & 1) * 4 * 132;
                rb[dq * 132 + e] = pnum; if (e == 0) rb[dq * 132 + 128] = pden;
                __syncthreads();
                if (dq == 0) { const float num = (rb[e] + rb[132 + e]) + (rb[264 + e] + rb[396 + e]); const float den = (rb[128] + rb[132 + 128]) + (rb[264 + 128] + rb[396 + 128]);
                    hbuf[s * 128 + e] = num / fmaxf(fabsf(den), expf(-m)); }
            }
            __syncthreads();
            for (int s = F.wave; s < nrows; s += NWAVES) {
                const float a0 = hbuf[s * 128 + F.lane], a1 = hbuf[s * 128 + 64 + F.lane];
                const float r = 1.0f / sqrtf(wave_sum(a0 * a0 + a1 * a1) * (1.0f / DV) + EPS);
                const float o0 = bf2f(os[s * 128 + F.lane]), o1 = bf2f(os[s * 128 + 64 + F.lane]);
                const float g0 = F.m_hgain[h * DV + F.lane], g1 = F.m_hgain[h * DV + 64 + F.lane];
                bf16* dst = F.MIX + (size_t)(row0 + s) * D + h * DV;
                dst[F.lane] = (bf16)f2bf(a0 * r * g0 / (1.0f + expf(-o0))); dst[64 + F.lane] = (bf16)f2bf(a1 * r * g1 / (1.0f + expf(-o1)));
            }
        }
    }
}

__device__ __forceinline__ void attn_simple_phase(Frame& F) {
    LAS bf16* Ks = (LAS bf16*)(F.lds);
    LAS bf16* Vs = Ks + 64 * 128;
    LAS float* ob = (LAS float*)(Vs + 64 * 128);
    LAS float* ssb = ob + 64 * 2 * 128;
    const int tid = F.tid, qi = tid & 63, comp = (tid >> 6) & 1, vq = tid >> 7;
    const float lambda_init = 0.8f - 0.6f * expf(-0.3f * 1.0f);
    float lam; { float s01 = 0.f, s23 = 0.f; for (int i = 0; i < 64; ++i) { s01 += F.d_lam[i] * F.d_lam[64 + i]; s23 += F.d_lam[128 + i] * F.d_lam[192 + i]; } lam = expf(s01) - expf(s23) + lambda_init; }
    for (int u = blockIdx.x; u < NB * NH * 33; u += F.G) {
        const int c = 32 - u / (NB * NH), bh = u % (NB * NH), b = bh >> 3, h = bh & 7;
        const int nq = c == 0 ? 16 : 64; const int qrow0 = c == 0 ? b * 16 : META_ROWS + b * SEQ + (c - 1) * 64;
        float q[64];
        { const bf16* qp = F.P + (size_t)(qrow0 + (qi < nq ? qi : 0)) * NPROJ + h * 128 + comp * 64;
#pragma unroll
          for (int i = 0; i < 8; ++i) { const v4u w = *(const GAS v4u*)(qp + 8 * i); q[8 * i] = bflo(w.x); q[8 * i + 1] = bfhi(w.x); q[8 * i + 2] = bflo(w.y); q[8 * i + 3] = bfhi(w.y); q[8 * i + 4] = bflo(w.z); q[8 * i + 5] = bfhi(w.z); q[8 * i + 6] = bflo(w.w); q[8 * i + 7] = bfhi(w.w); } }
        float acc[32]; float m = -INFINITY, l = 0.f;
#pragma unroll
        for (int i = 0; i < 32; ++i) acc[i] = 0.f;
        for (int t = 0; t <= c; ++t) {
            const int nk = t == 0 ? 16 : 64; const int krow0 = t == 0 ? b * 16 : META_ROWS + b * SEQ + (t - 1) * 64;
            __syncthreads();
            for (int i = tid; i < nk * 16; i += 512) { const int r = i >> 4, c8 = i & 15; const bf16* src = F.P + (size_t)(krow0 + r) * NPROJ + 1024 + h * 128 + c8 * 8;
                *(LAS v4u*)(Ks + r * 128 + c8 * 8) = *(const GAS v4u*)src; *(LAS v4u*)(Vs + r * 128 + c8 * 8) = *(const GAS v4u*)(src + 1024); }
            __syncthreads();
            for (int j = 0; j < nk; ++j) {
                const LAS v4u* kp = (const LAS v4u*)(Ks + j * 128 + comp * 64); float s = 0.f;
#pragma unroll
                for (int i = 0; i < 8; ++i) { const v4u w = kp[i]; s += q[8 * i] * bflo(w.x) + q[8 * i + 1] * bfhi(w.x) + q[8 * i + 2] * bflo(w.y) + q[8 * i + 3] * bfhi(w.y) + q[8 * i + 4] * bflo(w.z) + q[8 * i + 5] * bfhi(w.z) + q[8 * i + 6] * bflo(w.w) + q[8 * i + 7] * bfhi(w.w); }
                const float mn = fmaxf(m, s), sc = expf(m - mn), p = expf(s - mn); l = l * sc + p; m = mn;
                const LAS v4u* vp = (const LAS v4u*)(Vs + j * 128 + vq * 32);
#pragma unroll
                for (int i = 0; i < 4; ++i) { const v4u w = vp[i];
                    acc[8 * i] = acc[8 * i] * sc + p * bflo(w.x); acc[8 * i + 1] = acc[8 * i + 1] * sc + p * bfhi(w.x); acc[8 * i + 2] = acc[8 * i + 2] * sc + p * bflo(w.y); acc[8 * i + 3] = acc[8 * i + 3] * sc + p * bfhi(w.y);
                    acc[8 * i + 4] = acc[8 * i + 4] * sc + p * bflo(w.z); acc[8 * i + 5] = acc[8 * i + 5] * sc + p * bfhi(w.z); acc[8 * i + 6] = acc[8 * i + 6] * sc + p * bflo(w.w); acc[8 * i + 7] = acc[8 * i + 7] * sc + p * bfhi(w.w); }
            }
        }
        __syncthreads();
        { const float il = 1.0f / l;
#pragma unroll
          for (int i = 0; i < 32; ++i) ob[(qi * 2 + comp) * 128 + vq * 32 + i] = acc[i] * il; }
        __syncthreads();
        const int part = tid >> 6; float dvv[16]; float sq = 0.f;
#pragma unroll
        for (int i = 0; i < 16; ++i) { const int e = part * 16 + i; dvv[i] = ob[(qi * 2 + 0) * 128 + e] - lam * ob[(qi * 2 + 1) * 128 + e]; sq += dvv[i] * dvv[i]; }
        ssb[part * 64 + qi] = sq;
        __syncthreads();
        float tot = 0.f;
#pragma unroll
        for (int i = 0; i < 8; ++i) tot += ssb[i * 64 + qi];
        const float r = (1.0f - lambda_init) / sqrtf(tot * (1.0f / DV) + SUBLN_EPS);
        if (qi < nq) { bf16* dst = F.MIX + (size_t)(qrow0 + qi) * D + h * DV + part * 16; unsigned w[8];
#pragma unroll
            for (int i = 0; i < 8; ++i) w[i] = pk2(dvv[2 * i] * r * F.d_hgain[h * DV + part * 16 + 2 * i], dvv[2 * i + 1] * r * F.d_hgain[h * DV + part * 16 + 2 * i + 1]);
            *(GAS v4u*)dst = (v4u){w[0], w[1], w[2], w[3]}; *(GAS v4u*)(dst + 8) = (v4u){w[4], w[5], w[6], w[7]}; }
    }
}

__device__ __forceinline__ void final_norm_phase(Frame& F) {
    const int gw = F.vcu * NWAVES + F.wave, NGW = F.G * NWAVES;
    for (int row = META_ROWS + gw; row < MROWS; row += NGW) {
        const float rs = pg8::row_rstd<16>(F.SS, row, EPS);
        GAS f32x4* p = (GAS f32x4*)(F.out + (size_t)(row - META_ROWS) * D);
#pragma unroll
        for (int j = 0; j < 4; ++j) { f32x4 v = p[64 * j + F.lane]; const f32x4 g = ((const GAS f32x4*)F.fgain)[64 * j + F.lane]; v = v * rs * g; p[64 * j + F.lane] = v; }
    }
}
namespace attn2 {
typedef short bf16x8 __attribute__((ext_vector_type(8)));
typedef short s16x4 __attribute__((ext_vector_type(4)));
typedef float f32x16 __attribute__((ext_vector_type(16)));
constexpr int KSTR = 272, VSTR = 320, KBYTES = 64 * KSTR, VBYTES = 64 * VSTR, BUFB = KBYTES + VBYTES;
constexpr int CBS = 129;
constexpr float LOG2E = 1.4426950408889634f;
__device__ __forceinline__ int crow(int r, int hi) { return (r & 3) + 8 * (r >> 2) + 4 * hi; }
__device__ __forceinline__ s16x4 vtr(const LAS unsigned char* p) { return __builtin_bit_cast(s16x4, __builtin_amdgcn_ds_read_tr16_b64_v4i16((LAS s16x4*)p)); }
__device__ __forceinline__ bf16x8 pack8(const f32x16& p, int b0) {
    v4u w; w.x = pg8::cvt_pk_bf16(p[b0], p[b0 + 1]); w.y = pg8::cvt_pk_bf16(p[b0 + 2], p[b0 + 3]); w.z = pg8::cvt_pk_bf16(p[b0 + 4], p[b0 + 5]); w.w = pg8::cvt_pk_bf16(p[b0 + 6], p[b0 + 7]);
    return __builtin_bit_cast(bf16x8, w);
}
}
__device__ __forceinline__ void attn_mfma_phase(Frame& F) {
    using namespace attn2;
    const int tid = F.tid, lane = F.lane, wave = F.wave, r32 = lane & 31, hi = lane >> 5, rb = wave >> 1, comp = wave & 1;
    const float lambda_init = 0.8f - 0.6f * expf(-0.3f * 1.0f);
    float lam; { float s01 = 0.f, s23 = 0.f; for (int i = 0; i < 64; ++i) { s01 += F.d_lam[i] * F.d_lam[64 + i]; s23 += F.d_lam[128 + i] * F.d_lam[192 + i]; } lam = expf(s01) - expf(s23) + lambda_init; }
    const int npw = (1024 + F.G - 1) / F.G;
    LAS unsigned char* lds = F.lds;
    LAS float* cb = (LAS float*)lds;
    const int li = lane & 15, q4 = li >> 2, p4 = li & 3, g1 = (lane >> 4) & 1;
    for (int it = 0; it < 2 * npw; ++it) {
        const int pi = F.vcu * npw + (it >> 1); if (pi >= 1024) break;
        const int bh = pi >> 3, s = pi & 7, b = bh >> 3, h = bh & 7, jq = (it & 1) ? 15 - s : s;
        const int qrow = META_ROWS + b * SEQ + 128 * jq + 32 * rb + r32;
        const int cw = 2 * jq + 1 + (rb >> 1), NT = 2 * jq + 3;
        bf16x8 qf[4];
        { const bf16* qp = F.P + (size_t)qrow * NPROJ + h * 128 + comp * 64 + hi * 8;
#pragma unroll
          for (int d0 = 0; d0 < 4; ++d0) qf[d0] = *(const GAS bf16x8*)(qp + 16 * d0); }
        f32x16 o[4];
#pragma unroll
        for (int k = 0; k < 4; ++k)
#pragma unroll
            for (int r = 0; r < 16; ++r) o[k][r] = 0.f;
        float m = -1e30f, l = 0.f;
        v4u sv[4];
#define ATT_LOAD(t) do { _Pragma("unroll") for (int i_ = 0; i_ < 4; ++i_) { const int id_ = i_ * 512 + tid, row_ = id_ >> 5, pc_ = id_ & 31; \
            const int col_ = (pc_ < 16 ? 1024 + pc_ * 8 : 2048 + (pc_ - 16) * 8) + h * 128; \
            if ((t) == 0) { if (row_ < 16) sv[i_] = *(const GAS v4u*)(F.P + (size_t)(b * 16 + row_) * NPROJ + col_); else sv[i_] = (v4u){0u, 0u, 0u, 0u}; } \
            else sv[i_] = *(const GAS v4u*)(F.P + (size_t)(META_ROWS + b * SEQ + ((t) - 1) * 64 + row_) * NPROJ + col_); } } while (0)
#define ATT_STORE(buf) do { _Pragma("unroll") for (int i_ = 0; i_ < 4; ++i_) { const int id_ = i_ * 512 + tid, row_ = id_ >> 5, pc_ = id_ & 31; \
            LAS unsigned char* d_ = lds + (buf) * BUFB + (pc_ < 16 ? row_ * KSTR + pc_ * 16 : KBYTES + row_ * VSTR + (pc_ - 16) * 16); *(LAS v4u*)d_ = sv[i_]; } } while (0)
        __syncthreads();
        ATT_LOAD(0); ATT_STORE(0);
        __syncthreads();
        for (int t = 0; t < NT; ++t) {
            if (t + 1 < NT) ATT_LOAD(t + 1);
            if (t <= cw) {
                const LAS unsigned char* Kb = lds + (t & 1) * BUFB; const LAS unsigned char* Vb = Kb + KBYTES;
                bf16x8 kf[2][4];
#pragma unroll
                for (int kh = 0; kh < 2; ++kh)
#pragma unroll
                    for (int d0 = 0; d0 < 4; ++d0) kf[kh][d0] = *(const LAS bf16x8*)(Kb + (32 * kh + r32) * KSTR + comp * 128 + d0 * 32 + hi * 16);
                f32x16 p0, p1;
#pragma unroll
                for (int r = 0; r < 16; ++r) { p0[r] = 0.f; p1[r] = 0.f; }
#pragma unroll
                for (int d0 = 0; d0 < 4; ++d0) { p0 = __builtin_amdgcn_mfma_f32_32x32x16_bf16(kf[0][d0], qf[d0], p0, 0, 0, 0); p1 = __builtin_amdgcn_mfma_f32_32x32x16_bf16(kf[1][d0], qf[d0], p1, 0, 0, 0); }
                if (t == 0) {
#pragma unroll
                    for (int r = 0; r < 16; ++r) { if (r >= 8) p0[r] = -INFINITY; p1[r] = -INFINITY; } }
                float rm = fmaxf(p0[0], p1[0]);
#pragma unroll
                for (int r = 1; r < 16; ++r) rm = fmaxf(rm, fmaxf(p0[r], p1[r]));
                rm = fmaxf(rm, __shfl_xor(rm, 32));
                const float mn = fmaxf(m, rm), alpha = __builtin_amdgcn_exp2f((m - mn) * LOG2E), mL = mn * LOG2E; m = mn;
                float ls = 0.f;
#pragma unroll
                for (int r = 0; r < 16; ++r) { p0[r] = __builtin_amdgcn_exp2f(fmaf(p0[r], LOG2E, -mL)); p1[r] = __builtin_amdgcn_exp2f(fmaf(p1[r], LOG2E, -mL)); ls += p0[r] + p1[r]; }
                l = l * alpha + ls;
#pragma unroll
                for (int k = 0; k < 4; ++k)
#pragma unroll
                    for (int r = 0; r < 16; ++r) o[k][r] *= alpha;
                bf16x8 pf[4]; pf[0] = pack8(p0, 0); pf[1] = pack8(p0, 8); pf[2] = pack8(p1, 0); pf[3] = pack8(p1, 8);
                const LAS unsigned char* vbase = Vb + (4 * hi + q4) * VSTR + (16 * g1 + 4 * p4) * 2;
#pragma unroll
                for (int blk = 0; blk < 4; ++blk)
#pragma unroll
                    for (int ks = 0; ks < 4; ++ks) {
                        const s16x4 lo = vtr(vbase + (16 * ks) * VSTR + blk * 64), hh = vtr(vbase + (16 * ks + 8) * VSTR + blk * 64);
                        const bf16x8 vf = (bf16x8){lo[0], lo[1], lo[2], lo[3], hh[0], hh[1], hh[2], hh[3]};
                        o[blk] = __builtin_amdgcn_mfma_f32_32x32x16_bf16(vf, pf[ks], o[blk], 0, 0, 0);
                    }
            }
            if (t + 1 < NT) ATT_STORE((t + 1) & 1);
            __syncthreads();
        }
#undef ATT_LOAD
#undef ATT_STORE
        l += __shfl_xor(l, 32);
        const float inv = 1.0f / l;
        LAS float* cbw = cb + (rb * 32 + r32) * CBS;
        if (comp == 1) {
#pragma unroll
            for (int blk = 0; blk < 4; ++blk)
#pragma unroll
                for (int r = 0; r < 16; ++r) cbw[32 * blk + crow(r, hi)] = o[blk][r] * inv;
        }
        __syncthreads();
        if (comp == 0) {
            float ssq = 0.f;
#pragma unroll
            for (int blk = 0; blk < 4; ++blk)
#pragma unroll
                for (int r = 0; r < 16; ++r) { const float d = o[blk][r] * inv - lam * cbw[32 * blk + crow(r, hi)]; o[blk][r] = d; ssq += d * d; }
            ssq += __shfl_xor(ssq, 32);
            const float rr = (1.0f - lambda_init) / sqrtf(ssq * (1.0f / DV) + SUBLN_EPS);
            bf16* dst = F.MIX + (size_t)qrow * D + h * DV; const float* gp = F.d_hgain + h * DV;
#pragma unroll
            for (int blk = 0; blk < 4; ++blk)
#pragma unroll
                for (int r = 0; r < 16; ++r) { const int dv = 32 * blk + crow(r, hi); dst[dv] = (bf16)f2bf(o[blk][r] * rr * gp[dv]); }
        }
    }
}
namespace ml2 {
typedef short bf16x8 __attribute__((ext_vector_type(8)));
typedef short s16x4 __attribute__((ext_vector_type(4)));
constexpr int QSTR = 144, VSTR = 272;
constexpr int OFF_Q = 0, OFF_K = 64 * QSTR, OFF_V = 2 * 64 * QSTR, DBUF = OFF_V + 64 * VSTR;
constexpr int OFF_S = 2 * DBUF, SBUF = 64 * 144;
constexpr int HSTR = 132, OFF_H = OFF_S + 2 * SBUF, HBYTES = 64 * HSTR * 4;
constexpr int OFF_SM = OFF_H + HBYTES, SMB = 12 * 256;
constexpr int A_G = 0, A_M = 64, A_B = 128, A_W = 192, A_RS = 256  , A_QN = 512, A_CT = 576, A_AT = 640, A_N = 704;
static_assert(OFF_SM + 2 * SMB <= RING_BYTES, "mLSTM LDS map");
__device__ __forceinline__ s16x4 vtr(const LAS unsigned char* p) { return __builtin_bit_cast(s16x4, __builtin_amdgcn_ds_read_tr16_b64_v4i16((LAS s16x4*)p)); }
__device__ __forceinline__ f32x4 mfma16(bf16x8 a, bf16x8 b, f32x4 c) { return __builtin_amdgcn_mfma_f32_16x16x32_bf16(a, b, c, 0, 0, 0); }
}
__device__ __forceinline__ void mlstm_mfma_phase(Frame& F) {
    using namespace ml2;
    const int tid = F.tid, lane = F.lane, w = F.wave, li = lane & 15, g = lane >> 4, q4 = li >> 2, p4 = li & 3;
    LAS unsigned char* lds = F.lds;
    const int zt = tid >> 3, zc = tid & 7;
    for (int unit = F.vcu; unit < NB * NH; unit += F.G) {
        const int b = unit >> 3, h = unit & 7;
        __syncthreads();
        for (int i = tid; i < (2 * SBUF) / 16; i += 512) *(LAS v4u*)(lds + OFF_S + i * 16) = (v4u){0u, 0u, 0u, 0u};
        for (int i = tid; i < (2 * SMB) / 16; i += 512) *(LAS v4u*)(lds + OFF_SM + i * 16) = (v4u){0u, 0u, 0u, 0u};
        f32x4 Cacc[4];
#pragma unroll
        for (int i = 0; i < 4; ++i) Cacc[i] = (f32x4){0.f, 0.f, 0.f, 0.f};
        float m = 0.f;
        float gn[16];
#pragma unroll
        for (int i = 0; i < 4; ++i) { const f32x4 t4 = *(const GAS f32x4*)(F.m_hgain + h * DV + 16 * zc + 4 * i); gn[4 * i] = t4.x; gn[4 * i + 1] = t4.y; gn[4 * i + 2] = t4.z; gn[4 * i + 3] = t4.w; }
        v4u sq, sk, sv0, sv1;
#define ML_ROW0(c) ((c) == 0 ? b * 16 : META_ROWS + b * SEQ + ((c) - 1) * 64)
#define ML_LOAD(c) do { const int r0_ = ML_ROW0(c); const bool okq_ = ((c) != 0) || (zt < 16); \
            const bf16* pq_ = F.P + (size_t)(r0_ + zt) * NPROJ + h * 64 + 8 * zc; \
            if (okq_) { sq = *(const GAS v4u*)pq_; sk = *(const GAS v4u*)(pq_ + 512); } else { sq = (v4u){0u, 0u, 0u, 0u}; sk = sq; } \
            const int rv0_ = tid >> 4, rv1_ = (tid + 512) >> 4, pv_ = tid & 15; \
            if (((c) != 0) || rv0_ < 16) sv0 = *(const GAS v4u*)(F.P + (size_t)(r0_ + rv0_) * NPROJ + 1024 + h * 128 + 8 * pv_); else sv0 = (v4u){0u, 0u, 0u, 0u}; \
            if ((c) != 0) sv1 = *(const GAS v4u*)(F.P + (size_t)(r0_ + rv1_) * NPROJ + 1024 + h * 128 + 8 * pv_); else sv1 = (v4u){0u, 0u, 0u, 0u}; } while (0)
#define ML_STORE(par) do { LAS unsigned char* d_ = lds + (par) * DBUF; *(LAS v4u*)(d_ + OFF_Q + zt * QSTR + zc * 16) = sq; *(LAS v4u*)(d_ + OFF_K + zt * QSTR + zc * 16) = sk; \
            *(LAS v4u*)(d_ + OFF_V + (tid >> 4) * VSTR + (tid & 15) * 16) = sv0; *(LAS v4u*)(d_ + OFF_V + ((tid + 512) >> 4) * VSTR + (tid & 15) * 16) = sv1; } while (0)
        ML_LOAD(0); ML_STORE(0);
        __syncthreads();
        for (int c = 0; c <= 32; ++c) {
            const int par = c & 1; const int row0 = ML_ROW0(c);
            LAS unsigned char* db = lds + par * DBUF; LAS float* sm = (LAS float*)(lds + OFF_SM + par * SMB); LAS float* smn = (LAS float*)(lds + OFF_SM + (par ^ 1) * SMB);
            LAS unsigned char* Sb = lds + OFF_S + par * SBUF;
            if (c < 32) ML_LOAD(c + 1);
            v4u og0 = (v4u){0u, 0u, 0u, 0u}, og1 = og0; const bool zvalid = (c != 0) || (zt < 16);
            if (zvalid) { const bf16* po = F.P + (size_t)(row0 + zt) * NPROJ + 2048 + h * 128 + 16 * zc; og0 = *(const GAS v4u*)po; og1 = *(const GAS v4u*)(po + 8); }
            float lf = 0.f, ig = -1e30f;
            if (c != 0 || lane < 16) { const float* gp = F.GATES + (size_t)(row0 + lane) * 16; const float fg = gp[8 + h]; ig = gp[h]; lf = fminf(fg, 0.f) - log1pf(expf(-fabsf(fg))); }
            float bs = lf;
#pragma unroll
            for (int o = 1; o < 64; o <<= 1) { const float v = __shfl_up(bs, o); if (lane >= o) bs += v; }
            const float gs = ig - bs; float pm = gs;
#pragma unroll
            for (int o = 1; o < 64; o <<= 1) { const float v = __shfl_up(pm, o); if (lane >= o) pm = fmaxf(pm, v); }
            const float Mt = fmaxf(m, pm);
            const float MT = __shfl(Mt, 63), bT = __shfl(bs, 63);
            const float ws = expf(gs - MT), decay = expf(m - MT);
            sm[A_G + lane] = gs; sm[A_M + lane] = Mt; sm[A_B + lane] = bs; sm[A_W + lane] = ws;
            for (int ti = w; ti < 10; ti += 8) {
                const int rt = ti < 1 ? 0 : ti < 3 ? 1 : ti < 6 ? 2 : 3, st = ti - rt * (rt + 1) / 2;
                f32x4 acc = (f32x4){0.f, 0.f, 0.f, 0.f};
#pragma unroll
                for (int ks = 0; ks < 2; ++ks) { const bf16x8 a = *(const LAS bf16x8*)(db + OFF_Q + (16 * rt + li) * QSTR + (32 * ks + 8 * g) * 2), bb = *(const LAS bf16x8*)(db + OFF_K + (16 * st + li) * QSTR + (32 * ks + 8 * g) * 2);
                    acc = mfma16(a, bb, acc); }
                const float g_s = sm[A_G + 16 * st + li]; const f32x4 M4 = *(const LAS f32x4*)(sm + A_M + 16 * rt + 4 * g);
                float val[4];
#pragma unroll
                for (int r = 0; r < 4; ++r) { const bool ok = (16 * st + li) <= (16 * rt + 4 * g + r); val[r] = ok ? acc[r] * __expf(g_s - M4[r]) : 0.f; }
                float rs[4];
#pragma unroll
                for (int r = 0; r < 4; ++r) { float x = val[r]; x += __shfl_xor(x, 1); x += __shfl_xor(x, 2); x += __shfl_xor(x, 4); x += __shfl_xor(x, 8); rs[r] = x; }
                if (li == 0) *(LAS f32x4*)(sm + A_RS + st * 64 + 16 * rt + 4 * g) = (f32x4){rs[0], rs[1], rs[2], rs[3]};
#pragma unroll
                for (int r = 0; r < 4; ++r) *(LAS bf16*)(Sb + (16 * rt + 4 * g + r) * 144 + (16 * st + li) * 2) = (bf16)f2bf(val[r]);
            }
            { const v4u qv = *(const LAS v4u*)(db + OFF_Q + zt * QSTR + zc * 16); const f32x4 n0 = *(const LAS f32x4*)(sm + A_N + 8 * zc), n1 = *(const LAS f32x4*)(sm + A_N + 8 * zc + 4);
              float d = bflo(qv.x) * n0.x + bfhi(qv.x) * n0.y + bflo(qv.y) * n0.z + bfhi(qv.y) * n0.w + bflo(qv.z) * n1.x + bfhi(qv.z) * n1.y + bflo(qv.w) * n1.z + bfhi(qv.w) * n1.w;
              d += __shfl_xor(d, 1); d += __shfl_xor(d, 2); d += __shfl_xor(d, 4);
              if (zc == 0) sm[A_QN + zt] = d; }
            __syncthreads();
            { const float rsum = (sm[A_RS + lane] + sm[A_RS + 64 + lane]) + (sm[A_RS + 128 + lane] + sm[A_RS + 192 + lane]);
              const float inter = expf(m - Mt), den = rsum + inter * sm[A_QN + lane], dmax = fmaxf(fabsf(den), expf(-(bs + Mt))), ci = 1.0f / dmax;
              sm[A_CT + lane] = ci; sm[A_AT + lane] = inter * ci; }
            if (c < 32) ML_STORE(par ^ 1);
            bf16x8 vf[2], wv[2];
#pragma unroll
            for (int ks = 0; ks < 2; ++ks) {
                const LAS unsigned char* vp = db + OFF_V + (32 * ks + 8 * g + q4) * VSTR + (16 * w + 4 * p4) * 2;
                const s16x4 lo = vtr(vp), hh = vtr(vp + 4 * VSTR);
                vf[ks] = (bf16x8){lo[0], lo[1], lo[2], lo[3], hh[0], hh[1], hh[2], hh[3]};
                const f32x4 w0 = *(const LAS f32x4*)(sm + A_W + 32 * ks + 8 * g), w1 = *(const LAS f32x4*)(sm + A_W + 32 * ks + 8 * g + 4);
                v4u pw; pw.x = pk2(bf2f((unsigned short)lo[0]) * w0.x, bf2f((unsigned short)lo[1]) * w0.y); pw.y = pk2(bf2f((unsigned short)lo[2]) * w0.z, bf2f((unsigned short)lo[3]) * w0.w);
                pw.z = pk2(bf2f((unsigned short)hh[0]) * w1.x, bf2f((unsigned short)hh[1]) * w1.y); pw.w = pk2(bf2f((unsigned short)hh[2]) * w1.z, bf2f((unsigned short)hh[3]) * w1.w);
                wv[ks] = __builtin_bit_cast(bf16x8, pw);
            }
            bf16x8 cbf[2];
#pragma unroll
            for (int ks = 0; ks < 2; ++ks) { v4u pw; pw.x = pk2(Cacc[2 * ks][0], Cacc[2 * ks][1]); pw.y = pk2(Cacc[2 * ks][2], Cacc[2 * ks][3]); pw.z = pk2(Cacc[2 * ks + 1][0], Cacc[2 * ks + 1][1]); pw.w = pk2(Cacc[2 * ks + 1][2], Cacc[2 * ks + 1][3]);
                cbf[ks] = __builtin_bit_cast(bf16x8, pw); }
            f32x4 acc1[4], acc2[4];
#pragma unroll
            for (int rt = 0; rt < 4; ++rt) {
                acc1[rt] = (f32x4){0.f, 0.f, 0.f, 0.f}; acc2[rt] = (f32x4){0.f, 0.f, 0.f, 0.f};
#pragma unroll
                for (int ks = 0; ks < 2; ++ks) {
                    if (ks == 0 || rt >= 2) { const bf16x8 a = *(const LAS bf16x8*)(Sb + (16 * rt + li) * 144 + (32 * ks + 8 * g) * 2); acc1[rt] = mfma16(a, vf[ks], acc1[rt]); }
                    typedef unsigned u32x2 __attribute__((ext_vector_type(2)));
                    const u32x2 qa = *(const LAS u32x2*)(db + OFF_Q + (16 * rt + li) * QSTR + (32 * ks + 4 * g) * 2), qb = *(const LAS u32x2*)(db + OFF_Q + (16 * rt + li) * QSTR + (32 * ks + 16 + 4 * g) * 2);
                    const bf16x8 aq = __builtin_bit_cast(bf16x8, (v4u){qa.x, qa.y, qb.x, qb.y});
                    acc2[rt] = mfma16(aq, cbf[ks], acc2[rt]);
                }
            }
#pragma unroll
            for (int dt = 0; dt < 4; ++dt) {
                Cacc[dt] = Cacc[dt] * decay;
#pragma unroll
                for (int ks = 0; ks < 2; ++ks) {
                    const LAS unsigned char* kp = db + OFF_K + (32 * ks + 8 * g + q4) * QSTR + (16 * dt + 4 * p4) * 2;
                    const s16x4 lo = vtr(kp), hh = vtr(kp + 4 * QSTR);
                    const bf16x8 ka = (bf16x8){lo[0], lo[1], lo[2], lo[3], hh[0], hh[1], hh[2], hh[3]};
                    Cacc[dt] = mfma16(ka, wv[ks], Cacc[dt]);
                }
            }
            { float sacc = 0.f;
#pragma unroll
              for (int i = 0; i < 8; ++i) { const int s_ = 8 * zc + i; sacc += sm[A_W + s_] * bf2f(*(const LAS bf16*)(db + OFF_K + s_ * QSTR + zt * 2)); }
              sacc += __shfl_xor(sacc, 1); sacc += __shfl_xor(sacc, 2); sacc += __shfl_xor(sacc, 4);
              if (zc == 0) smn[A_N + zt] = decay * sm[A_N + zt] + sacc; }
            { LAS float* hb = (LAS float*)(lds + OFF_H);
#pragma unroll
              for (int rt = 0; rt < 4; ++rt) { const f32x4 c4 = *(const LAS f32x4*)(sm + A_CT + 16 * rt + 4 * g), a4 = *(const LAS f32x4*)(sm + A_AT + 16 * rt + 4 * g);
#pragma unroll
                  for (int r = 0; r < 4; ++r) hb[(16 * rt + 4 * g + r) * HSTR + 16 * w + li] = acc1[rt][r] * c4[r] + acc2[rt][r] * a4[r]; } }
            m = bT + MT;
            __syncthreads();
            { const LAS float* hb = (const LAS float*)(lds + OFF_H) + zt * HSTR + 16 * zc; float hv[16]; float ss = 0.f;
#pragma unroll
              for (int i = 0; i < 4; ++i) { const f32x4 t4 = *(const LAS f32x4*)(hb + 4 * i); hv[4 * i] = t4.x; hv[4 * i + 1] = t4.y; hv[4 * i + 2] = t4.z; hv[4 * i + 3] = t4.w; ss += (t4.x * t4.x + t4.y * t4.y) + (t4.z * t4.z + t4.w * t4.w); }
              ss += __shfl_xor(ss, 1); ss += __shfl_xor(ss, 2); ss += __shfl_xor(ss, 4);
              const float rn = 1.0f / sqrtf(ss * (1.0f / DV) + EPS);
              const unsigned ow[8] = {og0.x, og0.y, og0.z, og0.w, og1.x, og1.y, og1.z, og1.w}; unsigned res[8];
#pragma unroll
              for (int i = 0; i < 8; ++i) { const float o0 = bflo(ow[i]), o1 = bfhi(ow[i]);
                  res[i] = pk2(hv[2 * i] * rn * gn[2 * i] / (1.0f + __expf(-o0)), hv[2 * i + 1] * rn * gn[2 * i + 1] / (1.0f + __expf(-o1))); }
              if (zvalid) { bf16* dst = F.MIX + (size_t)(row0 + zt) * D + h * DV + 16 * zc; *(GAS v4u*)dst = (v4u){res[0], res[1], res[2], res[3]}; *(GAS v4u*)(dst + 8) = (v4u){res[4], res[5], res[6], res[7]}; } }
        }
#undef ML_ROW0
#undef ML_LOAD
#undef ML_STORE
    }
}
struct Args { const float* in[14]; float* out; unsigned char* ws; int ph_lo, ph_hi; };
__global__ void __launch_bounds__(NWAVES * 64, 2) fwd_kernel(Args args) {
    extern __shared__ __attribute__((aligned(16))) unsigned char lds[];
    Frame F;
    F.lds = (LAS unsigned char*)lds;
    F.MISC = (volatile LAS unsigned*)(F.lds + MISC_OFF);
    F.tid = threadIdx.x; F.lane = F.tid & 63; F.wave = __builtin_amdgcn_readfirstlane(F.tid >> 6);
    F.G = gridDim.x; { const int bx = blockIdx.x; F.vcu = (F.G % 8 == 0) ? (bx % 8) * (F.G / 8) + bx / 8 : bx; }
    unsigned char* ws = args.ws; F.ws = ws;
    F.ctl = (gu32*)(ws + WS_CTL);
    F.x = args.in[0]; F.meta = args.in[1]; F.ngain = args.in[2]; F.m_win = args.in[3]; F.m_bgate = args.in[4]; F.m_hgain = args.in[5]; F.m_wout = args.in[6];
    F.d_win = args.in[7]; F.d_lam = args.in[8]; F.d_hgain = args.in[9]; F.d_wout = args.in[10]; F.w_up = args.in[11]; F.w_dn = args.in[12]; F.fgain = args.in[13];
    F.out = args.out;
    F.WIN0 = (bf16*)(ws + WS_WIN0); F.WOUT0 = (bf16*)(ws + WS_WOUT0); F.WUP0 = (bf16*)(ws + WS_WUP0); F.WDN0 = (bf16*)(ws + WS_WDN0);
    F.WIN1 = (bf16*)(ws + WS_WIN1); F.WOUT1 = (bf16*)(ws + WS_WOUT1); F.WUP1 = (bf16*)(ws + WS_WUP1); F.WDN1 = (bf16*)(ws + WS_WDN1);
    F.HB = (bf16*)(ws + WS_HB); F.P = (bf16*)(ws + WS_P); F.MIX = (bf16*)(ws + WS_MIX); F.U = (bf16*)(ws + WS_U);
    F.WG = (float*)(ws + WS_WG); F.HMETA = (float*)(ws + WS_HMETA); F.SS = (float*)(ws + WS_SS); F.GATES = (float*)(ws + WS_GATES);
    for (int u = F.tid; u < (LDS_BYTES - LDSCTL_OFF) / 4; u += NWAVES * 64) ((LAS unsigned*)(F.lds + LDSCTL_OFF))[u] = 0u;
    __syncthreads();
    const int lo = args.ph_lo, hi = args.ph_hi;
    const bool use_bar = (hi - lo) > 1;
    XcdBarrier bar; bar.bar = (unsigned*)(F.ctl + CW_BAR); bar.x = 0; bar.st = nullptr;
    if (use_bar) bar = xcd_barrier_post((unsigned*)(F.ctl + CW_BAR), F.MISC + 8);
#define IN(k) (lo <= (k) && (k) < hi)
#define SEAM(k) do { if (IN(k) && IN((k) + 1)) xcd_barrier(bar); } while (0)
#define GEMM_PHASE(k, EPI, MM, Aptr, Bptr, NN, KK, ...) if (IN(k)) { pg8::Gemm g{Aptr, Bptr, MM, NN, KK}; pg8::StaticOrder S; S.init(MM, NN, F.G, (int)blockIdx.x); \
        EPI E{__VA_ARGS__}; pg8::gemm_phase<EPI, pg8::StaticOrder, PG8_ALIGN, PG8_SP2>(F.lds + RING_OFF, g, S, E); SEAM(k); }
    typedef pg8::EpiScale<0, 1> EpiIn0; typedef pg8::EpiScale<0, 16> EpiIn1; typedef pg8::EpiScale<1, 16> EpiUp;
    if (IN(0)) { p0_prologue(F); SEAM(0); }
    GEMM_PHASE(1, EpiIn0, MROWS, F.HB, F.WIN0, NPROJ, D, F.P, NPROJ, F.SS, EPS)
#ifdef MLSTM_SIMPLE
    if (IN(2)) { mlstm_simple_phase(F); SEAM(2); }
#else
    if (IN(2)) { mlstm_mfma_phase(F); SEAM(2); }
#endif
    GEMM_PHASE(3, pg8::EpiRes, MROWS, F.MIX, F.WOUT0, D, D, F.HMETA, F.out, F.HB, F.SS, 1)
    GEMM_PHASE(4, EpiUp, MROWS, F.HB, F.WUP0, FF, D, F.U, FF, F.SS, EPS)
    GEMM_PHASE(5, pg8::EpiRes, MROWS, F.U, F.WDN0, D, FF, F.HMETA, F.out, F.HB, F.SS, 1)
    GEMM_PHASE(6, EpiIn1, MROWS, F.HB, F.WIN1, NPROJ, D, F.P, NPROJ, F.SS, EPS)
#ifdef ATTN_SIMPLE
    if (IN(7)) { attn_simple_phase(F); SEAM(7); }
#else
    if (IN(7)) { attn_mfma_phase(F); SEAM(7); }
#endif
    constexpr int MR = MROWS - META_ROWS;
    GEMM_PHASE(8, pg8::EpiRes, MR, F.MIX + (size_t)META_ROWS * D, F.WOUT1, D, D, F.HMETA, F.out, F.HB + (size_t)META_ROWS * D, F.SS + (size_t)META_ROWS * 16, 0)
    GEMM_PHASE(9, EpiUp, MR, F.HB + (size_t)META_ROWS * D, F.WUP1, FF, D, F.U + (size_t)META_ROWS * FF, FF, F.SS + (size_t)META_ROWS * 16, EPS)
    GEMM_PHASE(10, pg8::EpiRes, MR, F.U + (size_t)META_ROWS * FF, F.WDN1, D, FF, F.HMETA, F.out, (bf16*)nullptr, F.SS + (size_t)META_ROWS * 16, 0)
    if (IN(11)) { final_norm_phase(F); }
#undef IN
#undef SEAM
#undef GEMM_PHASE
}

extern "C" void kernel_launch(void* const* d_in, const int* in_sizes, int n_in, void* d_out, int out_size, void* d_ws, size_t ws_size, hipStream_t stream) {
    static int grid = 0;
    if (grid == 0) {
        if (n_in != 14 || in_sizes[0] != NB * SEQ * D || out_size != NB * SEQ * D || ws_size < WS_END) { fprintf(stderr, "kernel_launch: unexpected shapes (n_in %d, in0 %d, out %d, ws %zu)\n", n_in, n_in > 0 ? in_sizes[0] : -1, out_size, ws_size); grid = -1; return; }
        int dev = 0, cus = 0, per_cu = 0;
        if (hipGetDevice(&dev) != hipSuccess || hipDeviceGetAttribute(&cus, hipDeviceAttributeMultiprocessorCount, dev) != hipSuccess) { grid = -1; return; }
        if (hipFuncSetAttribute((const void*)fwd_kernel, hipFuncAttributeMaxDynamicSharedMemorySize, LDS_BYTES) != hipSuccess) { fprintf(stderr, "kernel_launch: hipFuncSetAttribute failed\n"); grid = -1; return; }
        if (hipOccupancyMaxActiveBlocksPerMultiprocessor(&per_cu, (const void*)fwd_kernel, NWAVES * 64, LDS_BYTES) != hipSuccess || per_cu < 1) { fprintf(stderr, "kernel_launch: occupancy query reports %d blocks per CU\n", per_cu); (void)hipGetLastError(); grid = -1; return; }
        grid = cus;
    }
    if (grid < 0) return;
    if (hipMemsetAsync((char*)d_ws + WS_CTL, 0, CTL_ZERO_BYTES, stream) != hipSuccess) return;
    Args a{};
    for (int i = 0; i < 14; ++i) a.in[i] = (const float*)d_in[i];
    a.out = (float*)d_out; a.ws = (unsigned char*)d_ws;
    if (MK_N_LAUNCHES == 1) { a.ph_lo = 0; a.ph_hi = NPHASE; hipLaunchKernelGGL(fwd_kernel, dim3(grid), dim3(NWAVES * 64), LDS_BYTES, stream, a); }
    else for (int p = 0; p < NPHASE; ++p) { a.ph_lo = p; a.ph_hi = p + 1; hipLaunchKernelGGL(fwd_kernel, dim3(grid), dim3(NWAVES * 64), LDS_BYTES, stream, a); }
}
```

```cpp
#include <hip/hip_runtime.h>
#include <cstdio>
#include <cstdint>
namespace pg8 {
#define PG8_LAS __attribute__((address_space(3)))
typedef unsigned short bf16_t;
typedef short bf16x8 __attribute__((ext_vector_type(8)));
typedef float f32x4 __attribute__((ext_vector_type(4)));
typedef unsigned u32x4 __attribute__((ext_vector_type(4)));
constexpr int BM = 256, BK = 64, HALF = 128, HTB = HALF * BK * 2  , STAGE_BYTES = 8 * HTB, NXCD = 8, WGM = 8;

__host__ __device__ __forceinline__ int lds_byte(int r, int c) { const int st = (r >> 4) * 2 + (c >> 5), rr = r & 15, cc = c & 31, ob = rr * 64 + cc * 2; return st * 1024 + (ob ^ (((ob >> 9) & 1) << 5)); }
__host__ __device__ __forceinline__ void stage_rc(int b, int& R, int& C) { const int st = b / 1024, sb = b % 1024, swz = sb ^ (((sb >> 9) & 1) << 5); R = (st >> 1) * 16 + swz / 64; C = (st & 1) * 32 + (swz % 64) / 2; }
__host__ __device__ __forceinline__ int perm32(int rho) { const int n = rho >> 4, i = rho & 15; return 8 * (i >> 2) + 4 * n + (i & 3); }

struct Unit { int pm, pn; };
struct Gemm { const bf16_t* A; const bf16_t* Bt; int M, N, K; };

struct StaticOrder {
    int nM, nN, nwg, G, c;
    __host__ __device__ void init(int M, int N, int G_, int c_) { nM = M / BM; nN = N / BM; nwg = nM * nN; G = G_; c = c_; }
    __host__ __device__ bool next(int i, Unit& u) const {
        const long L = (long)i * G + c; if (L >= nwg) return false;
        int wgid = (int)L; { const int q = nwg / NXCD, r = nwg % NXCD, xcd = wgid % NXCD, off = wgid / NXCD; wgid = (xcd < r ? xcd * (q + 1) : r * (q + 1) + (xcd - r) * q) + off; }
        const int nig = WGM * nN, gid = wgid / nig, fm = gid * WGM, gsz = (nM - fm) < WGM ? (nM - fm) : WGM;
        u.pm = fm + ((wgid % nig) % gsz); u.pn = (wgid % nig) / gsz; return true;
    }
    __device__ __forceinline__ void a_ready(const Unit&) const {}
    __device__ __forceinline__ void done(const Unit&) const {}
};

__device__ __forceinline__ unsigned cvt_pk_bf16(float lo, float hi) { unsigned r; asm volatile("v_cvt_pk_bf16_f32 %0, %1, %2" : "=v"(r) : "v"(lo), "v"(hi)); return r; }
typedef unsigned u32x2 __attribute__((ext_vector_type(2)));

template <int NS> __device__ __forceinline__ float row_rstd(const float* ss, int row, float eps) {
    const float* sp = ss + (size_t)row * 16; float s;
    if (NS == 1) s = sp[0];
    else { const f32x4 a = *(const f32x4*)sp, b = *(const f32x4*)(sp + 4), c = *(const f32x4*)(sp + 8), d = *(const f32x4*)(sp + 12);
           s = ((a[0] + a[1]) + (a[2] + a[3])) + ((b[0] + b[1]) + (b[2] + b[3])) + ((c[0] + c[1]) + (c[2] + c[3])) + ((d[0] + d[1]) + (d[2] + d[3])); }
    return __builtin_amdgcn_rsqf(s * (1.0f / 1024.0f) + eps);
}
template <int ACT, int NS> struct EpiScale {
    static constexpr bool PERM = true, AFTER_DRAIN = false;
    bf16_t* O; int ldc; const float* ss; float eps;
    __device__ __forceinline__ void operator()(const f32x4 (&acc)[2][2][4][2], const Unit& u, int wr, int wc, int fr, int fq) const {
        const int row0 = u.pm * BM + wr * 64 + fr, col0 = u.pn * BM + wc * 32 + 8 * fq;
#pragma unroll
        for (int ai = 0; ai < 2; ++ai)
#pragma unroll
            for (int m = 0; m < 4; ++m) { const int row = row0 + ai * HALF + m * 16; const float rs = row_rstd<NS>(ss, row, eps);
                bf16_t* rowp = O + (size_t)row * ldc + col0;
#pragma unroll
                for (int bj = 0; bj < 2; ++bj) { f32x4 v0 = acc[ai][bj][m][0] * rs, v1 = acc[ai][bj][m][1] * rs;
                    if (ACT == 1) {
#pragma unroll
                        for (int i = 0; i < 4; ++i) { const float a = fmaxf(v0[i], 0.f), b = fmaxf(v1[i], 0.f); v0[i] = a * a; v1[i] = b * b; } }
                    u32x4 w; w.x = cvt_pk_bf16(v0[0], v0[1]); w.y = cvt_pk_bf16(v0[2], v0[3]); w.z = cvt_pk_bf16(v1[0], v1[1]); w.w = cvt_pk_bf16(v1[2], v1[3]);
                    *(u32x4*)(rowp + bj * HALF) = w; } }
    }
};
struct EpiRes {
    static constexpr bool PERM = false, AFTER_DRAIN = false;
    const float* Hin; float* Hout; bf16_t* HB; float* ss;
    __device__ __forceinline__ void operator()(const f32x4 (&acc)[2][2][4][2], const Unit& u, int wr, int wc, int fr, int fq) const {
        const int row0 = u.pm * BM + wr * 64 + fr, col0 = u.pn * BM + wc * 32 + 4 * fq;
#pragma unroll
        for (int ai = 0; ai < 2; ++ai)
#pragma unroll
            for (int m = 0; m < 4; ++m) { const int row = row0 + ai * HALF + m * 16;
                const float* hi = Hin + (size_t)row * 1024 + col0; float* ho = Hout + (size_t)row * 1024 + col0; float q = 0.f;
#pragma unroll
                for (int bj = 0; bj < 2; ++bj)
#pragma unroll
                    for (int n = 0; n < 2; ++n) { const int off = bj * HALF + n * 16; const f32x4 hv = *(const f32x4*)(hi + off) + acc[ai][bj][m][n]; *(f32x4*)(ho + off) = hv;
                        q += (hv[0] * hv[0] + hv[1] * hv[1]) + (hv[2] * hv[2] + hv[3] * hv[3]);
                        if (HB) { u32x2 w; w.x = cvt_pk_bf16(hv[0], hv[1]); w.y = cvt_pk_bf16(hv[2], hv[3]); *(u32x2*)(HB + (size_t)row * 1024 + col0 + off) = w; } }
                q += __shfl_xor(q, 16); q += __shfl_xor(q, 32);
                if (fq == 0) ss[(size_t)row * 16 + u.pn * 4 + wc] = q; }
    }
};

template <class Epi, class Sched, bool ALIGN_EPI = false, bool SP2 = false>
__device__ __forceinline__ void gemm_phase(PG8_LAS unsigned char* lds, const Gemm g, const Sched& S, const Epi& E) {
    const int tid = threadIdx.x, wid = __builtin_amdgcn_readfirstlane(tid >> 6), lane = tid & 63, wr = wid >> 2, wc = wid & 3, fr = lane & 15, fq = lane >> 4;
    const int K = g.K, nt = K / BK;
    unsigned voffA[2], voffB[2];
#pragma unroll
    for (int i = 0; i < 2; ++i) { int R, C; stage_rc(tid * 16 + i * 8192, R, C); const int Rb = Epi::PERM ? ((R & ~31) + perm32(R & 31)) : R;
        voffA[i] = (unsigned)(R * K + C) * 2u; voffB[i] = (unsigned)(Rb * K + C) * 2u; }
    const size_t kstep = (size_t)(BK * 2);
    const size_t hstep = (size_t)HALF * K * 2;
    const size_t tstep = 2 * hstep;
    const unsigned ldsw = (unsigned)wid * 1024u;
    const int aoff = lds_byte(wr * 64 + fr, fq * 8), boff = lds_byte(wc * 32 + fr, fq * 8);
#define PG8_SA(b, h) (((b) * 2 + (h)) * HTB)
#define PG8_SB(b, h) ((4 + (b) * 2 + (h)) * HTB)
#define PG8_STAGE(bufoff, gbase, voff) do { _Pragma("unroll") for (int _i = 0; _i < 2; ++_i) \
        __builtin_amdgcn_global_load_lds((const unsigned*)((const char*)(gbase) + (voff)[_i]), (PG8_LAS unsigned*)(lds + (bufoff) + ldsw + _i * 8192), 16, 0, 0); } while (0)
#define PG8_LDA(dst, b, h) do { _Pragma("unroll") for (int m = 0; m < 4; ++m) _Pragma("unroll") for (int k = 0; k < 2; ++k) dst[m][k] = *(const PG8_LAS bf16x8*)(lds + PG8_SA(b, h) + aoff + m * 2048 + k * 1024); } while (0)
#define PG8_LDB(dst, b, h) do { _Pragma("unroll") for (int n = 0; n < 2; ++n) _Pragma("unroll") for (int k = 0; k < 2; ++k) dst[n][k] = *(const PG8_LAS bf16x8*)(lds + PG8_SB(b, h) + boff + n * 2048 + k * 1024); } while (0)
#define PG8_MMA(ai, bj, At, Bt) do { __builtin_amdgcn_s_setprio(1); _Pragma("unroll") for (int m = 0; m < 4; ++m) _Pragma("unroll") for (int n = 0; n < 2; ++n) _Pragma("unroll") for (int k = 0; k < 2; ++k) \
        acc[ai][bj][m][n] = __builtin_amdgcn_mfma_f32_16x16x32_bf16(Bt[n][k], At[m][k], acc[ai][bj][m][n], 0, 0, 0); __builtin_amdgcn_s_setprio(0); } while (0)
#define PG8_WAIT_V(n) asm volatile("s_waitcnt vmcnt(" #n ")" ::: "memory")
#define PG8_WAIT_L(n) asm volatile("s_waitcnt lgkmcnt(" #n ")" ::: "memory")
#define PG8_BAR __builtin_amdgcn_s_barrier()
#define PG8_SCHED __builtin_amdgcn_sched_barrier(0)
    Unit cur, nxt; int ui = 0;
    if (!S.next(0, cur)) return;
    f32x4 acc[2][2][4][2];
#pragma unroll
    for (int a = 0; a < 2; ++a)
#pragma unroll
        for (int b = 0; b < 2; ++b)
#pragma unroll
            for (int m = 0; m < 4; ++m)
#pragma unroll
                for (int n = 0; n < 2; ++n) acc[a][b][m][n] = (f32x4){0.f, 0.f, 0.f, 0.f};
    bf16x8 At[4][2], B0[2][2], B1[2][2];
    const char* cA = (const char*)g.A + (size_t)cur.pm * tstep; const char* cB = (const char*)g.Bt + (size_t)cur.pn * tstep;
    S.a_ready(cur);
    if constexpr (SP2) {
        PG8_STAGE(PG8_SB(0, 0), cB, voffB); PG8_STAGE(PG8_SB(0, 1), cB + hstep, voffB); PG8_STAGE(PG8_SA(0, 0), cA, voffA); PG8_STAGE(PG8_SA(0, 1), cA + hstep, voffA);
        if (wr == 1) PG8_BAR;
        PG8_WAIT_V(2); PG8_BAR;
        PG8_STAGE(PG8_SB(1, 0), cB + kstep, voffB); PG8_STAGE(PG8_SA(1, 0), cA + kstep, voffA); PG8_STAGE(PG8_SB(1, 1), cB + hstep + kstep, voffB);
        PG8_WAIT_V(6); PG8_BAR;
    } else {
        PG8_STAGE(PG8_SB(0, 0), cB, voffB); PG8_STAGE(PG8_SA(0, 0), cA, voffA); PG8_STAGE(PG8_SB(0, 1), cB + hstep, voffB); PG8_STAGE(PG8_SA(0, 1), cA + hstep, voffA);
        if (wr == 1) PG8_BAR;
        PG8_WAIT_V(4); PG8_BAR;
        PG8_STAGE(PG8_SB(1, 0), cB + kstep, voffB); PG8_STAGE(PG8_SA(1, 0), cA + kstep, voffA); PG8_STAGE(PG8_SB(1, 1), cB + hstep + kstep, voffB);
        PG8_WAIT_V(6); PG8_BAR;
    }
    for (;;) {
        const bool has_next = S.next(ui + 1, nxt);
        const char* nA = has_next ? (const char*)g.A + (size_t)nxt.pm * tstep : cA; const char* nB = has_next ? (const char*)g.Bt + (size_t)nxt.pn * tstep : cB;
        for (int t = 0; t < nt; t += 2) {
            const bool last = (t == nt - 2);
            const char* a1 = cA + (size_t)(t + 1) * kstep;
            const char* a2 = last ? nA : cA + (size_t)(t + 2) * kstep; const char* b2 = last ? nB : cB + (size_t)(t + 2) * kstep;
            const char* a3 = a2 + kstep; const char* b3 = b2 + kstep;
            if (last && has_next) S.a_ready(nxt);
            if constexpr (SP2) {
            PG8_LDB(B0, 0, 0); PG8_LDB(B1, 0, 1); PG8_SCHED; PG8_LDA(At, 0, 0); PG8_STAGE(PG8_SA(1, 1), a1 + hstep, voffA);
            PG8_WAIT_V(8); PG8_WAIT_L(0); PG8_BAR; PG8_MMA(0, 0, At, B0); PG8_MMA(0, 1, At, B1); PG8_BAR; PG8_SCHED;
            PG8_LDA(At, 0, 1); PG8_STAGE(PG8_SB(0, 0), b2, voffB); PG8_STAGE(PG8_SB(0, 1), b2 + hstep, voffB); PG8_STAGE(PG8_SA(0, 0), a2, voffA);
            PG8_WAIT_V(8); PG8_WAIT_L(0); PG8_BAR; PG8_MMA(1, 0, At, B0); PG8_MMA(1, 1, At, B1); PG8_BAR; PG8_SCHED;
            PG8_LDB(B0, 1, 0); PG8_LDB(B1, 1, 1); PG8_SCHED; PG8_LDA(At, 1, 0); PG8_STAGE(PG8_SA(0, 1), a2 + hstep, voffA);
            PG8_WAIT_V(8); PG8_WAIT_L(0); PG8_BAR; PG8_MMA(0, 0, At, B0); PG8_MMA(0, 1, At, B1); PG8_BAR; PG8_SCHED;
            PG8_LDA(At, 1, 1); PG8_STAGE(PG8_SB(1, 0), b3, voffB); PG8_STAGE(PG8_SB(1, 1), b3 + hstep, voffB); PG8_STAGE(PG8_SA(1, 0), a3, voffA);
            PG8_WAIT_V(8); PG8_WAIT_L(0); PG8_BAR; PG8_MMA(1, 0, At, B0); PG8_MMA(1, 1, At, B1); PG8_BAR; PG8_SCHED;
            } else {
            PG8_LDB(B0, 0, 0); PG8_SCHED; PG8_LDA(At, 0, 0); PG8_STAGE(PG8_SA(1, 1), a1 + hstep, voffA);
            PG8_WAIT_L(8); PG8_BAR; PG8_WAIT_L(0); PG8_MMA(0, 0, At, B0); PG8_BAR; PG8_SCHED;
            PG8_LDB(B1, 0, 1); PG8_STAGE(PG8_SB(0, 0), b2, voffB);
            PG8_BAR; PG8_WAIT_L(0); PG8_MMA(0, 1, At, B1); PG8_BAR;
            PG8_LDA(At, 0, 1); PG8_STAGE(PG8_SA(0, 0), a2, voffA);
            PG8_BAR; PG8_WAIT_L(0); PG8_MMA(1, 0, At, B0); PG8_BAR; PG8_SCHED;
            PG8_STAGE(PG8_SB(0, 1), b2 + hstep, voffB);
            PG8_WAIT_V(6); PG8_BAR; PG8_MMA(1, 1, At, B1); PG8_BAR;
            PG8_LDB(B0, 1, 0); PG8_SCHED; PG8_LDA(At, 1, 0); PG8_STAGE(PG8_SA(0, 1), a2 + hstep, voffA);
            PG8_WAIT_L(8); PG8_BAR; PG8_WAIT_L(0); PG8_MMA(0, 0, At, B0); PG8_BAR; PG8_SCHED;
            PG8_LDB(B1, 1, 1); PG8_STAGE(PG8_SB(1, 0), b3, voffB);
            PG8_BAR; PG8_WAIT_L(0); PG8_MMA(0, 1, At, B1); PG8_BAR;
            PG8_LDA(At, 1, 1); PG8_STAGE(PG8_SA(1, 0), a3, voffA);
            PG8_BAR; PG8_WAIT_L(0); PG8_MMA(1, 0, At, B0); PG8_BAR; PG8_SCHED;
            PG8_STAGE(PG8_SB(1, 1), b3 + hstep, voffB);
            PG8_WAIT_V(6); PG8_BAR; PG8_MMA(1, 1, At, B1); PG8_BAR;
            }
        }
        if constexpr (ALIGN_EPI) { if (wr == 0) PG8_BAR; }
        if constexpr (!Epi::AFTER_DRAIN) { E(acc, cur, wr, wc, fr, fq); S.done(cur); }
        if (!has_next) break;
#pragma unroll
        for (int a = 0; a < 2; ++a)
#pragma unroll
            for (int b = 0; b < 2; ++b)
#pragma unroll
                for (int m = 0; m < 4; ++m)
#pragma unroll
                    for (int n = 0; n < 2; ++n) acc[a][b][m][n] = (f32x4){0.f, 0.f, 0.f, 0.f};
        cur = nxt; cA = nA; cB = nB; ++ui;
        if constexpr (ALIGN_EPI) { if (wr == 1) PG8_BAR; }
    }
    PG8_WAIT_V(0);
    if constexpr (!ALIGN_EPI) { if (wr == 0) PG8_BAR; }
    PG8_BAR;
    if constexpr (Epi::AFTER_DRAIN) { E.fused(acc, cur, wr, wc, fr, fq, lds, wid, lane); S.done(cur); }
#undef PG8_SA
#undef PG8_SB
#undef PG8_STAGE
#undef PG8_LDA
#undef PG8_LDB
#undef PG8_MMA
#undef PG8_WAIT_V
#undef PG8_WAIT_L
#undef PG8_BAR
#undef PG8_SCHED
}
}

#ifndef PG8_SP2
#define PG8_SP2 true
#endif
#ifndef PG8_ALIGN
#define PG8_ALIGN true
#endif
constexpr int NB = 16, SEQ = 2048, NMETA = 16, D = 1024, FF = 4096;
constexpr int MR = NB * SEQ;
constexpr int NH = 8, DQK = 64, DV = 128;
constexpr int NPROJ = 3072;
constexpr float EPS = 1e-6f, SUBLN_EPS = 1e-5f;
constexpr int NWAVES = 8;
#ifndef MK_N_LAUNCHES
#define MK_N_LAUNCHES 1
#endif
constexpr int NPHASE = 12;

constexpr size_t MiB = 1u << 20;
constexpr size_t WS_CTL = 0, CTL_ZERO_BYTES = 1 * MiB;
constexpr size_t WS_WIN0 = 1 * MiB, WS_WOUT0 = 7 * MiB, WS_WUP0 = 9 * MiB, WS_WDN0 = 17 * MiB;
constexpr size_t WS_WIN1 = 25 * MiB, WS_WOUT1 = 31 * MiB, WS_WUP1 = 33 * MiB, WS_WDN1 = 41 * MiB;
constexpr size_t WS_META = 49 * MiB;
constexpr size_t WS_HMETA = WS_META;
constexpr size_t WS_HBM = WS_HMETA + 16 * D * 4;
constexpr size_t WS_PM = WS_HBM + 16 * D * 2;
constexpr size_t WS_MIXM = WS_PM + 16 * NPROJ * 2;
constexpr size_t WS_UM = WS_MIXM + 16 * D * 2;
constexpr size_t WS_GATESM = WS_UM + 16 * FF * 2;
constexpr size_t WS_SS = 50 * MiB;
constexpr size_t WS_GATES = 52 * MiB;
constexpr size_t WS_HB = 54 * MiB;
constexpr size_t WS_P = 118 * MiB;
constexpr size_t WS_MIX = 310 * MiB;
constexpr size_t WS_U = WS_P;
constexpr size_t WS_END = 374 * MiB;
static_assert(WS_GATESM + 1024 <= WS_SS && WS_HB + (size_t)MR * D * 2 <= WS_P && WS_P + (size_t)MR * NPROJ * 2 <= WS_MIX && WS_U + (size_t)MR * FF * 2 <= WS_END && WS_MIX + (size_t)MR * D * 2 <= WS_END, "d_ws map");
constexpr int CW_BAR = 4096;
constexpr int CW_SSM = 16384;

constexpr int RING_OFF = 0, RING_BYTES = 131072;
constexpr int XTRA_OFF = RING_BYTES, XTRA_BYTES = 30720;
constexpr int LDSCTL_OFF = XTRA_OFF + XTRA_BYTES, MISC_OFF = LDSCTL_OFF + 320;
constexpr int LDS_BYTES = 163840;
static_assert(MISC_OFF + 128 <= LDS_BYTES, "LDS map");

#define GAS __attribute__((address_space(1)))
#define LAS __attribute__((address_space(3)))
typedef unsigned short bf16;
typedef unsigned v4u __attribute__((ext_vector_type(4)));
typedef float f32x4 __attribute__((ext_vector_type(4)));
typedef GAS unsigned gu32;
#define RLX_AGENT __ATOMIC_RELAXED, __HIP_MEMORY_SCOPE_AGENT
#define LDS_WAIT() asm volatile("s_waitcnt lgkmcnt(0)" ::: "memory")
__device__ __forceinline__ unsigned f2bf(float f) { unsigned u = __builtin_bit_cast(unsigned, f); return (u + 0x7fffu + ((u >> 16) & 1u)) >> 16; }
__device__ __forceinline__ unsigned pk2(float lo, float hi) { return f2bf(lo) | (f2bf(hi) << 16); }
__device__ __forceinline__ float bf2f(unsigned short v) { return __builtin_bit_cast(float, (unsigned)v << 16); }
__device__ __forceinline__ float bflo(unsigned w) { return __builtin_bit_cast(float, w << 16); }
__device__ __forceinline__ float bfhi(unsigned w) { return __builtin_bit_cast(float, w & 0xffff0000u); }

#define XB_TMO      128
#define XB_XCNT(j)  (256  + 64 * (j))
#define XB_XSUB(j)  (1280 + 64 * (j))
#define XB_XGEN(j)  (2304 + 64 * (j))
#define XB_TOP      3328
#define XB_TOPGEN   3392
#define XCD_BAR_WORDS 3456
#define XB_SPIN_CAP (1u << 18)
__device__ __forceinline__ unsigned xb_ld(unsigned* p)              { return __hip_atomic_load(p, __ATOMIC_RELAXED, __HIP_MEMORY_SCOPE_AGENT); }
__device__ __forceinline__ unsigned xb_add(unsigned* p, unsigned v) { return __hip_atomic_fetch_add(p, v, __ATOMIC_RELAXED, __HIP_MEMORY_SCOPE_AGENT); }
__device__ __forceinline__ unsigned xb_xcc_id() { return (unsigned)__builtin_amdgcn_s_getreg((3 << 11) | 20) & 0xFu; }
#define XB_SPIN(cond, bar) do { unsigned _sp = 0; while (cond) { __builtin_amdgcn_s_sleep(1); \
    if ((++_sp & 255u) == 0u) { if (xb_ld(&(bar)[XB_TMO])) break; if (_sp > XB_SPIN_CAP) { atomicAdd(&(bar)[XB_TMO], 1u); break; } } } } while (0)
struct XcdBarrier { unsigned* bar; unsigned x; volatile LAS unsigned* st; };
__device__ __forceinline__ XcdBarrier xcd_barrier_post(unsigned* bar, volatile LAS unsigned* st) {
    XcdBarrier b; b.bar = bar; b.x = xb_xcc_id(); b.st = st;
    if (threadIdx.x == 0) (void)xb_add(&bar[XB_XCNT(b.x)], 1u);
    return b;
}
__device__ __forceinline__ void xcd_barrier_complete(unsigned* bar, unsigned x, unsigned& nloc, unsigned& nx) {
    const unsigned G = gridDim.x * gridDim.y * gridDim.z;
    unsigned sum, cnt, mine, sp = 0u;
    for (;;) {
        sum = 0u; cnt = 0u; mine = 0u;
#pragma unroll
        for (unsigned j = 0; j < 16; ++j) { const unsigned c = xb_ld(&bar[XB_XCNT(j)]); sum += c; cnt += (c > 0u) ? 1u : 0u; mine = (j == x) ? c : mine; }
        if (sum == G) break;
        __builtin_amdgcn_s_sleep(1);
        if ((++sp & 255u) == 0u) { if (xb_ld(&bar[XB_TMO])) break; if (sp > XB_SPIN_CAP) { atomicAdd(&bar[XB_TMO], 1u); break; } }
    }
    nloc = mine > 0u ? mine : 1u; nx = cnt > 0u ? cnt : 1u;
}
__device__ __forceinline__ void xcd_barrier(const XcdBarrier& b) {
    asm volatile("s_waitcnt vmcnt(0)" ::: "memory");
    __syncthreads();
    if (threadIdx.x == 0) {
        unsigned* bar = b.bar;
        __builtin_amdgcn_s_waitcnt(0);
        unsigned nloc = b.st[0], nx = b.st[1];
        if (nloc == 0u) { xcd_barrier_complete(bar, b.x, nloc, nx); b.st[0] = nloc; b.st[1] = nx; }
        const unsigned old = xb_add(&bar[XB_XSUB(b.x)], 1u);
        const unsigned gen = old / nloc;
        if (old + 1u == (gen + 1u) * nloc) {
            __builtin_amdgcn_fence(__ATOMIC_RELEASE, "agent");
            asm volatile("s_waitcnt vmcnt(0)" ::: "memory");
            const unsigned og = xb_add(&bar[XB_TOP], 1u);
            const unsigned tg = og / nx;
            if (og + 1u == (tg + 1u) * nx) xb_add(&bar[XB_TOPGEN], 1u);
            else XB_SPIN(xb_ld(&bar[XB_TOPGEN]) == tg, bar);
            __builtin_amdgcn_fence(__ATOMIC_ACQUIRE, "agent");
            xb_add(&bar[XB_XGEN(b.x)], 1u);
            asm volatile("s_waitcnt vmcnt(0)" ::: "memory");
        } else {
            XB_SPIN(xb_ld(&bar[XB_XGEN(b.x)]) == gen, bar);
            __builtin_amdgcn_fence(__ATOMIC_ACQUIRE, "agent");
            asm volatile("s_waitcnt vmcnt(0)" ::: "memory");
        }
    }
    __syncthreads();
}

struct Frame {
    LAS unsigned char* lds;
    volatile LAS unsigned* MISC;
    gu32* ctl;
    int tid, lane, wave, vcu, G;
    const float *x, *meta, *ngain, *m_win, *m_bgate, *m_hgain, *m_wout, *d_win, *d_lam, *d_hgain, *d_wout, *w_up, *w_dn, *fgain;
    float* out; unsigned char* ws;
    bf16 *WIN0, *WOUT0, *WUP0, *WDN0, *WIN1, *WOUT1, *WUP1, *WDN1, *HB, *P, *MIX, *U;
    float *SS, *GATES;
    bf16 *HBM, *PM, *MIXM, *UM; float *HMETA, *GATESM, *SSM;
};
__device__ __forceinline__ float wave_sum(float v) {
#pragma unroll
    for (int o = 1; o < 64; o <<= 1) v += __shfl_xor(v, o);
    return v;
}
typedef short bf16x8_t __attribute__((ext_vector_type(8)));
__device__ __forceinline__ f32x4 mfma16(bf16x8_t a, bf16x8_t b, f32x4 c) { return __builtin_amdgcn_mfma_f32_16x16x32_bf16(a, b, c, 0, 0, 0); }
__device__ __forceinline__ void transpose_item(const float* W, int K, int ldw, int Nuse, const float* gk, int nscale, bf16* WT, LAS float* scr, int item, int lane) {
    const int nblk = Nuse / 32, kb = item / nblk, nb = item % nblk, k0 = 64 * kb, n0 = 32 * nb;
    const float cs = (n0 < nscale) ? 0.125f : 1.f;
    const int lr = lane >> 3, lp = lane & 7;
#pragma unroll
    for (int i = 0; i < 8; ++i) { const int kk = 8 * i + lr; const float g = gk ? gk[k0 + kk] * cs : cs; const f32x4 v = *(const GAS f32x4*)(W + (size_t)(k0 + kk) * ldw + n0 + 4 * lp);
        LAS float* d = scr + kk * 33 + 4 * lp; d[0] = v.x * g; d[1] = v.y * g; d[2] = v.z * g; d[3] = v.w * g; }
    LDS_WAIT(); asm volatile("" ::: "memory");
    const int c = lane & 7;
#pragma unroll
    for (int j = 0; j < 4; ++j) { const int n = (lane >> 3) + 8 * j; const LAS float* s = scr + (8 * c) * 33 + n;
        v4u o; o.x = pk2(s[0 * 33], s[1 * 33]); o.y = pk2(s[2 * 33], s[3 * 33]); o.z = pk2(s[4 * 33], s[5 * 33]); o.w = pk2(s[6 * 33], s[7 * 33]);
        *(GAS v4u*)(WT + (size_t)(n0 + n) * K + k0 + 8 * c) = o; }
    LDS_WAIT(); asm volatile("" ::: "memory");
}
constexpr int I_IN = (D / 64) * (NPROJ / 32), I_OUT = (D / 64) * (D / 32), I_UP = (D / 64) * (FF / 32), I_DN = (FF / 64) * (D / 32);
constexpr int I_LAYER = I_IN + I_OUT + I_UP + I_DN, NITEMS = 2 * I_LAYER;
__device__ __forceinline__ void convert_weights(Frame& F, int it0, int it1, int gw, int ngw, LAS float* scr) {
    for (int it = it0 + gw; it < it1; it += ngw) {
        const int layer = it / I_LAYER; int r = it % I_LAYER;
        const float* g0 = F.ngain + (layer * 2 + 0) * D; const float* g1 = F.ngain + (layer * 2 + 1) * D;
        if (r < I_IN) { if (layer == 0) transpose_item(F.m_win, D, 3088, NPROJ, g0, 512, F.WIN0, scr, r, F.lane); else transpose_item(F.d_win, D, NPROJ, NPROJ, g0, 1024, F.WIN1, scr, r, F.lane); continue; } r -= I_IN;
        if (r < I_OUT) { transpose_item(layer == 0 ? F.m_wout : F.d_wout, D, D, D, nullptr, 0, layer == 0 ? F.WOUT0 : F.WOUT1, scr, r, F.lane); continue; } r -= I_OUT;
        if (r < I_UP) { transpose_item(F.w_up + (size_t)layer * D * FF, D, FF, FF, g1, 0, layer == 0 ? F.WUP0 : F.WUP1, scr, r, F.lane); continue; } r -= I_UP;
        transpose_item(F.w_dn + (size_t)layer * FF * D, FF, D, D, nullptr, 0, layer == 0 ? F.WDN0 : F.WDN1, scr, r, F.lane);
    }
}
constexpr int WGSTR = 2048 + 16;
__device__ __forceinline__ void embed_group(Frame& F, const float* src, bf16* hb, float* ssd, int ss_stride, float* gd, const LAS unsigned char* wgl) {
    const int li = F.lane & 15, g = F.lane >> 4;
    const float* sp = src + (size_t)li * D + 8 * g; bf16* hp = hb + (size_t)li * D + 8 * g; const LAS unsigned char* wp = wgl + li * WGSTR + 16 * g;
    f32x4 acc = (f32x4){0.f, 0.f, 0.f, 0.f}; float ssp = 0.f;
#pragma unroll 8
    for (int ks = 0; ks < 32; ++ks) {
        const f32x4 a0 = *(const GAS f32x4*)(sp + 32 * ks), a1 = *(const GAS f32x4*)(sp + 32 * ks + 4);
        ssp += ((a0.x * a0.x + a0.y * a0.y) + (a0.z * a0.z + a0.w * a0.w)) + ((a1.x * a1.x + a1.y * a1.y) + (a1.z * a1.z + a1.w * a1.w));
        v4u pw; pw.x = pg8::cvt_pk_bf16(a0.x, a0.y); pw.y = pg8::cvt_pk_bf16(a0.z, a0.w); pw.z = pg8::cvt_pk_bf16(a1.x, a1.y); pw.w = pg8::cvt_pk_bf16(a1.z, a1.w);
        *(GAS v4u*)(hp + 32 * ks) = pw;
        acc = mfma16(__builtin_bit_cast(bf16x8_t, pw), *(const LAS bf16x8_t*)(wp + 64 * ks), acc);
    }
    ssp += __shfl_xor(ssp, 16); ssp += __shfl_xor(ssp, 32);
    const float rstd = 1.0f / sqrtf(ssp * (1.0f / D) + EPS);
    if (g == 0) ssd[(size_t)li * ss_stride] = ssp;
    const float bg = F.m_bgate[li];
#pragma unroll
    for (int r = 0; r < 4; ++r) { const float rs = __shfl(rstd, 4 * g + r); gd[(size_t)(4 * g + r) * 16 + li] = acc[r] * rs + bg; }
}
__device__ __forceinline__ void p0_prologue(Frame& F) {
    LAS float* scr = (LAS float*)(F.lds + RING_OFF + F.wave * 16384);
    const int gw = F.vcu * NWAVES + F.wave, NGW = F.G * NWAVES;
    convert_weights(F, 0, I_IN, gw, NGW, scr);
    __syncthreads();
    LAS unsigned char* wgl = F.lds + RING_OFF;
    for (int i = F.tid; i < 16 * D; i += NWAVES * 64) { const int k = i >> 4, j = i & 15; *(LAS bf16*)(wgl + j * WGSTR + k * 2) = (bf16)f2bf(F.m_win[(size_t)k * 3088 + NPROJ + j] * F.ngain[k]); }
    __syncthreads();
    for (int grp = gw; grp <= MR / 16; grp += NGW) {
        if (grp < MR / 16) embed_group(F, F.x + (size_t)grp * 16 * D, F.HB + (size_t)grp * 16 * D, F.SS + (size_t)grp * 16 * 16, 16, F.GATES + (size_t)grp * 16 * 16, wgl);
        else embed_group(F, F.meta, F.HBM, F.SSM, 64, F.GATESM, wgl);
    }
}
__device__ __forceinline__ float meta_rstd(const float* ssm, int lane) {
    float mine = 0.f;
#pragma unroll 4
    for (int r = 0; r < 16; ++r) { const float s = wave_sum(ssm[r * 64 + lane]); if (lane == r) mine = 1.0f / sqrtf(s * (1.0f / D) + EPS); }
    return mine;
}
template <int ACT> struct MEpiScale {
    bf16* O; int ldc; const float* ssm;
    __device__ __forceinline__ void operator()(int cb, int li, int g, int lane, const float (&v)[4]) const {
        const float mine = meta_rstd(ssm, lane);
#pragma unroll
        for (int r = 0; r < 4; ++r) { float x = v[r] * __shfl(mine, 4 * g + r); if (ACT == 1) { x = fmaxf(x, 0.f); x = x * x; } O[(size_t)(4 * g + r) * ldc + 16 * cb + li] = (bf16)f2bf(x); }
    }
};
struct MEpiRes {
    const float* Hin; float* H; bf16* HB; float* ssm;
    __device__ __forceinline__ void operator()(int cb, int li, int g, int lane, const float (&v)[4]) const {
#pragma unroll
        for (int r = 0; r < 4; ++r) { const int row = 4 * g + r; const float hv = Hin[(size_t)row * D + 16 * cb + li] + v[r]; H[(size_t)row * D + 16 * cb + li] = hv; HB[(size_t)row * D + 16 * cb + li] = (bf16)f2bf(hv);
            float q = hv * hv; q += __shfl_xor(q, 1); q += __shfl_xor(q, 2); q += __shfl_xor(q, 4); q += __shfl_xor(q, 8);
            if (li == 0) ssm[row * 64 + cb] = q; }
    }
};
template <class MEpi> __device__ __forceinline__ void meta_gemm(Frame& F, const bf16* A, const bf16* Bt, int cb0, int cb1, int K, const MEpi& E) {
    LAS float* red = (LAS float*)(F.lds + XTRA_OFF);
    const int li = F.lane & 15, g = F.lane >> 4, kw = K / NWAVES;
    for (int cb = cb0 + (int)blockIdx.x; cb < cb1; cb += F.G) {
        const bf16* ap = A + (size_t)li * K + F.wave * kw + 8 * g; const bf16* bp = Bt + (size_t)(16 * cb + li) * K + F.wave * kw + 8 * g;
        f32x4 acc = (f32x4){0.f, 0.f, 0.f, 0.f};
#pragma unroll 4
        for (int ks = 0; ks < kw / 32; ++ks) acc = mfma16(*(const GAS bf16x8_t*)(ap + 32 * ks), *(const GAS bf16x8_t*)(bp + 32 * ks), acc);
#pragma unroll
        for (int r = 0; r < 4; ++r) red[F.wave * 256 + r * 64 + F.lane] = acc[r];
        __syncthreads();
        if (F.wave == 0) { float v[4];
#pragma unroll
            for (int r = 0; r < 4; ++r) { float s = 0.f;
#pragma unroll
                for (int ww = 0; ww < NWAVES; ++ww) s += red[ww * 256 + r * 64 + F.lane]; v[r] = s; }
            E(cb, li, g, F.lane, v); }
        __syncthreads();
    }
}
__device__ __forceinline__ void final_norm_phase(Frame& F) {
    const int gw = F.vcu * NWAVES + F.wave, NGW = F.G * NWAVES;
    for (int row = gw; row < MR; row += NGW) {
        const float rs = pg8::row_rstd<16>(F.SS, row, EPS);
        GAS f32x4* p = (GAS f32x4*)(F.out + (size_t)row * D);
#pragma unroll
        for (int j = 0; j < 4; ++j) { f32x4 v = p[64 * j + F.lane]; const f32x4 g = ((const GAS f32x4*)F.fgain)[64 * j + F.lane]; v = v * rs * g; p[64 * j + F.lane] = v; }
    }
}
namespace attn2 {
typedef short bf16x8 __attribute__((ext_vector_type(8)));
typedef short s16x4 __attribute__((ext_vector_type(4)));
typedef float f32x16 __attribute__((ext_vector_type(16)));
constexpr int KSTR = 272, VSTR = 320, KBYTES = 64 * KSTR, VBYTES = 64 * VSTR, BUFB = KBYTES + VBYTES;
constexpr int CBS = 129;
constexpr float LOG2E = 1.4426950408889634f;
__device__ __forceinline__ int crow(int r, int hi) { return (r & 3) + 8 * (r >> 2) + 4 * hi; }
__device__ __forceinline__ s16x4 vtr(const LAS unsigned char* p) { return __builtin_bit_cast(s16x4, __builtin_amdgcn_ds_read_tr16_b64_v4i16((LAS s16x4*)p)); }
__device__ __forceinline__ bf16x8 pack8(const f32x16& p, int b0) {
    v4u w; w.x = pg8::cvt_pk_bf16(p[b0], p[b0 + 1]); w.y = pg8::cvt_pk_bf16(p[b0 + 2], p[b0 + 3]); w.z = pg8::cvt_pk_bf16(p[b0 + 4], p[b0 + 5]); w.w = pg8::cvt_pk_bf16(p[b0 + 6], p[b0 + 7]);
    return __builtin_bit_cast(bf16x8, w);
}
}
__device__ __forceinline__ void attn_mfma_phase(Frame& F) {
    using namespace attn2;
    const int tid = F.tid, lane = F.lane, wave = F.wave, r32 = lane & 31, hi = lane >> 5, rb = wave >> 1, comp = wave & 1;
    const float lambda_init = 0.8f - 0.6f * expf(-0.3f * 1.0f);
    float lam; { float s01 = 0.f, s23 = 0.f; for (int i = 0; i < 64; ++i) { s01 += F.d_lam[i] * F.d_lam[64 + i]; s23 += F.d_lam[128 + i] * F.d_lam[192 + i]; } lam = expf(s01) - expf(s23) + lambda_init; }
    const int npw = (1024 + F.G - 1) / F.G;
    LAS unsigned char* lds = F.lds;
    LAS float* cb = (LAS float*)lds;
    const int li = lane & 15, q4 = li >> 2, p4 = li & 3, g1 = (lane >> 4) & 1;
    for (int it = 0; it < 2 * npw; ++it) {
        const int pi = F.vcu * npw + (it >> 1); if (pi >= 1024) break;
        const int bh = pi >> 3, s = pi & 7, b = bh >> 3, h = bh & 7, jq = (it & 1) ? 15 - s : s;
        const int qrow = b * SEQ + 128 * jq + 32 * rb + r32;
        const int cw = 2 * jq + 1 + (rb >> 1), NT = 2 * jq + 3;
        bf16x8 qf[4];
        { const bf16* qp = F.P + (size_t)qrow * NPROJ + h * 128 + comp * 64 + hi * 8;
#pragma unroll
          for (int d0 = 0; d0 < 4; ++d0) qf[d0] = *(const GAS bf16x8*)(qp + 16 * d0); }
        f32x16 o[4];
#pragma unroll
        for (int k = 0; k < 4; ++k)
#pragma unroll
            for (int r = 0; r < 16; ++r) o[k][r] = 0.f;
        float m = -1e30f, l = 0.f;
        v4u sv[4];
#define ATT_LOAD(t) do { _Pragma("unroll") for (int i_ = 0; i_ < 4; ++i_) { const int id_ = i_ * 512 + tid, row_ = id_ >> 5, pc_ = id_ & 31; \
            const int col_ = (pc_ < 16 ? 1024 + pc_ * 8 : 2048 + (pc_ - 16) * 8) + h * 128; \
            if ((t) == 0) { if (row_ < 16) sv[i_] = *(const GAS v4u*)(F.PM + (size_t)row_ * NPROJ + col_); else sv[i_] = (v4u){0u, 0u, 0u, 0u}; } \
            else sv[i_] = *(const GAS v4u*)(F.P + (size_t)(b * SEQ + ((t) - 1) * 64 + row_) * NPROJ + col_); } } while (0)
#define ATT_STORE(buf) do { _Pragma("unroll") for (int i_ = 0; i_ < 4; ++i_) { const int id_ = i_ * 512 + tid, row_ = id_ >> 5, pc_ = id_ & 31; \
            LAS unsigned char* d_ = lds + (buf) * BUFB + (pc_ < 16 ? row_ * KSTR + pc_ * 16 : KBYTES + row_ * VSTR + (pc_ - 16) * 16); *(LAS v4u*)d_ = sv[i_]; } } while (0)
        __syncthreads();
        ATT_LOAD(0); ATT_STORE(0);
        __syncthreads();
        for (int t = 0; t < NT; ++t) {
            if (t + 1 < NT) ATT_LOAD(t + 1);
            if (t <= cw) {
                const LAS unsigned char* Kb = lds + (t & 1) * BUFB; const LAS unsigned char* Vb = Kb + KBYTES;
                bf16x8 kf[2][4];
#pragma unroll
                for (int kh = 0; kh < 2; ++kh)
#pragma unroll
                    for (int d0 = 0; d0 < 4; ++d0) kf[kh][d0] = *(const LAS bf16x8*)(Kb + (32 * kh + r32) * KSTR + comp * 128 + d0 * 32 + hi * 16);
                f32x16 p0, p1;
#pragma unroll
                for (int r = 0; r < 16; ++r) { p0[r] = 0.f; p1[r] = 0.f; }
#pragma unroll
                for (int d0 = 0; d0 < 4; ++d0) { p0 = __builtin_amdgcn_mfma_f32_32x32x16_bf16(kf[0][d0], qf[d0], p0, 0, 0, 0); p1 = __builtin_amdgcn_mfma_f32_32x32x16_bf16(kf[1][d0], qf[d0], p1, 0, 0, 0); }
                if (t == 0) {
#pragma unroll
                    for (int r = 0; r < 16; ++r) { if (r >= 8) p0[r] = -INFINITY; p1[r] = -INFINITY; } }
                float rm = fmaxf(p0[0], p1[0]);
#pragma unroll
                for (int r = 1; r < 16; ++r) rm = fmaxf(rm, fmaxf(p0[r], p1[r]));
                rm = fmaxf(rm, __shfl_xor(rm, 32));
                const float mn = fmaxf(m, rm), alpha = __builtin_amdgcn_exp2f((m - mn) * LOG2E), mL = mn * LOG2E; m = mn;
                float ls = 0.f;
#pragma unroll
                for (int r = 0; r < 16; ++r) { p0[r] = __builtin_amdgcn_exp2f(fmaf(p0[r], LOG2E, -mL)); p1[r] = __builtin_amdgcn_exp2f(fmaf(p1[r], LOG2E, -mL)); ls += p0[r] + p1[r]; }
                l = l * alpha + ls;
#pragma unroll
                for (int k = 0; k < 4; ++k)
#pragma unroll
                    for (int r = 0; r < 16; ++r) o[k][r] *= alpha;
                bf16x8 pf[4]; pf[0] = pack8(p0, 0); pf[1] = pack8(p0, 8); pf[2] = pack8(p1, 0); pf[3] = pack8(p1, 8);
                const LAS unsigned char* vbase = Vb + (4 * hi + q4) * VSTR + (16 * g1 + 4 * p4) * 2;
#pragma unroll
                for (int blk = 0; blk < 4; ++blk)
#pragma unroll
                    for (int ks = 0; ks < 4; ++ks) {
                        const s16x4 lo = vtr(vbase + (16 * ks) * VSTR + blk * 64), hh = vtr(vbase + (16 * ks + 8) * VSTR + blk * 64);
                        const bf16x8 vf = (bf16x8){lo[0], lo[1], lo[2], lo[3], hh[0], hh[1], hh[2], hh[3]};
                        o[blk] = __builtin_amdgcn_mfma_f32_32x32x16_bf16(vf, pf[ks], o[blk], 0, 0, 0);
                    }
            }
            if (t + 1 < NT) ATT_STORE((t + 1) & 1);
            __syncthreads();
        }
#undef ATT_LOAD
#undef ATT_STORE
        l += __shfl_xor(l, 32);
        const float inv = 1.0f / l;
        LAS float* cbw = cb + (rb * 32 + r32) * CBS;
        if (comp == 1) {
#pragma unroll
            for (int blk = 0; blk < 4; ++blk)
#pragma unroll
                for (int r = 0; r < 16; ++r) cbw[32 * blk + crow(r, hi)] = o[blk][r] * inv;
        }
        __syncthreads();
        if (comp == 0) {
            float ssq = 0.f;
#pragma unroll
            for (int blk = 0; blk < 4; ++blk)
#pragma unroll
                for (int r = 0; r < 16; ++r) { const float d = o[blk][r] * inv - lam * cbw[32 * blk + crow(r, hi)]; o[blk][r] = d; ssq += d * d; }
            ssq += __shfl_xor(ssq, 32);
            const float rr = (1.0f - lambda_init) / sqrtf(ssq * (1.0f / DV) + SUBLN_EPS);
            bf16* dst = F.MIX + (size_t)qrow * D + h * DV; const float* gp = F.d_hgain + h * DV;
#pragma unroll
            for (int blk = 0; blk < 4; ++blk)
#pragma unroll
                for (int r = 0; r < 16; ++r) { const int dv = 32 * blk + crow(r, hi); dst[dv] = (bf16)f2bf(o[blk][r] * rr * gp[dv]); }
        }
    }
}
namespace ml2 {
typedef short bf16x8 __attribute__((ext_vector_type(8)));
typedef short s16x4 __attribute__((ext_vector_type(4)));
constexpr int QSTR = 144, VSTR = 272;
constexpr int OFF_Q = 0, OFF_K = 64 * QSTR, OFF_V = 2 * 64 * QSTR, DBUF = OFF_V + 64 * VSTR;
constexpr int OFF_S = 2 * DBUF, SBUF = 64 * 144;
constexpr int HSTR = 132, OFF_H = OFF_S + 2 * SBUF, HBYTES = 64 * HSTR * 4;
constexpr int OFF_SM = OFF_H + HBYTES, SMB = 12 * 256;
constexpr int A_G = 0, A_M = 64, A_B = 128, A_W = 192, A_RS = 256  , A_QN = 512, A_CT = 576, A_AT = 640, A_N = 704;
static_assert(OFF_SM + 2 * SMB <= RING_BYTES, "mLSTM LDS map");
__device__ __forceinline__ s16x4 vtr(const LAS unsigned char* p) { return __builtin_bit_cast(s16x4, __builtin_amdgcn_ds_read_tr16_b64_v4i16((LAS s16x4*)p)); }

}
__device__ __forceinline__ void mlstm_mfma_phase(Frame& F) {
    using namespace ml2;
    const int tid = F.tid, lane = F.lane, w = F.wave, li = lane & 15, g = lane >> 4, q4 = li >> 2, p4 = li & 3;
    LAS unsigned char* lds = F.lds;
    const int zt = tid >> 3, zc = tid & 7;
    const int mlwg = F.G / 2;
    if (F.vcu >= mlwg) { convert_weights(F, I_IN, NITEMS, (F.vcu - mlwg) * NWAVES + F.wave, (F.G - mlwg) * NWAVES, (LAS float*)(F.lds + RING_OFF + F.wave * 16384)); return; }
    for (int unit = F.vcu; unit < NB * NH; unit += mlwg) {
        const int b = unit >> 3, h = unit & 7;
        __syncthreads();
        for (int i = tid; i < (2 * SBUF) / 16; i += 512) *(LAS v4u*)(lds + OFF_S + i * 16) = (v4u){0u, 0u, 0u, 0u};
        for (int i = tid; i < (2 * SMB) / 16; i += 512) *(LAS v4u*)(lds + OFF_SM + i * 16) = (v4u){0u, 0u, 0u, 0u};
        f32x4 Cacc[4];
#pragma unroll
        for (int i = 0; i < 4; ++i) Cacc[i] = (f32x4){0.f, 0.f, 0.f, 0.f};
        float m = 0.f;
        float gn[16];
#pragma unroll
        for (int i = 0; i < 4; ++i) { const f32x4 t4 = *(const GAS f32x4*)(F.m_hgain + h * DV + 16 * zc + 4 * i); gn[4 * i] = t4.x; gn[4 * i + 1] = t4.y; gn[4 * i + 2] = t4.z; gn[4 * i + 3] = t4.w; }
        v4u sq, sk, sv0, sv1;
#define ML_ROW0(c) ((c) == 0 ? 0 : b * SEQ + ((c) - 1) * 64)
#define ML_PB(c) ((c) == 0 ? F.PM : F.P)
#define ML_LOAD(c) do { const int r0_ = ML_ROW0(c); const bool okq_ = ((c) != 0) || (zt < 16); \
            const bf16* pq_ = ML_PB(c) + (size_t)(r0_ + zt) * NPROJ + h * 64 + 8 * zc; \
            if (okq_) { sq = *(const GAS v4u*)pq_; sk = *(const GAS v4u*)(pq_ + 512); } else { sq = (v4u){0u, 0u, 0u, 0u}; sk = sq; } \
            const int rv0_ = tid >> 4, rv1_ = (tid + 512) >> 4, pv_ = tid & 15; \
            if (((c) != 0) || rv0_ < 16) sv0 = *(const GAS v4u*)(ML_PB(c) + (size_t)(r0_ + rv0_) * NPROJ + 1024 + h * 128 + 8 * pv_); else sv0 = (v4u){0u, 0u, 0u, 0u}; \
            if ((c) != 0) sv1 = *(const GAS v4u*)(F.P + (size_t)(r0_ + rv1_) * NPROJ + 1024 + h * 128 + 8 * pv_); else sv1 = (v4u){0u, 0u, 0u, 0u}; } while (0)
#define ML_STORE(par) do { LAS unsigned char* d_ = lds + (par) * DBUF; *(LAS v4u*)(d_ + OFF_Q + zt * QSTR + zc * 16) = sq; *(LAS v4u*)(d_ + OFF_K + zt * QSTR + zc * 16) = sk; \
            *(LAS v4u*)(d_ + OFF_V + (tid >> 4) * VSTR + (tid & 15) * 16) = sv0; *(LAS v4u*)(d_ + OFF_V + ((tid + 512) >> 4) * VSTR + (tid & 15) * 16) = sv1; } while (0)
        ML_LOAD(0); ML_STORE(0);
        __syncthreads();
        for (int c = 0; c <= 32; ++c) {
            const int par = c & 1; const int row0 = ML_ROW0(c);
            LAS unsigned char* db = lds + par * DBUF; LAS float* sm = (LAS float*)(lds + OFF_SM + par * SMB); LAS float* smn = (LAS float*)(lds + OFF_SM + (par ^ 1) * SMB);
            LAS unsigned char* Sb = lds + OFF_S + par * SBUF;
            if (c < 32) ML_LOAD(c + 1);
            v4u og0 = (v4u){0u, 0u, 0u, 0u}, og1 = og0; const bool zvalid = (c != 0) || (zt < 16);
            if (zvalid) { const bf16* po = ML_PB(c) + (size_t)(row0 + zt) * NPROJ + 2048 + h * 128 + 16 * zc; og0 = *(const GAS v4u*)po; og1 = *(const GAS v4u*)(po + 8); }
            float lf = 0.f, ig = -1e30f;
            if (c != 0 || lane < 16) { const float* gp = (c == 0 ? F.GATESM : F.GATES) + (size_t)(row0 + lane) * 16; const float fg = gp[8 + h]; ig = gp[h]; lf = fminf(fg, 0.f) - log1pf(expf(-fabsf(fg))); }
            float bs = lf;
#pragma unroll
            for (int o = 1; o < 64; o <<= 1) { const float v = __shfl_up(bs, o); if (lane >= o) bs += v; }
            const float gs = ig - bs; float pm = gs;
#pragma unroll
            for (int o = 1; o < 64; o <<= 1) { const float v = __shfl_up(pm, o); if (lane >= o) pm = fmaxf(pm, v); }
            const float Mt = fmaxf(m, pm);
            const float MT = __shfl(Mt, 63), bT = __shfl(bs, 63);
            const float ws = expf(gs - MT), decay = expf(m - MT);
            sm[A_G + lane] = gs; sm[A_M + lane] = Mt; sm[A_B + lane] = bs; sm[A_W + lane] = ws;
            for (int ti = w; ti < 10; ti += 8) {
                const int rt = ti < 1 ? 0 : ti < 3 ? 1 : ti < 6 ? 2 : 3, st = ti - rt * (rt + 1) / 2;
                f32x4 acc = (f32x4){0.f, 0.f, 0.f, 0.f};
#pragma unroll
                for (int ks = 0; ks < 2; ++ks) { const bf16x8 a = *(const LAS bf16x8*)(db + OFF_Q + (16 * rt + li) * QSTR + (32 * ks + 8 * g) * 2), bb = *(const LAS bf16x8*)(db + OFF_K + (16 * st + li) * QSTR + (32 * ks + 8 * g) * 2);
                    acc = mfma16(a, bb, acc); }
                const float g_s = sm[A_G + 16 * st + li]; const f32x4 M4 = *(const LAS f32x4*)(sm + A_M + 16 * rt + 4 * g);
                float val[4];
#pragma unroll
                for (int r = 0; r < 4; ++r) { const bool ok = (16 * st + li) <= (16 * rt + 4 * g + r); val[r] = ok ? acc[r] * __expf(g_s - M4[r]) : 0.f; }
                float rs[4];
#pragma unroll
                for (int r = 0; r < 4; ++r) { float x = val[r]; x += __shfl_xor(x, 1); x += __shfl_xor(x, 2); x += __shfl_xor(x, 4); x += __shfl_xor(x, 8); rs[r] = x; }
                if (li == 0) *(LAS f32x4*)(sm + A_RS + st * 64 + 16 * rt + 4 * g) = (f32x4){rs[0], rs[1], rs[2], rs[3]};
#pragma unroll
                for (int r = 0; r < 4; ++r) *(LAS bf16*)(Sb + (16 * rt + 4 * g + r) * 144 + (16 * st + li) * 2) = (bf16)f2bf(val[r]);
            }
            { const v4u qv = *(const LAS v4u*)(db + OFF_Q + zt * QSTR + zc * 16); const f32x4 n0 = *(const LAS f32x4*)(sm + A_N + 8 * zc), n1 = *(const LAS f32x4*)(sm + A_N + 8 * zc + 4);
              float d = bflo(qv.x) * n0.x + bfhi(qv.x) * n0.y + bflo(qv.y) * n0.z + bfhi(qv.y) * n0.w + bflo(qv.z) * n1.x + bfhi(qv.z) * n1.y + bflo(qv.w) * n1.z + bfhi(qv.w) * n1.w;
              d += __shfl_xor(d, 1); d += __shfl_xor(d, 2); d += __shfl_xor(d, 4);
              if (zc == 0) sm[A_QN + zt] = d; }
            __syncthreads();
            { const float rsum = (sm[A_RS + lane] + sm[A_RS + 64 + lane]) + (sm[A_RS + 128 + lane] + sm[A_RS + 192 + lane]);
              const float inter = expf(m - Mt), den = rsum + inter * sm[A_QN + lane], dmax = fmaxf(fabsf(den), expf(-(bs + Mt))), ci = 1.0f / dmax;
              sm[A_CT + lane] = ci; sm[A_AT + lane] = inter * ci; }
            if (c < 32) ML_STORE(par ^ 1);
            bf16x8 vf[2], wv[2];
#pragma unroll
            for (int ks = 0; ks < 2; ++ks) {
                const LAS unsigned char* vp = db + OFF_V + (32 * ks + 8 * g + q4) * VSTR + (16 * w + 4 * p4) * 2;
                const s16x4 lo = vtr(vp), hh = vtr(vp + 4 * VSTR);
                vf[ks] = (bf16x8){lo[0], lo[1], lo[2], lo[3], hh[0], hh[1], hh[2], hh[3]};
                const f32x4 w0 = *(const LAS f32x4*)(sm + A_W + 32 * ks + 8 * g), w1 = *(const LAS f32x4*)(sm + A_W + 32 * ks + 8 * g + 4);
                v4u pw; pw.x = pk2(bf2f((unsigned short)lo[0]) * w0.x, bf2f((unsigned short)lo[1]) * w0.y); pw.y = pk2(bf2f((unsigned short)lo[2]) * w0.z, bf2f((unsigned short)lo[3]) * w0.w);
                pw.z = pk2(bf2f((unsigned short)hh[0]) * w1.x, bf2f((unsigned short)hh[1]) * w1.y); pw.w = pk2(bf2f((unsigned short)hh[2]) * w1.z, bf2f((unsigned short)hh[3]) * w1.w);
                wv[ks] = __builtin_bit_cast(bf16x8, pw);
            }
            bf16x8 cbf[2];
#pragma unroll
            for (int ks = 0; ks < 2; ++ks) { v4u pw; pw.x = pk2(Cacc[2 * ks][0], Cacc[2 * ks][1]); pw.y = pk2(Cacc[2 * ks][2], Cacc[2 * ks][3]); pw.z = pk2(Cacc[2 * ks + 1][0], Cacc[2 * ks + 1][1]); pw.w = pk2(Cacc[2 * ks + 1][2], Cacc[2 * ks + 1][3]);
                cbf[ks] = __builtin_bit_cast(bf16x8, pw); }
            f32x4 acc1[4], acc2[4];
#pragma unroll
            for (int rt = 0; rt < 4; ++rt) {
                acc1[rt] = (f32x4){0.f, 0.f, 0.f, 0.f}; acc2[rt] = (f32x4){0.f, 0.f, 0.f, 0.f};
#pragma unroll
                for (int ks = 0; ks < 2; ++ks) {
                    if (ks == 0 || rt >= 2) { const bf16x8 a = *(const LAS bf16x8*)(Sb + (16 * rt + li) * 144 + (32 * ks + 8 * g) * 2); acc1[rt] = mfma16(a, vf[ks], acc1[rt]); }
                    typedef unsigned u32x2 __attribute__((ext_vector_type(2)));
                    const u32x2 qa = *(const LAS u32x2*)(db + OFF_Q + (16 * rt + li) * QSTR + (32 * ks + 4 * g) * 2), qb = *(const LAS u32x2*)(db + OFF_Q + (16 * rt + li) * QSTR + (32 * ks + 16 + 4 * g) * 2);
                    const bf16x8 aq = __builtin_bit_cast(bf16x8, (v4u){qa.x, qa.y, qb.x, qb.y});
                    acc2[rt] = mfma16(aq, cbf[ks], acc2[rt]);
                }
            }
#pragma unroll
            for (int dt = 0; dt < 4; ++dt) {
                Cacc[dt] = Cacc[dt] * decay;
#pragma unroll
                for (int ks = 0; ks < 2; ++ks) {
                    const LAS unsigned char* kp = db + OFF_K + (32 * ks + 8 * g + q4) * QSTR + (16 * dt + 4 * p4) * 2;
                    const s16x4 lo = vtr(kp), hh = vtr(kp + 4 * QSTR);
                    const bf16x8 ka = (bf16x8){lo[0], lo[1], lo[2], lo[3], hh[0], hh[1], hh[2], hh[3]};
                    Cacc[dt] = mfma16(ka, wv[ks], Cacc[dt]);
                }
            }
            { float sacc = 0.f;
#pragma unroll
              for (int i = 0; i < 8; ++i) { const int s_ = 8 * zc + i; sacc += sm[A_W + s_] * bf2f(*(const LAS bf16*)(db + OFF_K + s_ * QSTR + zt * 2)); }
              sacc += __shfl_xor(sacc, 1); sacc += __shfl_xor(sacc, 2); sacc += __shfl_xor(sacc, 4);
              if (zc == 0) smn[A_N + zt] = decay * sm[A_N + zt] + sacc; }
            { LAS float* hb = (LAS float*)(lds + OFF_H);
#pragma unroll
              for (int rt = 0; rt < 4; ++rt) { const f32x4 c4 = *(const LAS f32x4*)(sm + A_CT + 16 * rt + 4 * g), a4 = *(const LAS f32x4*)(sm + A_AT + 16 * rt + 4 * g);
#pragma unroll
                  for (int r = 0; r < 4; ++r) hb[(16 * rt + 4 * g + r) * HSTR + 16 * w + li] = acc1[rt][r] * c4[r] + acc2[rt][r] * a4[r]; } }
            m = bT + MT;
            __syncthreads();
            { const LAS float* hb = (const LAS float*)(lds + OFF_H) + zt * HSTR + 16 * zc; float hv[16]; float ss = 0.f;
#pragma unroll
              for (int i = 0; i < 4; ++i) { const f32x4 t4 = *(const LAS f32x4*)(hb + 4 * i); hv[4 * i] = t4.x; hv[4 * i + 1] = t4.y; hv[4 * i + 2] = t4.z; hv[4 * i + 3] = t4.w; ss += (t4.x * t4.x + t4.y * t4.y) + (t4.z * t4.z + t4.w * t4.w); }
              ss += __shfl_xor(ss, 1); ss += __shfl_xor(ss, 2); ss += __shfl_xor(ss, 4);
              const float rn = 1.0f / sqrtf(ss * (1.0f / DV) + EPS);
              const unsigned ow[8] = {og0.x, og0.y, og0.z, og0.w, og1.x, og1.y, og1.z, og1.w}; unsigned res[8];
#pragma unroll
              for (int i = 0; i < 8; ++i) { const float o0 = bflo(ow[i]), o1 = bfhi(ow[i]);
                  res[i] = pk2(hv[2 * i] * rn * gn[2 * i] / (1.0f + __expf(-o0)), hv[2 * i + 1] * rn * gn[2 * i + 1] / (1.0f + __expf(-o1))); }
              if (zvalid && (c != 0 || b == 0)) { bf16* dst = (c == 0 ? F.MIXM : F.MIX) + (size_t)(row0 + zt) * D + h * DV + 16 * zc; *(GAS v4u*)dst = (v4u){res[0], res[1], res[2], res[3]}; *(GAS v4u*)(dst + 8) = (v4u){res[4], res[5], res[6], res[7]}; } }
        }
#undef ML_ROW0
#undef ML_PB
#undef ML_LOAD
#undef ML_STORE
    }
}
struct Args { const float* in[14]; float* out; unsigned char* ws; int ph_lo, ph_hi; };
__global__ void __launch_bounds__(NWAVES * 64, 2) fwd_kernel(Args args) {
    extern __shared__ __attribute__((aligned(16))) unsigned char lds[];
    Frame F;
    F.lds = (LAS unsigned char*)lds;
    F.MISC = (volatile LAS unsigned*)(F.lds + MISC_OFF);
    F.tid = threadIdx.x; F.lane = F.tid & 63; F.wave = __builtin_amdgcn_readfirstlane(F.tid >> 6);
    F.G = gridDim.x; { const int bx = blockIdx.x; F.vcu = (F.G % 8 == 0) ? (bx % 8) * (F.G / 8) + bx / 8 : bx; }
    unsigned char* ws = args.ws; F.ws = ws;
    F.ctl = (gu32*)(ws + WS_CTL);
    F.x = args.in[0]; F.meta = args.in[1]; F.ngain = args.in[2]; F.m_win = args.in[3]; F.m_bgate = args.in[4]; F.m_hgain = args.in[5]; F.m_wout = args.in[6];
    F.d_win = args.in[7]; F.d_lam = args.in[8]; F.d_hgain = args.in[9]; F.d_wout = args.in[10]; F.w_up = args.in[11]; F.w_dn = args.in[12]; F.fgain = args.in[13];
    F.out = args.out;
    F.WIN0 = (bf16*)(ws + WS_WIN0); F.WOUT0 = (bf16*)(ws + WS_WOUT0); F.WUP0 = (bf16*)(ws + WS_WUP0); F.WDN0 = (bf16*)(ws + WS_WDN0);
    F.WIN1 = (bf16*)(ws + WS_WIN1); F.WOUT1 = (bf16*)(ws + WS_WOUT1); F.WUP1 = (bf16*)(ws + WS_WUP1); F.WDN1 = (bf16*)(ws + WS_WDN1);
    F.HB = (bf16*)(ws + WS_HB); F.P = (bf16*)(ws + WS_P); F.MIX = (bf16*)(ws + WS_MIX); F.U = (bf16*)(ws + WS_U);
    F.SS = (float*)(ws + WS_SS); F.GATES = (float*)(ws + WS_GATES);
    F.HMETA = (float*)(ws + WS_HMETA); F.HBM = (bf16*)(ws + WS_HBM); F.PM = (bf16*)(ws + WS_PM); F.MIXM = (bf16*)(ws + WS_MIXM); F.UM = (bf16*)(ws + WS_UM); F.GATESM = (float*)(ws + WS_GATESM);
    F.SSM = (float*)(ws + WS_CTL) + CW_SSM;
    for (int u = F.tid; u < (LDS_BYTES - LDSCTL_OFF) / 4; u += NWAVES * 64) ((LAS unsigned*)(F.lds + LDSCTL_OFF))[u] = 0u;
    __syncthreads();
    const int lo = args.ph_lo, hi = args.ph_hi;
    const bool use_bar = (hi - lo) > 1;
    XcdBarrier bar; bar.bar = (unsigned*)(F.ctl + CW_BAR); bar.x = 0; bar.st = nullptr;
    if (use_bar) bar = xcd_barrier_post((unsigned*)(F.ctl + CW_BAR), F.MISC + 8);
#define IN(k) (lo <= (k) && (k) < hi)
#ifdef PROBE_PHASE
    unsigned long long t_prev = __builtin_amdgcn_s_memrealtime(); float probe_val = 0.f;
#define STAMP(k) do { const unsigned long long t_now = __builtin_amdgcn_s_memrealtime(); if ((k) == PROBE_PHASE) probe_val = (float)(t_now - t_prev) * 0.01f; t_prev = t_now; } while (0)
#else
#define STAMP(k) do {} while (0)
#endif
#define SEAM(k) do { if (IN(k) && IN((k) + 1)) xcd_barrier(bar); STAMP(k); } while (0)
#define GEMM_PHASE(k, EPI, Aptr, Bptr, NN, KK, METAJOB, ...) if (IN(k)) { METAJOB; pg8::Gemm g{Aptr, Bptr, MR, NN, KK}; pg8::StaticOrder S; S.init(MR, NN, F.G, (int)blockIdx.x); \
        EPI E{__VA_ARGS__}; pg8::gemm_phase<EPI, pg8::StaticOrder, PG8_ALIGN, PG8_SP2>(F.lds + RING_OFF, g, S, E); SEAM(k); }
    typedef pg8::EpiScale<0, 1> EpiIn0; typedef pg8::EpiScale<0, 16> EpiIn1; typedef pg8::EpiScale<1, 16> EpiUp;
#ifdef DOUBLE_PHASE
#define DBL(k, stmt) if (DOUBLE_PHASE == (k)) { stmt; xcd_barrier(bar); }
#else
#define DBL(k, stmt)
#endif
    DBL(0, p0_prologue(F))
    if (IN(0)) { p0_prologue(F); SEAM(0); }
    GEMM_PHASE(1, EpiIn0, F.HB, F.WIN0, NPROJ, D, meta_gemm(F, F.HBM, F.WIN0, 0, NPROJ / 16, D, MEpiScale<0>{F.PM, NPROJ, F.SSM}), F.P, NPROJ, F.SS, EPS)
    DBL(2, mlstm_mfma_phase(F))
    if (IN(2)) { mlstm_mfma_phase(F); SEAM(2); }
    GEMM_PHASE(3, pg8::EpiRes, F.MIX, F.WOUT0, D, D, meta_gemm(F, F.MIXM, F.WOUT0, 0, D / 16, D, MEpiRes{F.meta, F.HMETA, F.HBM, F.SSM}), F.x, F.out, F.HB, F.SS)
    GEMM_PHASE(4, EpiUp, F.HB, F.WUP0, FF, D, meta_gemm(F, F.HBM, F.WUP0, 0, FF / 16, D, MEpiScale<1>{F.UM, FF, F.SSM}), F.U, FF, F.SS, EPS)
    GEMM_PHASE(5, pg8::EpiRes, F.U, F.WDN0, D, FF, meta_gemm(F, F.UM, F.WDN0, 0, D / 16, FF, MEpiRes{F.HMETA, F.HMETA, F.HBM, F.SSM}), F.out, F.out, F.HB, F.SS)
    GEMM_PHASE(6, EpiIn1, F.HB, F.WIN1, NPROJ, D, meta_gemm(F, F.HBM, F.WIN1, 1024 / 16, NPROJ / 16, D, MEpiScale<0>{F.PM, NPROJ, F.SSM}), F.P, NPROJ, F.SS, EPS)
    DBL(7, attn_mfma_phase(F))
    if (IN(7)) { attn_mfma_phase(F); SEAM(7); }
    GEMM_PHASE(8, pg8::EpiRes, F.MIX, F.WOUT1, D, D, (void)0, F.out, F.out, F.HB, F.SS)
    GEMM_PHASE(9, EpiUp, F.HB, F.WUP1, FF, D, (void)0, F.U, FF, F.SS, EPS)
    GEMM_PHASE(10, pg8::EpiRes, F.U, F.WDN1, D, FF, (void)0, F.out, F.out, (bf16*)nullptr, F.SS)
    if (IN(11)) { final_norm_phase(F); }
#ifdef PROBE_PHASE
    STAMP(11);
    if (blockIdx.x == 0 && F.tid == 0) { asm volatile("s_waitcnt vmcnt(0)" ::: "memory"); F.out[0] = probe_val; }
#endif
#undef IN
#undef SEAM
#undef GEMM_PHASE
}

extern "C" void kernel_launch(void* const* d_in, const int* in_sizes, int n_in, void* d_out, int out_size, void* d_ws, size_t ws_size, hipStream_t stream) {
    static int grid = 0;
    if (grid == 0) {
        if (n_in != 14 || in_sizes[0] != NB * SEQ * D || out_size != NB * SEQ * D || ws_size < WS_END) { fprintf(stderr, "kernel_launch: unexpected shapes (n_in %d, in0 %d, out %d, ws %zu)\n", n_in, n_in > 0 ? in_sizes[0] : -1, out_size, ws_size); grid = -1; return; }
        int dev = 0, cus = 0, per_cu = 0;
        if (hipGetDevice(&dev) != hipSuccess || hipDeviceGetAttribute(&cus, hipDeviceAttributeMultiprocessorCount, dev) != hipSuccess) { grid = -1; return; }
        if (hipFuncSetAttribute((const void*)fwd_kernel, hipFuncAttributeMaxDynamicSharedMemorySize, LDS_BYTES) != hipSuccess) { fprintf(stderr, "kernel_launch: hipFuncSetAttribute failed\n"); grid = -1; return; }
        if (hipOccupancyMaxActiveBlocksPerMultiprocessor(&per_cu, (const void*)fwd_kernel, NWAVES * 64, LDS_BYTES) != hipSuccess || per_cu < 1) { fprintf(stderr, "kernel_launch: occupancy query reports %d blocks per CU\n", per_cu); (void)hipGetLastError(); grid = -1; return; }
        grid = cus;
    }
    if (grid < 0) return;
    if (hipMemsetAsync((char*)d_ws + WS_CTL, 0, CTL_ZERO_BYTES, stream) != hipSuccess) return;
    Args a{};
    for (int i = 0; i < 14; ++i) a.in[i] = (const float*)d_in[i];
    a.out = (float*)d_out; a.ws = (unsigned char*)d_ws;
    if (MK_N_LAUNCHES == 1) { a.ph_lo = 0; a.ph_hi = NPHASE; hipLaunchKernelGGL(fwd_kernel, dim3(grid), dim3(NWAVES * 64), LDS_BYTES, stream, a); }
    else for (int p = 0; p < NPHASE; ++p) { a.ph_lo = p; a.ph_hi = p + 1; hipLaunchKernelGGL(fwd_kernel, dim3(grid), dim3(NWAVES * 64), LDS_BYTES, stream, a); }
}
```

```cpp
#include <hip/hip_runtime.h>
#include <cstdio>
#include <cstdint>
namespace pg8 {
#define PG8_LAS __attribute__((address_space(3)))
typedef unsigned short bf16_t;
typedef short bf16x8 __attribute__((ext_vector_type(8)));
typedef float f32x4 __attribute__((ext_vector_type(4)));
typedef unsigned u32x4 __attribute__((ext_vector_type(4)));
constexpr int BM = 256, BK = 64, HALF = 128, HTB = HALF * BK * 2  , STAGE_BYTES = 8 * HTB, NXCD = 8, WGM = 8;

__host__ __device__ __forceinline__ int lds_byte(int r, int c) { const int st = (r >> 4) * 2 + (c >> 5), rr = r & 15, cc = c & 31, ob = rr * 64 + cc * 2; return st * 1024 + (ob ^ (((ob >> 9) & 1) << 5)); }
__host__ __device__ __forceinline__ void stage_rc(int b, int& R, int& C) { const int st = b / 1024, sb = b % 1024, swz = sb ^ (((sb >> 9) & 1) << 5); R = (st >> 1) * 16 + swz / 64; C = (st & 1) * 32 + (swz % 64) / 2; }
__host__ __device__ __forceinline__ int perm32(int rho) { const int n = rho >> 4, i = rho & 15; return 8 * (i >> 2) + 4 * n + (i & 3); }

struct Unit { int pm, pn; };
struct Gemm { const bf16_t* A; const bf16_t* Bt; int M, N, K; };

struct StaticOrder {
    int nM, nN, nwg, G, c;
    __host__ __device__ void init(int M, int N, int G_, int c_) { nM = M / BM; nN = N / BM; nwg = nM * nN; G = G_; c = c_; }
    __host__ __device__ bool next(int i, Unit& u) const {
        const long L = (long)i * G + c; if (L >= nwg) return false;
        int wgid = (int)L; { const int q = nwg / NXCD, r = nwg % NXCD, xcd = wgid % NXCD, off = wgid / NXCD; wgid = (xcd < r ? xcd * (q + 1) : r * (q + 1) + (xcd - r) * q) + off; }
        const int nig = WGM * nN, gid = wgid / nig, fm = gid * WGM, gsz = (nM - fm) < WGM ? (nM - fm) : WGM;
        u.pm = fm + ((wgid % nig) % gsz); u.pn = (wgid % nig) / gsz; return true;
    }
    __device__ __forceinline__ void a_ready(const Unit&) const {}
    __device__ __forceinline__ void done(const Unit&) const {}
};

__device__ __forceinline__ unsigned cvt_pk_bf16(float lo, float hi) { unsigned r; asm volatile("v_cvt_pk_bf16_f32 %0, %1, %2" : "=v"(r) : "v"(lo), "v"(hi)); return r; }
typedef unsigned u32x2 __attribute__((ext_vector_type(2)));

template <int NS> __device__ __forceinline__ float row_rstd(const float* ss, int row, float eps) {
    const float* sp = ss + (size_t)row * 16; float s;
    if (NS == 1) s = sp[0];
    else { const f32x4 a = *(const f32x4*)sp, b = *(const f32x4*)(sp + 4), c = *(const f32x4*)(sp + 8), d = *(const f32x4*)(sp + 12);
           s = ((a[0] + a[1]) + (a[2] + a[3])) + ((b[0] + b[1]) + (b[2] + b[3])) + ((c[0] + c[1]) + (c[2] + c[3])) + ((d[0] + d[1]) + (d[2] + d[3])); }
    return __builtin_amdgcn_rsqf(s * (1.0f / 1024.0f) + eps);
}
template <int ACT, int NS> struct EpiScale {
    static constexpr bool PERM = true, AFTER_DRAIN = false;
    bf16_t* O; int ldc; const float* ss; float eps;
    __device__ __forceinline__ void operator()(const f32x4 (&acc)[2][2][4][2], const Unit& u, int wr, int wc, int fr, int fq) const {
        const int row0 = u.pm * BM + wr * 64 + fr, col0 = u.pn * BM + wc * 32 + 8 * fq;
#pragma unroll
        for (int ai = 0; ai < 2; ++ai)
#pragma unroll
            for (int m = 0; m < 4; ++m) { const int row = row0 + ai * HALF + m * 16; const float rs = row_rstd<NS>(ss, row, eps);
                bf16_t* rowp = O + (size_t)row * ldc + col0;
#pragma unroll
                for (int bj = 0; bj < 2; ++bj) { f32x4 v0 = acc[ai][bj][m][0] * rs, v1 = acc[ai][bj][m][1] * rs;
                    if (ACT == 1) {
#pragma unroll
                        for (int i = 0; i < 4; ++i) { const float a = fmaxf(v0[i], 0.f), b = fmaxf(v1[i], 0.f); v0[i] = a * a; v1[i] = b * b; } }
                    u32x4 w; w.x = cvt_pk_bf16(v0[0], v0[1]); w.y = cvt_pk_bf16(v0[2], v0[3]); w.z = cvt_pk_bf16(v1[0], v1[1]); w.w = cvt_pk_bf16(v1[2], v1[3]);
                    *(u32x4*)(rowp + bj * HALF) = w; } }
    }
};
struct EpiRes {
    static constexpr bool PERM = false, AFTER_DRAIN = false;
    const float* Hin; float* Hout; bf16_t* HB; float* ss;
    __device__ __forceinline__ void operator()(const f32x4 (&acc)[2][2][4][2], const Unit& u, int wr, int wc, int fr, int fq) const {
        const int row0 = u.pm * BM + wr * 64 + fr, col0 = u.pn * BM + wc * 32 + 4 * fq;
#pragma unroll
        for (int ai = 0; ai < 2; ++ai)
#pragma unroll
            for (int m = 0; m < 4; ++m) { const int row = row0 + ai * HALF + m * 16;
                const float* hi = Hin + (size_t)row * 1024 + col0; float* ho = Hout + (size_t)row * 1024 + col0; float q = 0.f;
#pragma unroll
                for (int bj = 0; bj < 2; ++bj)
#pragma unroll
                    for (int n = 0; n < 2; ++n) { const int off = bj * HALF + n * 16; const f32x4 hv = *(const f32x4*)(hi + off) + acc[ai][bj][m][n]; *(f32x4*)(ho + off) = hv;
                        q += (hv[0] * hv[0] + hv[1] * hv[1]) + (hv[2] * hv[2] + hv[3] * hv[3]);
                        if (HB) { u32x2 w; w.x = cvt_pk_bf16(hv[0], hv[1]); w.y = cvt_pk_bf16(hv[2], hv[3]); *(u32x2*)(HB + (size_t)row * 1024 + col0 + off) = w; } }
                q += __shfl_xor(q, 16); q += __shfl_xor(q, 32);
                if (fq == 0) ss[(size_t)row * 16 + u.pn * 4 + wc] = q; }
    }
};

template <class Epi, class Sched, bool ALIGN_EPI = false, bool SP2 = false>
__device__ __forceinline__ void gemm_phase(PG8_LAS unsigned char* lds, const Gemm g, const Sched& S, const Epi& E) {
    const int tid = threadIdx.x, wid = __builtin_amdgcn_readfirstlane(tid >> 6), lane = tid & 63, wr = wid >> 2, wc = wid & 3, fr = lane & 15, fq = lane >> 4;
    const int K = g.K, nt = K / BK;
    unsigned voffA[2], voffB[2];
#pragma unroll
    for (int i = 0; i < 2; ++i) { int R, C; stage_rc(tid * 16 + i * 8192, R, C); const int Rb = Epi::PERM ? ((R & ~31) + perm32(R & 31)) : R;
        voffA[i] = (unsigned)(R * K + C) * 2u; voffB[i] = (unsigned)(Rb * K + C) * 2u; }
    const size_t kstep = (size_t)(BK * 2);
    const size_t hstep = (size_t)HALF * K * 2;
    const size_t tstep = 2 * hstep;
    const unsigned ldsw = (unsigned)wid * 1024u;
    const int aoff = lds_byte(wr * 64 + fr, fq * 8), boff = lds_byte(wc * 32 + fr, fq * 8);
#define PG8_SA(b, h) (((b) * 2 + (h)) * HTB)
#define PG8_SB(b, h) ((4 + (b) * 2 + (h)) * HTB)
#define PG8_STAGE(bufoff, gbase, voff) do { _Pragma("unroll") for (int _i = 0; _i < 2; ++_i) \
        __builtin_amdgcn_global_load_lds((const unsigned*)((const char*)(gbase) + (voff)[_i]), (PG8_LAS unsigned*)(lds + (bufoff) + ldsw + _i * 8192), 16, 0, 0); } while (0)
#define PG8_LDA(dst, b, h) do { _Pragma("unroll") for (int m = 0; m < 4; ++m) _Pragma("unroll") for (int k = 0; k < 2; ++k) dst[m][k] = *(const PG8_LAS bf16x8*)(lds + PG8_SA(b, h) + aoff + m * 2048 + k * 1024); } while (0)
#define PG8_LDB(dst, b, h) do { _Pragma("unroll") for (int n = 0; n < 2; ++n) _Pragma("unroll") for (int k = 0; k < 2; ++k) dst[n][k] = *(const PG8_LAS bf16x8*)(lds + PG8_SB(b, h) + boff + n * 2048 + k * 1024); } while (0)
#define PG8_MMA(ai, bj, At, Bt) do { __builtin_amdgcn_s_setprio(1); _Pragma("unroll") for (int m = 0; m < 4; ++m) _Pragma("unroll") for (int n = 0; n < 2; ++n) _Pragma("unroll") for (int k = 0; k < 2; ++k) \
        acc[ai][bj][m][n] = __builtin_amdgcn_mfma_f32_16x16x32_bf16(Bt[n][k], At[m][k], acc[ai][bj][m][n], 0, 0, 0); __builtin_amdgcn_s_setprio(0); } while (0)
#define PG8_WAIT_V(n) asm volatile("s_waitcnt vmcnt(" #n ")" ::: "memory")
#define PG8_WAIT_L(n) asm volatile("s_waitcnt lgkmcnt(" #n ")" ::: "memory")
#define PG8_BAR __builtin_amdgcn_s_barrier()
#define PG8_SCHED __builtin_amdgcn_sched_barrier(0)
    Unit cur, nxt; int ui = 0;
    if (!S.next(0, cur)) return;
    f32x4 acc[2][2][4][2];
#pragma unroll
    for (int a = 0; a < 2; ++a)
#pragma unroll
        for (int b = 0; b < 2; ++b)
#pragma unroll
            for (int m = 0; m < 4; ++m)
#pragma unroll
                for (int n = 0; n < 2; ++n) acc[a][b][m][n] = (f32x4){0.f, 0.f, 0.f, 0.f};
    bf16x8 At[4][2], B0[2][2], B1[2][2];
    const char* cA = (const char*)g.A + (size_t)cur.pm * tstep; const char* cB = (const char*)g.Bt + (size_t)cur.pn * tstep;
    S.a_ready(cur);
    if constexpr (SP2) {
        PG8_STAGE(PG8_SB(0, 0), cB, voffB); PG8_STAGE(PG8_SB(0, 1), cB + hstep, voffB); PG8_STAGE(PG8_SA(0, 0), cA, voffA); PG8_STAGE(PG8_SA(0, 1), cA + hstep, voffA);
        if (wr == 1) PG8_BAR;
        PG8_WAIT_V(2); PG8_BAR;
        PG8_STAGE(PG8_SB(1, 0), cB + kstep, voffB); PG8_STAGE(PG8_SA(1, 0), cA + kstep, voffA); PG8_STAGE(PG8_SB(1, 1), cB + hstep + kstep, voffB);
        PG8_WAIT_V(6); PG8_BAR;
    } else {
        PG8_STAGE(PG8_SB(0, 0), cB, voffB); PG8_STAGE(PG8_SA(0, 0), cA, voffA); PG8_STAGE(PG8_SB(0, 1), cB + hstep, voffB); PG8_STAGE(PG8_SA(0, 1), cA + hstep, voffA);
        if (wr == 1) PG8_BAR;
        PG8_WAIT_V(4); PG8_BAR;
        PG8_STAGE(PG8_SB(1, 0), cB + kstep, voffB); PG8_STAGE(PG8_SA(1, 0), cA + kstep, voffA); PG8_STAGE(PG8_SB(1, 1), cB + hstep + kstep, voffB);
        PG8_WAIT_V(6); PG8_BAR;
    }
    for (;;) {
        const bool has_next = S.next(ui + 1, nxt);
        const char* nA = has_next ? (const char*)g.A + (size_t)nxt.pm * tstep : cA; const char* nB = has_next ? (const char*)g.Bt + (size_t)nxt.pn * tstep : cB;
        for (int t = 0; t < nt; t += 2) {
            const bool last = (t == nt - 2);
            const char* a1 = cA + (size_t)(t + 1) * kstep;
            const char* a2 = last ? nA : cA + (size_t)(t + 2) * kstep; const char* b2 = last ? nB : cB + (size_t)(t + 2) * kstep;
            const char* a3 = a2 + kstep; const char* b3 = b2 + kstep;
            if (last && has_next) S.a_ready(nxt);
            if constexpr (SP2) {
            PG8_LDB(B0, 0, 0); PG8_LDB(B1, 0, 1); PG8_SCHED; PG8_LDA(At, 0, 0); PG8_STAGE(PG8_SA(1, 1), a1 + hstep, voffA);
            PG8_WAIT_V(8); PG8_WAIT_L(0); PG8_BAR; PG8_MMA(0, 0, At, B0); PG8_MMA(0, 1, At, B1); PG8_BAR; PG8_SCHED;
            PG8_LDA(At, 0, 1); PG8_STAGE(PG8_SB(0, 0), b2, voffB); PG8_STAGE(PG8_SB(0, 1), b2 + hstep, voffB); PG8_STAGE(PG8_SA(0, 0), a2, voffA);
            PG8_WAIT_V(8); PG8_WAIT_L(0); PG8_BAR; PG8_MMA(1, 0, At, B0); PG8_MMA(1, 1, At, B1); PG8_BAR; PG8_SCHED;
            PG8_LDB(B0, 1, 0); PG8_LDB(B1, 1, 1); PG8_SCHED; PG8_LDA(At, 1, 0); PG8_STAGE(PG8_SA(0, 1), a2 + hstep, voffA);
            PG8_WAIT_V(8); PG8_WAIT_L(0); PG8_BAR; PG8_MMA(0, 0, At, B0); PG8_MMA(0, 1, At, B1); PG8_BAR; PG8_SCHED;
            PG8_LDA(At, 1, 1); PG8_STAGE(PG8_SB(1, 0), b3, voffB); PG8_STAGE(PG8_SB(1, 1), b3 + hstep, voffB); PG8_STAGE(PG8_SA(1, 0), a3, voffA);
            PG8_WAIT_V(8); PG8_WAIT_L(0); PG8_BAR; PG8_MMA(1, 0, At, B0); PG8_MMA(1, 1, At, B1); PG8_BAR; PG8_SCHED;
            } else {
            PG8_LDB(B0, 0, 0); PG8_SCHED; PG8_LDA(At, 0, 0); PG8_STAGE(PG8_SA(1, 1), a1 + hstep, voffA);
            PG8_WAIT_L(8); PG8_BAR; PG8_WAIT_L(0); PG8_MMA(0, 0, At, B0); PG8_BAR; PG8_SCHED;
            PG8_LDB(B1, 0, 1); PG8_STAGE(PG8_SB(0, 0), b2, voffB);
            PG8_BAR; PG8_WAIT_L(0); PG8_MMA(0, 1, At, B1); PG8_BAR;
            PG8_LDA(At, 0, 1); PG8_STAGE(PG8_SA(0, 0), a2, voffA);
            PG8_BAR; PG8_WAIT_L(0); PG8_MMA(1, 0, At, B0); PG8_BAR; PG8_SCHED;
            PG8_STAGE(PG8_SB(0, 1), b2 + hstep, voffB);
            PG8_WAIT_V(6); PG8_BAR; PG8_MMA(1, 1, At, B1); PG8_BAR;
            PG8_LDB(B0, 1, 0); PG8_SCHED; PG8_LDA(At, 1, 0); PG8_STAGE(PG8_SA(0, 1), a2 + hstep, voffA);
            PG8_WAIT_L(8); PG8_BAR; PG8_WAIT_L(0); PG8_MMA(0, 0, At, B0); PG8_BAR; PG8_SCHED;
            PG8_LDB(B1, 1, 1); PG8_STAGE(PG8_SB(1, 0), b3, voffB);
            PG8_BAR; PG8_WAIT_L(0); PG8_MMA(0, 1, At, B1); PG8_BAR;
            PG8_LDA(At, 1, 1); PG8_STAGE(PG8_SA(1, 0), a3, voffA);
            PG8_BAR; PG8_WAIT_L(0); PG8_MMA(1, 0, At, B0); PG8_BAR; PG8_SCHED;
            PG8_STAGE(PG8_SB(1, 1), b3 + hstep, voffB);
            PG8_WAIT_V(6); PG8_BAR; PG8_MMA(1, 1, At, B1); PG8_BAR;
            }
        }
        if constexpr (ALIGN_EPI) { if (wr == 0) PG8_BAR; }
        if constexpr (!Epi::AFTER_DRAIN) { E(acc, cur, wr, wc, fr, fq); S.done(cur); }
        if (!has_next) break;
#pragma unroll
        for (int a = 0; a < 2; ++a)
#pragma unroll
            for (int b = 0; b < 2; ++b)
#pragma unroll
                for (int m = 0; m < 4; ++m)
#pragma unroll
                    for (int n = 0; n < 2; ++n) acc[a][b][m][n] = (f32x4){0.f, 0.f, 0.f, 0.f};
        cur = nxt; cA = nA; cB = nB; ++ui;
        if constexpr (ALIGN_EPI) { if (wr == 1) PG8_BAR; }
    }
    PG8_WAIT_V(0);
    if constexpr (!ALIGN_EPI) { if (wr == 0) PG8_BAR; }
    PG8_BAR;
    if constexpr (Epi::AFTER_DRAIN) { E.fused(acc, cur, wr, wc, fr, fq, lds, wid, lane); S.done(cur); }
#undef PG8_SA
#undef PG8_SB
#undef PG8_STAGE
#undef PG8_LDA
#undef PG8_LDB
#undef PG8_MMA
#undef PG8_WAIT_V
#undef PG8_WAIT_L
#undef PG8_BAR
#undef PG8_SCHED
}
}

#ifndef PG8_SP2
#define PG8_SP2 true
#endif
#ifndef PG8_ALIGN
#define PG8_ALIGN true
#endif
constexpr int NB = 16, SEQ = 2048, NMETA = 16, D = 1024, FF = 4096;
constexpr int MR = NB * SEQ;
constexpr int NH = 8, DQK = 64, DV = 128;
constexpr int NPROJ = 3072;
constexpr float EPS = 1e-6f, SUBLN_EPS = 1e-5f;
constexpr int NWAVES = 8;
#ifndef MK_N_LAUNCHES
#define MK_N_LAUNCHES 1
#endif
constexpr int NPHASE = 12;

constexpr size_t MiB = 1u << 20;
constexpr size_t WS_CTL = 0, CTL_ZERO_BYTES = 1 * MiB;
constexpr size_t WS_WIN0 = 1 * MiB, WS_WOUT0 = 7 * MiB, WS_WUP0 = 9 * MiB, WS_WDN0 = 17 * MiB;
constexpr size_t WS_WIN1 = 25 * MiB, WS_WOUT1 = 31 * MiB, WS_WUP1 = 33 * MiB, WS_WDN1 = 41 * MiB;
constexpr size_t WS_META = 49 * MiB;
constexpr size_t WS_HMETA = WS_META;
constexpr size_t WS_HBM = WS_HMETA + 16 * D * 4;
constexpr size_t WS_PM = WS_HBM + 16 * D * 2;
constexpr size_t WS_MIXM = WS_PM + 16 * NPROJ * 2;
constexpr size_t WS_UM = WS_MIXM + 16 * D * 2;
constexpr size_t WS_GATESM = WS_UM + 16 * FF * 2;
constexpr size_t WS_SS = 50 * MiB;
constexpr size_t WS_GATES = 52 * MiB;
constexpr size_t WS_HB = 54 * MiB;
constexpr size_t WS_P = 118 * MiB;
constexpr size_t WS_MIX = 310 * MiB;
constexpr size_t WS_U = WS_P;
constexpr size_t WS_GSC = 374 * MiB;
constexpr size_t WS_END = 378 * MiB;
static_assert(WS_GATESM + 1024 <= WS_SS && WS_HB + (size_t)MR * D * 2 <= WS_P && WS_P + (size_t)MR * NPROJ * 2 <= WS_MIX && WS_U + (size_t)MR * FF * 2 <= WS_END && WS_MIX + (size_t)MR * D * 2 <= WS_GSC, "d_ws map");
constexpr int CW_BAR = 4096;
constexpr int CW_SSM = 16384;

constexpr int RING_OFF = 0, RING_BYTES = 131072;
constexpr int XTRA_OFF = RING_BYTES, XTRA_BYTES = 30720;
constexpr int LDSCTL_OFF = XTRA_OFF + XTRA_BYTES, MISC_OFF = LDSCTL_OFF + 320;
constexpr int LDS_BYTES = 163840;
static_assert(MISC_OFF + 128 <= LDS_BYTES, "LDS map");

#define GAS __attribute__((address_space(1)))
#define LAS __attribute__((address_space(3)))
typedef unsigned short bf16;
typedef unsigned v4u __attribute__((ext_vector_type(4)));
typedef float f32x4 __attribute__((ext_vector_type(4)));
typedef GAS unsigned gu32;
#define RLX_AGENT __ATOMIC_RELAXED, __HIP_MEMORY_SCOPE_AGENT
#define LDS_WAIT() asm volatile("s_waitcnt lgkmcnt(0)" ::: "memory")
__device__ __forceinline__ unsigned f2bf(float f) { unsigned u = __builtin_bit_cast(unsigned, f); return (u + 0x7fffu + ((u >> 16) & 1u)) >> 16; }
__device__ __forceinline__ unsigned pk2(float lo, float hi) { return f2bf(lo) | (f2bf(hi) << 16); }
__device__ __forceinline__ float bf2f(unsigned short v) { return __builtin_bit_cast(float, (unsigned)v << 16); }
__device__ __forceinline__ float bflo(unsigned w) { return __builtin_bit_cast(float, w << 16); }
__device__ __forceinline__ float bfhi(unsigned w) { return __builtin_bit_cast(float, w & 0xffff0000u); }

#define XB_TMO      128
#define XB_XCNT(j)  (256  + 64 * (j))
#define XB_XSUB(j)  (1280 + 64 * (j))
#define XB_XGEN(j)  (2304 + 64 * (j))
#define XB_TOP      3328
#define XB_TOPGEN   3392
#define XCD_BAR_WORDS 3456
#define XB_SPIN_CAP (1u << 18)
__device__ __forceinline__ unsigned xb_ld(unsigned* p)              { return __hip_atomic_load(p, __ATOMIC_RELAXED, __HIP_MEMORY_SCOPE_AGENT); }
__device__ __forceinline__ unsigned xb_add(unsigned* p, unsigned v) { return __hip_atomic_fetch_add(p, v, __ATOMIC_RELAXED, __HIP_MEMORY_SCOPE_AGENT); }
__device__ __forceinline__ unsigned xb_xcc_id() { return (unsigned)__builtin_amdgcn_s_getreg((3 << 11) | 20) & 0xFu; }
#define XB_SPIN(cond, bar) do { unsigned _sp = 0; while (cond) { __builtin_amdgcn_s_sleep(1); \
    if ((++_sp & 255u) == 0u) { if (xb_ld(&(bar)[XB_TMO])) break; if (_sp > XB_SPIN_CAP) { atomicAdd(&(bar)[XB_TMO], 1u); break; } } } } while (0)
struct XcdBarrier { unsigned* bar; unsigned x; volatile LAS unsigned* st; };
__device__ __forceinline__ XcdBarrier xcd_barrier_post(unsigned* bar, volatile LAS unsigned* st) {
    XcdBarrier b; b.bar = bar; b.x = xb_xcc_id(); b.st = st;
    if (threadIdx.x == 0) (void)xb_add(&bar[XB_XCNT(b.x)], 1u);
    return b;
}
__device__ __forceinline__ void xcd_barrier_complete(unsigned* bar, unsigned x, unsigned& nloc, unsigned& nx) {
    const unsigned G = gridDim.x * gridDim.y * gridDim.z;
    unsigned sum, cnt, mine, sp = 0u;
    for (;;) {
        sum = 0u; cnt = 0u; mine = 0u;
#pragma unroll
        for (unsigned j = 0; j < 16; ++j) { const unsigned c = xb_ld(&bar[XB_XCNT(j)]); sum += c; cnt += (c > 0u) ? 1u : 0u; mine = (j == x) ? c : mine; }
        if (sum == G) break;
        __builtin_amdgcn_s_sleep(1);
        if ((++sp & 255u) == 0u) { if (xb_ld(&bar[XB_TMO])) break; if (sp > XB_SPIN_CAP) { atomicAdd(&bar[XB_TMO], 1u); break; } }
    }
    nloc = mine > 0u ? mine : 1u; nx = cnt > 0u ? cnt : 1u;
}
__device__ __forceinline__ void xcd_barrier(const XcdBarrier& b) {
    asm volatile("s_waitcnt vmcnt(0)" ::: "memory");
    __syncthreads();
    if (threadIdx.x == 0) {
        unsigned* bar = b.bar;
        __builtin_amdgcn_s_waitcnt(0);
        unsigned nloc = b.st[0], nx = b.st[1];
        if (nloc == 0u) { xcd_barrier_complete(bar, b.x, nloc, nx); b.st[0] = nloc; b.st[1] = nx; }
        const unsigned old = xb_add(&bar[XB_XSUB(b.x)], 1u);
        const unsigned gen = old / nloc;
        if (old + 1u == (gen + 1u) * nloc) {
            __builtin_amdgcn_fence(__ATOMIC_RELEASE, "agent");
            asm volatile("s_waitcnt vmcnt(0)" ::: "memory");
            const unsigned og = xb_add(&bar[XB_TOP], 1u);
            const unsigned tg = og / nx;
            if (og + 1u == (tg + 1u) * nx) xb_add(&bar[XB_TOPGEN], 1u);
            else XB_SPIN(xb_ld(&bar[XB_TOPGEN]) == tg, bar);
            __builtin_amdgcn_fence(__ATOMIC_ACQUIRE, "agent");
            xb_add(&bar[XB_XGEN(b.x)], 1u);
            asm volatile("s_waitcnt vmcnt(0)" ::: "memory");
        } else {
            XB_SPIN(xb_ld(&bar[XB_XGEN(b.x)]) == gen, bar);
            __builtin_amdgcn_fence(__ATOMIC_ACQUIRE, "agent");
            asm volatile("s_waitcnt vmcnt(0)" ::: "memory");
        }
    }
    __syncthreads();
}

struct Frame {
    LAS unsigned char* lds;
    volatile LAS unsigned* MISC;
    gu32* ctl;
    int tid, lane, wave, vcu, G;
    const float *x, *meta, *ngain, *m_win, *m_bgate, *m_hgain, *m_wout, *d_win, *d_lam, *d_hgain, *d_wout, *w_up, *w_dn, *fgain;
    float* out; unsigned char* ws;
    bf16 *WIN0, *WOUT0, *WUP0, *WDN0, *WIN1, *WOUT1, *WUP1, *WDN1, *HB, *P, *MIX, *U;
    float *SS, *GATES, *GSC;
    bf16 *HBM, *PM, *MIXM, *UM; float *HMETA, *GATESM, *SSM;
};
__device__ __forceinline__ float wave_sum(float v) {
#pragma unroll
    for (int o = 1; o < 64; o <<= 1) v += __shfl_xor(v, o);
    return v;
}
typedef short bf16x8_t __attribute__((ext_vector_type(8)));
__device__ __forceinline__ f32x4 mfma16(bf16x8_t a, bf16x8_t b, f32x4 c) { return __builtin_amdgcn_mfma_f32_16x16x32_bf16(a, b, c, 0, 0, 0); }
__device__ __forceinline__ void transpose_item(const float* W, int K, int ldw, int Nuse, const float* gk, int nscale, float qscale, bf16* WT, LAS float* scr, int item, int lane) {
    const int nblk = Nuse / 32, kb = item / nblk, nb = item % nblk, k0 = 64 * kb, n0 = 32 * nb;
    const float cs = (n0 < nscale) ? qscale : 1.f;
    const int lr = lane >> 3, lp = lane & 7;
#pragma unroll
    for (int i = 0; i < 8; ++i) { const int kk = 8 * i + lr; const float g = gk ? gk[k0 + kk] * cs : cs; const f32x4 v = *(const GAS f32x4*)(W + (size_t)(k0 + kk) * ldw + n0 + 4 * lp);
        LAS float* d = scr + kk * 33 + 4 * lp; d[0] = v.x * g; d[1] = v.y * g; d[2] = v.z * g; d[3] = v.w * g; }
    LDS_WAIT(); asm volatile("" ::: "memory");
    const int c = lane & 7;
#pragma unroll
    for (int j = 0; j < 4; ++j) { const int n = (lane >> 3) + 8 * j; const LAS float* s = scr + (8 * c) * 33 + n;
        v4u o; o.x = pk2(s[0 * 33], s[1 * 33]); o.y = pk2(s[2 * 33], s[3 * 33]); o.z = pk2(s[4 * 33], s[5 * 33]); o.w = pk2(s[6 * 33], s[7 * 33]);
        *(GAS v4u*)(WT + (size_t)(n0 + n) * K + k0 + 8 * c) = o; }
    LDS_WAIT(); asm volatile("" ::: "memory");
}
constexpr int I_IN = (D / 64) * (NPROJ / 32), I_OUT = (D / 64) * (D / 32), I_UP = (D / 64) * (FF / 32), I_DN = (FF / 64) * (D / 32);
constexpr int I_LAYER = I_IN + I_OUT + I_UP + I_DN, NITEMS = 2 * I_LAYER;
__device__ __forceinline__ void convert_weights(Frame& F, int it0, int it1, int gw, int ngw, LAS float* scr) {
    for (int it = it0 + gw; it < it1; it += ngw) {
        const int layer = it / I_LAYER; int r = it % I_LAYER;
        const float* g0 = F.ngain + (layer * 2 + 0) * D; const float* g1 = F.ngain + (layer * 2 + 1) * D;
        if (r < I_IN) { if (layer == 0) transpose_item(F.m_win, D, 3088, NPROJ, g0, 512, 0.125f, F.WIN0, scr, r, F.lane); else transpose_item(F.d_win, D, NPROJ, NPROJ, g0, 1024, 0.125f * 1.4426950408889634f, F.WIN1, scr, r, F.lane);   continue; } r -= I_IN;
        if (r < I_OUT) { transpose_item(layer == 0 ? F.m_wout : F.d_wout, D, D, D, nullptr, 0, 1.f, layer == 0 ? F.WOUT0 : F.WOUT1, scr, r, F.lane); continue; } r -= I_OUT;
        if (r < I_UP) { transpose_item(F.w_up + (size_t)layer * D * FF, D, FF, FF, g1, 0, 1.f, layer == 0 ? F.WUP0 : F.WUP1, scr, r, F.lane); continue; } r -= I_UP;
        transpose_item(F.w_dn + (size_t)layer * FF * D, FF, D, D, nullptr, 0, 1.f, layer == 0 ? F.WDN0 : F.WDN1, scr, r, F.lane);
    }
}
constexpr int WGSTR = 2048 + 16;
__device__ __forceinline__ void embed_group(Frame& F, const float* src, bf16* hb, float* ssd, int ss_stride, float* gd, const LAS unsigned char* wgl) {
    const int li = F.lane & 15, g = F.lane >> 4;
    const float* sp = src + (size_t)li * D + 8 * g; bf16* hp = hb + (size_t)li * D + 8 * g; const LAS unsigned char* wp = wgl + li * WGSTR + 16 * g;
    f32x4 acc = (f32x4){0.f, 0.f, 0.f, 0.f}; float ssp = 0.f;
#pragma unroll 8
    for (int ks = 0; ks < 32; ++ks) {
        const f32x4 a0 = *(const GAS f32x4*)(sp + 32 * ks), a1 = *(const GAS f32x4*)(sp + 32 * ks + 4);
        ssp += ((a0.x * a0.x + a0.y * a0.y) + (a0.z * a0.z + a0.w * a0.w)) + ((a1.x * a1.x + a1.y * a1.y) + (a1.z * a1.z + a1.w * a1.w));
        v4u pw; pw.x = pg8::cvt_pk_bf16(a0.x, a0.y); pw.y = pg8::cvt_pk_bf16(a0.z, a0.w); pw.z = pg8::cvt_pk_bf16(a1.x, a1.y); pw.w = pg8::cvt_pk_bf16(a1.z, a1.w);
        *(GAS v4u*)(hp + 32 * ks) = pw;
        acc = mfma16(__builtin_bit_cast(bf16x8_t, pw), *(const LAS bf16x8_t*)(wp + 64 * ks), acc);
    }
    ssp += __shfl_xor(ssp, 16); ssp += __shfl_xor(ssp, 32);
    const float rstd = 1.0f / sqrtf(ssp * (1.0f / D) + EPS);
    if (g == 0) ssd[(size_t)li * ss_stride] = ssp;
    const float bg = F.m_bgate[li];
#pragma unroll
    for (int r = 0; r < 4; ++r) { const float rs = __shfl(rstd, 4 * g + r); gd[(size_t)(4 * g + r) * 16 + li] = acc[r] * rs + bg; }
}
__device__ __forceinline__ void p0_prologue(Frame& F) {
    LAS float* scr = (LAS float*)(F.lds + RING_OFF + F.wave * 16384);
    const int gw = F.vcu * NWAVES + F.wave, NGW = F.G * NWAVES;
    convert_weights(F, 0, I_IN, gw, NGW, scr);
    __syncthreads();
    LAS unsigned char* wgl = F.lds + RING_OFF;
    for (int i = F.tid; i < 16 * D; i += NWAVES * 64) { const int k = i >> 4, j = i & 15; *(LAS bf16*)(wgl + j * WGSTR + k * 2) = (bf16)f2bf(F.m_win[(size_t)k * 3088 + NPROJ + j] * F.ngain[k]); }
    __syncthreads();
    for (int grp = gw; grp <= MR / 16; grp += NGW) {
        if (grp < MR / 16) embed_group(F, F.x + (size_t)grp * 16 * D, F.HB + (size_t)grp * 16 * D, F.SS + (size_t)grp * 16 * 16, 16, F.GATES + (size_t)grp * 16 * 16, wgl);
        else embed_group(F, F.meta, F.HBM, F.SSM, 64, F.GATESM, wgl);
    }
}
__device__ __forceinline__ float meta_rstd(const float* ssm, int lane) {
    float mine = 0.f;
#pragma unroll 4
    for (int r = 0; r < 16; ++r) { const float s = wave_sum(ssm[r * 64 + lane]); if (lane == r) mine = 1.0f / sqrtf(s * (1.0f / D) + EPS); }
    return mine;
}
template <int ACT> struct MEpiScale {
    bf16* O; int ldc; const float* ssm;
    __device__ __forceinline__ void operator()(int cb, int li, int g, int lane, const float (&v)[4]) const {
        const float mine = meta_rstd(ssm, lane);
#pragma unroll
        for (int r = 0; r < 4; ++r) { float x = v[r] * __shfl(mine, 4 * g + r); if (ACT == 1) { x = fmaxf(x, 0.f); x = x * x; } O[(size_t)(4 * g + r) * ldc + 16 * cb + li] = (bf16)f2bf(x); }
    }
};
struct MEpiRes {
    const float* Hin; float* H; bf16* HB; float* ssm;
    __device__ __forceinline__ void operator()(int cb, int li, int g, int lane, const float (&v)[4]) const {
#pragma unroll
        for (int r = 0; r < 4; ++r) { const int row = 4 * g + r; const float hv = Hin[(size_t)row * D + 16 * cb + li] + v[r]; H[(size_t)row * D + 16 * cb + li] = hv; HB[(size_t)row * D + 16 * cb + li] = (bf16)f2bf(hv);
            float q = hv * hv; q += __shfl_xor(q, 1); q += __shfl_xor(q, 2); q += __shfl_xor(q, 4); q += __shfl_xor(q, 8);
            if (li == 0) ssm[row * 64 + cb] = q; }
    }
};
template <class MEpi> __device__ __forceinline__ void meta_gemm(Frame& F, const bf16* A, const bf16* Bt, int cb0, int cb1, int K, const MEpi& E) {
    LAS float* red = (LAS float*)(F.lds + XTRA_OFF);
    const int li = F.lane & 15, g = F.lane >> 4, kw = K / NWAVES;
    for (int cb = cb0 + (int)blockIdx.x; cb < cb1; cb += F.G) {
        const bf16* ap = A + (size_t)li * K + F.wave * kw + 8 * g; const bf16* bp = Bt + (size_t)(16 * cb + li) * K + F.wave * kw + 8 * g;
        f32x4 acc = (f32x4){0.f, 0.f, 0.f, 0.f};
#pragma unroll 4
        for (int ks = 0; ks < kw / 32; ++ks) acc = mfma16(*(const GAS bf16x8_t*)(ap + 32 * ks), *(const GAS bf16x8_t*)(bp + 32 * ks), acc);
#pragma unroll
        for (int r = 0; r < 4; ++r) red[F.wave * 256 + r * 64 + F.lane] = acc[r];
        __syncthreads();
        if (F.wave == 0) { float v[4];
#pragma unroll
            for (int r = 0; r < 4; ++r) { float s = 0.f;
#pragma unroll
                for (int ww = 0; ww < NWAVES; ++ww) s += red[ww * 256 + r * 64 + F.lane]; v[r] = s; }
            E(cb, li, g, F.lane, v); }
        __syncthreads();
    }
}
__device__ __forceinline__ void final_norm_phase(Frame& F) {
    const int gw = F.vcu * NWAVES + F.wave, NGW = F.G * NWAVES;
    for (int row = gw; row < MR; row += NGW) {
        const float rs = pg8::row_rstd<16>(F.SS, row, EPS);
        GAS f32x4* p = (GAS f32x4*)(F.out + (size_t)row * D);
#pragma unroll
        for (int j = 0; j < 4; ++j) { f32x4 v = p[64 * j + F.lane]; const f32x4 g = ((const GAS f32x4*)F.fgain)[64 * j + F.lane]; v = v * rs * g; p[64 * j + F.lane] = v; }
    }
}
namespace attn3 {
typedef short bf16x8 __attribute__((ext_vector_type(8)));
typedef short s16x4 __attribute__((ext_vector_type(4)));
typedef float f32x16 __attribute__((ext_vector_type(16)));
constexpr int KSTR = 256, VSTR = 256, KBYTES = 64 * KSTR, VBYTES = 64 * VSTR, BUFB = KBYTES + VBYTES, NBUF = 3;
constexpr int CBS = 129;
constexpr int OBS = 272;
constexpr float THR = 8.0f;
static_assert(NBUF * BUFB + 8 * 4096 <= RING_BYTES + XTRA_BYTES && 4 * 32 * CBS * 4 + 4 * 32 * OBS <= RING_BYTES + XTRA_BYTES, "attention LDS map");
__device__ __forceinline__ constexpr int crow0(int r) { return (r & 3) + 8 * (r >> 2); }
__device__ __forceinline__ s16x4 vtr(const LAS unsigned char* p) { return __builtin_bit_cast(s16x4, __builtin_amdgcn_ds_read_tr16_b64_v4i16((LAS s16x4*)p)); }
__device__ __forceinline__ bf16x8 pack8(const f32x16& p, int b0) {
    v4u w; w.x = pg8::cvt_pk_bf16(p[b0], p[b0 + 1]); w.y = pg8::cvt_pk_bf16(p[b0 + 2], p[b0 + 3]); w.z = pg8::cvt_pk_bf16(p[b0 + 4], p[b0 + 5]); w.w = pg8::cvt_pk_bf16(p[b0 + 6], p[b0 + 7]);
    return __builtin_bit_cast(bf16x8, w);
}
__device__ __forceinline__ float xmax32(float a) { auto rr = __builtin_amdgcn_permlane32_swap(__float_as_uint(a), __float_as_uint(a), false, false); return fmaxf(__uint_as_float(rr[0]), __uint_as_float(rr[1])); }
__device__ __forceinline__ float xsum32(float a) { auto rr = __builtin_amdgcn_permlane32_swap(__float_as_uint(a), __float_as_uint(a), false, false); return __uint_as_float(rr[0]) + __uint_as_float(rr[1]); }
#define ATT_SBAR() __builtin_amdgcn_sched_barrier(0)
__device__ __forceinline__ void glds16(const void* gsrc, unsigned lds_dst) { unsigned keep;
    asm volatile("s_mov_b32 %0, m0\n\ts_mov_b32 m0, %2\n\ts_nop 0\n\tglobal_load_lds_dwordx4 %1, off\n\ts_mov_b32 m0, %0" : "=&s"(keep) : "v"(gsrc), "s"(lds_dst) : "memory"); }
#define ATT_DMA_WAIT() asm volatile("s_waitcnt vmcnt(0)" ::: "memory")
template <bool DO_PV, bool DO_SM, bool FIRST>
__device__ __forceinline__ void step(f32x16 (&o)[4], f32x16& p0, f32x16& p1, bf16x8 (&pf)[4], float& m, float& l, const LAS unsigned char* vbase) {
    s16x4 vl[4], vh[4]; float mx0 = 0.f, mx1 = 0.f, mx2 = 0.f, ls = 0.f, fsc = 1.f; bool resc = false;
#define ATT_VRD(i) do { vl[(i) & 3] = vtr(vbase + (4 * ((i) & 3)) * 1024 + ((i) >> 2) * 256); vh[(i) & 3] = vtr(vbase + (4 * ((i) & 3) + 2) * 1024 + ((i) >> 2) * 256); } while (0)
    if (DO_PV) { ATT_VRD(0); ATT_VRD(1); ATT_VRD(2); }
#pragma unroll
    for (int i = 0; i < 16; ++i) {
        if (DO_PV) {
            if (i + 3 < 16) ATT_VRD(i + 3);
            const s16x4 lo = vl[i & 3], hh = vh[i & 3];
            const bf16x8 vf = (bf16x8){lo[0], lo[1], lo[2], lo[3], hh[0], hh[1], hh[2], hh[3]};
            o[i >> 2] = __builtin_amdgcn_mfma_f32_32x32x16_bf16(vf, pf[i & 3], o[i >> 2], 0, 0, 0);
        }
        if (DO_SM) {
            if (i == 0) { mx0 = fmaxf(fmaxf(p0[0], p0[1]), p0[2]); mx0 = fmaxf(fmaxf(mx0, p0[3]), p0[4]); mx0 = fmaxf(fmaxf(mx0, p0[5]), p0[6]); mx0 = fmaxf(fmaxf(mx0, p0[7]), p0[8]); }
            else if (i == 1) { mx1 = fmaxf(fmaxf(p0[9], p0[10]), p0[11]); mx1 = fmaxf(fmaxf(mx1, p0[12]), p0[13]); mx1 = fmaxf(fmaxf(mx1, p0[14]), p0[15]); mx1 = fmaxf(fmaxf(mx1, p1[0]), p1[1]); }
            else if (i == 2) { mx2 = fmaxf(fmaxf(p1[2], p1[3]), p1[4]); mx2 = fmaxf(fmaxf(mx2, p1[5]), p1[6]); mx2 = fmaxf(fmaxf(mx2, p1[7]), p1[8]); mx2 = fmaxf(fmaxf(mx2, p1[9]), p1[10]); }
            else if (i == 3) {
                float mx3 = fmaxf(fmaxf(p1[11], p1[12]), p1[13]); mx3 = fmaxf(fmaxf(mx3, p1[14]), p1[15]); mx3 = fmaxf(fmaxf(mx3, mx0), mx1);
                const float rm = xmax32(fmaxf(mx3, mx2)) - m;
                if (FIRST || __any(rm > THR)) {
                    const float dl = FIRST ? rm : fmaxf(rm, 0.f); m += dl;
                    if (!FIRST) { fsc = __builtin_amdgcn_exp2f(-dl); l *= fsc; resc = true; }
                }
            }
            else if (i < 8) {
#pragma unroll
                for (int r = 4 * (i - 4); r < 4 * (i - 4) + 4; ++r) { p0[r] = __builtin_amdgcn_exp2f(p0[r] - m); ls += p0[r]; } }
            else if (i < 12) {
#pragma unroll
                for (int r = 4 * (i - 8); r < 4 * (i - 8) + 4; ++r) { p1[r] = __builtin_amdgcn_exp2f(p1[r] - m); ls += p1[r]; } }
            else if (i == 12) pf[0] = pack8(p0, 0);
            else if (i == 13) pf[1] = pack8(p0, 8);
            else if (i == 14) pf[2] = pack8(p1, 0);
            else pf[3] = pack8(p1, 8);
        }
        ATT_SBAR();
    }
#undef ATT_VRD
    if (DO_SM) {
        l += ls;
        if (resc) {
#pragma unroll
            for (int k = 0; k < 4; ++k)
#pragma unroll
                for (int r = 0; r < 16; ++r) o[k][r] *= fsc; }
    }
}
}
__device__ __forceinline__ void attn_mfma_phase(Frame& F) {
    using namespace attn3;
    const int tid = F.tid, lane = F.lane, wave = F.wave, r32 = lane & 31, hi = lane >> 5, rb = wave >> 1, comp = wave & 1;
    const float lambda_init = 0.8f - 0.6f * expf(-0.3f * 1.0f);
    { float s01 = 0.f, s23 = 0.f; for (int i = 0; i < 64; ++i) { s01 += F.d_lam[i] * F.d_lam[64 + i]; s23 += F.d_lam[128 + i] * F.d_lam[192 + i]; }
      ((volatile LAS float*)F.MISC)[16] = expf(s01) - expf(s23) + lambda_init; }
    LAS unsigned char* lds = F.lds;
    LAS float* gl = (LAS float*)(lds + XTRA_OFF);
    for (int i = tid; i < NH * DV; i += 512) gl[i] = F.d_hgain[i];
    const unsigned lds0 = (unsigned)(size_t)lds;
    LAS float* cb = (LAS float*)lds;
    LAS unsigned char* obase = lds + 4 * 32 * CBS * 4;
    const int li = lane & 15, q4 = li >> 2, p4 = li & 3, g1 = (lane >> 4) & 1;
    const int voff = hi * 1024 + q4 * 64 + 32 * g1 + 16 * (p4 >> 1) + 8 * (p4 & 1);
    const int nun = (F.G == 256) ? 8 : (2048 + F.G - 1) / F.G;
    for (int it = 0; it < nun; ++it) {
        int bh, jq;
        if (F.G == 256) { const int X = F.vcu >> 5, w = F.vcu & 31, j = w & 15; bh = X * 16 + 2 * it + (w >> 4); jq = (it & 1) ? 15 - j : j; }
        else { const int u = F.vcu * nun + it; if (u >= 2048) break; bh = u >> 4; jq = u & 15; }
        const int b = bh >> 3, h = bh & 7;
        const int qrow = b * SEQ + 128 * jq + 32 * rb + r32;
        const int cw = 2 * jq + 1 + (rb >> 1), NT = 2 * jq + 3;
        bf16x8 qf0[4];
        { const bf16* qp = F.P + (size_t)qrow * NPROJ + h * 128 + comp * 64 + hi * 8;
#pragma unroll
          for (int d0 = 0; d0 < 4; ++d0) qf0[d0] = *(const GAS bf16x8*)(qp + 16 * d0); }
        LAS unsigned char* qlds = lds + NBUF * BUFB + wave * 4096 + lane * 16;
        f32x16 o[4], p0, p1; bf16x8 pf[4];
#pragma unroll
        for (int r = 0; r < 16; ++r) { p0[r] = 0.f; p1[r] = 0.f;
#pragma unroll
            for (int k = 0; k < 4; ++k) o[k][r] = 0.f; }
#pragma unroll
        for (int k = 0; k < 4; ++k) pf[k] = (bf16x8){0, 0, 0, 0, 0, 0, 0, 0};
        float m = 0.f, l = 0.f;
        __syncthreads();
        int koff[2], vofs[2];
#pragma unroll
        for (int e = 0; e < 2; ++e) { const int row_ = 8 * wave + 4 * e + (lane >> 4), c_ = lane & 15; koff[e] = row_ * NPROJ + 1024 + h * 128 + ((c_ ^ (row_ & 15)) << 3); vofs[e] = (8 * wave + 4 * e + ((lane >> 2) & 3)) * NPROJ + 2048 + h * 128 + 32 * (lane >> 4) + 8 * (lane & 3); }
#define ATT_DMA(t, buf) do { const bf16* tb_ = F.P + (size_t)(b * SEQ + ((t) - 1) * 64) * NPROJ; _Pragma("unroll") for (int e_ = 0; e_ < 2; ++e_) { \
            glds16(tb_ + koff[e_], (unsigned)__builtin_amdgcn_readfirstlane((int)(lds0 + (buf) * BUFB + (2 * wave + e_) * 1024))); \
            glds16(tb_ + vofs[e_], (unsigned)__builtin_amdgcn_readfirstlane((int)(lds0 + (buf) * BUFB + KBYTES + (2 * wave + e_) * 1024))); } } while (0)
        { const bf16* zsrc = (const bf16*)(F.ws + WS_CTL);
#pragma unroll
          for (int e = 0; e < 2; ++e) { const int row_ = 8 * wave + 4 * e + (lane >> 4); const bf16* ks_ = row_ < 16 ? F.PM + koff[e] : zsrc; const bf16* vs_ = (8 * wave + 4 * e) < 16 ? F.PM + vofs[e] : zsrc;
              glds16(ks_, (unsigned)__builtin_amdgcn_readfirstlane((int)(lds0 + (2 * wave + e) * 1024)));
              glds16(vs_, (unsigned)__builtin_amdgcn_readfirstlane((int)(lds0 + KBYTES + (2 * wave + e) * 1024))); } }
        ATT_DMA(1, 1);
#pragma unroll
        for (int d0 = 0; d0 < 4; ++d0) *(LAS bf16x8*)(qlds + d0 * 1024) = qf0[d0];
#define ATT_QK(buf) do { const LAS unsigned char* Kb_ = lds + (buf) * BUFB; bf16x8 kf_[2][4], qf[4]; \
            _Pragma("unroll") for (int d0_ = 0; d0_ < 4; ++d0_) qf[d0_] = *(const LAS bf16x8*)(qlds + d0_ * 1024); \
            _Pragma("unroll") for (int kh_ = 0; kh_ < 2; ++kh_) _Pragma("unroll") for (int d0_ = 0; d0_ < 4; ++d0_) kf_[kh_][d0_] = *(const LAS bf16x8*)(Kb_ + (32 * kh_ + r32) * KSTR + (((8 * comp + 2 * d0_ + hi) ^ (r32 & 15)) << 4)); \
            _Pragma("unroll") for (int r_ = 0; r_ < 16; ++r_) { p0[r_] = 0.f; p1[r_] = 0.f; } \
            _Pragma("unroll") for (int d0_ = 0; d0_ < 4; ++d0_) p0 = __builtin_amdgcn_mfma_f32_32x32x16_bf16(kf_[0][d0_], qf[d0_], p0, 0, 0, 0); \
            _Pragma("unroll") for (int d0_ = 0; d0_ < 4; ++d0_) p1 = __builtin_amdgcn_mfma_f32_32x32x16_bf16(kf_[1][d0_], qf[d0_], p1, 0, 0, 0); } while (0)
        ATT_DMA_WAIT(); __syncthreads();
        ATT_QK(0);
#pragma unroll
        for (int r = 0; r < 16; ++r) { if (r >= 8) p0[r] = -INFINITY; p1[r] = -INFINITY; }
        step<false, true, true>(o, p0, p1, pf, m, l, lds);
        int bc = 1, bp = 0, bn = 2;
#ifdef PROBE_SEG
#define PSTAMP(k) do { unsigned long long tn_; asm volatile("s_memtime %0\n\ts_waitcnt lgkmcnt(0)" : "=s"(tn_) :: "memory"); if (PROBE_SEG == (k) || PROBE_SEG == 0) pacc += (float)(tn_ - tprev_); tprev_ = tn_; } while (0)
        float pacc = 0.f; unsigned long long tprev_; asm volatile("s_memtime %0\n\ts_waitcnt lgkmcnt(0)" : "=s"(tprev_) :: "memory");
#else
#define PSTAMP(k) do {} while (0)
#endif
        for (int t = 1; t < NT; ++t) {
            PSTAMP(9);
            if (t + 1 < NT) ATT_DMA(t + 1, bn);
            PSTAMP(1);
            const LAS unsigned char* vb = lds + bp * BUFB + KBYTES + voff;
            if (t <= cw) { ATT_QK(bc); asm volatile("" : "+v"(p0), "+v"(p1)); PSTAMP(2); step<true, true, false>(o, p0, p1, pf, m, l, vb); }
            else step<true, false, false>(o, p0, p1, pf, m, l, vb);
            PSTAMP(3);
            ATT_DMA_WAIT(); __syncthreads();
            PSTAMP(4);
            const int tmp = bp; bp = bc; bc = bn; bn = tmp;
        }
#ifdef PROBE_SEG
        if (blockIdx.x == 0 && it == 1) ((volatile LAS float*)F.MISC)[17] = pacc / (float)(NT - 1);
#endif
        if (NT - 1 <= cw) step<true, false, false>(o, p0, p1, pf, m, l, lds + bp * BUFB + KBYTES + voff);
#undef ATT_DMA
#undef ATT_QK
        l = xsum32(l);
        const float inv = 1.0f / l;
        LAS float* cbw = cb + (rb * 32 + r32) * CBS + 4 * hi;
        __syncthreads();
        if (comp == 1) {
#pragma unroll
            for (int blk = 0; blk < 4; ++blk)
#pragma unroll
                for (int r = 0; r < 16; ++r) cbw[32 * blk + crow0(r)] = o[blk][r] * inv;
        }
        __syncthreads();
        if (comp == 0) {
            const float lam = ((volatile LAS float*)F.MISC)[16];
            float ssq = 0.f;
#pragma unroll
            for (int blk = 0; blk < 4; ++blk)
#pragma unroll
                for (int r = 0; r < 16; ++r) { const float d = o[blk][r] * inv - lam * cbw[32 * blk + crow0(r)]; o[blk][r] = d; ssq += d * d; if (r == 15) ATT_SBAR(); }
            ssq = xsum32(ssq);
            const float rr = (1.0f - lambda_init) * __builtin_amdgcn_rsqf(ssq * (1.0f / DV) + SUBLN_EPS);
            const LAS float* gpb = gl + h * DV + 4 * hi;
            LAS unsigned char* ob = obase + (rb * 32) * OBS;
            LAS unsigned char* obw = ob + r32 * OBS + 8 * hi;
#pragma unroll
            for (int blk = 0; blk < 4; ++blk)
#pragma unroll
                for (int r = 0; r < 16; r += 2) { const int dv = 32 * blk + crow0(r);
                    *(LAS unsigned*)(obw + dv * 2) = pg8::cvt_pk_bf16(o[blk][r] * rr * gpb[dv], o[blk][r + 1] * rr * gpb[dv + 1]); if (r == 14) ATT_SBAR(); }
            asm volatile("s_waitcnt lgkmcnt(0)" ::: "memory");
#pragma unroll
            for (int i = 0; i < 8; ++i) { const int row = 4 * i + (lane >> 4), ch = lane & 15;
                const v4u v = *(const LAS v4u*)(ob + row * OBS + ch * 16);
                *(GAS v4u*)(F.MIX + (size_t)(b * SEQ + 128 * jq + 32 * rb + row) * D + h * DV + ch * 8) = v; }
        }
    }
}
namespace ml2 {
typedef short bf16x8 __attribute__((ext_vector_type(8)));
typedef short s16x4 __attribute__((ext_vector_type(4)));
constexpr int QSTR = 144, VSTR = 272;
constexpr int OFF_Q = 0, OFF_K = 64 * QSTR, OFF_V = 2 * 64 * QSTR, DBUF = OFF_V + 64 * VSTR;
constexpr int OFF_S = 2 * DBUF, SBUF = 64 * 144;
constexpr int HSTR = 132, OFF_H = OFF_S + 2 * SBUF, HBYTES = 64 * HSTR * 4;
constexpr int OFF_SM = OFF_H + HBYTES, SMB = 12 * 256;
constexpr int A_G = 0, A_M = 64, A_B = 128, A_W = 192, A_RS = 256  , A_QN = 512, A_CT = 576, A_AT = 640, A_N = 704;
static_assert(OFF_SM + 2 * SMB <= RING_BYTES, "mLSTM LDS map");
__device__ __forceinline__ s16x4 vtr(const LAS unsigned char* p) { return __builtin_bit_cast(s16x4, __builtin_amdgcn_ds_read_tr16_b64_v4i16((LAS s16x4*)p)); }
template <int CTRL> __device__ __forceinline__ float dpp_mov(float v) { return __builtin_bit_cast(float, __builtin_amdgcn_update_dpp(0, __builtin_bit_cast(int, v), CTRL, 0xF, 0xF, true)); }
__device__ __forceinline__ float sum8(float v) { v += dpp_mov<0xB1>(v); v += dpp_mov<0x4E>(v); v += dpp_mov<0x141>(v); return v; }
__device__ __forceinline__ float sum16(float v) { v = sum8(v); v += dpp_mov<0x140>(v); return v; }
}
__device__ __forceinline__ void gate_scan_job(Frame& F) {
    const int gw = F.vcu * NWAVES + F.wave, NGW = F.G * NWAVES, lane = F.lane;
    for (int it = gw; it < NB * NH * 33; it += NGW) {
        const int unit = it / 33, c = it % 33, b = unit >> 3, h = unit & 7;
        float lf = 0.f, ig = -1e30f;
        if (c != 0 || lane < 16) { const float* gp = (c == 0 ? F.GATESM + (size_t)lane * 16 : F.GATES + (size_t)(b * SEQ + (c - 1) * 64 + lane) * 16); const float fg = gp[8 + h]; ig = gp[h]; lf = fminf(fg, 0.f) - log1pf(expf(-fabsf(fg))); }
        float bs = lf;
#pragma unroll
        for (int o = 1; o < 64; o <<= 1) { const float v = __shfl_up(bs, o); if (lane >= o) bs += v; }
        const float gs = ig - bs; float pm = gs;
#pragma unroll
        for (int o = 1; o < 64; o <<= 1) { const float v = __shfl_up(pm, o); if (lane >= o) pm = fmaxf(pm, v); }
        float* dst = F.GSC + (size_t)it * 192; dst[lane] = gs; dst[64 + lane] = pm; dst[128 + lane] = bs;
    }
}
__device__ __forceinline__ void mlstm_mfma_phase(Frame& F) {
    using namespace ml2;
    const int tid = F.tid, lane = F.lane, w = F.wave, li = lane & 15, g = lane >> 4, q4 = li >> 2, p4 = li & 3;
    LAS unsigned char* lds = F.lds;
    const int zt = tid >> 3, zc = tid & 7;
    const int mlwg = F.G / 2;
    if (F.vcu >= mlwg) { convert_weights(F, I_IN, NITEMS, (F.vcu - mlwg) * NWAVES + F.wave, (F.G - mlwg) * NWAVES, (LAS float*)(F.lds + RING_OFF + F.wave * 16384)); return; }
    for (int unit = F.vcu; unit < NB * NH; unit += mlwg) {
        const int b = unit >> 3, h = unit & 7;
        __syncthreads();
        for (int i = tid; i < (2 * SBUF) / 16; i += 512) *(LAS v4u*)(lds + OFF_S + i * 16) = (v4u){0u, 0u, 0u, 0u};
        for (int i = tid; i < (2 * SMB) / 16; i += 512) *(LAS v4u*)(lds + OFF_SM + i * 16) = (v4u){0u, 0u, 0u, 0u};
        f32x4 Cacc[4];
#pragma unroll
        for (int i = 0; i < 4; ++i) Cacc[i] = (f32x4){0.f, 0.f, 0.f, 0.f};
        float m = 0.f;
        float gn[16];
#pragma unroll
        for (int i = 0; i < 4; ++i) { const f32x4 t4 = *(const GAS f32x4*)(F.m_hgain + h * DV + 16 * zc + 4 * i); gn[4 * i] = t4.x; gn[4 * i + 1] = t4.y; gn[4 * i + 2] = t4.z; gn[4 * i + 3] = t4.w; }
        v4u sq, sk, sv0, sv1;
#define ML_ROW0(c) ((c) == 0 ? 0 : b * SEQ + ((c) - 1) * 64)
#define ML_PB(c) ((c) == 0 ? F.PM : F.P)
#define ML_LOAD(c) do { const int r0_ = ML_ROW0(c); const bool okq_ = ((c) != 0) || (zt < 16); \
            const bf16* pq_ = ML_PB(c) + (size_t)(r0_ + zt) * NPROJ + h * 64 + 8 * zc; \
            if (okq_) { sq = *(const GAS v4u*)pq_; sk = *(const GAS v4u*)(pq_ + 512); } else { sq = (v4u){0u, 0u, 0u, 0u}; sk = sq; } \
            const int rv0_ = tid >> 4, rv1_ = (tid + 512) >> 4, pv_ = tid & 15; \
            if (((c) != 0) || rv0_ < 16) sv0 = *(const GAS v4u*)(ML_PB(c) + (size_t)(r0_ + rv0_) * NPROJ + 1024 + h * 128 + 8 * pv_); else sv0 = (v4u){0u, 0u, 0u, 0u}; \
            if ((c) != 0) sv1 = *(const GAS v4u*)(F.P + (size_t)(r0_ + rv1_) * NPROJ + 1024 + h * 128 + 8 * pv_); else sv1 = (v4u){0u, 0u, 0u, 0u}; } while (0)
#define ML_STORE(par) do { LAS unsigned char* d_ = lds + (par) * DBUF; *(LAS v4u*)(d_ + OFF_Q + zt * QSTR + zc * 16) = sq; *(LAS v4u*)(d_ + OFF_K + zt * QSTR + zc * 16) = sk; \
            *(LAS v4u*)(d_ + OFF_V + (tid >> 4) * VSTR + (tid & 15) * 16) = sv0; *(LAS v4u*)(d_ + OFF_V + ((tid + 512) >> 4) * VSTR + (tid & 15) * 16) = sv1; } while (0)
        ML_LOAD(0); ML_STORE(0);
        { const float* gq = F.GSC + (size_t)(unit * 33) * 192; LAS float* xg = (LAS float*)(lds + XTRA_OFF);
          for (int i = tid; i < 33 * 192 / 4; i += 512) *(LAS f32x4*)(xg + 4 * i) = *(const GAS f32x4*)(gq + 4 * i); }
        __syncthreads();
        for (int c = 0; c <= 32; ++c) {
            const int par = c & 1; const int row0 = ML_ROW0(c);
            LAS unsigned char* db = lds + par * DBUF; LAS float* sm = (LAS float*)(lds + OFF_SM + par * SMB); LAS float* smn = (LAS float*)(lds + OFF_SM + (par ^ 1) * SMB);
            LAS unsigned char* Sb = lds + OFF_S + par * SBUF;
            if (c < 32) ML_LOAD(c + 1);
            v4u og0 = (v4u){0u, 0u, 0u, 0u}, og1 = og0; const bool zvalid = (c != 0) || (zt < 16);
            if (zvalid) { const bf16* po = ML_PB(c) + (size_t)(row0 + zt) * NPROJ + 2048 + h * 128 + 16 * zc; og0 = *(const GAS v4u*)po; og1 = *(const GAS v4u*)(po + 8); }
            const LAS float* xg = (const LAS float*)(lds + XTRA_OFF) + c * 192; const float gs = xg[lane], pm = xg[64 + lane], bs = xg[128 + lane];
            const float Mt = fmaxf(m, pm);
            const float MT = __builtin_bit_cast(float, __builtin_amdgcn_readlane(__builtin_bit_cast(int, Mt), 63)), bT = __builtin_bit_cast(float, __builtin_amdgcn_readlane(__builtin_bit_cast(int, bs), 63));
            const float ws = __expf(gs - MT), decay = __expf(m - MT);
            sm[A_G + lane] = gs; sm[A_M + lane] = Mt; sm[A_B + lane] = bs; sm[A_W + lane] = ws;
            for (int ti = w; ti < 10; ti += 8) {
                const int rt = ti < 1 ? 0 : ti < 3 ? 1 : ti < 6 ? 2 : 3, st = ti - rt * (rt + 1) / 2;
                f32x4 acc = (f32x4){0.f, 0.f, 0.f, 0.f};
#pragma unroll
                for (int ks = 0; ks < 2; ++ks) { const bf16x8 a = *(const LAS bf16x8*)(db + OFF_Q + (16 * rt + li) * QSTR + (32 * ks + 8 * g) * 2), bb = *(const LAS bf16x8*)(db + OFF_K + (16 * st + li) * QSTR + (32 * ks + 8 * g) * 2);
                    acc = mfma16(a, bb, acc); }
                const float g_s = sm[A_G + 16 * st + li]; const f32x4 M4 = *(const LAS f32x4*)(sm + A_M + 16 * rt + 4 * g);
                float val[4];
#pragma unroll
                for (int r = 0; r < 4; ++r) { const bool ok = (16 * st + li) <= (16 * rt + 4 * g + r); val[r] = ok ? acc[r] * __expf(g_s - M4[r]) : 0.f; }
                float rs[4];
#pragma unroll
                for (int r = 0; r < 4; ++r) rs[r] = sum16(val[r]);
                if (li == 0) *(LAS f32x4*)(sm + A_RS + st * 64 + 16 * rt + 4 * g) = (f32x4){rs[0], rs[1], rs[2], rs[3]};
#pragma unroll
                for (int r = 0; r < 4; ++r) *(LAS bf16*)(Sb + (16 * rt + 4 * g + r) * 144 + (16 * st + li) * 2) = (bf16)f2bf(val[r]);
            }
            { const v4u qv = *(const LAS v4u*)(db + OFF_Q + zt * QSTR + zc * 16); const f32x4 n0 = *(const LAS f32x4*)(sm + A_N + 8 * zc), n1 = *(const LAS f32x4*)(sm + A_N + 8 * zc + 4);
              float d = bflo(qv.x) * n0.x + bfhi(qv.x) * n0.y + bflo(qv.y) * n0.z + bfhi(qv.y) * n0.w + bflo(qv.z) * n1.x + bfhi(qv.z) * n1.y + bflo(qv.w) * n1.z + bfhi(qv.w) * n1.w;
              d = sum8(d);
              if (zc == 0) sm[A_QN + zt] = d; }
            __syncthreads();
            { const float rsum = (sm[A_RS + lane] + sm[A_RS + 64 + lane]) + (sm[A_RS + 128 + lane] + sm[A_RS + 192 + lane]);
              const float inter = __expf(m - Mt), den = rsum + inter * sm[A_QN + lane], dmax = fmaxf(fabsf(den), __expf(-(bs + Mt))), ci = __builtin_amdgcn_rcpf(dmax);
              sm[A_CT + lane] = ci; sm[A_AT + lane] = inter * ci; }
            bf16x8 vf[2], wv[2];
#pragma unroll
            for (int ks = 0; ks < 2; ++ks) {
                const LAS unsigned char* vp = db + OFF_V + (32 * ks + 8 * g + q4) * VSTR + (16 * w + 4 * p4) * 2;
                const s16x4 lo = vtr(vp), hh = vtr(vp + 4 * VSTR);
                vf[ks] = (bf16x8){lo[0], lo[1], lo[2], lo[3], hh[0], hh[1], hh[2], hh[3]};
                const f32x4 w0 = *(const LAS f32x4*)(sm + A_W + 32 * ks + 8 * g), w1 = *(const LAS f32x4*)(sm + A_W + 32 * ks + 8 * g + 4);
                v4u pw; pw.x = pk2(bf2f((unsigned short)lo[0]) * w0.x, bf2f((unsigned short)lo[1]) * w0.y); pw.y = pk2(bf2f((unsigned short)lo[2]) * w0.z, bf2f((unsigned short)lo[3]) * w0.w);
                pw.z = pk2(bf2f((unsigned short)hh[0]) * w1.x, bf2f((unsigned short)hh[1]) * w1.y); pw.w = pk2(bf2f((unsigned short)hh[2]) * w1.z, bf2f((unsigned short)hh[3]) * w1.w);
                wv[ks] = __builtin_bit_cast(bf16x8, pw);
            }
            bf16x8 cbf[2];
#pragma unroll
            for (int ks = 0; ks < 2; ++ks) { v4u pw; pw.x = pk2(Cacc[2 * ks][0], Cacc[2 * ks][1]); pw.y = pk2(Cacc[2 * ks][2], Cacc[2 * ks][3]); pw.z = pk2(Cacc[2 * ks + 1][0], Cacc[2 * ks + 1][1]); pw.w = pk2(Cacc[2 * ks + 1][2], Cacc[2 * ks + 1][3]);
                cbf[ks] = __builtin_bit_cast(bf16x8, pw); }
            f32x4 acc1[4], acc2[4];
#pragma unroll
            for (int rt = 0; rt < 4; ++rt) {
                acc1[rt] = (f32x4){0.f, 0.f, 0.f, 0.f}; acc2[rt] = (f32x4){0.f, 0.f, 0.f, 0.f};
#pragma unroll
                for (int ks = 0; ks < 2; ++ks) {
                    if (ks == 0 || rt >= 2) { const bf16x8 a = *(const LAS bf16x8*)(Sb + (16 * rt + li) * 144 + (32 * ks + 8 * g) * 2); acc1[rt] = mfma16(a, vf[ks], acc1[rt]); }
                    typedef unsigned u32x2 __attribute__((ext_vector_type(2)));
                    const u32x2 qa = *(const LAS u32x2*)(db + OFF_Q + (16 * rt + li) * QSTR + (32 * ks + 4 * g) * 2), qb = *(const LAS u32x2*)(db + OFF_Q + (16 * rt + li) * QSTR + (32 * ks + 16 + 4 * g) * 2);
                    const bf16x8 aq = __builtin_bit_cast(bf16x8, (v4u){qa.x, qa.y, qb.x, qb.y});
                    acc2[rt] = mfma16(aq, cbf[ks], acc2[rt]);
                }
            }
#pragma unroll
            for (int dt = 0; dt < 4; ++dt) {
                Cacc[dt] = Cacc[dt] * decay;
#pragma unroll
                for (int ks = 0; ks < 2; ++ks) {
                    const LAS unsigned char* kp = db + OFF_K + (32 * ks + 8 * g + q4) * QSTR + (16 * dt + 4 * p4) * 2;
                    const s16x4 lo = vtr(kp), hh = vtr(kp + 4 * QSTR);
                    const bf16x8 ka = (bf16x8){lo[0], lo[1], lo[2], lo[3], hh[0], hh[1], hh[2], hh[3]};
                    Cacc[dt] = mfma16(ka, wv[ks], Cacc[dt]);
                }
            }
            { float sacc = 0.f;
#pragma unroll
              for (int i = 0; i < 8; ++i) { const int s_ = 8 * zc + i; sacc += sm[A_W + s_] * bf2f(*(const LAS bf16*)(db + OFF_K + s_ * QSTR + zt * 2)); }
              sacc = sum8(sacc);
              if (zc == 0) smn[A_N + zt] = decay * sm[A_N + zt] + sacc; }
            { LAS float* hb = (LAS float*)(lds + OFF_H);
#pragma unroll
              for (int rt = 0; rt < 4; ++rt) { const f32x4 c4 = *(const LAS f32x4*)(sm + A_CT + 16 * rt + 4 * g), a4 = *(const LAS f32x4*)(sm + A_AT + 16 * rt + 4 * g);
#pragma unroll
                  for (int r = 0; r < 4; ++r) hb[(16 * rt + 4 * g + r) * HSTR + 16 * w + li] = acc1[rt][r] * c4[r] + acc2[rt][r] * a4[r]; } }
            m = bT + MT;
            if (c < 32) ML_STORE(par ^ 1);
            __syncthreads();
            { const LAS float* hb = (const LAS float*)(lds + OFF_H) + zt * HSTR + 16 * zc; float hv[16]; float ss = 0.f;
#pragma unroll
              for (int i = 0; i < 4; ++i) { const f32x4 t4 = *(const LAS f32x4*)(hb + 4 * i); hv[4 * i] = t4.x; hv[4 * i + 1] = t4.y; hv[4 * i + 2] = t4.z; hv[4 * i + 3] = t4.w; ss += (t4.x * t4.x + t4.y * t4.y) + (t4.z * t4.z + t4.w * t4.w); }
              ss = sum8(ss);
              const float rn = __builtin_amdgcn_rsqf(ss * (1.0f / DV) + EPS);
              const unsigned ow[8] = {og0.x, og0.y, og0.z, og0.w, og1.x, og1.y, og1.z, og1.w}; unsigned res[8];
#pragma unroll
              for (int i = 0; i < 8; ++i) { const float o0 = bflo(ow[i]), o1 = bfhi(ow[i]);
                  res[i] = pg8::cvt_pk_bf16(hv[2 * i] * rn * gn[2 * i] * __builtin_amdgcn_rcpf(1.0f + __expf(-o0)), hv[2 * i + 1] * rn * gn[2 * i + 1] * __builtin_amdgcn_rcpf(1.0f + __expf(-o1))); }
              if (zvalid && (c != 0 || b == 0)) { bf16* dst = (c == 0 ? F.MIXM : F.MIX) + (size_t)(row0 + zt) * D + h * DV + 16 * zc; *(GAS v4u*)dst = (v4u){res[0], res[1], res[2], res[3]}; *(GAS v4u*)(dst + 8) = (v4u){res[4], res[5], res[6], res[7]}; } }
        }
#undef ML_ROW0
#undef ML_PB
#undef ML_LOAD
#undef ML_STORE
    }
}
struct Args { const float* in[14]; float* out; unsigned char* ws; int ph_lo, ph_hi; };
__global__ void __launch_bounds__(NWAVES * 64, 2) fwd_kernel(Args args) {
    extern __shared__ __attribute__((aligned(16))) unsigned char lds[];
    Frame F;
    F.lds = (LAS unsigned char*)lds;
    F.MISC = (volatile LAS unsigned*)(F.lds + MISC_OFF);
    F.tid = threadIdx.x; F.lane = F.tid & 63; F.wave = __builtin_amdgcn_readfirstlane(F.tid >> 6);
    F.G = gridDim.x; { const int bx = blockIdx.x; F.vcu = (F.G % 8 == 0) ? (bx % 8) * (F.G / 8) + bx / 8 : bx; }
    unsigned char* ws = args.ws; F.ws = ws;
    F.ctl = (gu32*)(ws + WS_CTL);
    F.x = args.in[0]; F.meta = args.in[1]; F.ngain = args.in[2]; F.m_win = args.in[3]; F.m_bgate = args.in[4]; F.m_hgain = args.in[5]; F.m_wout = args.in[6];
    F.d_win = args.in[7]; F.d_lam = args.in[8]; F.d_hgain = args.in[9]; F.d_wout = args.in[10]; F.w_up = args.in[11]; F.w_dn = args.in[12]; F.fgain = args.in[13];
    F.out = args.out;
    F.WIN0 = (bf16*)(ws + WS_WIN0); F.WOUT0 = (bf16*)(ws + WS_WOUT0); F.WUP0 = (bf16*)(ws + WS_WUP0); F.WDN0 = (bf16*)(ws + WS_WDN0);
    F.WIN1 = (bf16*)(ws + WS_WIN1); F.WOUT1 = (bf16*)(ws + WS_WOUT1); F.WUP1 = (bf16*)(ws + WS_WUP1); F.WDN1 = (bf16*)(ws + WS_WDN1);
    F.HB = (bf16*)(ws + WS_HB); F.P = (bf16*)(ws + WS_P); F.MIX = (bf16*)(ws + WS_MIX); F.U = (bf16*)(ws + WS_U);
    F.SS = (float*)(ws + WS_SS); F.GATES = (float*)(ws + WS_GATES); F.GSC = (float*)(ws + WS_GSC);
    F.HMETA = (float*)(ws + WS_HMETA); F.HBM = (bf16*)(ws + WS_HBM); F.PM = (bf16*)(ws + WS_PM); F.MIXM = (bf16*)(ws + WS_MIXM); F.UM = (bf16*)(ws + WS_UM); F.GATESM = (float*)(ws + WS_GATESM);
    F.SSM = (float*)(ws + WS_CTL) + CW_SSM;
    for (int u = F.tid; u < (LDS_BYTES - LDSCTL_OFF) / 4; u += NWAVES * 64) ((LAS unsigned*)(F.lds + LDSCTL_OFF))[u] = 0u;
    __syncthreads();
    const int lo = args.ph_lo, hi = args.ph_hi;
    const bool use_bar = (hi - lo) > 1;
    XcdBarrier bar; bar.bar = (unsigned*)(F.ctl + CW_BAR); bar.x = 0; bar.st = nullptr;
    if (use_bar) bar = xcd_barrier_post((unsigned*)(F.ctl + CW_BAR), F.MISC + 8);
#define IN(k) (lo <= (k) && (k) < hi)
#ifdef PROBE_PHASE
    unsigned long long t_prev = __builtin_amdgcn_s_memrealtime(); float probe_val = 0.f;
#define STAMP(k) do { const unsigned long long t_now = __builtin_amdgcn_s_memrealtime(); if ((k) == PROBE_PHASE) probe_val = (float)(t_now - t_prev) * 0.01f; t_prev = t_now; } while (0)
#else
#define STAMP(k) do {} while (0)
#endif
#define SEAM(k) do { if (IN(k) && IN((k) + 1)) xcd_barrier(bar); STAMP(k); } while (0)
#define GEMM_PHASE(k, EPI, Aptr, Bptr, NN, KK, METAJOB, ...) if (IN(k)) { METAJOB; pg8::Gemm g{Aptr, Bptr, MR, NN, KK}; pg8::StaticOrder S; S.init(MR, NN, F.G, (int)blockIdx.x); \
        EPI E{__VA_ARGS__}; pg8::gemm_phase<EPI, pg8::StaticOrder, PG8_ALIGN, PG8_SP2>(F.lds + RING_OFF, g, S, E); SEAM(k); }
    typedef pg8::EpiScale<0, 1> EpiIn0; typedef pg8::EpiScale<0, 16> EpiIn1; typedef pg8::EpiScale<1, 16> EpiUp;
#ifdef DOUBLE_PHASE
#define DBL(k, stmt) if (DOUBLE_PHASE == (k)) { stmt; xcd_barrier(bar); }
#else
#define DBL(k, stmt)
#endif
    DBL(0, p0_prologue(F))
    if (IN(0)) { p0_prologue(F); SEAM(0); }
    GEMM_PHASE(1, EpiIn0, F.HB, F.WIN0, NPROJ, D, gate_scan_job(F); meta_gemm(F, F.HBM, F.WIN0, 0, NPROJ / 16, D, MEpiScale<0>{F.PM, NPROJ, F.SSM}), F.P, NPROJ, F.SS, EPS)
    DBL(2, mlstm_mfma_phase(F))
    if (IN(2)) { mlstm_mfma_phase(F); SEAM(2); }
    GEMM_PHASE(3, pg8::EpiRes, F.MIX, F.WOUT0, D, D, meta_gemm(F, F.MIXM, F.WOUT0, 0, D / 16, D, MEpiRes{F.meta, F.HMETA, F.HBM, F.SSM}), F.x, F.out, F.HB, F.SS)
    GEMM_PHASE(4, EpiUp, F.HB, F.WUP0, FF, D, meta_gemm(F, F.HBM, F.WUP0, 0, FF / 16, D, MEpiScale<1>{F.UM, FF, F.SSM}), F.U, FF, F.SS, EPS)
    GEMM_PHASE(5, pg8::EpiRes, F.U, F.WDN0, D, FF, meta_gemm(F, F.UM, F.WDN0, 0, D / 16, FF, MEpiRes{F.HMETA, F.HMETA, F.HBM, F.SSM}), F.out, F.out, F.HB, F.SS)
    GEMM_PHASE(6, EpiIn1, F.HB, F.WIN1, NPROJ, D, meta_gemm(F, F.HBM, F.WIN1, 1024 / 16, NPROJ / 16, D, MEpiScale<0>{F.PM, NPROJ, F.SSM}), F.P, NPROJ, F.SS, EPS)
    DBL(7, attn_mfma_phase(F))
    if (IN(7)) { attn_mfma_phase(F); SEAM(7); }
    GEMM_PHASE(8, pg8::EpiRes, F.MIX, F.WOUT1, D, D, (void)0, F.out, F.out, F.HB, F.SS)
    GEMM_PHASE(9, EpiUp, F.HB, F.WUP1, FF, D, (void)0, F.U, FF, F.SS, EPS)
    GEMM_PHASE(10, pg8::EpiRes, F.U, F.WDN1, D, FF, (void)0, F.out, F.out, (bf16*)nullptr, F.SS)
    if (IN(11)) { final_norm_phase(F); }
#ifdef PROBE_SEG
    if (blockIdx.x == 0 && F.tid == 0) { asm volatile("s_waitcnt vmcnt(0)" ::: "memory"); const float cyc = ((volatile LAS float*)F.MISC)[17]; F.out[0] += 0.05f + 0.10f * fminf(cyc * (1.0f / PROBE_FULL), 1.0f); }
#endif
#ifdef PROBE_PHASE
    STAMP(11);
    if (blockIdx.x == 0 && F.tid == 0) { asm volatile("s_waitcnt vmcnt(0)" ::: "memory"); F.out[0] = probe_val; }
#endif
#undef IN
#undef SEAM
#undef GEMM_PHASE
}

extern "C" void kernel_launch(void* const* d_in, const int* in_sizes, int n_in, void* d_out, int out_size, void* d_ws, size_t ws_size, hipStream_t stream) {
    static int grid = 0;
    if (grid == 0) {
        if (n_in != 14 || in_sizes[0] != NB * SEQ * D || out_size != NB * SEQ * D || ws_size < WS_END) { fprintf(stderr, "kernel_launch: unexpected shapes (n_in %d, in0 %d, out %d, ws %zu)\n", n_in, n_in > 0 ? in_sizes[0] : -1, out_size, ws_size); grid = -1; return; }
        int dev = 0, cus = 0, per_cu = 0;
        if (hipGetDevice(&dev) != hipSuccess || hipDeviceGetAttribute(&cus, hipDeviceAttributeMultiprocessorCount, dev) != hipSuccess) { grid = -1; return; }
        if (hipFuncSetAttribute((const void*)fwd_kernel, hipFuncAttributeMaxDynamicSharedMemorySize, LDS_BYTES) != hipSuccess) { fprintf(stderr, "kernel_launch: hipFuncSetAttribute failed\n"); grid = -1; return; }
        if (hipOccupancyMaxActiveBlocksPerMultiprocessor(&per_cu, (const void*)fwd_kernel, NWAVES * 64, LDS_BYTES) != hipSuccess || per_cu < 1) { fprintf(stderr, "kernel_launch: occupancy query reports %d blocks per CU\n", per_cu); (void)hipGetLastError(); grid = -1; return; }
        grid = cus;
    }
    if (grid < 0) return;
    if (hipMemsetAsync((char*)d_ws + WS_CTL, 0, CTL_ZERO_BYTES, stream) != hipSuccess) return;
    Args a{};
    for (int i = 0; i < 14; ++i) a.in[i] = (const float*)d_in[i];
    a.out = (float*)d_out; a.ws = (unsigned char*)d_ws;
    if (MK_N_LAUNCHES == 1) { a.ph_lo = 0; a.ph_hi = NPHASE; hipLaunchKernelGGL(fwd_kernel, dim3(grid), dim3(NWAVES * 64), LDS_BYTES, stream, a); }
    else for (int p = 0; p < NPHASE; ++p) { a.ph_lo = p; a.ph_hi = p + 1; hipLaunchKernelGGL(fwd_kernel, dim3(grid), dim3(NWAVES * 64), LDS_BYTES, stream, a); }
}
```

```cpp
#include <hip/hip_runtime.h>
#include <cstdio>
#include <cstdint>
namespace pg8 {
#define PG8_LAS __attribute__((address_space(3)))
typedef unsigned short bf16_t;
typedef short bf16x8 __attribute__((ext_vector_type(8)));
typedef float f32x4 __attribute__((ext_vector_type(4)));
typedef unsigned u32x4 __attribute__((ext_vector_type(4)));
constexpr int BM = 256, BK = 64, HALF = 128, HTB = HALF * BK * 2  , STAGE_BYTES = 8 * HTB, NXCD = 8, WGM = 8;

__host__ __device__ __forceinline__ int lds_byte(int r, int c) { const int st = (r >> 4) * 2 + (c >> 5), rr = r & 15, cc = c & 31, ob = rr * 64 + cc * 2; return st * 1024 + (ob ^ (((ob >> 9) & 1) << 5)); }
__host__ __device__ __forceinline__ void stage_rc(int b, int& R, int& C) { const int st = b / 1024, sb = b % 1024, swz = sb ^ (((sb >> 9) & 1) << 5); R = (st >> 1) * 16 + swz / 64; C = (st & 1) * 32 + (swz % 64) / 2; }
__host__ __device__ __forceinline__ int perm32(int rho) { const int n = rho >> 4, i = rho & 15; return 8 * (i >> 2) + 4 * n + (i & 3); }

struct Unit { int pm, pn; };
struct Gemm { const bf16_t* A; const bf16_t* Bt; int M, N, K; };

struct StaticOrder {
    int nM, nN, nwg, G, c;
    __host__ __device__ void init(int M, int N, int G_, int c_) { nM = M / BM; nN = N / BM; nwg = nM * nN; G = G_; c = c_; }
    __host__ __device__ bool next(int i, Unit& u) const {
        const long L = (long)i * G + c; if (L >= nwg) return false;
        int wgid = (int)L; { const int q = nwg / NXCD, r = nwg % NXCD, xcd = wgid % NXCD, off = wgid / NXCD; wgid = (xcd < r ? xcd * (q + 1) : r * (q + 1) + (xcd - r) * q) + off; }
        const int nig = WGM * nN, gid = wgid / nig, fm = gid * WGM, gsz = (nM - fm) < WGM ? (nM - fm) : WGM;
        u.pm = fm + ((wgid % nig) % gsz); u.pn = (wgid % nig) / gsz; return true;
    }
    __device__ __forceinline__ void a_ready(const Unit&) const {}
    __device__ __forceinline__ void done(const Unit&) const {}
};

__device__ __forceinline__ unsigned cvt_pk_bf16(float lo, float hi) { unsigned r; asm volatile("v_cvt_pk_bf16_f32 %0, %1, %2" : "=v"(r) : "v"(lo), "v"(hi)); return r; }
typedef unsigned u32x2 __attribute__((ext_vector_type(2)));

template <int NS> __device__ __forceinline__ float row_rstd(const float* ss, int row, float eps) {
    const float* sp = ss + (size_t)row * 16; float s;
    if (NS == 1) s = sp[0];
    else { const f32x4 a = *(const f32x4*)sp, b = *(const f32x4*)(sp + 4), c = *(const f32x4*)(sp + 8), d = *(const f32x4*)(sp + 12);
           s = ((a[0] + a[1]) + (a[2] + a[3])) + ((b[0] + b[1]) + (b[2] + b[3])) + ((c[0] + c[1]) + (c[2] + c[3])) + ((d[0] + d[1]) + (d[2] + d[3])); }
    return __builtin_amdgcn_rsqf(s * (1.0f / 1024.0f) + eps);
}
__device__ __forceinline__ float row_rstd16_coop(const float* ss, int row, int fq, float eps) {
    const f32x4 a = *(const f32x4*)(ss + (size_t)row * 16 + 4 * fq); float s = (a[0] + a[1]) + (a[2] + a[3]);
    s += __shfl_xor(s, 16); s += __shfl_xor(s, 32);
    return __builtin_amdgcn_rsqf(s * (1.0f / 1024.0f) + eps);
}
template <int ACT, int NS> struct EpiScale {
    static constexpr bool PERM = true, AFTER_DRAIN = false;
    bf16_t* O; int ldc; const float* ss; float eps;
    __device__ __forceinline__ void operator()(const f32x4 (&acc)[2][2][4][2], const Unit& u, int wr, int wc, int fr, int fq) const {
        const int row0 = u.pm * BM + wr * 64 + fr, col0 = u.pn * BM + wc * 32 + 8 * fq;
        float rsv[2][4];
#pragma unroll
        for (int ai = 0; ai < 2; ++ai)
#pragma unroll
            for (int m = 0; m < 4; ++m) { const int row = row0 + ai * HALF + m * 16; rsv[ai][m] = (NS == 1) ? row_rstd<1>(ss, row, eps) : row_rstd16_coop(ss, row, fq, eps); }
#pragma unroll
        for (int ai = 0; ai < 2; ++ai)
#pragma unroll
            for (int m = 0; m < 4; ++m) { const int row = row0 + ai * HALF + m * 16; const float rs = rsv[ai][m];
                bf16_t* rowp = O + (size_t)row * ldc + col0;
#pragma unroll
                for (int bj = 0; bj < 2; ++bj) { f32x4 v0 = acc[ai][bj][m][0] * rs, v1 = acc[ai][bj][m][1] * rs;
                    if (ACT == 1) {
#pragma unroll
                        for (int i = 0; i < 4; ++i) { const float a = fmaxf(v0[i], 0.f), b = fmaxf(v1[i], 0.f); v0[i] = a * a; v1[i] = b * b; } }
                    u32x4 w; w.x = cvt_pk_bf16(v0[0], v0[1]); w.y = cvt_pk_bf16(v0[2], v0[3]); w.z = cvt_pk_bf16(v1[0], v1[1]); w.w = cvt_pk_bf16(v1[2], v1[3]);
                    *(u32x4*)(rowp + bj * HALF) = w; } }
    }
};
template <bool IN_F32, bool OUT_F32> struct EpiRes {
    static constexpr bool PERM = true, AFTER_DRAIN = false;
    const float* Hin; float* Hout; bf16_t* HB; float* ss;
    __device__ __forceinline__ void operator()(const f32x4 (&acc)[2][2][4][2], const Unit& u, int wr, int wc, int fr, int fq) const {
        const int row0 = u.pm * BM + wr * 64 + fr, col0 = u.pn * BM + wc * 32 + 8 * fq;
#pragma unroll
        for (int ai = 0; ai < 2; ++ai)
#pragma unroll
            for (int m = 0; m < 4; ++m) { const int row = row0 + ai * HALF + m * 16; const size_t off = (size_t)row * 1024 + col0; float q = 0.f;
#pragma unroll
                for (int bj = 0; bj < 2; ++bj) { f32x4 h0, h1;
                    if (IN_F32) { h0 = *(const f32x4*)(Hin + off + bj * HALF); h1 = *(const f32x4*)(Hin + off + bj * HALF + 4); }
                    else { const u32x4 w = *(const u32x4*)(HB + off + bj * HALF);
                        h0 = (f32x4){__builtin_bit_cast(float, w.x << 16), __builtin_bit_cast(float, w.x & 0xffff0000u), __builtin_bit_cast(float, w.y << 16), __builtin_bit_cast(float, w.y & 0xffff0000u)};
                        h1 = (f32x4){__builtin_bit_cast(float, w.z << 16), __builtin_bit_cast(float, w.z & 0xffff0000u), __builtin_bit_cast(float, w.w << 16), __builtin_bit_cast(float, w.w & 0xffff0000u)}; }
                    h0 = h0 + acc[ai][bj][m][0]; h1 = h1 + acc[ai][bj][m][1];
                    q += ((h0[0] * h0[0] + h0[1] * h0[1]) + (h0[2] * h0[2] + h0[3] * h0[3])) + ((h1[0] * h1[0] + h1[1] * h1[1]) + (h1[2] * h1[2] + h1[3] * h1[3]));
                    if (OUT_F32) { *(f32x4*)(Hout + off + bj * HALF) = h0; *(f32x4*)(Hout + off + bj * HALF + 4) = h1; }
                    else { u32x4 w; w.x = cvt_pk_bf16(h0[0], h0[1]); w.y = cvt_pk_bf16(h0[2], h0[3]); w.z = cvt_pk_bf16(h1[0], h1[1]); w.w = cvt_pk_bf16(h1[2], h1[3]); *(u32x4*)(HB + off + bj * HALF) = w; } }
                q += __shfl_xor(q, 16); q += __shfl_xor(q, 32);
                if (fq == 0) ss[(size_t)row * 16 + u.pn * 4 + wc] = q; }
    }
};

template <class Epi, class Sched, bool ALIGN_EPI = false, bool SP2 = false>
__device__ __forceinline__ void gemm_phase(PG8_LAS unsigned char* lds, const Gemm g, const Sched& S, const Epi& E) {
    const int tid = threadIdx.x, wid = __builtin_amdgcn_readfirstlane(tid >> 6), lane = tid & 63, wr = wid >> 2, wc = wid & 3, fr = lane & 15, fq = lane >> 4;
    const int K = g.K, nt = K / BK;
    unsigned voffA[2], voffB[2];
#pragma unroll
    for (int i = 0; i < 2; ++i) { int R, C; stage_rc(tid * 16 + i * 8192, R, C); const int Rb = Epi::PERM ? ((R & ~31) + perm32(R & 31)) : R;
        voffA[i] = (unsigned)(R * K + C) * 2u; voffB[i] = (unsigned)(Rb * K + C) * 2u; }
    const size_t kstep = (size_t)(BK * 2);
    const size_t hstep = (size_t)HALF * K * 2;
    const size_t tstep = 2 * hstep;
    const unsigned ldsw = (unsigned)wid * 1024u;
    const int aoff = lds_byte(wr * 64 + fr, fq * 8), boff = lds_byte(wc * 32 + fr, fq * 8);
#define PG8_SA(b, h) (((b) * 2 + (h)) * HTB)
#define PG8_SB(b, h) ((4 + (b) * 2 + (h)) * HTB)
#define PG8_STAGE(bufoff, gbase, voff) do { _Pragma("unroll") for (int _i = 0; _i < 2; ++_i) \
        __builtin_amdgcn_global_load_lds((const unsigned*)((const char*)(gbase) + (voff)[_i]), (PG8_LAS unsigned*)(lds + (bufoff) + ldsw + _i * 8192), 16, 0, 0); } while (0)
#define PG8_LDA(dst, b, h) do { _Pragma("unroll") for (int m = 0; m < 4; ++m) _Pragma("unroll") for (int k = 0; k < 2; ++k) dst[m][k] = *(const PG8_LAS bf16x8*)(lds + PG8_SA(b, h) + aoff + m * 2048 + k * 1024); } while (0)
#define PG8_LDB(dst, b, h) do { _Pragma("unroll") for (int n = 0; n < 2; ++n) _Pragma("unroll") for (int k = 0; k < 2; ++k) dst[n][k] = *(const PG8_LAS bf16x8*)(lds + PG8_SB(b, h) + boff + n * 2048 + k * 1024); } while (0)
#define PG8_MMA(ai, bj, At, Bt) do { __builtin_amdgcn_s_setprio(1); _Pragma("unroll") for (int m = 0; m < 4; ++m) _Pragma("unroll") for (int n = 0; n < 2; ++n) _Pragma("unroll") for (int k = 0; k < 2; ++k) \
        acc[ai][bj][m][n] = __builtin_amdgcn_mfma_f32_16x16x32_bf16(Bt[n][k], At[m][k], acc[ai][bj][m][n], 0, 0, 0); __builtin_amdgcn_s_setprio(0); } while (0)
#define PG8_WAIT_V(n) asm volatile("s_waitcnt vmcnt(" #n ")" ::: "memory")
#define PG8_WAIT_L(n) asm volatile("s_waitcnt lgkmcnt(" #n ")" ::: "memory")
#define PG8_BAR __builtin_amdgcn_s_barrier()
#define PG8_SCHED __builtin_amdgcn_sched_barrier(0)
    Unit cur, nxt; int ui = 0;
#ifdef PROBE_GEMM
    float probe_epi_cycles = 0.f, probe_units = 0.f; unsigned long long tph0_; const unsigned long long trl0_ = __builtin_amdgcn_s_memrealtime(); asm volatile("s_memtime %0\n\ts_waitcnt lgkmcnt(0)" : "=s"(tph0_) :: "memory");
#endif
    if (!S.next(0, cur)) return;
    f32x4 acc[2][2][4][2];
#pragma unroll
    for (int a = 0; a < 2; ++a)
#pragma unroll
        for (int b = 0; b < 2; ++b)
#pragma unroll
            for (int m = 0; m < 4; ++m)
#pragma unroll
                for (int n = 0; n < 2; ++n) acc[a][b][m][n] = (f32x4){0.f, 0.f, 0.f, 0.f};
    bf16x8 At[4][2], B0[2][2], B1[2][2];
    const char* cA = (const char*)g.A + (size_t)cur.pm * tstep; const char* cB = (const char*)g.Bt + (size_t)cur.pn * tstep;
    S.a_ready(cur);
    if constexpr (SP2) {
        PG8_STAGE(PG8_SB(0, 0), cB, voffB); PG8_STAGE(PG8_SB(0, 1), cB + hstep, voffB); PG8_STAGE(PG8_SA(0, 0), cA, voffA); PG8_STAGE(PG8_SA(0, 1), cA + hstep, voffA);
        if (wr == 1) PG8_BAR;
        PG8_WAIT_V(2); PG8_BAR;
        PG8_STAGE(PG8_SB(1, 0), cB + kstep, voffB); PG8_STAGE(PG8_SA(1, 0), cA + kstep, voffA); PG8_STAGE(PG8_SB(1, 1), cB + hstep + kstep, voffB);
        PG8_WAIT_V(6); PG8_BAR;
    } else {
        PG8_STAGE(PG8_SB(0, 0), cB, voffB); PG8_STAGE(PG8_SA(0, 0), cA, voffA); PG8_STAGE(PG8_SB(0, 1), cB + hstep, voffB); PG8_STAGE(PG8_SA(0, 1), cA + hstep, voffA);
        if (wr == 1) PG8_BAR;
        PG8_WAIT_V(4); PG8_BAR;
        PG8_STAGE(PG8_SB(1, 0), cB + kstep, voffB); PG8_STAGE(PG8_SA(1, 0), cA + kstep, voffA); PG8_STAGE(PG8_SB(1, 1), cB + hstep + kstep, voffB);
        PG8_WAIT_V(6); PG8_BAR;
    }
    for (;;) {
        const bool has_next = S.next(ui + 1, nxt);
        const char* nA = has_next ? (const char*)g.A + (size_t)nxt.pm * tstep : cA; const char* nB = has_next ? (const char*)g.Bt + (size_t)nxt.pn * tstep : cB;
        for (int t = 0; t < nt; t += 2) {
            const bool last = (t == nt - 2);
            const char* a1 = cA + (size_t)(t + 1) * kstep;
            const char* a2 = last ? nA : cA + (size_t)(t + 2) * kstep; const char* b2 = last ? nB : cB + (size_t)(t + 2) * kstep;
            const char* a3 = a2 + kstep; const char* b3 = b2 + kstep;
            if (last && has_next) S.a_ready(nxt);
            if constexpr (SP2) {
            PG8_LDB(B0, 0, 0); PG8_LDB(B1, 0, 1); PG8_SCHED; PG8_LDA(At, 0, 0); PG8_STAGE(PG8_SA(1, 1), a1 + hstep, voffA);
            PG8_WAIT_V(8); PG8_WAIT_L(0); PG8_BAR; PG8_MMA(0, 0, At, B0); PG8_MMA(0, 1, At, B1); PG8_BAR; PG8_SCHED;
            PG8_LDA(At, 0, 1); PG8_STAGE(PG8_SB(0, 0), b2, voffB); PG8_STAGE(PG8_SB(0, 1), b2 + hstep, voffB); PG8_STAGE(PG8_SA(0, 0), a2, voffA);
            PG8_WAIT_V(8); PG8_WAIT_L(0); PG8_BAR; PG8_MMA(1, 0, At, B0); PG8_MMA(1, 1, At, B1); PG8_BAR; PG8_SCHED;
            PG8_LDB(B0, 1, 0); PG8_LDB(B1, 1, 1); PG8_SCHED; PG8_LDA(At, 1, 0); PG8_STAGE(PG8_SA(0, 1), a2 + hstep, voffA);
            PG8_WAIT_V(8); PG8_WAIT_L(0); PG8_BAR; PG8_MMA(0, 0, At, B0); PG8_MMA(0, 1, At, B1); PG8_BAR; PG8_SCHED;
            PG8_LDA(At, 1, 1); PG8_STAGE(PG8_SB(1, 0), b3, voffB); PG8_STAGE(PG8_SB(1, 1), b3 + hstep, voffB); PG8_STAGE(PG8_SA(1, 0), a3, voffA);
            PG8_WAIT_V(8); PG8_WAIT_L(0); PG8_BAR; PG8_MMA(1, 0, At, B0); PG8_MMA(1, 1, At, B1); PG8_BAR; PG8_SCHED;
            } else {
            PG8_LDB(B0, 0, 0); PG8_SCHED; PG8_LDA(At, 0, 0); PG8_STAGE(PG8_SA(1, 1), a1 + hstep, voffA);
            PG8_WAIT_L(8); PG8_BAR; PG8_WAIT_L(0); PG8_MMA(0, 0, At, B0); PG8_BAR; PG8_SCHED;
            PG8_LDB(B1, 0, 1); PG8_STAGE(PG8_SB(0, 0), b2, voffB);
            PG8_BAR; PG8_WAIT_L(0); PG8_MMA(0, 1, At, B1); PG8_BAR;
            PG8_LDA(At, 0, 1); PG8_STAGE(PG8_SA(0, 0), a2, voffA);
            PG8_BAR; PG8_WAIT_L(0); PG8_MMA(1, 0, At, B0); PG8_BAR; PG8_SCHED;
            PG8_STAGE(PG8_SB(0, 1), b2 + hstep, voffB);
            PG8_WAIT_V(6); PG8_BAR; PG8_MMA(1, 1, At, B1); PG8_BAR;
            PG8_LDB(B0, 1, 0); PG8_SCHED; PG8_LDA(At, 1, 0); PG8_STAGE(PG8_SA(0, 1), a2 + hstep, voffA);
            PG8_WAIT_L(8); PG8_BAR; PG8_WAIT_L(0); PG8_MMA(0, 0, At, B0); PG8_BAR; PG8_SCHED;
            PG8_LDB(B1, 1, 1); PG8_STAGE(PG8_SB(1, 0), b3, voffB);
            PG8_BAR; PG8_WAIT_L(0); PG8_MMA(0, 1, At, B1); PG8_BAR;
            PG8_LDA(At, 1, 1); PG8_STAGE(PG8_SA(1, 0), a3, voffA);
            PG8_BAR; PG8_WAIT_L(0); PG8_MMA(1, 0, At, B0); PG8_BAR; PG8_SCHED;
            PG8_STAGE(PG8_SB(1, 1), b3 + hstep, voffB);
            PG8_WAIT_V(6); PG8_BAR; PG8_MMA(1, 1, At, B1); PG8_BAR;
            }
        }
        if constexpr (ALIGN_EPI) { if (wr == 0) PG8_BAR; }
#ifdef PROBE_GEMM
        unsigned long long tg0_; asm volatile("s_memtime %0\n\ts_waitcnt lgkmcnt(0)" : "=s"(tg0_) :: "memory");
#endif
        if constexpr (!Epi::AFTER_DRAIN) { E(acc, cur, wr, wc, fr, fq); S.done(cur); }
#ifdef PROBE_GEMM
        { unsigned long long tg1_; asm volatile("s_waitcnt vmcnt(0)\n\ts_memtime %0\n\ts_waitcnt lgkmcnt(0)" : "=s"(tg1_) :: "memory"); probe_epi_cycles += (float)(tg1_ - tg0_); probe_units += 1.f; }
#endif
        if (!has_next) break;
#pragma unroll
        for (int a = 0; a < 2; ++a)
#pragma unroll
            for (int b = 0; b < 2; ++b)
#pragma unroll
                for (int m = 0; m < 4; ++m)
#pragma unroll
                    for (int n = 0; n < 2; ++n) acc[a][b][m][n] = (f32x4){0.f, 0.f, 0.f, 0.f};
        cur = nxt; cA = nA; cB = nB; ++ui;
        if constexpr (ALIGN_EPI) { if (wr == 1) PG8_BAR; }
    }
#ifdef PROBE_GEMM
    if (g.N == PROBE_GEMM_N && g.K == PROBE_GEMM_K) { unsigned long long tph1_; asm volatile("s_memtime %0\n\ts_waitcnt lgkmcnt(0)" : "=s"(tph1_) :: "memory");
        if (blockIdx.x == 0 && tid == 0) { ((volatile PG8_LAS float*)(lds + 162112))[17] = (PROBE_GEMM == 1) ? probe_epi_cycles / probe_units : (PROBE_GEMM == 2) ? (float)(tph1_ - tph0_) / probe_units : (PROBE_GEMM == 3) ? (float)(tph1_ - tph0_) / (float)(__builtin_amdgcn_s_memrealtime() - trl0_) * 100.0f : (float)(__builtin_amdgcn_s_memrealtime() - trl0_) * 0.01f; } }
#endif
    PG8_WAIT_V(0);
    if constexpr (!ALIGN_EPI) { if (wr == 0) PG8_BAR; }
    PG8_BAR;
    if constexpr (Epi::AFTER_DRAIN) { E.fused(acc, cur, wr, wc, fr, fq, lds, wid, lane); S.done(cur); }
#undef PG8_SA
#undef PG8_SB
#undef PG8_STAGE
#undef PG8_LDA
#undef PG8_LDB
#undef PG8_MMA
#undef PG8_WAIT_V
#undef PG8_WAIT_L
#undef PG8_BAR
#undef PG8_SCHED
}
}

#ifndef PG8_SP2
#define PG8_SP2 true
#endif
#ifndef PG8_ALIGN
#define PG8_ALIGN true
#endif
constexpr int NB = 16, SEQ = 2048, NMETA = 16, D = 1024, FF = 4096;
constexpr int MR = NB * SEQ;
constexpr int NH = 8, DQK = 64, DV = 128;
constexpr int NPROJ = 3072;
constexpr float EPS = 1e-6f, SUBLN_EPS = 1e-5f;
constexpr int NWAVES = 8;
#ifndef MK_N_LAUNCHES
#define MK_N_LAUNCHES 1
#endif
constexpr int NPHASE = 12;

constexpr size_t MiB = 1u << 20;
constexpr size_t WS_CTL = 0, CTL_ZERO_BYTES = 1 * MiB;
constexpr size_t WS_WIN0 = 1 * MiB, WS_WOUT0 = 7 * MiB, WS_WUP0 = 9 * MiB, WS_WDN0 = 17 * MiB;
constexpr size_t WS_WIN1 = 25 * MiB, WS_WOUT1 = 31 * MiB, WS_WUP1 = 33 * MiB, WS_WDN1 = 41 * MiB;
constexpr size_t WS_META = 49 * MiB;
constexpr size_t WS_HMETA = WS_META;
constexpr size_t WS_HBM = WS_HMETA + 16 * D * 4;
constexpr size_t WS_PM = WS_HBM + 16 * D * 2;
constexpr size_t WS_MIXM = WS_PM + 16 * NPROJ * 2;
constexpr size_t WS_UM = WS_MIXM + 16 * D * 2;
constexpr size_t WS_GATESM = WS_UM + 16 * FF * 2;
constexpr size_t WS_SS = 50 * MiB;
constexpr size_t WS_GATES = 52 * MiB;
constexpr size_t WS_HB = 54 * MiB;
constexpr size_t WS_P = 118 * MiB;
constexpr size_t WS_MIX = 310 * MiB;
constexpr size_t WS_U = WS_P;
constexpr size_t WS_GSC = 374 * MiB;
constexpr size_t WS_END = 378 * MiB;
static_assert(WS_GATESM + 1024 <= WS_SS && WS_HB + (size_t)MR * D * 2 <= WS_P && WS_P + (size_t)MR * NPROJ * 2 <= WS_MIX && WS_U + (size_t)MR * FF * 2 <= WS_END && WS_MIX + (size_t)MR * D * 2 <= WS_GSC, "d_ws map");
constexpr int CW_BAR = 4096;
constexpr int CW_SSM = 16384;

constexpr int RING_OFF = 0, RING_BYTES = 131072;
constexpr int XTRA_OFF = RING_BYTES, XTRA_BYTES = 30720;
constexpr int LDSCTL_OFF = XTRA_OFF + XTRA_BYTES, MISC_OFF = LDSCTL_OFF + 320;
constexpr int LDS_BYTES = 163840;
static_assert(MISC_OFF + 128 <= LDS_BYTES, "LDS map");

#define GAS __attribute__((address_space(1)))
#define LAS __attribute__((address_space(3)))
typedef unsigned short bf16;
typedef unsigned v4u __attribute__((ext_vector_type(4)));
typedef float f32x4 __attribute__((ext_vector_type(4)));
typedef GAS unsigned gu32;
#define RLX_AGENT __ATOMIC_RELAXED, __HIP_MEMORY_SCOPE_AGENT
#define LDS_WAIT() asm volatile("s_waitcnt lgkmcnt(0)" ::: "memory")
__device__ __forceinline__ unsigned f2bf(float f) { unsigned u = __builtin_bit_cast(unsigned, f); return (u + 0x7fffu + ((u >> 16) & 1u)) >> 16; }
__device__ __forceinline__ unsigned pk2(float lo, float hi) { return f2bf(lo) | (f2bf(hi) << 16); }
__device__ __forceinline__ float bf2f(unsigned short v) { return __builtin_bit_cast(float, (unsigned)v << 16); }
__device__ __forceinline__ float bflo(unsigned w) { return __builtin_bit_cast(float, w << 16); }
__device__ __forceinline__ float bfhi(unsigned w) { return __builtin_bit_cast(float, w & 0xffff0000u); }

#define XB_TMO      128
#define XB_XCNT(j)  (256  + 64 * (j))
#define XB_XSUB(j)  (1280 + 64 * (j))
#define XB_XGEN(j)  (2304 + 64 * (j))
#define XB_TOP      3328
#define XB_TOPGEN   3392
#define XCD_BAR_WORDS 3456
#define XB_SPIN_CAP (1u << 18)
__device__ __forceinline__ unsigned xb_ld(unsigned* p)              { return __hip_atomic_load(p, __ATOMIC_RELAXED, __HIP_MEMORY_SCOPE_AGENT); }
__device__ __forceinline__ unsigned xb_add(unsigned* p, unsigned v) { return __hip_atomic_fetch_add(p, v, __ATOMIC_RELAXED, __HIP_MEMORY_SCOPE_AGENT); }
__device__ __forceinline__ unsigned xb_xcc_id() { return (unsigned)__builtin_amdgcn_s_getreg((3 << 11) | 20) & 0xFu; }
#define XB_SPIN(cond, bar) do { unsigned _sp = 0; while (cond) { __builtin_amdgcn_s_sleep(1); \
    if ((++_sp & 255u) == 0u) { if (xb_ld(&(bar)[XB_TMO])) break; if (_sp > XB_SPIN_CAP) { atomicAdd(&(bar)[XB_TMO], 1u); break; } } } } while (0)
struct XcdBarrier { unsigned* bar; unsigned x; volatile LAS unsigned* st; };
__device__ __forceinline__ XcdBarrier xcd_barrier_post(unsigned* bar, volatile LAS unsigned* st) {
    XcdBarrier b; b.bar = bar; b.x = xb_xcc_id(); b.st = st;
    if (threadIdx.x == 0) (void)xb_add(&bar[XB_XCNT(b.x)], 1u);
    return b;
}
__device__ __forceinline__ void xcd_barrier_complete(unsigned* bar, unsigned x, unsigned& nloc, unsigned& nx) {
    const unsigned G = gridDim.x * gridDim.y * gridDim.z;
    unsigned sum, cnt, mine, sp = 0u;
    for (;;) {
        sum = 0u; cnt = 0u; mine = 0u;
#pragma unroll
        for (unsigned j = 0; j < 16; ++j) { const unsigned c = xb_ld(&bar[XB_XCNT(j)]); sum += c; cnt += (c > 0u) ? 1u : 0u; mine = (j == x) ? c : mine; }
        if (sum == G) break;
        __builtin_amdgcn_s_sleep(1);
        if ((++sp & 255u) == 0u) { if (xb_ld(&bar[XB_TMO])) break; if (sp > XB_SPIN_CAP) { atomicAdd(&bar[XB_TMO], 1u); break; } }
    }
    nloc = mine > 0u ? mine : 1u; nx = cnt > 0u ? cnt : 1u;
}
__device__ __forceinline__ void xcd_barrier(const XcdBarrier& b) {
    asm volatile("s_waitcnt vmcnt(0)" ::: "memory");
    __syncthreads();
    if (threadIdx.x == 0) {
        unsigned* bar = b.bar;
        __builtin_amdgcn_s_waitcnt(0);
        unsigned nloc = b.st[0], nx = b.st[1];
        if (nloc == 0u) { xcd_barrier_complete(bar, b.x, nloc, nx); b.st[0] = nloc; b.st[1] = nx; }
        const unsigned old = xb_add(&bar[XB_XSUB(b.x)], 1u);
        const unsigned gen = old / nloc;
        if (old + 1u == (gen + 1u) * nloc) {
            __builtin_amdgcn_fence(__ATOMIC_RELEASE, "agent");
            asm volatile("s_waitcnt vmcnt(0)" ::: "memory");
            const unsigned og = xb_add(&bar[XB_TOP], 1u);
            const unsigned tg = og / nx;
            if (og + 1u == (tg + 1u) * nx) xb_add(&bar[XB_TOPGEN], 1u);
            else XB_SPIN(xb_ld(&bar[XB_TOPGEN]) == tg, bar);
            __builtin_amdgcn_fence(__ATOMIC_ACQUIRE, "agent");
            xb_add(&bar[XB_XGEN(b.x)], 1u);
            asm volatile("s_waitcnt vmcnt(0)" ::: "memory");
        } else {
            XB_SPIN(xb_ld(&bar[XB_XGEN(b.x)]) == gen, bar);
            __builtin_amdgcn_fence(__ATOMIC_ACQUIRE, "agent");
            asm volatile("s_waitcnt vmcnt(0)" ::: "memory");
        }
    }
    __syncthreads();
}

struct Frame {
    LAS unsigned char* lds;
    volatile LAS unsigned* MISC;
    gu32* ctl;
    int tid, lane, wave, vcu, G;
    const float *x, *meta, *ngain, *m_win, *m_bgate, *m_hgain, *m_wout, *d_win, *d_lam, *d_hgain, *d_wout, *w_up, *w_dn, *fgain;
    float* out; unsigned char* ws;
    bf16 *WIN0, *WOUT0, *WUP0, *WDN0, *WIN1, *WOUT1, *WUP1, *WDN1, *HB, *P, *MIX, *U;
    float *SS, *GATES, *GSC;
    bf16 *HBM, *PM, *MIXM, *UM; float *HMETA, *GATESM, *SSM;
};
__device__ __forceinline__ float wave_sum(float v) {
#pragma unroll
    for (int o = 1; o < 64; o <<= 1) v += __shfl_xor(v, o);
    return v;
}
typedef short bf16x8_t __attribute__((ext_vector_type(8)));
__device__ __forceinline__ f32x4 mfma16(bf16x8_t a, bf16x8_t b, f32x4 c) { return __builtin_amdgcn_mfma_f32_16x16x32_bf16(a, b, c, 0, 0, 0); }
__device__ __forceinline__ void transpose_item(const float* W, int K, int ldw, int Nuse, const float* gk, int nscale, float qscale, bf16* WT, LAS float* scr, int item, int lane) {
    const int nblk = Nuse / 32, kb = item / nblk, nb = item % nblk, k0 = 64 * kb, n0 = 32 * nb;
    const float cs = (n0 < nscale) ? qscale : 1.f;
    const int lr = lane >> 3, lp = lane & 7;
#pragma unroll
    for (int i = 0; i < 8; ++i) { const int kk = 8 * i + lr; const float g = gk ? gk[k0 + kk] * cs : cs; const f32x4 v = *(const GAS f32x4*)(W + (size_t)(k0 + kk) * ldw + n0 + 4 * lp);
        LAS float* d = scr + kk * 33 + 4 * lp; d[0] = v.x * g; d[1] = v.y * g; d[2] = v.z * g; d[3] = v.w * g; }
    LDS_WAIT(); asm volatile("" ::: "memory");
    const int c = lane & 7;
#pragma unroll
    for (int j = 0; j < 4; ++j) { const int n = (lane >> 3) + 8 * j; const LAS float* s = scr + (8 * c) * 33 + n;
        v4u o; o.x = pk2(s[0 * 33], s[1 * 33]); o.y = pk2(s[2 * 33], s[3 * 33]); o.z = pk2(s[4 * 33], s[5 * 33]); o.w = pk2(s[6 * 33], s[7 * 33]);
        *(GAS v4u*)(WT + (size_t)(n0 + n) * K + k0 + 8 * c) = o; }
    LDS_WAIT(); asm volatile("" ::: "memory");
}
constexpr int I_IN = (D / 64) * (NPROJ / 32), I_OUT = (D / 64) * (D / 32), I_UP = (D / 64) * (FF / 32), I_DN = (FF / 64) * (D / 32);
constexpr int I_LAYER = I_IN + I_OUT + I_UP + I_DN, NITEMS = 2 * I_LAYER;
__device__ __forceinline__ void convert_weights(Frame& F, int it0, int it1, int gw, int ngw, LAS float* scr) {
    for (int it = it0 + gw; it < it1; it += ngw) {
        const int layer = it / I_LAYER; int r = it % I_LAYER;
        const float* g0 = F.ngain + (layer * 2 + 0) * D; const float* g1 = F.ngain + (layer * 2 + 1) * D;
        if (r < I_IN) { if (layer == 0) transpose_item(F.m_win, D, 3088, NPROJ, g0, 512, 0.125f, F.WIN0, scr, r, F.lane); else transpose_item(F.d_win, D, NPROJ, NPROJ, g0, 1024, 0.125f * 1.4426950408889634f, F.WIN1, scr, r, F.lane);   continue; } r -= I_IN;
        if (r < I_OUT) { transpose_item(layer == 0 ? F.m_wout : F.d_wout, D, D, D, nullptr, 0, 1.f, layer == 0 ? F.WOUT0 : F.WOUT1, scr, r, F.lane); continue; } r -= I_OUT;
        if (r < I_UP) { transpose_item(F.w_up + (size_t)layer * D * FF, D, FF, FF, g1, 0, 1.f, layer == 0 ? F.WUP0 : F.WUP1, scr, r, F.lane); continue; } r -= I_UP;
        transpose_item(F.w_dn + (size_t)layer * FF * D, FF, D, D, nullptr, 0, 1.f, layer == 0 ? F.WDN0 : F.WDN1, scr, r, F.lane);
    }
}
constexpr int WGSTR = 2048 + 16;
__device__ __forceinline__ void embed_group(Frame& F, const float* src, bf16* hb, float* ssd, int ss_stride, float* gd, const LAS unsigned char* wgl) {
    const int li = F.lane & 15, g = F.lane >> 4;
    const float* sp = src + (size_t)li * D + 8 * g; bf16* hp = hb + (size_t)li * D + 8 * g; const LAS unsigned char* wp = wgl + li * WGSTR + 16 * g;
    f32x4 acc = (f32x4){0.f, 0.f, 0.f, 0.f}; float ssp = 0.f;
#pragma unroll 8
    for (int ks = 0; ks < 32; ++ks) {
        const f32x4 a0 = *(const GAS f32x4*)(sp + 32 * ks), a1 = *(const GAS f32x4*)(sp + 32 * ks + 4);
        ssp += ((a0.x * a0.x + a0.y * a0.y) + (a0.z * a0.z + a0.w * a0.w)) + ((a1.x * a1.x + a1.y * a1.y) + (a1.z * a1.z + a1.w * a1.w));
        v4u pw; pw.x = pg8::cvt_pk_bf16(a0.x, a0.y); pw.y = pg8::cvt_pk_bf16(a0.z, a0.w); pw.z = pg8::cvt_pk_bf16(a1.x, a1.y); pw.w = pg8::cvt_pk_bf16(a1.z, a1.w);
        *(GAS v4u*)(hp + 32 * ks) = pw;
        acc = mfma16(__builtin_bit_cast(bf16x8_t, pw), *(const LAS bf16x8_t*)(wp + 64 * ks), acc);
    }
    ssp += __shfl_xor(ssp, 16); ssp += __shfl_xor(ssp, 32);
    const float rstd = 1.0f / sqrtf(ssp * (1.0f / D) + EPS);
    if (g == 0) ssd[(size_t)li * ss_stride] = ssp;
    const float bg = F.m_bgate[li];
#pragma unroll
    for (int r = 0; r < 4; ++r) { const float rs = __shfl(rstd, 4 * g + r); gd[(size_t)(4 * g + r) * 16 + li] = acc[r] * rs + bg; }
}
__device__ __forceinline__ void p0_prologue(Frame& F) {
    LAS float* scr = (LAS float*)(F.lds + RING_OFF + F.wave * 16384);
    const int gw = F.vcu * NWAVES + F.wave, NGW = F.G * NWAVES;
    convert_weights(F, 0, I_IN, gw, NGW, scr);
    __syncthreads();
    LAS unsigned char* wgl = F.lds + RING_OFF;
    for (int i = F.tid; i < 16 * D; i += NWAVES * 64) { const int k = i >> 4, j = i & 15; *(LAS bf16*)(wgl + j * WGSTR + k * 2) = (bf16)f2bf(F.m_win[(size_t)k * 3088 + NPROJ + j] * F.ngain[k]); }
    __syncthreads();
    for (int grp = gw; grp <= MR / 16; grp += NGW) {
        if (grp < MR / 16) embed_group(F, F.x + (size_t)grp * 16 * D, F.HB + (size_t)grp * 16 * D, F.SS + (size_t)grp * 16 * 16, 16, F.GATES + (size_t)grp * 16 * 16, wgl);
        else embed_group(F, F.meta, F.HBM, F.SSM, 64, F.GATESM, wgl);
    }
}
__device__ __forceinline__ float meta_rstd(const float* ssm, int lane) {
    float mine = 0.f;
#pragma unroll 4
    for (int r = 0; r < 16; ++r) { const float s = wave_sum(ssm[r * 64 + lane]); if (lane == r) mine = 1.0f / sqrtf(s * (1.0f / D) + EPS); }
    return mine;
}
template <int ACT> struct MEpiScale {
    bf16* O; int ldc; const float* ssm;
    __device__ __forceinline__ void operator()(int cb, int li, int g, int lane, const float (&v)[4]) const {
        const float mine = meta_rstd(ssm, lane);
#pragma unroll
        for (int r = 0; r < 4; ++r) { float x = v[r] * __shfl(mine, 4 * g + r); if (ACT == 1) { x = fmaxf(x, 0.f); x = x * x; } O[(size_t)(4 * g + r) * ldc + 16 * cb + li] = (bf16)f2bf(x); }
    }
};
struct MEpiRes {
    const float* Hin; float* H; bf16* HB; float* ssm;
    __device__ __forceinline__ void operator()(int cb, int li, int g, int lane, const float (&v)[4]) const {
#pragma unroll
        for (int r = 0; r < 4; ++r) { const int row = 4 * g + r; const float hv = Hin[(size_t)row * D + 16 * cb + li] + v[r]; H[(size_t)row * D + 16 * cb + li] = hv; HB[(size_t)row * D + 16 * cb + li] = (bf16)f2bf(hv);
            float q = hv * hv; q += __shfl_xor(q, 1); q += __shfl_xor(q, 2); q += __shfl_xor(q, 4); q += __shfl_xor(q, 8);
            if (li == 0) ssm[row * 64 + cb] = q; }
    }
};
template <class MEpi> __device__ __forceinline__ void meta_gemm(Frame& F, const bf16* A, const bf16* Bt, int cb0, int cb1, int K, const MEpi& E) {
    LAS float* red = (LAS float*)(F.lds + XTRA_OFF);
    const int li = F.lane & 15, g = F.lane >> 4, kw = K / NWAVES;
    for (int cb = cb0 + (int)blockIdx.x; cb < cb1; cb += F.G) {
        const bf16* ap = A + (size_t)li * K + F.wave * kw + 8 * g; const bf16* bp = Bt + (size_t)(16 * cb + li) * K + F.wave * kw + 8 * g;
        f32x4 acc = (f32x4){0.f, 0.f, 0.f, 0.f};
#pragma unroll 4
        for (int ks = 0; ks < kw / 32; ++ks) acc = mfma16(*(const GAS bf16x8_t*)(ap + 32 * ks), *(const GAS bf16x8_t*)(bp + 32 * ks), acc);
#pragma unroll
        for (int r = 0; r < 4; ++r) red[F.wave * 256 + r * 64 + F.lane] = acc[r];
        __syncthreads();
        if (F.wave == 0) { float v[4];
#pragma unroll
            for (int r = 0; r < 4; ++r) { float s = 0.f;
#pragma unroll
                for (int ww = 0; ww < NWAVES; ++ww) s += red[ww * 256 + r * 64 + F.lane]; v[r] = s; }
            E(cb, li, g, F.lane, v); }
        __syncthreads();
    }
}
__device__ __forceinline__ void final_norm_phase(Frame& F) {
    const int gw = F.vcu * NWAVES + F.wave, NGW = F.G * NWAVES;
    for (int row = gw; row < MR; row += NGW) {
        const float rs = pg8::row_rstd<16>(F.SS, row, EPS);
        GAS f32x4* p = (GAS f32x4*)(F.out + (size_t)row * D);
#pragma unroll
        for (int j = 0; j < 4; ++j) { f32x4 v = p[64 * j + F.lane]; const f32x4 g = ((const GAS f32x4*)F.fgain)[64 * j + F.lane]; v = v * rs * g; p[64 * j + F.lane] = v; }
    }
}
namespace attn3 {
typedef short bf16x8 __attribute__((ext_vector_type(8)));
typedef short s16x4 __attribute__((ext_vector_type(4)));
typedef float f32x16 __attribute__((ext_vector_type(16)));
constexpr int KSTR = 256, VSTR = 256, KBYTES = 64 * KSTR, VBYTES = 64 * VSTR, BUFB = KBYTES + VBYTES, NBUF = 3;
constexpr int CBS = 129;
constexpr int OBS = 272;
constexpr float THR = 8.0f;
static_assert(NBUF * BUFB + 8 * 4096 <= RING_BYTES + XTRA_BYTES && 4 * 32 * CBS * 4 + 4 * 32 * OBS <= RING_BYTES + XTRA_BYTES, "attention LDS map");
__device__ __forceinline__ constexpr int crow0(int r) { return (r & 3) + 8 * (r >> 2); }
__device__ __forceinline__ s16x4 vtr(const LAS unsigned char* p) { return __builtin_bit_cast(s16x4, __builtin_amdgcn_ds_read_tr16_b64_v4i16((LAS s16x4*)p)); }
__device__ __forceinline__ bf16x8 pack8(const f32x16& p, int b0) {
    v4u w; w.x = pg8::cvt_pk_bf16(p[b0], p[b0 + 1]); w.y = pg8::cvt_pk_bf16(p[b0 + 2], p[b0 + 3]); w.z = pg8::cvt_pk_bf16(p[b0 + 4], p[b0 + 5]); w.w = pg8::cvt_pk_bf16(p[b0 + 6], p[b0 + 7]);
    return __builtin_bit_cast(bf16x8, w);
}
__device__ __forceinline__ float xmax32(float a) { auto rr = __builtin_amdgcn_permlane32_swap(__float_as_uint(a), __float_as_uint(a), false, false); return fmaxf(__uint_as_float(rr[0]), __uint_as_float(rr[1])); }
__device__ __forceinline__ float xsum32(float a) { auto rr = __builtin_amdgcn_permlane32_swap(__float_as_uint(a), __float_as_uint(a), false, false); return __uint_as_float(rr[0]) + __uint_as_float(rr[1]); }
#define ATT_SBAR() __builtin_amdgcn_sched_barrier(0)
__device__ __forceinline__ void glds16(const void* gsrc, unsigned lds_dst) { unsigned keep;
    asm volatile("s_mov_b32 %0, m0\n\ts_mov_b32 m0, %2\n\ts_nop 0\n\tglobal_load_lds_dwordx4 %1, off\n\ts_mov_b32 m0, %0" : "=&s"(keep) : "v"(gsrc), "s"(lds_dst) : "memory"); }
#define ATT_DMA_WAIT() asm volatile("s_waitcnt vmcnt(0)" ::: "memory")
template <bool DO_PV, bool DO_SM, bool FIRST>
__device__ __forceinline__ void step(f32x16 (&o)[4], f32x16& p0, f32x16& p1, bf16x8 (&pf)[4], float& m, float& l, const LAS unsigned char* vbase) {
    s16x4 vl[4], vh[4]; float mx0 = 0.f, mx1 = 0.f, mx2 = 0.f, ls = 0.f, fsc = 1.f; bool resc = false;
#define ATT_VRD(i) do { vl[(i) & 3] = vtr(vbase + (4 * ((i) & 3)) * 1024 + ((i) >> 2) * 256); vh[(i) & 3] = vtr(vbase + (4 * ((i) & 3) + 2) * 1024 + ((i) >> 2) * 256); } while (0)
    if (DO_PV) { ATT_VRD(0); ATT_VRD(1); ATT_VRD(2); }
#pragma unroll
    for (int i = 0; i < 16; ++i) {
        if (DO_PV) {
            if (i + 3 < 16) ATT_VRD(i + 3);
            const s16x4 lo = vl[i & 3], hh = vh[i & 3];
            const bf16x8 vf = (bf16x8){lo[0], lo[1], lo[2], lo[3], hh[0], hh[1], hh[2], hh[3]};
            o[i >> 2] = __builtin_amdgcn_mfma_f32_32x32x16_bf16(vf, pf[i & 3], o[i >> 2], 0, 0, 0);
        }
        if (DO_SM) {
            if (i == 0) { mx0 = fmaxf(fmaxf(p0[0], p0[1]), p0[2]); mx0 = fmaxf(fmaxf(mx0, p0[3]), p0[4]); mx0 = fmaxf(fmaxf(mx0, p0[5]), p0[6]); mx0 = fmaxf(fmaxf(mx0, p0[7]), p0[8]); }
            else if (i == 1) { mx1 = fmaxf(fmaxf(p0[9], p0[10]), p0[11]); mx1 = fmaxf(fmaxf(mx1, p0[12]), p0[13]); mx1 = fmaxf(fmaxf(mx1, p0[14]), p0[15]); mx1 = fmaxf(fmaxf(mx1, p1[0]), p1[1]); }
            else if (i == 2) { mx2 = fmaxf(fmaxf(p1[2], p1[3]), p1[4]); mx2 = fmaxf(fmaxf(mx2, p1[5]), p1[6]); mx2 = fmaxf(fmaxf(mx2, p1[7]), p1[8]); mx2 = fmaxf(fmaxf(mx2, p1[9]), p1[10]); }
            else if (i == 3) {
                float mx3 = fmaxf(fmaxf(p1[11], p1[12]), p1[13]); mx3 = fmaxf(fmaxf(mx3, p1[14]), p1[15]); mx3 = fmaxf(fmaxf(mx3, mx0), mx1);
                const float rm = xmax32(fmaxf(mx3, mx2)) - m;
                if (FIRST || __any(rm > THR)) {
                    const float dl = FIRST ? rm : fmaxf(rm, 0.f); m += dl;
                    if (!FIRST) { fsc = __builtin_amdgcn_exp2f(-dl); l *= fsc; resc = true; }
                }
            }
            else if (i < 8) {
#pragma unroll
                for (int r = 4 * (i - 4); r < 4 * (i - 4) + 4; ++r) { p0[r] = __builtin_amdgcn_exp2f(p0[r] - m); ls += p0[r]; } }
            else if (i < 12) {
#pragma unroll
                for (int r = 4 * (i - 8); r < 4 * (i - 8) + 4; ++r) { p1[r] = __builtin_amdgcn_exp2f(p1[r] - m); ls += p1[r]; } }
            else if (i == 12) pf[0] = pack8(p0, 0);
            else if (i == 13) pf[1] = pack8(p0, 8);
            else if (i == 14) pf[2] = pack8(p1, 0);
            else pf[3] = pack8(p1, 8);
        }
        ATT_SBAR();
    }
#undef ATT_VRD
    if (DO_SM) {
        l += ls;
        if (resc) {
#pragma unroll
            for (int k = 0; k < 4; ++k)
#pragma unroll
                for (int r = 0; r < 16; ++r) o[k][r] *= fsc; }
    }
}
}
__device__ __forceinline__ void attn_mfma_phase(Frame& F) {
    using namespace attn3;
    const int tid = F.tid, lane = F.lane, wave = F.wave, r32 = lane & 31, hi = lane >> 5, rb = wave >> 1, comp = wave & 1;
    const float lambda_init = 0.8f - 0.6f * expf(-0.3f * 1.0f);
    { float s01 = 0.f, s23 = 0.f; for (int i = 0; i < 64; ++i) { s01 += F.d_lam[i] * F.d_lam[64 + i]; s23 += F.d_lam[128 + i] * F.d_lam[192 + i]; }
      ((volatile LAS float*)F.MISC)[16] = expf(s01) - expf(s23) + lambda_init; }
    LAS unsigned char* lds = F.lds;
    LAS float* gl = (LAS float*)(lds + XTRA_OFF);
    for (int i = tid; i < NH * DV; i += 512) gl[i] = F.d_hgain[i];
    const unsigned lds0 = (unsigned)(size_t)lds;
    LAS float* cb = (LAS float*)lds;
    LAS unsigned char* obase = lds + 4 * 32 * CBS * 4;
    const int li = lane & 15, q4 = li >> 2, p4 = li & 3, g1 = (lane >> 4) & 1;
    const int voff = hi * 1024 + q4 * 64 + 32 * g1 + 16 * (p4 >> 1) + 8 * (p4 & 1);
    const int nun = (F.G == 256) ? 8 : (2048 + F.G - 1) / F.G;
    for (int it = 0; it < nun; ++it) {
        int bh, jq;
        if (F.G == 256) { const int X = F.vcu >> 5, w = F.vcu & 31, j = w & 15; bh = X * 16 + 2 * it + (w >> 4); jq = (it & 1) ? 15 - j : j; }
        else { const int u = F.vcu * nun + it; if (u >= 2048) break; bh = u >> 4; jq = u & 15; }
        const int b = bh >> 3, h = bh & 7;
        const int qrow = b * SEQ + 128 * jq + 32 * rb + r32;
        const int cw = 2 * jq + 1 + (rb >> 1), NT = 2 * jq + 3;
        bf16x8 qf0[4];
        { const bf16* qp = F.P + (size_t)qrow * NPROJ + h * 128 + comp * 64 + hi * 8;
#pragma unroll
          for (int d0 = 0; d0 < 4; ++d0) qf0[d0] = *(const GAS bf16x8*)(qp + 16 * d0); }
        LAS unsigned char* qlds = lds + NBUF * BUFB + wave * 4096 + lane * 16;
        f32x16 o[4], p0, p1; bf16x8 pf[4];
#pragma unroll
        for (int r = 0; r < 16; ++r) { p0[r] = 0.f; p1[r] = 0.f;
#pragma unroll
            for (int k = 0; k < 4; ++k) o[k][r] = 0.f; }
#pragma unroll
        for (int k = 0; k < 4; ++k) pf[k] = (bf16x8){0, 0, 0, 0, 0, 0, 0, 0};
        float m = 0.f, l = 0.f;
        __syncthreads();
        int koff[2], vofs[2];
#pragma unroll
        for (int e = 0; e < 2; ++e) { const int row_ = 8 * wave + 4 * e + (lane >> 4), c_ = lane & 15; koff[e] = row_ * NPROJ + 1024 + h * 128 + ((c_ ^ (row_ & 15)) << 3); vofs[e] = (8 * wave + 4 * e + ((lane >> 2) & 3)) * NPROJ + 2048 + h * 128 + 32 * (lane >> 4) + 8 * (lane & 3); }
#define ATT_DMA(t, buf) do { const bf16* tb_ = F.P + (size_t)(b * SEQ + ((t) - 1) * 64) * NPROJ; _Pragma("unroll") for (int e_ = 0; e_ < 2; ++e_) { \
            glds16(tb_ + koff[e_], (unsigned)__builtin_amdgcn_readfirstlane((int)(lds0 + (buf) * BUFB + (2 * wave + e_) * 1024))); \
            glds16(tb_ + vofs[e_], (unsigned)__builtin_amdgcn_readfirstlane((int)(lds0 + (buf) * BUFB + KBYTES + (2 * wave + e_) * 1024))); } } while (0)
        { const bf16* zsrc = (const bf16*)(F.ws + WS_CTL);
#pragma unroll
          for (int e = 0; e < 2; ++e) { const int row_ = 8 * wave + 4 * e + (lane >> 4); const bf16* ks_ = row_ < 16 ? F.PM + koff[e] : zsrc; const bf16* vs_ = (8 * wave + 4 * e) < 16 ? F.PM + vofs[e] : zsrc;
              glds16(ks_, (unsigned)__builtin_amdgcn_readfirstlane((int)(lds0 + (2 * wave + e) * 1024)));
              glds16(vs_, (unsigned)__builtin_amdgcn_readfirstlane((int)(lds0 + KBYTES + (2 * wave + e) * 1024))); } }
        ATT_DMA(1, 1);
#pragma unroll
        for (int d0 = 0; d0 < 4; ++d0) *(LAS bf16x8*)(qlds + d0 * 1024) = qf0[d0];
#define ATT_QK(buf) do { const LAS unsigned char* Kb_ = lds + (buf) * BUFB; bf16x8 kf_[2][4], qf[4]; \
            _Pragma("unroll") for (int d0_ = 0; d0_ < 4; ++d0_) qf[d0_] = *(const LAS bf16x8*)(qlds + d0_ * 1024); \
            _Pragma("unroll") for (int kh_ = 0; kh_ < 2; ++kh_) _Pragma("unroll") for (int d0_ = 0; d0_ < 4; ++d0_) kf_[kh_][d0_] = *(const LAS bf16x8*)(Kb_ + (32 * kh_ + r32) * KSTR + (((8 * comp + 2 * d0_ + hi) ^ (r32 & 15)) << 4)); \
            _Pragma("unroll") for (int r_ = 0; r_ < 16; ++r_) { p0[r_] = 0.f; p1[r_] = 0.f; } \
            _Pragma("unroll") for (int d0_ = 0; d0_ < 4; ++d0_) p0 = __builtin_amdgcn_mfma_f32_32x32x16_bf16(kf_[0][d0_], qf[d0_], p0, 0, 0, 0); \
            _Pragma("unroll") for (int d0_ = 0; d0_ < 4; ++d0_) p1 = __builtin_amdgcn_mfma_f32_32x32x16_bf16(kf_[1][d0_], qf[d0_], p1, 0, 0, 0); } while (0)
        ATT_DMA_WAIT(); __syncthreads();
        ATT_QK(0);
#pragma unroll
        for (int r = 0; r < 16; ++r) { if (r >= 8) p0[r] = -INFINITY; p1[r] = -INFINITY; }
        step<false, true, true>(o, p0, p1, pf, m, l, lds);
        int bc = 1, bp = 0, bn = 2;
#ifdef PROBE_SEG
#define PSTAMP(k) do { unsigned long long tn_; asm volatile("s_memtime %0\n\ts_waitcnt lgkmcnt(0)" : "=s"(tn_) :: "memory"); if (PROBE_SEG == (k) || PROBE_SEG == 0) pacc += (float)(tn_ - tprev_); tprev_ = tn_; } while (0)
        float pacc = 0.f; unsigned long long tprev_; asm volatile("s_memtime %0\n\ts_waitcnt lgkmcnt(0)" : "=s"(tprev_) :: "memory");
#else
#define PSTAMP(k) do {} while (0)
#endif
        for (int t = 1; t < NT; ++t) {
            PSTAMP(9);
            if (t + 1 < NT) ATT_DMA(t + 1, bn);
            PSTAMP(1);
            const LAS unsigned char* vb = lds + bp * BUFB + KBYTES + voff;
            if (t <= cw) { ATT_QK(bc); asm volatile("" : "+v"(p0), "+v"(p1)); PSTAMP(2); step<true, true, false>(o, p0, p1, pf, m, l, vb); }
            else step<true, false, false>(o, p0, p1, pf, m, l, vb);
            PSTAMP(3);
            ATT_DMA_WAIT(); __syncthreads();
            PSTAMP(4);
            const int tmp = bp; bp = bc; bc = bn; bn = tmp;
        }
#ifdef PROBE_SEG
        if (blockIdx.x == 0 && it == 1) ((volatile LAS float*)F.MISC)[17] = pacc / (float)(NT - 1);
#endif
        if (NT - 1 <= cw) step<true, false, false>(o, p0, p1, pf, m, l, lds + bp * BUFB + KBYTES + voff);
#undef ATT_DMA
#undef ATT_QK
        l = xsum32(l);
        const float inv = 1.0f / l;
        LAS float* cbw = cb + (rb * 32 + r32) * CBS + 4 * hi;
        __syncthreads();
        if (comp == 1) {
#pragma unroll
            for (int blk = 0; blk < 4; ++blk)
#pragma unroll
                for (int r = 0; r < 16; ++r) cbw[32 * blk + crow0(r)] = o[blk][r] * inv;
        }
        __syncthreads();
        if (comp == 0) {
            const float lam = ((volatile LAS float*)F.MISC)[16];
            float ssq = 0.f;
#pragma unroll
            for (int blk = 0; blk < 4; ++blk)
#pragma unroll
                for (int r = 0; r < 16; ++r) { const float d = o[blk][r] * inv - lam * cbw[32 * blk + crow0(r)]; o[blk][r] = d; ssq += d * d; if (r == 15) ATT_SBAR(); }
            ssq = xsum32(ssq);
            const float rr = (1.0f - lambda_init) * __builtin_amdgcn_rsqf(ssq * (1.0f / DV) + SUBLN_EPS);
            const LAS float* gpb = gl + h * DV + 4 * hi;
            LAS unsigned char* ob = obase + (rb * 32) * OBS;
            LAS unsigned char* obw = ob + r32 * OBS + 8 * hi;
#pragma unroll
            for (int blk = 0; blk < 4; ++blk)
#pragma unroll
                for (int r = 0; r < 16; r += 2) { const int dv = 32 * blk + crow0(r);
                    *(LAS unsigned*)(obw + dv * 2) = pg8::cvt_pk_bf16(o[blk][r] * rr * gpb[dv], o[blk][r + 1] * rr * gpb[dv + 1]); if (r == 14) ATT_SBAR(); }
            asm volatile("s_waitcnt lgkmcnt(0)" ::: "memory");
#pragma unroll
            for (int i = 0; i < 8; ++i) { const int row = 4 * i + (lane >> 4), ch = lane & 15;
                const v4u v = *(const LAS v4u*)(ob + row * OBS + ch * 16);
                *(GAS v4u*)(F.MIX + (size_t)(b * SEQ + 128 * jq + 32 * rb + row) * D + h * DV + ch * 8) = v; }
        }
    }
}
namespace ml2 {
typedef short bf16x8 __attribute__((ext_vector_type(8)));
typedef short s16x4 __attribute__((ext_vector_type(4)));
constexpr int QSTR = 144, VSTR = 272;
constexpr int OFF_Q = 0, OFF_K = 64 * QSTR, OFF_V = 2 * 64 * QSTR, DBUF = OFF_V + 64 * VSTR;
constexpr int OFF_S = 2 * DBUF, SBUF = 64 * 144;
constexpr int HSTR = 132, OFF_H = OFF_S + 2 * SBUF, HBYTES = 64 * HSTR * 4;
constexpr int OFF_SM = OFF_H + HBYTES, SMB = 12 * 256;
constexpr int A_G = 0, A_M = 64, A_B = 128, A_W = 192, A_RS = 256  , A_QN = 512, A_CT = 576, A_AT = 640, A_N = 704;
static_assert(OFF_SM + 2 * SMB <= RING_BYTES, "mLSTM LDS map");
__device__ __forceinline__ s16x4 vtr(const LAS unsigned char* p) { return __builtin_bit_cast(s16x4, __builtin_amdgcn_ds_read_tr16_b64_v4i16((LAS s16x4*)p)); }
template <int CTRL> __device__ __forceinline__ float dpp_mov(float v) { return __builtin_bit_cast(float, __builtin_amdgcn_update_dpp(0, __builtin_bit_cast(int, v), CTRL, 0xF, 0xF, true)); }
__device__ __forceinline__ float sum8(float v) { v += dpp_mov<0xB1>(v); v += dpp_mov<0x4E>(v); v += dpp_mov<0x141>(v); return v; }
__device__ __forceinline__ float sum16(float v) { v = sum8(v); v += dpp_mov<0x140>(v); return v; }
}
__device__ __forceinline__ void gate_scan_job(Frame& F) {
    const int gw = F.vcu * NWAVES + F.wave, NGW = F.G * NWAVES, lane = F.lane;
    for (int it = gw; it < NB * NH * 33; it += NGW) {
        const int unit = it / 33, c = it % 33, b = unit >> 3, h = unit & 7;
        float lf = 0.f, ig = -1e30f;
        if (c != 0 || lane < 16) { const float* gp = (c == 0 ? F.GATESM + (size_t)lane * 16 : F.GATES + (size_t)(b * SEQ + (c - 1) * 64 + lane) * 16); const float fg = gp[8 + h]; ig = gp[h]; lf = fminf(fg, 0.f) - log1pf(expf(-fabsf(fg))); }
        float bs = lf;
#pragma unroll
        for (int o = 1; o < 64; o <<= 1) { const float v = __shfl_up(bs, o); if (lane >= o) bs += v; }
        const float gs = ig - bs; float pm = gs;
#pragma unroll
        for (int o = 1; o < 64; o <<= 1) { const float v = __shfl_up(pm, o); if (lane >= o) pm = fmaxf(pm, v); }
        float* dst = F.GSC + (size_t)it * 192; dst[lane] = gs; dst[64 + lane] = pm; dst[128 + lane] = bs;
    }
}
__device__ __forceinline__ void mlstm_mfma_phase(Frame& F) {
    using namespace ml2;
    const int tid = F.tid, lane = F.lane, w = F.wave, li = lane & 15, g = lane >> 4, q4 = li >> 2, p4 = li & 3;
    LAS unsigned char* lds = F.lds;
    const int zt = tid >> 3, zc = tid & 7;
    const int mlwg = F.G / 2;
    if (F.vcu >= mlwg) { convert_weights(F, I_IN, NITEMS, (F.vcu - mlwg) * NWAVES + F.wave, (F.G - mlwg) * NWAVES, (LAS float*)(F.lds + RING_OFF + F.wave * 16384)); return; }
    for (int unit = F.vcu; unit < NB * NH; unit += mlwg) {
        const int b = unit >> 3, h = unit & 7;
        __syncthreads();
        for (int i = tid; i < (2 * SBUF) / 16; i += 512) *(LAS v4u*)(lds + OFF_S + i * 16) = (v4u){0u, 0u, 0u, 0u};
        for (int i = tid; i < (2 * SMB) / 16; i += 512) *(LAS v4u*)(lds + OFF_SM + i * 16) = (v4u){0u, 0u, 0u, 0u};
        f32x4 Cacc[4];
#pragma unroll
        for (int i = 0; i < 4; ++i) Cacc[i] = (f32x4){0.f, 0.f, 0.f, 0.f};
        float m = 0.f;
        float gn[16];
#pragma unroll
        for (int i = 0; i < 4; ++i) { const f32x4 t4 = *(const GAS f32x4*)(F.m_hgain + h * DV + 16 * zc + 4 * i); gn[4 * i] = t4.x; gn[4 * i + 1] = t4.y; gn[4 * i + 2] = t4.z; gn[4 * i + 3] = t4.w; }
        v4u sq, sk, sv0, sv1;
#define ML_ROW0(c) ((c) == 0 ? 0 : b * SEQ + ((c) - 1) * 64)
#define ML_PB(c) ((c) == 0 ? F.PM : F.P)
#define ML_LOAD(c) do { const int r0_ = ML_ROW0(c); const bool okq_ = ((c) != 0) || (zt < 16); \
            const bf16* pq_ = ML_PB(c) + (size_t)(r0_ + zt) * NPROJ + h * 64 + 8 * zc; \
            if (okq_) { sq = *(const GAS v4u*)pq_; sk = *(const GAS v4u*)(pq_ + 512); } else { sq = (v4u){0u, 0u, 0u, 0u}; sk = sq; } \
            const int rv0_ = tid >> 4, rv1_ = (tid + 512) >> 4, pv_ = tid & 15; \
            if (((c) != 0) || rv0_ < 16) sv0 = *(const GAS v4u*)(ML_PB(c) + (size_t)(r0_ + rv0_) * NPROJ + 1024 + h * 128 + 8 * pv_); else sv0 = (v4u){0u, 0u, 0u, 0u}; \
            if ((c) != 0) sv1 = *(const GAS v4u*)(F.P + (size_t)(r0_ + rv1_) * NPROJ + 1024 + h * 128 + 8 * pv_); else sv1 = (v4u){0u, 0u, 0u, 0u}; } while (0)
#define ML_STORE(par) do { LAS unsigned char* d_ = lds + (par) * DBUF; *(LAS v4u*)(d_ + OFF_Q + zt * QSTR + zc * 16) = sq; *(LAS v4u*)(d_ + OFF_K + zt * QSTR + zc * 16) = sk; \
            *(LAS v4u*)(d_ + OFF_V + (tid >> 4) * VSTR + (tid & 15) * 16) = sv0; *(LAS v4u*)(d_ + OFF_V + ((tid + 512) >> 4) * VSTR + (tid & 15) * 16) = sv1; } while (0)
        ML_LOAD(0); ML_STORE(0);
        { const float* gq = F.GSC + (size_t)(unit * 33) * 192; LAS float* xg = (LAS float*)(lds + XTRA_OFF);
          for (int i = tid; i < 33 * 192 / 4; i += 512) *(LAS f32x4*)(xg + 4 * i) = *(const GAS f32x4*)(gq + 4 * i); }
        __syncthreads();
        for (int c = 0; c <= 32; ++c) {
            const int par = c & 1; const int row0 = ML_ROW0(c);
            LAS unsigned char* db = lds + par * DBUF; LAS float* sm = (LAS float*)(lds + OFF_SM + par * SMB); LAS float* smn = (LAS float*)(lds + OFF_SM + (par ^ 1) * SMB);
            LAS unsigned char* Sb = lds + OFF_S + par * SBUF;
            if (c < 32) ML_LOAD(c + 1);
            v4u og0 = (v4u){0u, 0u, 0u, 0u}, og1 = og0; const bool zvalid = (c != 0) || (zt < 16);
            if (zvalid) { const bf16* po = ML_PB(c) + (size_t)(row0 + zt) * NPROJ + 2048 + h * 128 + 16 * zc; og0 = *(const GAS v4u*)po; og1 = *(const GAS v4u*)(po + 8); }
            const LAS float* xg = (const LAS float*)(lds + XTRA_OFF) + c * 192; const float gs = xg[lane], pm = xg[64 + lane], bs = xg[128 + lane];
            const float Mt = fmaxf(m, pm);
            const float MT = __builtin_bit_cast(float, __builtin_amdgcn_readlane(__builtin_bit_cast(int, Mt), 63)), bT = __builtin_bit_cast(float, __builtin_amdgcn_readlane(__builtin_bit_cast(int, bs), 63));
            const float ws = __expf(gs - MT), decay = __expf(m - MT);
            sm[A_G + lane] = gs; sm[A_M + lane] = Mt; sm[A_B + lane] = bs; sm[A_W + lane] = ws;
            for (int ti = w; ti < 10; ti += 8) {
                const int rt = ti < 1 ? 0 : ti < 3 ? 1 : ti < 6 ? 2 : 3, st = ti - rt * (rt + 1) / 2;
                f32x4 acc = (f32x4){0.f, 0.f, 0.f, 0.f};
#pragma unroll
                for (int ks = 0; ks < 2; ++ks) { const bf16x8 a = *(const LAS bf16x8*)(db + OFF_Q + (16 * rt + li) * QSTR + (32 * ks + 8 * g) * 2), bb = *(const LAS bf16x8*)(db + OFF_K + (16 * st + li) * QSTR + (32 * ks + 8 * g) * 2);
                    acc = mfma16(a, bb, acc); }
                const float g_s = sm[A_G + 16 * st + li]; const f32x4 M4 = *(const LAS f32x4*)(sm + A_M + 16 * rt + 4 * g);
                float val[4];
#pragma unroll
                for (int r = 0; r < 4; ++r) { const bool ok = (16 * st + li) <= (16 * rt + 4 * g + r); val[r] = ok ? acc[r] * __expf(g_s - M4[r]) : 0.f; }
                float rs[4];
#pragma unroll
                for (int r = 0; r < 4; ++r) rs[r] = sum16(val[r]);
                if (li == 0) *(LAS f32x4*)(sm + A_RS + st * 64 + 16 * rt + 4 * g) = (f32x4){rs[0], rs[1], rs[2], rs[3]};
#pragma unroll
                for (int r = 0; r < 4; ++r) *(LAS bf16*)(Sb + (16 * rt + 4 * g + r) * 144 + (16 * st + li) * 2) = (bf16)f2bf(val[r]);
            }
            { const v4u qv = *(const LAS v4u*)(db + OFF_Q + zt * QSTR + zc * 16); const f32x4 n0 = *(const LAS f32x4*)(sm + A_N + 8 * zc), n1 = *(const LAS f32x4*)(sm + A_N + 8 * zc + 4);
              float d = bflo(qv.x) * n0.x + bfhi(qv.x) * n0.y + bflo(qv.y) * n0.z + bfhi(qv.y) * n0.w + bflo(qv.z) * n1.x + bfhi(qv.z) * n1.y + bflo(qv.w) * n1.z + bfhi(qv.w) * n1.w;
              d = sum8(d);
              if (zc == 0) sm[A_QN + zt] = d; }
            __syncthreads();
            { const float rsum = (sm[A_RS + lane] + sm[A_RS + 64 + lane]) + (sm[A_RS + 128 + lane] + sm[A_RS + 192 + lane]);
              const float inter = __expf(m - Mt), den = rsum + inter * sm[A_QN + lane], dmax = fmaxf(fabsf(den), __expf(-(bs + Mt))), ci = __builtin_amdgcn_rcpf(dmax);
              sm[A_CT + lane] = ci; sm[A_AT + lane] = inter * ci; }
            bf16x8 vf[2], wv[2];
#pragma unroll
            for (int ks = 0; ks < 2; ++ks) {
                const LAS unsigned char* vp = db + OFF_V + (32 * ks + 8 * g + q4) * VSTR + (16 * w + 4 * p4) * 2;
                const s16x4 lo = vtr(vp), hh = vtr(vp + 4 * VSTR);
                vf[ks] = (bf16x8){lo[0], lo[1], lo[2], lo[3], hh[0], hh[1], hh[2], hh[3]};
                const f32x4 w0 = *(const LAS f32x4*)(sm + A_W + 32 * ks + 8 * g), w1 = *(const LAS f32x4*)(sm + A_W + 32 * ks + 8 * g + 4);
                v4u pw; pw.x = pk2(bf2f((unsigned short)lo[0]) * w0.x, bf2f((unsigned short)lo[1]) * w0.y); pw.y = pk2(bf2f((unsigned short)lo[2]) * w0.z, bf2f((unsigned short)lo[3]) * w0.w);
                pw.z = pk2(bf2f((unsigned short)hh[0]) * w1.x, bf2f((unsigned short)hh[1]) * w1.y); pw.w = pk2(bf2f((unsigned short)hh[2]) * w1.z, bf2f((unsigned short)hh[3]) * w1.w);
                wv[ks] = __builtin_bit_cast(bf16x8, pw);
            }
            bf16x8 cbf[2];
#pragma unroll
            for (int ks = 0; ks < 2; ++ks) { v4u pw; pw.x = pk2(Cacc[2 * ks][0], Cacc[2 * ks][1]); pw.y = pk2(Cacc[2 * ks][2], Cacc[2 * ks][3]); pw.z = pk2(Cacc[2 * ks + 1][0], Cacc[2 * ks + 1][1]); pw.w = pk2(Cacc[2 * ks + 1][2], Cacc[2 * ks + 1][3]);
                cbf[ks] = __builtin_bit_cast(bf16x8, pw); }
            f32x4 acc1[4], acc2[4];
#pragma unroll
            for (int rt = 0; rt < 4; ++rt) {
                acc1[rt] = (f32x4){0.f, 0.f, 0.f, 0.f}; acc2[rt] = (f32x4){0.f, 0.f, 0.f, 0.f};
#pragma unroll
                for (int ks = 0; ks < 2; ++ks) {
                    if (ks == 0 || rt >= 2) { const bf16x8 a = *(const LAS bf16x8*)(Sb + (16 * rt + li) * 144 + (32 * ks + 8 * g) * 2); acc1[rt] = mfma16(a, vf[ks], acc1[rt]); }
                    typedef unsigned u32x2 __attribute__((ext_vector_type(2)));
                    const u32x2 qa = *(const LAS u32x2*)(db + OFF_Q + (16 * rt + li) * QSTR + (32 * ks + 4 * g) * 2), qb = *(const LAS u32x2*)(db + OFF_Q + (16 * rt + li) * QSTR + (32 * ks + 16 + 4 * g) * 2);
                    const bf16x8 aq = __builtin_bit_cast(bf16x8, (v4u){qa.x, qa.y, qb.x, qb.y});
                    acc2[rt] = mfma16(aq, cbf[ks], acc2[rt]);
                }
            }
#pragma unroll
            for (int dt = 0; dt < 4; ++dt) {
                Cacc[dt] = Cacc[dt] * decay;
#pragma unroll
                for (int ks = 0; ks < 2; ++ks) {
                    const LAS unsigned char* kp = db + OFF_K + (32 * ks + 8 * g + q4) * QSTR + (16 * dt + 4 * p4) * 2;
                    const s16x4 lo = vtr(kp), hh = vtr(kp + 4 * QSTR);
                    const bf16x8 ka = (bf16x8){lo[0], lo[1], lo[2], lo[3], hh[0], hh[1], hh[2], hh[3]};
                    Cacc[dt] = mfma16(ka, wv[ks], Cacc[dt]);
                }
            }
            { float sacc = 0.f;
#pragma unroll
              for (int i = 0; i < 8; ++i) { const int s_ = 8 * zc + i; sacc += sm[A_W + s_] * bf2f(*(const LAS bf16*)(db + OFF_K + s_ * QSTR + zt * 2)); }
              sacc = sum8(sacc);
              if (zc == 0) smn[A_N + zt] = decay * sm[A_N + zt] + sacc; }
            { LAS float* hb = (LAS float*)(lds + OFF_H);
#pragma unroll
              for (int rt = 0; rt < 4; ++rt) { const f32x4 c4 = *(const LAS f32x4*)(sm + A_CT + 16 * rt + 4 * g), a4 = *(const LAS f32x4*)(sm + A_AT + 16 * rt + 4 * g);
#pragma unroll
                  for (int r = 0; r < 4; ++r) hb[(16 * rt + 4 * g + r) * HSTR + 16 * w + li] = acc1[rt][r] * c4[r] + acc2[rt][r] * a4[r]; } }
            m = bT + MT;
            if (c < 32) ML_STORE(par ^ 1);
            __syncthreads();
            { const LAS float* hb = (const LAS float*)(lds + OFF_H) + zt * HSTR + 16 * zc; float hv[16]; float ss = 0.f;
#pragma unroll
              for (int i = 0; i < 4; ++i) { const f32x4 t4 = *(const LAS f32x4*)(hb + 4 * i); hv[4 * i] = t4.x; hv[4 * i + 1] = t4.y; hv[4 * i + 2] = t4.z; hv[4 * i + 3] = t4.w; ss += (t4.x * t4.x + t4.y * t4.y) + (t4.z * t4.z + t4.w * t4.w); }
              ss = sum8(ss);
              const float rn = __builtin_amdgcn_rsqf(ss * (1.0f / DV) + EPS);
              const unsigned ow[8] = {og0.x, og0.y, og0.z, og0.w, og1.x, og1.y, og1.z, og1.w}; unsigned res[8];
#pragma unroll
              for (int i = 0; i < 8; ++i) { const float o0 = bflo(ow[i]), o1 = bfhi(ow[i]);
                  res[i] = pg8::cvt_pk_bf16(hv[2 * i] * rn * gn[2 * i] * __builtin_amdgcn_rcpf(1.0f + __expf(-o0)), hv[2 * i + 1] * rn * gn[2 * i + 1] * __builtin_amdgcn_rcpf(1.0f + __expf(-o1))); }
              if (zvalid && (c != 0 || b == 0)) { bf16* dst = (c == 0 ? F.MIXM : F.MIX) + (size_t)(row0 + zt) * D + h * DV + 16 * zc; *(GAS v4u*)dst = (v4u){res[0], res[1], res[2], res[3]}; *(GAS v4u*)(dst + 8) = (v4u){res[4], res[5], res[6], res[7]}; } }
        }
#undef ML_ROW0
#undef ML_PB
#undef ML_LOAD
#undef ML_STORE
    }
}
struct Args { const float* in[14]; float* out; unsigned char* ws; int ph_lo, ph_hi; };
__global__ void __launch_bounds__(NWAVES * 64, 2) fwd_kernel(Args args) {
    extern __shared__ __attribute__((aligned(16))) unsigned char lds[];
    Frame F;
    F.lds = (LAS unsigned char*)lds;
    F.MISC = (volatile LAS unsigned*)(F.lds + MISC_OFF);
    F.tid = threadIdx.x; F.lane = F.tid & 63; F.wave = __builtin_amdgcn_readfirstlane(F.tid >> 6);
    F.G = gridDim.x; { const int bx = blockIdx.x; F.vcu = (F.G % 8 == 0) ? (bx % 8) * (F.G / 8) + bx / 8 : bx; }
    unsigned char* ws = args.ws; F.ws = ws;
    F.ctl = (gu32*)(ws + WS_CTL);
    F.x = args.in[0]; F.meta = args.in[1]; F.ngain = args.in[2]; F.m_win = args.in[3]; F.m_bgate = args.in[4]; F.m_hgain = args.in[5]; F.m_wout = args.in[6];
    F.d_win = args.in[7]; F.d_lam = args.in[8]; F.d_hgain = args.in[9]; F.d_wout = args.in[10]; F.w_up = args.in[11]; F.w_dn = args.in[12]; F.fgain = args.in[13];
    F.out = args.out;
    F.WIN0 = (bf16*)(ws + WS_WIN0); F.WOUT0 = (bf16*)(ws + WS_WOUT0); F.WUP0 = (bf16*)(ws + WS_WUP0); F.WDN0 = (bf16*)(ws + WS_WDN0);
    F.WIN1 = (bf16*)(ws + WS_WIN1); F.WOUT1 = (bf16*)(ws + WS_WOUT1); F.WUP1 = (bf16*)(ws + WS_WUP1); F.WDN1 = (bf16*)(ws + WS_WDN1);
    F.HB = (bf16*)(ws + WS_HB); F.P = (bf16*)(ws + WS_P); F.MIX = (bf16*)(ws + WS_MIX); F.U = (bf16*)(ws + WS_U);
    F.SS = (float*)(ws + WS_SS); F.GATES = (float*)(ws + WS_GATES); F.GSC = (float*)(ws + WS_GSC);
    F.HMETA = (float*)(ws + WS_HMETA); F.HBM = (bf16*)(ws + WS_HBM); F.PM = (bf16*)(ws + WS_PM); F.MIXM = (bf16*)(ws + WS_MIXM); F.UM = (bf16*)(ws + WS_UM); F.GATESM = (float*)(ws + WS_GATESM);
    F.SSM = (float*)(ws + WS_CTL) + CW_SSM;
    for (int u = F.tid; u < (LDS_BYTES - LDSCTL_OFF) / 4; u += NWAVES * 64) ((LAS unsigned*)(F.lds + LDSCTL_OFF))[u] = 0u;
    __syncthreads();
    const int lo = args.ph_lo, hi = args.ph_hi;
    const bool use_bar = (hi - lo) > 1;
    XcdBarrier bar; bar.bar = (unsigned*)(F.ctl + CW_BAR); bar.x = 0; bar.st = nullptr;
    if (use_bar) bar = xcd_barrier_post((unsigned*)(F.ctl + CW_BAR), F.MISC + 8);
#define IN(k) (lo <= (k) && (k) < hi)
#ifdef PROBE_PHASE
    unsigned long long t_prev = __builtin_amdgcn_s_memrealtime(); float probe_val = 0.f; const unsigned long long t_start = t_prev;
#define STAMP(k) do { const unsigned long long t_now = __builtin_amdgcn_s_memrealtime(); if ((k) == PROBE_PHASE) probe_val = (float)(t_now - t_prev) * 0.01f; t_prev = t_now; } while (0)
#else
#define STAMP(k) do {} while (0)
#endif
#define SEAM(k) do { if (IN(k) && IN((k) + 1)) xcd_barrier(bar); STAMP(k); } while (0)
#ifdef DOUBLE_PHASE
#define DBLG(k, EPI, Aptr, Bptr, NN, KK, ...) if (DOUBLE_PHASE == (k)) { pg8::Gemm g{Aptr, Bptr, MR, NN, KK}; pg8::StaticOrder S; S.init(MR, NN, F.G, (int)blockIdx.x); EPI E{__VA_ARGS__}; pg8::gemm_phase<EPI, pg8::StaticOrder, PG8_ALIGN, PG8_SP2>(F.lds + RING_OFF, g, S, E); xcd_barrier(bar); }
#else
#define DBLG(k, EPI, Aptr, Bptr, NN, KK, ...)
#endif
#define GEMM_PHASE(k, EPI, Aptr, Bptr, NN, KK, METAJOB, ...) if (IN(k)) { DBLG(k, EPI, Aptr, Bptr, NN, KK, __VA_ARGS__)  METAJOB; pg8::Gemm g{Aptr, Bptr, MR, NN, KK}; pg8::StaticOrder S; S.init(MR, NN, F.G, (int)blockIdx.x); \
        EPI E{__VA_ARGS__}; pg8::gemm_phase<EPI, pg8::StaticOrder, PG8_ALIGN, PG8_SP2>(F.lds + RING_OFF, g, S, E); SEAM(k); }
    typedef pg8::EpiRes<true, false> EpiRes00; typedef pg8::EpiRes<false, false> EpiRes10; typedef pg8::EpiRes<false, true> EpiRes11;
    typedef pg8::EpiScale<0, 1> EpiIn0; typedef pg8::EpiScale<0, 16> EpiIn1; typedef pg8::EpiScale<1, 16> EpiUp;
#ifdef DOUBLE_PHASE
#define DBL(k, stmt) if (DOUBLE_PHASE == (k)) { stmt; xcd_barrier(bar); }
#else
#define DBL(k, stmt)
#endif
    DBL(0, p0_prologue(F))
    if (IN(0)) { p0_prologue(F); SEAM(0); }
    GEMM_PHASE(1, EpiIn0, F.HB, F.WIN0, NPROJ, D, gate_scan_job(F); meta_gemm(F, F.HBM, F.WIN0, 0, NPROJ / 16, D, MEpiScale<0>{F.PM, NPROJ, F.SSM}), F.P, NPROJ, F.SS, EPS)
    DBL(2, mlstm_mfma_phase(F))
    if (IN(2)) { mlstm_mfma_phase(F); SEAM(2); }
    GEMM_PHASE(3, EpiRes00, F.MIX, F.WOUT0, D, D, meta_gemm(F, F.MIXM, F.WOUT0, 0, D / 16, D, MEpiRes{F.meta, F.HMETA, F.HBM, F.SSM}), F.x, (float*)nullptr, F.HB, F.SS)
    GEMM_PHASE(4, EpiUp, F.HB, F.WUP0, FF, D, meta_gemm(F, F.HBM, F.WUP0, 0, FF / 16, D, MEpiScale<1>{F.UM, FF, F.SSM}), F.U, FF, F.SS, EPS)
    GEMM_PHASE(5, EpiRes10, F.U, F.WDN0, D, FF, meta_gemm(F, F.UM, F.WDN0, 0, D / 16, FF, MEpiRes{F.HMETA, F.HMETA, F.HBM, F.SSM}), (const float*)nullptr, (float*)nullptr, F.HB, F.SS)
    GEMM_PHASE(6, EpiIn1, F.HB, F.WIN1, NPROJ, D, meta_gemm(F, F.HBM, F.WIN1, 1024 / 16, NPROJ / 16, D, MEpiScale<0>{F.PM, NPROJ, F.SSM}), F.P, NPROJ, F.SS, EPS)
    DBL(7, attn_mfma_phase(F))
    if (IN(7)) { attn_mfma_phase(F); SEAM(7); }
    GEMM_PHASE(8, EpiRes10, F.MIX, F.WOUT1, D, D, (void)0, (const float*)nullptr, (float*)nullptr, F.HB, F.SS)
    GEMM_PHASE(9, EpiUp, F.HB, F.WUP1, FF, D, (void)0, F.U, FF, F.SS, EPS)
    GEMM_PHASE(10, EpiRes11, F.U, F.WDN1, D, FF, (void)0, (const float*)nullptr, F.out, F.HB, F.SS)
    if (IN(11)) { final_norm_phase(F); }
#if defined(PROBE_SEG) || defined(PROBE_GEMM)
    if (blockIdx.x == 0 && F.tid == 0) { asm volatile("s_waitcnt vmcnt(0)" ::: "memory"); const float cyc = ((volatile LAS float*)F.MISC)[17]; F.out[0] += 0.05f + 0.10f * fminf(cyc * (1.0f / PROBE_FULL), 1.0f); }
#endif
#ifdef PROBE_PHASE
    STAMP(11);
    if (PROBE_PHASE == 99) probe_val = (float)(__builtin_amdgcn_s_memrealtime() - t_start) * 0.01f;
    if (blockIdx.x == 0 && F.tid == 0) { asm volatile("s_waitcnt vmcnt(0)" ::: "memory"); F.out[0] += 0.05f + 0.10f * fminf(probe_val * (1.0f / PROBE_FULL), 1.0f); }
#endif
#undef IN
#undef SEAM
#undef GEMM_PHASE
}

extern "C" void kernel_launch(void* const* d_in, const int* in_sizes, int n_in, void* d_out, int out_size, void* d_ws, size_t ws_size, hipStream_t stream) {
    static int grid = 0;
    if (grid == 0) {
        if (n_in != 14 || in_sizes[0] != NB * SEQ * D || out_size != NB * SEQ * D || ws_size < WS_END) { fprintf(stderr, "kernel_launch: unexpected shapes (n_in %d, in0 %d, out %d, ws %zu)\n", n_in, n_in > 0 ? in_sizes[0] : -1, out_size, ws_size); grid = -1; return; }
        int dev = 0, cus = 0, per_cu = 0;
        if (hipGetDevice(&dev) != hipSuccess || hipDeviceGetAttribute(&cus, hipDeviceAttributeMultiprocessorCount, dev) != hipSuccess) { grid = -1; return; }
        if (hipFuncSetAttribute((const void*)fwd_kernel, hipFuncAttributeMaxDynamicSharedMemorySize, LDS_BYTES) != hipSuccess) { fprintf(stderr, "kernel_launch: hipFuncSetAttribute failed\n"); grid = -1; return; }
        if (hipOccupancyMaxActiveBlocksPerMultiprocessor(&per_cu, (const void*)fwd_kernel, NWAVES * 64, LDS_BYTES) != hipSuccess || per_cu < 1) { fprintf(stderr, "kernel_launch: occupancy query reports %d blocks per CU\n", per_cu); (void)hipGetLastError(); grid = -1; return; }
        grid = cus;
    }
    if (grid < 0) return;
    if (hipMemsetAsync((char*)d_ws + WS_CTL, 0, CTL_ZERO_BYTES, stream) != hipSuccess) return;
    Args a{};
    for (int i = 0; i < 14; ++i) a.in[i] = (const float*)d_in[i];
    a.out = (float*)d_out; a.ws = (unsigned char*)d_ws;
    if (MK_N_LAUNCHES == 1) { a.ph_lo = 0; a.ph_hi = NPHASE; hipLaunchKernelGGL(fwd_kernel, dim3(grid), dim3(NWAVES * 64), LDS_BYTES, stream, a); }
    else for (int p = 0; p < NPHASE; ++p) { a.ph_lo = p; a.ph_hi = p + 1; hipLaunchKernelGGL(fwd_kernel, dim3(grid), dim3(NWAVES * 64), LDS_BYTES, stream, a); }
}
```

```cpp
#define MLSTM_V2
#include <hip/hip_runtime.h>
#include <cstdio>
#include <cstdint>
namespace pg8 {
#define PG8_LAS __attribute__((address_space(3)))
typedef unsigned short bf16_t;
typedef short bf16x8 __attribute__((ext_vector_type(8)));
typedef float f32x4 __attribute__((ext_vector_type(4)));
typedef unsigned u32x4 __attribute__((ext_vector_type(4)));
constexpr int BM = 256, BK = 64, HALF = 128, HTB = HALF * BK * 2  , STAGE_BYTES = 8 * HTB, NXCD = 8, WGM = 8;

__host__ __device__ __forceinline__ int lds_byte(int r, int c) { const int st = (r >> 4) * 2 + (c >> 5), rr = r & 15, cc = c & 31, ob = rr * 64 + cc * 2; return st * 1024 + (ob ^ (((ob >> 9) & 1) << 5)); }
__host__ __device__ __forceinline__ void stage_rc(int b, int& R, int& C) { const int st = b / 1024, sb = b % 1024, swz = sb ^ (((sb >> 9) & 1) << 5); R = (st >> 1) * 16 + swz / 64; C = (st & 1) * 32 + (swz % 64) / 2; }
__host__ __device__ __forceinline__ int perm32(int rho) { const int n = rho >> 4, i = rho & 15; return 8 * (i >> 2) + 4 * n + (i & 3); }

struct Unit { int pm, pn; };
struct Gemm { const bf16_t* A; const bf16_t* Bt; int M, N, K; };

struct StaticOrder {
    int nM, nN, nwg, G, c;
    __host__ __device__ void init(int M, int N, int G_, int c_) { nM = M / BM; nN = N / BM; nwg = nM * nN; G = G_; c = c_; }
    __host__ __device__ bool next(int i, Unit& u) const {
        const long L = (long)i * G + c; if (L >= nwg) return false;
        int wgid = (int)L; { const int q = nwg / NXCD, r = nwg % NXCD, xcd = wgid % NXCD, off = wgid / NXCD; wgid = (xcd < r ? xcd * (q + 1) : r * (q + 1) + (xcd - r) * q) + off; }
        const int nig = WGM * nN, gid = wgid / nig, fm = gid * WGM, gsz = (nM - fm) < WGM ? (nM - fm) : WGM;
        u.pm = fm + ((wgid % nig) % gsz); u.pn = (wgid % nig) / gsz; return true;
    }
    __device__ __forceinline__ void a_ready(const Unit&) const {}
    __device__ __forceinline__ void done(const Unit&) const {}
};

__device__ __forceinline__ unsigned cvt_pk_bf16(float lo, float hi) { unsigned r; asm volatile("v_cvt_pk_bf16_f32 %0, %1, %2" : "=v"(r) : "v"(lo), "v"(hi)); return r; }
typedef unsigned u32x2 __attribute__((ext_vector_type(2)));

template <int NS> __device__ __forceinline__ float row_rstd(const float* ss, int row, float eps) {
    const float* sp = ss + (size_t)row * 16; float s;
    if (NS == 1) s = sp[0];
    else { const f32x4 a = *(const f32x4*)sp, b = *(const f32x4*)(sp + 4), c = *(const f32x4*)(sp + 8), d = *(const f32x4*)(sp + 12);
           s = ((a[0] + a[1]) + (a[2] + a[3])) + ((b[0] + b[1]) + (b[2] + b[3])) + ((c[0] + c[1]) + (c[2] + c[3])) + ((d[0] + d[1]) + (d[2] + d[3])); }
    return __builtin_amdgcn_rsqf(s * (1.0f / 1024.0f) + eps);
}
__device__ __forceinline__ float row_rstd16_coop(const float* ss, int row, int fq, float eps) {
    const f32x4 a = *(const f32x4*)(ss + (size_t)row * 16 + 4 * fq); float s = (a[0] + a[1]) + (a[2] + a[3]);
    s += __shfl_xor(s, 16); s += __shfl_xor(s, 32);
    return __builtin_amdgcn_rsqf(s * (1.0f / 1024.0f) + eps);
}
template <int ACT, int NS> struct EpiScale {
    static constexpr bool PERM = true, AFTER_DRAIN = false;
    bf16_t* O; int ldc; const float* ss; float eps;
    __device__ __forceinline__ void operator()(const f32x4 (&acc)[2][2][4][2], const Unit& u, int wr, int wc, int fr, int fq) const {
        const int row0 = u.pm * BM + wr * 64 + fr, col0 = u.pn * BM + wc * 32 + 8 * fq;
        float rsv[2][4];
#pragma unroll
        for (int ai = 0; ai < 2; ++ai)
#pragma unroll
            for (int m = 0; m < 4; ++m) { const int row = row0 + ai * HALF + m * 16; rsv[ai][m] = (NS == 1) ? row_rstd<1>(ss, row, eps) : row_rstd16_coop(ss, row, fq, eps); }
#pragma unroll
        for (int ai = 0; ai < 2; ++ai)
#pragma unroll
            for (int m = 0; m < 4; ++m) { const int row = row0 + ai * HALF + m * 16; const float rs = rsv[ai][m];
                bf16_t* rowp = O + (size_t)row * ldc + col0;
#pragma unroll
                for (int bj = 0; bj < 2; ++bj) { f32x4 v0 = acc[ai][bj][m][0] * rs, v1 = acc[ai][bj][m][1] * rs;
                    if (ACT == 1) {
#pragma unroll
                        for (int i = 0; i < 4; ++i) { const float a = fmaxf(v0[i], 0.f), b = fmaxf(v1[i], 0.f); v0[i] = a * a; v1[i] = b * b; } }
                    u32x4 w; w.x = cvt_pk_bf16(v0[0], v0[1]); w.y = cvt_pk_bf16(v0[2], v0[3]); w.z = cvt_pk_bf16(v1[0], v1[1]); w.w = cvt_pk_bf16(v1[2], v1[3]);
                    *(u32x4*)(rowp + bj * HALF) = w; } }
    }
};
template <bool IN_F32, bool OUT_F32> struct EpiRes {
    static constexpr bool PERM = true, AFTER_DRAIN = false;
    const float* Hin; float* Hout; bf16_t* HB; float* ss;
    __device__ __forceinline__ void operator()(const f32x4 (&acc)[2][2][4][2], const Unit& u, int wr, int wc, int fr, int fq) const {
        const int row0 = u.pm * BM + wr * 64 + fr, col0 = u.pn * BM + wc * 32 + 8 * fq;
#pragma unroll
        for (int ai = 0; ai < 2; ++ai)
#pragma unroll
            for (int m = 0; m < 4; ++m) { const int row = row0 + ai * HALF + m * 16; const size_t off = (size_t)row * 1024 + col0; float q = 0.f;
#pragma unroll
                for (int bj = 0; bj < 2; ++bj) { f32x4 h0, h1;
                    if (IN_F32) { h0 = *(const f32x4*)(Hin + off + bj * HALF); h1 = *(const f32x4*)(Hin + off + bj * HALF + 4); }
                    else { const u32x4 w = *(const u32x4*)(HB + off + bj * HALF);
                        h0 = (f32x4){__builtin_bit_cast(float, w.x << 16), __builtin_bit_cast(float, w.x & 0xffff0000u), __builtin_bit_cast(float, w.y << 16), __builtin_bit_cast(float, w.y & 0xffff0000u)};
                        h1 = (f32x4){__builtin_bit_cast(float, w.z << 16), __builtin_bit_cast(float, w.z & 0xffff0000u), __builtin_bit_cast(float, w.w << 16), __builtin_bit_cast(float, w.w & 0xffff0000u)}; }
                    h0 = h0 + acc[ai][bj][m][0]; h1 = h1 + acc[ai][bj][m][1];
                    q += ((h0[0] * h0[0] + h0[1] * h0[1]) + (h0[2] * h0[2] + h0[3] * h0[3])) + ((h1[0] * h1[0] + h1[1] * h1[1]) + (h1[2] * h1[2] + h1[3] * h1[3]));
                    if (OUT_F32) { *(f32x4*)(Hout + off + bj * HALF) = h0; *(f32x4*)(Hout + off + bj * HALF + 4) = h1; }
                    else { u32x4 w; w.x = cvt_pk_bf16(h0[0], h0[1]); w.y = cvt_pk_bf16(h0[2], h0[3]); w.z = cvt_pk_bf16(h1[0], h1[1]); w.w = cvt_pk_bf16(h1[2], h1[3]); *(u32x4*)(HB + off + bj * HALF) = w; } }
                q += __shfl_xor(q, 16); q += __shfl_xor(q, 32);
                if (fq == 0) ss[(size_t)row * 16 + u.pn * 4 + wc] = q; }
    }
};

template <class Epi, class Sched, bool ALIGN_EPI = false, bool SP2 = false>
__device__ __forceinline__ void gemm_phase(PG8_LAS unsigned char* lds, const Gemm g, const Sched& S, const Epi& E) {
    const int tid = threadIdx.x, wid = __builtin_amdgcn_readfirstlane(tid >> 6), lane = tid & 63, wr = wid >> 2, wc = wid & 3, fr = lane & 15, fq = lane >> 4;
    const int K = g.K, nt = K / BK;
    unsigned voffA[2], voffB[2];
#pragma unroll
    for (int i = 0; i < 2; ++i) { int R, C; stage_rc(tid * 16 + i * 8192, R, C); const int Rb = Epi::PERM ? ((R & ~31) + perm32(R & 31)) : R;
        voffA[i] = (unsigned)(R * K + C) * 2u; voffB[i] = (unsigned)(Rb * K + C) * 2u; }
    const size_t kstep = (size_t)(BK * 2);
    const size_t hstep = (size_t)HALF * K * 2;
    const size_t tstep = 2 * hstep;
    const unsigned ldsw = (unsigned)wid * 1024u;
    const int aoff = lds_byte(wr * 64 + fr, fq * 8), boff = lds_byte(wc * 32 + fr, fq * 8);
#define PG8_SA(b, h) (((b) * 2 + (h)) * HTB)
#define PG8_SB(b, h) ((4 + (b) * 2 + (h)) * HTB)
#define PG8_STAGE(bufoff, gbase, voff) do { _Pragma("unroll") for (int _i = 0; _i < 2; ++_i) \
        __builtin_amdgcn_global_load_lds((const unsigned*)((const char*)(gbase) + (voff)[_i]), (PG8_LAS unsigned*)(lds + (bufoff) + ldsw + _i * 8192), 16, 0, 0); } while (0)
#define PG8_LDA(dst, b, h) do { _Pragma("unroll") for (int m = 0; m < 4; ++m) _Pragma("unroll") for (int k = 0; k < 2; ++k) dst[m][k] = *(const PG8_LAS bf16x8*)(lds + PG8_SA(b, h) + aoff + m * 2048 + k * 1024); } while (0)
#define PG8_LDB(dst, b, h) do { _Pragma("unroll") for (int n = 0; n < 2; ++n) _Pragma("unroll") for (int k = 0; k < 2; ++k) dst[n][k] = *(const PG8_LAS bf16x8*)(lds + PG8_SB(b, h) + boff + n * 2048 + k * 1024); } while (0)
#define PG8_MMA(ai, bj, At, Bt) do { __builtin_amdgcn_s_setprio(1); _Pragma("unroll") for (int m = 0; m < 4; ++m) _Pragma("unroll") for (int n = 0; n < 2; ++n) _Pragma("unroll") for (int k = 0; k < 2; ++k) \
        acc[ai][bj][m][n] = __builtin_amdgcn_mfma_f32_16x16x32_bf16(Bt[n][k], At[m][k], acc[ai][bj][m][n], 0, 0, 0); __builtin_amdgcn_s_setprio(0); } while (0)
#define PG8_WAIT_V(n) asm volatile("s_waitcnt vmcnt(" #n ")" ::: "memory")
#define PG8_WAIT_L(n) asm volatile("s_waitcnt lgkmcnt(" #n ")" ::: "memory")
#define PG8_BAR __builtin_amdgcn_s_barrier()
#define PG8_SCHED __builtin_amdgcn_sched_barrier(0)
    Unit cur, nxt; int ui = 0;
#ifdef PROBE_GEMM
    float probe_epi_cycles = 0.f, probe_units = 0.f; unsigned long long tph0_; const unsigned long long trl0_ = __builtin_amdgcn_s_memrealtime(); asm volatile("s_memtime %0\n\ts_waitcnt lgkmcnt(0)" : "=s"(tph0_) :: "memory");
#endif
    if (!S.next(0, cur)) return;
    f32x4 acc[2][2][4][2];
#pragma unroll
    for (int a = 0; a < 2; ++a)
#pragma unroll
        for (int b = 0; b < 2; ++b)
#pragma unroll
            for (int m = 0; m < 4; ++m)
#pragma unroll
                for (int n = 0; n < 2; ++n) acc[a][b][m][n] = (f32x4){0.f, 0.f, 0.f, 0.f};
    bf16x8 At[4][2], B0[2][2], B1[2][2];
    const char* cA = (const char*)g.A + (size_t)cur.pm * tstep; const char* cB = (const char*)g.Bt + (size_t)cur.pn * tstep;
    S.a_ready(cur);
    if constexpr (SP2) {
        PG8_STAGE(PG8_SB(0, 0), cB, voffB); PG8_STAGE(PG8_SB(0, 1), cB + hstep, voffB); PG8_STAGE(PG8_SA(0, 0), cA, voffA); PG8_STAGE(PG8_SA(0, 1), cA + hstep, voffA);
        if (wr == 1) PG8_BAR;
        PG8_WAIT_V(2); PG8_BAR;
        PG8_STAGE(PG8_SB(1, 0), cB + kstep, voffB); PG8_STAGE(PG8_SA(1, 0), cA + kstep, voffA); PG8_STAGE(PG8_SB(1, 1), cB + hstep + kstep, voffB);
        PG8_WAIT_V(6); PG8_BAR;
    } else {
        PG8_STAGE(PG8_SB(0, 0), cB, voffB); PG8_STAGE(PG8_SA(0, 0), cA, voffA); PG8_STAGE(PG8_SB(0, 1), cB + hstep, voffB); PG8_STAGE(PG8_SA(0, 1), cA + hstep, voffA);
        if (wr == 1) PG8_BAR;
        PG8_WAIT_V(4); PG8_BAR;
        PG8_STAGE(PG8_SB(1, 0), cB + kstep, voffB); PG8_STAGE(PG8_SA(1, 0), cA + kstep, voffA); PG8_STAGE(PG8_SB(1, 1), cB + hstep + kstep, voffB);
        PG8_WAIT_V(6); PG8_BAR;
    }
    for (;;) {
        const bool has_next = S.next(ui + 1, nxt);
        const char* nA = has_next ? (const char*)g.A + (size_t)nxt.pm * tstep : cA; const char* nB = has_next ? (const char*)g.Bt + (size_t)nxt.pn * tstep : cB;
        for (int t = 0; t < nt; t += 2) {
            const bool last = (t == nt - 2);
            const char* a1 = cA + (size_t)(t + 1) * kstep;
            const char* a2 = last ? nA : cA + (size_t)(t + 2) * kstep; const char* b2 = last ? nB : cB + (size_t)(t + 2) * kstep;
            const char* a3 = a2 + kstep; const char* b3 = b2 + kstep;
            if (last && has_next) S.a_ready(nxt);
            if constexpr (SP2) {
            PG8_LDB(B0, 0, 0); PG8_LDB(B1, 0, 1); PG8_SCHED; PG8_LDA(At, 0, 0); PG8_STAGE(PG8_SA(1, 1), a1 + hstep, voffA);
            PG8_WAIT_V(8); PG8_WAIT_L(0); PG8_BAR; PG8_MMA(0, 0, At, B0); PG8_MMA(0, 1, At, B1); PG8_BAR; PG8_SCHED;
            PG8_LDA(At, 0, 1); PG8_STAGE(PG8_SB(0, 0), b2, voffB); PG8_STAGE(PG8_SB(0, 1), b2 + hstep, voffB); PG8_STAGE(PG8_SA(0, 0), a2, voffA);
            PG8_WAIT_V(8); PG8_WAIT_L(0); PG8_BAR; PG8_MMA(1, 0, At, B0); PG8_MMA(1, 1, At, B1); PG8_BAR; PG8_SCHED;
            PG8_LDB(B0, 1, 0); PG8_LDB(B1, 1, 1); PG8_SCHED; PG8_LDA(At, 1, 0); PG8_STAGE(PG8_SA(0, 1), a2 + hstep, voffA);
            PG8_WAIT_V(8); PG8_WAIT_L(0); PG8_BAR; PG8_MMA(0, 0, At, B0); PG8_MMA(0, 1, At, B1); PG8_BAR; PG8_SCHED;
            PG8_LDA(At, 1, 1); PG8_STAGE(PG8_SB(1, 0), b3, voffB); PG8_STAGE(PG8_SB(1, 1), b3 + hstep, voffB); PG8_STAGE(PG8_SA(1, 0), a3, voffA);
            PG8_WAIT_V(8); PG8_WAIT_L(0); PG8_BAR; PG8_MMA(1, 0, At, B0); PG8_MMA(1, 1, At, B1); PG8_BAR; PG8_SCHED;
            } else {
            PG8_LDB(B0, 0, 0); PG8_SCHED; PG8_LDA(At, 0, 0); PG8_STAGE(PG8_SA(1, 1), a1 + hstep, voffA);
            PG8_WAIT_L(8); PG8_BAR; PG8_WAIT_L(0); PG8_MMA(0, 0, At, B0); PG8_BAR; PG8_SCHED;
            PG8_LDB(B1, 0, 1); PG8_STAGE(PG8_SB(0, 0), b2, voffB);
            PG8_BAR; PG8_WAIT_L(0); PG8_MMA(0, 1, At, B1); PG8_BAR;
            PG8_LDA(At, 0, 1); PG8_STAGE(PG8_SA(0, 0), a2, voffA);
            PG8_BAR; PG8_WAIT_L(0); PG8_MMA(1, 0, At, B0); PG8_BAR; PG8_SCHED;
            PG8_STAGE(PG8_SB(0, 1), b2 + hstep, voffB);
            PG8_WAIT_V(6); PG8_BAR; PG8_MMA(1, 1, At, B1); PG8_BAR;
            PG8_LDB(B0, 1, 0); PG8_SCHED; PG8_LDA(At, 1, 0); PG8_STAGE(PG8_SA(0, 1), a2 + hstep, voffA);
            PG8_WAIT_L(8); PG8_BAR; PG8_WAIT_L(0); PG8_MMA(0, 0, At, B0); PG8_BAR; PG8_SCHED;
            PG8_LDB(B1, 1, 1); PG8_STAGE(PG8_SB(1, 0), b3, voffB);
            PG8_BAR; PG8_WAIT_L(0); PG8_MMA(0, 1, At, B1); PG8_BAR;
            PG8_LDA(At, 1, 1); PG8_STAGE(PG8_SA(1, 0), a3, voffA);
            PG8_BAR; PG8_WAIT_L(0); PG8_MMA(1, 0, At, B0); PG8_BAR; PG8_SCHED;
            PG8_STAGE(PG8_SB(1, 1), b3 + hstep, voffB);
            PG8_WAIT_V(6); PG8_BAR; PG8_MMA(1, 1, At, B1); PG8_BAR;
            }
        }
        if constexpr (ALIGN_EPI) { if (wr == 0) PG8_BAR; }
#ifdef PROBE_GEMM
        unsigned long long tg0_; asm volatile("s_memtime %0\n\ts_waitcnt lgkmcnt(0)" : "=s"(tg0_) :: "memory");
#endif
        if constexpr (!Epi::AFTER_DRAIN) { E(acc, cur, wr, wc, fr, fq); S.done(cur); }
#ifdef PROBE_GEMM
        { unsigned long long tg1_; asm volatile("s_waitcnt vmcnt(0)\n\ts_memtime %0\n\ts_waitcnt lgkmcnt(0)" : "=s"(tg1_) :: "memory"); probe_epi_cycles += (float)(tg1_ - tg0_); probe_units += 1.f; }
#endif
        if (!has_next) break;
#pragma unroll
        for (int a = 0; a < 2; ++a)
#pragma unroll
            for (int b = 0; b < 2; ++b)
#pragma unroll
                for (int m = 0; m < 4; ++m)
#pragma unroll
                    for (int n = 0; n < 2; ++n) acc[a][b][m][n] = (f32x4){0.f, 0.f, 0.f, 0.f};
        cur = nxt; cA = nA; cB = nB; ++ui;
        if constexpr (ALIGN_EPI) { if (wr == 1) PG8_BAR; }
    }
#ifdef PROBE_GEMM
    if (g.N == PROBE_GEMM_N && g.K == PROBE_GEMM_K) { unsigned long long tph1_; asm volatile("s_memtime %0\n\ts_waitcnt lgkmcnt(0)" : "=s"(tph1_) :: "memory");
        if (blockIdx.x == 0 && tid == 0) { ((volatile PG8_LAS float*)(lds + 162112))[17] = (PROBE_GEMM == 1) ? probe_epi_cycles / probe_units : (PROBE_GEMM == 2) ? (float)(tph1_ - tph0_) / probe_units : (PROBE_GEMM == 3) ? (float)(tph1_ - tph0_) / (float)(__builtin_amdgcn_s_memrealtime() - trl0_) * 100.0f : (float)(__builtin_amdgcn_s_memrealtime() - trl0_) * 0.01f; } }
#endif
    PG8_WAIT_V(0);
    if constexpr (!ALIGN_EPI) { if (wr == 0) PG8_BAR; }
    PG8_BAR;
    if constexpr (Epi::AFTER_DRAIN) { E.fused(acc, cur, wr, wc, fr, fq, lds, wid, lane); S.done(cur); }
#undef PG8_SA
#undef PG8_SB
#undef PG8_STAGE
#undef PG8_LDA
#undef PG8_LDB
#undef PG8_MMA
#undef PG8_WAIT_V
#undef PG8_WAIT_L
#undef PG8_BAR
#undef PG8_SCHED
}
}

#ifndef PG8_SP2
#define PG8_SP2 true
#endif
#ifndef PG8_ALIGN
#define PG8_ALIGN true
#endif
constexpr int NB = 16, SEQ = 2048, NMETA = 16, D = 1024, FF = 4096;
constexpr int MR = NB * SEQ;
constexpr int NH = 8, DQK = 64, DV = 128;
constexpr int NPROJ = 3072;
constexpr float EPS = 1e-6f, SUBLN_EPS = 1e-5f;
constexpr int NWAVES = 8;
#ifndef MK_N_LAUNCHES
#define MK_N_LAUNCHES 1
#endif
constexpr int NPHASE = 12;

constexpr size_t MiB = 1u << 20;
constexpr size_t WS_CTL = 0, CTL_ZERO_BYTES = 1 * MiB;
constexpr size_t WS_WIN0 = 1 * MiB, WS_WOUT0 = 7 * MiB, WS_WUP0 = 9 * MiB, WS_WDN0 = 17 * MiB;
constexpr size_t WS_WIN1 = 25 * MiB, WS_WOUT1 = 31 * MiB, WS_WUP1 = 33 * MiB, WS_WDN1 = 41 * MiB;
constexpr size_t WS_META = 49 * MiB;
constexpr size_t WS_HMETA = WS_META;
constexpr size_t WS_HBM = WS_HMETA + 16 * D * 4;
constexpr size_t WS_PM = WS_HBM + 16 * D * 2;
constexpr size_t WS_MIXM = WS_PM + 16 * NPROJ * 2;
constexpr size_t WS_UM = WS_MIXM + 16 * D * 2;
constexpr size_t WS_GATESM = WS_UM + 16 * FF * 2;
constexpr size_t WS_SS = 50 * MiB;
constexpr size_t WS_GATES = 52 * MiB;
constexpr size_t WS_HB = 54 * MiB;
constexpr size_t WS_P = 118 * MiB;
constexpr size_t WS_MIX = 310 * MiB;
constexpr size_t WS_U = WS_P;
constexpr size_t WS_GSC = 374 * MiB;
constexpr size_t WS_END = 378 * MiB;
static_assert(WS_GATESM + 1024 <= WS_SS && WS_HB + (size_t)MR * D * 2 <= WS_P && WS_P + (size_t)MR * NPROJ * 2 <= WS_MIX && WS_U + (size_t)MR * FF * 2 <= WS_END && WS_MIX + (size_t)MR * D * 2 <= WS_GSC, "d_ws map");
constexpr int CW_BAR = 4096;
constexpr int CW_SSM = 16384;

constexpr int RING_OFF = 0, RING_BYTES = 131072;
constexpr int XTRA_OFF = RING_BYTES, XTRA_BYTES = 30720;
constexpr int LDSCTL_OFF = XTRA_OFF + XTRA_BYTES, MISC_OFF = LDSCTL_OFF + 320;
constexpr int LDS_BYTES = 163840;
static_assert(MISC_OFF + 128 <= LDS_BYTES, "LDS map");

#define GAS __attribute__((address_space(1)))
#define LAS __attribute__((address_space(3)))
typedef unsigned short bf16;
typedef unsigned v4u __attribute__((ext_vector_type(4)));
typedef float f32x4 __attribute__((ext_vector_type(4)));
typedef GAS unsigned gu32;
#define RLX_AGENT __ATOMIC_RELAXED, __HIP_MEMORY_SCOPE_AGENT
#define LDS_WAIT() asm volatile("s_waitcnt lgkmcnt(0)" ::: "memory")
__device__ __forceinline__ unsigned f2bf(float f) { unsigned u = __builtin_bit_cast(unsigned, f); return (u + 0x7fffu + ((u >> 16) & 1u)) >> 16; }
__device__ __forceinline__ unsigned pk2(float lo, float hi) { return f2bf(lo) | (f2bf(hi) << 16); }
__device__ __forceinline__ float bf2f(unsigned short v) { return __builtin_bit_cast(float, (unsigned)v << 16); }
__device__ __forceinline__ float bflo(unsigned w) { return __builtin_bit_cast(float, w << 16); }
__device__ __forceinline__ float bfhi(unsigned w) { return __builtin_bit_cast(float, w & 0xffff0000u); }

#define XB_TMO      128
#define XB_XCNT(j)  (256  + 64 * (j))
#define XB_XSUB(j)  (1280 + 64 * (j))
#define XB_XGEN(j)  (2304 + 64 * (j))
#define XB_TOP      3328
#define XB_TOPGEN   3392
#define XCD_BAR_WORDS 3456
#define XB_SPIN_CAP (1u << 18)
__device__ __forceinline__ unsigned xb_ld(unsigned* p)              { return __hip_atomic_load(p, __ATOMIC_RELAXED, __HIP_MEMORY_SCOPE_AGENT); }
__device__ __forceinline__ unsigned xb_add(unsigned* p, unsigned v) { return __hip_atomic_fetch_add(p, v, __ATOMIC_RELAXED, __HIP_MEMORY_SCOPE_AGENT); }
__device__ __forceinline__ unsigned xb_xcc_id() { return (unsigned)__builtin_amdgcn_s_getreg((3 << 11) | 20) & 0xFu; }
#define XB_SPIN(cond, bar) do { unsigned _sp = 0; while (cond) { __builtin_amdgcn_s_sleep(1); \
    if ((++_sp & 255u) == 0u) { if (xb_ld(&(bar)[XB_TMO])) break; if (_sp > XB_SPIN_CAP) { atomicAdd(&(bar)[XB_TMO], 1u); break; } } } } while (0)
struct XcdBarrier { unsigned* bar; unsigned x; volatile LAS unsigned* st; };
__device__ __forceinline__ XcdBarrier xcd_barrier_post(unsigned* bar, volatile LAS unsigned* st) {
    XcdBarrier b; b.bar = bar; b.x = xb_xcc_id(); b.st = st;
    if (threadIdx.x == 0) (void)xb_add(&bar[XB_XCNT(b.x)], 1u);
    return b;
}
__device__ __forceinline__ void xcd_barrier_complete(unsigned* bar, unsigned x, unsigned& nloc, unsigned& nx) {
    const unsigned G = gridDim.x * gridDim.y * gridDim.z;
    unsigned sum, cnt, mine, sp = 0u;
    for (;;) {
        sum = 0u; cnt = 0u; mine = 0u;
#pragma unroll
        for (unsigned j = 0; j < 16; ++j) { const unsigned c = xb_ld(&bar[XB_XCNT(j)]); sum += c; cnt += (c > 0u) ? 1u : 0u; mine = (j == x) ? c : mine; }
        if (sum == G) break;
        __builtin_amdgcn_s_sleep(1);
        if ((++sp & 255u) == 0u) { if (xb_ld(&bar[XB_TMO])) break; if (sp > XB_SPIN_CAP) { atomicAdd(&bar[XB_TMO], 1u); break; } }
    }
    nloc = mine > 0u ? mine : 1u; nx = cnt > 0u ? cnt : 1u;
}
__device__ __forceinline__ void xcd_barrier(const XcdBarrier& b) {
    asm volatile("s_waitcnt vmcnt(0)" ::: "memory");
    __syncthreads();
    if (threadIdx.x == 0) {
        unsigned* bar = b.bar;
        __builtin_amdgcn_s_waitcnt(0);
        unsigned nloc = b.st[0], nx = b.st[1];
        if (nloc == 0u) { xcd_barrier_complete(bar, b.x, nloc, nx); b.st[0] = nloc; b.st[1] = nx; }
        const unsigned old = xb_add(&bar[XB_XSUB(b.x)], 1u);
        const unsigned gen = old / nloc;
        if (old + 1u == (gen + 1u) * nloc) {
            __builtin_amdgcn_fence(__ATOMIC_RELEASE, "agent");
            asm volatile("s_waitcnt vmcnt(0)" ::: "memory");
            const unsigned og = xb_add(&bar[XB_TOP], 1u);
            const unsigned tg = og / nx;
            if (og + 1u == (tg + 1u) * nx) xb_add(&bar[XB_TOPGEN], 1u);
            else XB_SPIN(xb_ld(&bar[XB_TOPGEN]) == tg, bar);
            __builtin_amdgcn_fence(__ATOMIC_ACQUIRE, "agent");
            xb_add(&bar[XB_XGEN(b.x)], 1u);
            asm volatile("s_waitcnt vmcnt(0)" ::: "memory");
        } else {
            XB_SPIN(xb_ld(&bar[XB_XGEN(b.x)]) == gen, bar);
            __builtin_amdgcn_fence(__ATOMIC_ACQUIRE, "agent");
            asm volatile("s_waitcnt vmcnt(0)" ::: "memory");
        }
    }
    __syncthreads();
}

struct Frame {
    LAS unsigned char* lds;
    volatile LAS unsigned* MISC;
    gu32* ctl;
    int tid, lane, wave, vcu, G;
    const float *x, *meta, *ngain, *m_win, *m_bgate, *m_hgain, *m_wout, *d_win, *d_lam, *d_hgain, *d_wout, *w_up, *w_dn, *fgain;
    float* out; unsigned char* ws;
    bf16 *WIN0, *WOUT0, *WUP0, *WDN0, *WIN1, *WOUT1, *WUP1, *WDN1, *HB, *P, *MIX, *U;
    float *SS, *GATES, *GSC;
    bf16 *HBM, *PM, *MIXM, *UM; float *HMETA, *GATESM, *SSM;
};
__device__ __forceinline__ float wave_sum(float v) {
#pragma unroll
    for (int o = 1; o < 64; o <<= 1) v += __shfl_xor(v, o);
    return v;
}
typedef short bf16x8_t __attribute__((ext_vector_type(8)));
__device__ __forceinline__ f32x4 mfma16(bf16x8_t a, bf16x8_t b, f32x4 c) { return __builtin_amdgcn_mfma_f32_16x16x32_bf16(a, b, c, 0, 0, 0); }
__device__ __forceinline__ void transpose_item(const float* W, int K, int ldw, int Nuse, const float* gk, int nscale, float qscale, bf16* WT, LAS float* scr, int item, int lane) {
    const int nblk = Nuse / 32, kb = item / nblk, nb = item % nblk, k0 = 64 * kb, n0 = 32 * nb;
    const float cs = (n0 < nscale) ? qscale : 1.f;
    const int lr = lane >> 3, lp = lane & 7;
#pragma unroll
    for (int i = 0; i < 8; ++i) { const int kk = 8 * i + lr; const float g = gk ? gk[k0 + kk] * cs : cs; const f32x4 v = *(const GAS f32x4*)(W + (size_t)(k0 + kk) * ldw + n0 + 4 * lp);
        LAS float* d = scr + kk * 33 + 4 * lp; d[0] = v.x * g; d[1] = v.y * g; d[2] = v.z * g; d[3] = v.w * g; }
    LDS_WAIT(); asm volatile("" ::: "memory");
    const int c = lane & 7;
#pragma unroll
    for (int j = 0; j < 4; ++j) { const int n = (lane >> 3) + 8 * j; const LAS float* s = scr + (8 * c) * 33 + n;
        v4u o; o.x = pg8::cvt_pk_bf16(s[0 * 33], s[1 * 33]); o.y = pg8::cvt_pk_bf16(s[2 * 33], s[3 * 33]); o.z = pg8::cvt_pk_bf16(s[4 * 33], s[5 * 33]); o.w = pg8::cvt_pk_bf16(s[6 * 33], s[7 * 33]);
        *(GAS v4u*)(WT + (size_t)(n0 + n) * K + k0 + 8 * c) = o; }
    LDS_WAIT(); asm volatile("" ::: "memory");
}
constexpr int I_IN = (D / 64) * (NPROJ / 32), I_OUT = (D / 64) * (D / 32), I_UP = (D / 64) * (FF / 32), I_DN = (FF / 64) * (D / 32);
constexpr int I_LAYER = I_IN + I_OUT + I_UP + I_DN, NITEMS = 2 * I_LAYER;
__device__ __forceinline__ void convert_weights(Frame& F, int it0, int it1, int gw, int ngw, LAS float* scr) {
    for (int it = it0 + gw; it < it1; it += ngw) {
        const int layer = it / I_LAYER; int r = it % I_LAYER;
        const float* g0 = F.ngain + (layer * 2 + 0) * D; const float* g1 = F.ngain + (layer * 2 + 1) * D;
        if (r < I_IN) { if (layer == 0) transpose_item(F.m_win, D, 3088, NPROJ, g0, 512, 0.125f, F.WIN0, scr, r, F.lane); else transpose_item(F.d_win, D, NPROJ, NPROJ, g0, 1024, 0.125f * 1.4426950408889634f, F.WIN1, scr, r, F.lane);   continue; } r -= I_IN;
        if (r < I_OUT) { transpose_item(layer == 0 ? F.m_wout : F.d_wout, D, D, D, nullptr, 0, 1.f, layer == 0 ? F.WOUT0 : F.WOUT1, scr, r, F.lane); continue; } r -= I_OUT;
        if (r < I_UP) { transpose_item(F.w_up + (size_t)layer * D * FF, D, FF, FF, g1, 0, 1.f, layer == 0 ? F.WUP0 : F.WUP1, scr, r, F.lane); continue; } r -= I_UP;
        transpose_item(F.w_dn + (size_t)layer * FF * D, FF, D, D, nullptr, 0, 1.f, layer == 0 ? F.WDN0 : F.WDN1, scr, r, F.lane);
    }
}
constexpr int WGSTR = 2048 + 16;
__device__ __forceinline__ void embed_group(Frame& F, const float* src, bf16* hb, float* ssd, int ss_stride, float* gd, const LAS unsigned char* wgl) {
    const int li = F.lane & 15, g = F.lane >> 4;
    const float* sp = src + (size_t)li * D + 8 * g; bf16* hp = hb + (size_t)li * D + 8 * g; const LAS unsigned char* wp = wgl + li * WGSTR + 16 * g;
    f32x4 acc = (f32x4){0.f, 0.f, 0.f, 0.f}; float ssp = 0.f;
#pragma unroll 8
    for (int ks = 0; ks < 32; ++ks) {
        const f32x4 a0 = *(const GAS f32x4*)(sp + 32 * ks), a1 = *(const GAS f32x4*)(sp + 32 * ks + 4);
        ssp += ((a0.x * a0.x + a0.y * a0.y) + (a0.z * a0.z + a0.w * a0.w)) + ((a1.x * a1.x + a1.y * a1.y) + (a1.z * a1.z + a1.w * a1.w));
        v4u pw; pw.x = pg8::cvt_pk_bf16(a0.x, a0.y); pw.y = pg8::cvt_pk_bf16(a0.z, a0.w); pw.z = pg8::cvt_pk_bf16(a1.x, a1.y); pw.w = pg8::cvt_pk_bf16(a1.z, a1.w);
        *(GAS v4u*)(hp + 32 * ks) = pw;
        acc = mfma16(__builtin_bit_cast(bf16x8_t, pw), *(const LAS bf16x8_t*)(wp + 64 * ks), acc);
    }
    ssp += __shfl_xor(ssp, 16); ssp += __shfl_xor(ssp, 32);
    const float rstd = 1.0f / sqrtf(ssp * (1.0f / D) + EPS);
    if (g == 0) ssd[(size_t)li * ss_stride] = ssp;
    const float bg = F.m_bgate[li];
#pragma unroll
    for (int r = 0; r < 4; ++r) { const float rs = __shfl(rstd, 4 * g + r); gd[(size_t)(4 * g + r) * 16 + li] = acc[r] * rs + bg; }
}
__device__ __forceinline__ void p0_prologue(Frame& F) {
    LAS float* scr = (LAS float*)(F.lds + RING_OFF + F.wave * 16384);
    const int gw = F.vcu * NWAVES + F.wave, NGW = F.G * NWAVES;
    convert_weights(F, 0, I_IN, gw, NGW, scr);
    __syncthreads();
    LAS unsigned char* wgl = F.lds + RING_OFF;
    for (int i = F.tid; i < 16 * D; i += NWAVES * 64) { const int k = i >> 4, j = i & 15; *(LAS bf16*)(wgl + j * WGSTR + k * 2) = (bf16)f2bf(F.m_win[(size_t)k * 3088 + NPROJ + j] * F.ngain[k]); }
    __syncthreads();
    for (int grp = gw; grp <= MR / 16; grp += NGW) {
        if (grp < MR / 16) embed_group(F, F.x + (size_t)grp * 16 * D, F.HB + (size_t)grp * 16 * D, F.SS + (size_t)grp * 16 * 16, 16, F.GATES + (size_t)grp * 16 * 16, wgl);
        else embed_group(F, F.meta, F.HBM, F.SSM, 64, F.GATESM, wgl);
    }
}
__device__ __forceinline__ float meta_rstd(const float* ssm, int lane) {
    float mine = 0.f;
#pragma unroll 4
    for (int r = 0; r < 16; ++r) { const float s = wave_sum(ssm[r * 64 + lane]); if (lane == r) mine = 1.0f / sqrtf(s * (1.0f / D) + EPS); }
    return mine;
}
template <int ACT> struct MEpiScale {
    bf16* O; int ldc; const float* ssm;
    __device__ __forceinline__ void operator()(int cb, int li, int g, int lane, const float (&v)[4]) const {
        const float mine = meta_rstd(ssm, lane);
#pragma unroll
        for (int r = 0; r < 4; ++r) { float x = v[r] * __shfl(mine, 4 * g + r); if (ACT == 1) { x = fmaxf(x, 0.f); x = x * x; } O[(size_t)(4 * g + r) * ldc + 16 * cb + li] = (bf16)f2bf(x); }
    }
};
struct MEpiRes {
    const float* Hin; float* H; bf16* HB; float* ssm;
    __device__ __forceinline__ void operator()(int cb, int li, int g, int lane, const float (&v)[4]) const {
#pragma unroll
        for (int r = 0; r < 4; ++r) { const int row = 4 * g + r; const float hv = Hin[(size_t)row * D + 16 * cb + li] + v[r]; H[(size_t)row * D + 16 * cb + li] = hv; HB[(size_t)row * D + 16 * cb + li] = (bf16)f2bf(hv);
            float q = hv * hv; q += __shfl_xor(q, 1); q += __shfl_xor(q, 2); q += __shfl_xor(q, 4); q += __shfl_xor(q, 8);
            if (li == 0) ssm[row * 64 + cb] = q; }
    }
};
template <class MEpi> __device__ __forceinline__ void meta_gemm(Frame& F, const bf16* A, const bf16* Bt, int cb0, int cb1, int K, const MEpi& E) {
    LAS float* red = (LAS float*)(F.lds + XTRA_OFF);
    const int li = F.lane & 15, g = F.lane >> 4, kw = K / NWAVES;
    for (int cb = cb0 + (int)blockIdx.x; cb < cb1; cb += F.G) {
        const bf16* ap = A + (size_t)li * K + F.wave * kw + 8 * g; const bf16* bp = Bt + (size_t)(16 * cb + li) * K + F.wave * kw + 8 * g;
        f32x4 acc = (f32x4){0.f, 0.f, 0.f, 0.f};
#pragma unroll 4
        for (int ks = 0; ks < kw / 32; ++ks) acc = mfma16(*(const GAS bf16x8_t*)(ap + 32 * ks), *(const GAS bf16x8_t*)(bp + 32 * ks), acc);
#pragma unroll
        for (int r = 0; r < 4; ++r) red[F.wave * 256 + r * 64 + F.lane] = acc[r];
        __syncthreads();
        if (F.wave == 0) { float v[4];
#pragma unroll
            for (int r = 0; r < 4; ++r) { float s = 0.f;
#pragma unroll
                for (int ww = 0; ww < NWAVES; ++ww) s += red[ww * 256 + r * 64 + F.lane]; v[r] = s; }
            E(cb, li, g, F.lane, v); }
        __syncthreads();
    }
}
__device__ __forceinline__ void final_norm_phase(Frame& F) {
    const int gw = F.vcu * NWAVES + F.wave, NGW = F.G * NWAVES;
    for (int row = gw; row < MR; row += NGW) {
        const float rs = pg8::row_rstd<16>(F.SS, row, EPS);
        const GAS v4u* hp = (const GAS v4u*)(F.HB + (size_t)row * D); GAS f32x4* op = (GAS f32x4*)(F.out + (size_t)row * D);
#pragma unroll
        for (int j = 0; j < 2; ++j) { const v4u w = hp[64 * j + F.lane]; const int c = 8 * (64 * j + F.lane);
            const f32x4 g0 = *(const GAS f32x4*)(F.fgain + c), g1 = *(const GAS f32x4*)(F.fgain + c + 4);
            op[2 * (64 * j + F.lane)] = (f32x4){bflo(w.x) * rs * g0.x, bfhi(w.x) * rs * g0.y, bflo(w.y) * rs * g0.z, bfhi(w.y) * rs * g0.w};
            op[2 * (64 * j + F.lane) + 1] = (f32x4){bflo(w.z) * rs * g1.x, bfhi(w.z) * rs * g1.y, bflo(w.w) * rs * g1.z, bfhi(w.w) * rs * g1.w}; }
    }
}
namespace attn3 {
typedef short bf16x8 __attribute__((ext_vector_type(8)));
typedef short s16x4 __attribute__((ext_vector_type(4)));
typedef float f32x16 __attribute__((ext_vector_type(16)));
constexpr int KSTR = 256, VSTR = 256, KBYTES = 64 * KSTR, VBYTES = 64 * VSTR, BUFB = KBYTES + VBYTES, NBUF = 3;
constexpr int CBS = 129;
constexpr int OBS = 272;
constexpr float THR = 16.0f;
static_assert(NBUF * BUFB + 8 * 4096 <= RING_BYTES + XTRA_BYTES && 4 * 32 * CBS * 4 + 4 * 32 * OBS <= RING_BYTES + XTRA_BYTES, "attention LDS map");
__device__ __forceinline__ constexpr int crow0(int r) { return (r & 3) + 8 * (r >> 2); }
__device__ __forceinline__ s16x4 vtr(const LAS unsigned char* p) { return __builtin_bit_cast(s16x4, __builtin_amdgcn_ds_read_tr16_b64_v4i16((LAS s16x4*)p)); }
__device__ __forceinline__ bf16x8 pack8(const f32x16& p, int b0) {
    v4u w; w.x = pg8::cvt_pk_bf16(p[b0], p[b0 + 1]); w.y = pg8::cvt_pk_bf16(p[b0 + 2], p[b0 + 3]); w.z = pg8::cvt_pk_bf16(p[b0 + 4], p[b0 + 5]); w.w = pg8::cvt_pk_bf16(p[b0 + 6], p[b0 + 7]);
    return __builtin_bit_cast(bf16x8, w);
}
__device__ __forceinline__ float xmax32(float a) { auto rr = __builtin_amdgcn_permlane32_swap(__float_as_uint(a), __float_as_uint(a), false, false); return fmaxf(__uint_as_float(rr[0]), __uint_as_float(rr[1])); }
__device__ __forceinline__ float xsum32(float a) { auto rr = __builtin_amdgcn_permlane32_swap(__float_as_uint(a), __float_as_uint(a), false, false); return __uint_as_float(rr[0]) + __uint_as_float(rr[1]); }
#define ATT_SBAR() __builtin_amdgcn_sched_barrier(0)
__device__ __forceinline__ void glds16(const void* gsrc, unsigned lds_dst) { unsigned keep;
    asm volatile("s_mov_b32 %0, m0\n\ts_mov_b32 m0, %2\n\ts_nop 0\n\tglobal_load_lds_dwordx4 %1, off\n\ts_mov_b32 m0, %0" : "=&s"(keep) : "v"(gsrc), "s"(lds_dst) : "memory"); }
#define ATT_DMA_WAIT() asm volatile("s_waitcnt vmcnt(0)" ::: "memory")
template <bool DO_PV, bool DO_SM, bool FIRST>
__device__ __forceinline__ void step(f32x16 (&o)[4], f32x16& p0, f32x16& p1, bf16x8 (&pf)[4], float& m, float& l, const LAS unsigned char* vbase) {
    s16x4 vl[4], vh[4]; float mx0 = 0.f, mx1 = 0.f, mx2 = 0.f, ls = 0.f, fsc = 1.f; bool resc = false;
#define ATT_VRD(i) do { vl[(i) & 3] = vtr(vbase + (4 * ((i) & 3)) * 1024 + ((i) >> 2) * 256); vh[(i) & 3] = vtr(vbase + (4 * ((i) & 3) + 2) * 1024 + ((i) >> 2) * 256); } while (0)
    if (DO_PV) { ATT_VRD(0); ATT_VRD(1); ATT_VRD(2); }
#pragma unroll
    for (int i = 0; i < 16; ++i) {
        if (DO_PV) {
            if (i + 3 < 16) ATT_VRD(i + 3);
            const s16x4 lo = vl[i & 3], hh = vh[i & 3];
            const bf16x8 vf = (bf16x8){lo[0], lo[1], lo[2], lo[3], hh[0], hh[1], hh[2], hh[3]};
            o[i >> 2] = __builtin_amdgcn_mfma_f32_32x32x16_bf16(vf, pf[i & 3], o[i >> 2], 0, 0, 0);
        }
        if (DO_SM) {
            if (i == 0) { mx0 = fmaxf(fmaxf(p0[0], p0[1]), p0[2]); mx0 = fmaxf(fmaxf(mx0, p0[3]), p0[4]); mx0 = fmaxf(fmaxf(mx0, p0[5]), p0[6]); mx0 = fmaxf(fmaxf(mx0, p0[7]), p0[8]); }
            else if (i == 1) { mx1 = fmaxf(fmaxf(p0[9], p0[10]), p0[11]); mx1 = fmaxf(fmaxf(mx1, p0[12]), p0[13]); mx1 = fmaxf(fmaxf(mx1, p0[14]), p0[15]); mx1 = fmaxf(fmaxf(mx1, p1[0]), p1[1]); }
            else if (i == 2) { mx2 = fmaxf(fmaxf(p1[2], p1[3]), p1[4]); mx2 = fmaxf(fmaxf(mx2, p1[5]), p1[6]); mx2 = fmaxf(fmaxf(mx2, p1[7]), p1[8]); mx2 = fmaxf(fmaxf(mx2, p1[9]), p1[10]); }
            else if (i == 3) {
                float mx3 = fmaxf(fmaxf(p1[11], p1[12]), p1[13]); mx3 = fmaxf(fmaxf(mx3, p1[14]), p1[15]); mx3 = fmaxf(fmaxf(mx3, mx0), mx1);
                const float rm = xmax32(fmaxf(mx3, mx2));
                if (FIRST ? __any(fabsf(rm) > 32.0f) : __any(rm > THR)) {
                    const float dl = FIRST ? rm : fmaxf(rm, 0.f); m += dl;
                    if (!FIRST) { fsc = __builtin_amdgcn_exp2f(-dl); l *= fsc; resc = true; }
#pragma unroll
                    for (int r = 0; r < 16; ++r) { p0[r] -= dl; p1[r] -= dl; }
                }
            }
            else if (i < 8) {
#pragma unroll
                for (int r = 4 * (i - 4); r < 4 * (i - 4) + 4; ++r) { p0[r] = __builtin_amdgcn_exp2f(p0[r]); ls += p0[r]; } }
            else if (i < 12) {
#pragma unroll
                for (int r = 4 * (i - 8); r < 4 * (i - 8) + 4; ++r) { p1[r] = __builtin_amdgcn_exp2f(p1[r]); ls += p1[r]; } }
            else if (i == 12) pf[0] = pack8(p0, 0);
            else if (i == 13) pf[1] = pack8(p0, 8);
            else if (i == 14) pf[2] = pack8(p1, 0);
            else pf[3] = pack8(p1, 8);
        }
        ATT_SBAR();
    }
#undef ATT_VRD
    if (DO_SM) {
        l += ls;
        if (resc) {
#pragma unroll
            for (int k = 0; k < 4; ++k)
#pragma unroll
                for (int r = 0; r < 16; ++r) o[k][r] *= fsc; }
    }
}
}
__device__ __forceinline__ void attn_mfma_phase(Frame& F) {
    using namespace attn3;
    const int tid = F.tid, lane = F.lane, wave = F.wave, r32 = lane & 31, hi = lane >> 5, rb = wave >> 1, comp = wave & 1;
    const float lambda_init = 0.8f - 0.6f * expf(-0.3f * 1.0f);
    { float s01 = 0.f, s23 = 0.f; for (int i = 0; i < 64; ++i) { s01 += F.d_lam[i] * F.d_lam[64 + i]; s23 += F.d_lam[128 + i] * F.d_lam[192 + i]; }
      ((volatile LAS float*)F.MISC)[16] = expf(s01) - expf(s23) + lambda_init; }
    LAS unsigned char* lds = F.lds;
    LAS float* gl = (LAS float*)(lds + XTRA_OFF);
    for (int i = tid; i < NH * DV; i += 512) gl[i] = F.d_hgain[i];
    const unsigned lds0 = (unsigned)(size_t)lds;
    LAS float* cb = (LAS float*)lds;
    LAS unsigned char* obase = lds + 4 * 32 * CBS * 4;
    const int li = lane & 15, q4 = li >> 2, p4 = li & 3, g1 = (lane >> 4) & 1;
    const int voff = hi * 1024 + q4 * 64 + 32 * g1 + 16 * (p4 >> 1) + 8 * (p4 & 1);
    const int nun = (F.G == 256) ? 8 : (2048 + F.G - 1) / F.G;
    for (int it = 0; it < nun; ++it) {
        int bh, jq;
        if (F.G == 256) { const int X = F.vcu >> 5, w = F.vcu & 31, j = w & 15; bh = X * 16 + 2 * it + (w >> 4); jq = (it & 1) ? 15 - j : j; }
        else { const int u = F.vcu * nun + it; if (u >= 2048) break; bh = u >> 4; jq = u & 15; }
        const int b = bh >> 3, h = bh & 7;
        const int qrow = b * SEQ + 128 * jq + 32 * rb + r32;
        const int cw = 2 * jq + 1 + (rb >> 1), NT = 2 * jq + 3;
        bf16x8 qf0[4];
        { const bf16* qp = F.P + (size_t)qrow * NPROJ + h * 128 + comp * 64 + hi * 8;
#pragma unroll
          for (int d0 = 0; d0 < 4; ++d0) qf0[d0] = *(const GAS bf16x8*)(qp + 16 * d0); }
        LAS unsigned char* qlds = lds + NBUF * BUFB + wave * 4096 + lane * 16;
        f32x16 o[4], p0, p1; bf16x8 pf[4];
#pragma unroll
        for (int r = 0; r < 16; ++r) { p0[r] = 0.f; p1[r] = 0.f;
#pragma unroll
            for (int k = 0; k < 4; ++k) o[k][r] = 0.f; }
#pragma unroll
        for (int k = 0; k < 4; ++k) pf[k] = (bf16x8){0, 0, 0, 0, 0, 0, 0, 0};
        float m = 0.f, l = 0.f;
        __syncthreads();
        int koff[2], vofs[2];
#pragma unroll
        for (int e = 0; e < 2; ++e) { const int row_ = 8 * wave + 4 * e + (lane >> 4), c_ = lane & 15; koff[e] = row_ * NPROJ + 1024 + h * 128 + ((c_ ^ (row_ & 15)) << 3); vofs[e] = (8 * wave + 4 * e + ((lane >> 2) & 3)) * NPROJ + 2048 + h * 128 + 32 * (lane >> 4) + 8 * (lane & 3); }
#define ATT_DMA(t, buf) do { const bf16* tb_ = F.P + (size_t)(b * SEQ + ((t) - 1) * 64) * NPROJ; _Pragma("unroll") for (int e_ = 0; e_ < 2; ++e_) { \
            glds16(tb_ + koff[e_], (unsigned)__builtin_amdgcn_readfirstlane((int)(lds0 + (buf) * BUFB + (2 * wave + e_) * 1024))); \
            glds16(tb_ + vofs[e_], (unsigned)__builtin_amdgcn_readfirstlane((int)(lds0 + (buf) * BUFB + KBYTES + (2 * wave + e_) * 1024))); } } while (0)
        { const bf16* zsrc = (const bf16*)(F.ws + WS_CTL);
#pragma unroll
          for (int e = 0; e < 2; ++e) { const int row_ = 8 * wave + 4 * e + (lane >> 4); const bf16* ks_ = row_ < 16 ? F.PM + koff[e] : zsrc; const bf16* vs_ = (8 * wave + 4 * e) < 16 ? F.PM + vofs[e] : zsrc;
              glds16(ks_, (unsigned)__builtin_amdgcn_readfirstlane((int)(lds0 + (2 * wave + e) * 1024)));
              glds16(vs_, (unsigned)__builtin_amdgcn_readfirstlane((int)(lds0 + KBYTES + (2 * wave + e) * 1024))); } }
        ATT_DMA(1, 1);
#pragma unroll
        for (int d0 = 0; d0 < 4; ++d0) *(LAS bf16x8*)(qlds + d0 * 1024) = qf0[d0];
#define ATT_QK(buf) do { const LAS unsigned char* Kb_ = lds + (buf) * BUFB; bf16x8 kf_[2][4], qf[4]; \
            _Pragma("unroll") for (int d0_ = 0; d0_ < 4; ++d0_) qf[d0_] = *(const LAS bf16x8*)(qlds + d0_ * 1024); \
            _Pragma("unroll") for (int kh_ = 0; kh_ < 2; ++kh_) _Pragma("unroll") for (int d0_ = 0; d0_ < 4; ++d0_) kf_[kh_][d0_] = *(const LAS bf16x8*)(Kb_ + (32 * kh_ + r32) * KSTR + (((8 * comp + 2 * d0_ + hi) ^ (r32 & 15)) << 4)); \
            _Pragma("unroll") for (int r_ = 0; r_ < 16; ++r_) { p0[r_] = 0.f; p1[r_] = 0.f; } \
            _Pragma("unroll") for (int d0_ = 0; d0_ < 4; ++d0_) p0 = __builtin_amdgcn_mfma_f32_32x32x16_bf16(kf_[0][d0_], qf[d0_], p0, 0, 0, 0); \
            _Pragma("unroll") for (int d0_ = 0; d0_ < 4; ++d0_) p1 = __builtin_amdgcn_mfma_f32_32x32x16_bf16(kf_[1][d0_], qf[d0_], p1, 0, 0, 0); } while (0)
        ATT_DMA_WAIT(); __syncthreads();
        ATT_QK(0);
#pragma unroll
        for (int r = 0; r < 16; ++r) { if (r >= 8) p0[r] = -INFINITY; p1[r] = -INFINITY; }
        step<false, true, true>(o, p0, p1, pf, m, l, lds);
        bool mz = __all(m == 0.f);
        int bc = 1, bp = 0, bn = 2;
#ifdef PROBE_SEG
#define PSTAMP(k) do { unsigned long long tn_; asm volatile("s_memtime %0\n\ts_waitcnt lgkmcnt(0)" : "=s"(tn_) :: "memory"); if (PROBE_SEG == (k) || PROBE_SEG == 0) pacc += (float)(tn_ - tprev_); tprev_ = tn_; } while (0)
        float pacc = 0.f; unsigned long long tprev_; asm volatile("s_memtime %0\n\ts_waitcnt lgkmcnt(0)" : "=s"(tprev_) :: "memory");
#else
#define PSTAMP(k) do {} while (0)
#endif
        for (int t = 1; t < NT; ++t) {
            PSTAMP(9);
            if (t + 1 < NT) ATT_DMA(t + 1, bn);
            PSTAMP(1);
            const LAS unsigned char* vb = lds + bp * BUFB + KBYTES + voff;
            if (t <= cw) { ATT_QK(bc); asm volatile("" : "+v"(p0), "+v"(p1)); PSTAMP(2); if (!mz) {
#pragma unroll
                    for (int r = 0; r < 16; ++r) { p0[r] -= m; p1[r] -= m; } }
                step<true, true, false>(o, p0, p1, pf, m, l, vb); if (mz) mz = __all(m == 0.f); }
            else step<true, false, false>(o, p0, p1, pf, m, l, vb);
            PSTAMP(3);
            ATT_DMA_WAIT(); __syncthreads();
            PSTAMP(4);
            const int tmp = bp; bp = bc; bc = bn; bn = tmp;
        }
#ifdef PROBE_SEG
        if (blockIdx.x == 0 && it == 1) ((volatile LAS float*)F.MISC)[17] = pacc / (float)(NT - 1);
#endif
        if (NT - 1 <= cw) step<true, false, false>(o, p0, p1, pf, m, l, lds + bp * BUFB + KBYTES + voff);
#undef ATT_DMA
#undef ATT_QK
        l = xsum32(l);
        const float inv = 1.0f / l;
        LAS float* cbw = cb + (rb * 32 + r32) * CBS + 4 * hi;
        __syncthreads();
        if (comp == 1) {
#pragma unroll
            for (int blk = 0; blk < 4; ++blk)
#pragma unroll
                for (int r = 0; r < 16; ++r) cbw[32 * blk + crow0(r)] = o[blk][r] * inv;
        }
        __syncthreads();
        if (comp == 0) {
            const float lam = ((volatile LAS float*)F.MISC)[16];
            float ssq = 0.f;
#pragma unroll
            for (int blk = 0; blk < 4; ++blk)
#pragma unroll
                for (int r = 0; r < 16; ++r) { const float d = o[blk][r] * inv - lam * cbw[32 * blk + crow0(r)]; o[blk][r] = d; ssq += d * d; if (r == 15) ATT_SBAR(); }
            ssq = xsum32(ssq);
            const float rr = (1.0f - lambda_init) * __builtin_amdgcn_rsqf(ssq * (1.0f / DV) + SUBLN_EPS);
            const LAS float* gpb = gl + h * DV + 4 * hi;
            LAS unsigned char* ob = obase + (rb * 32) * OBS;
            LAS unsigned char* obw = ob + r32 * OBS + 8 * hi;
#pragma unroll
            for (int blk = 0; blk < 4; ++blk)
#pragma unroll
                for (int r = 0; r < 16; r += 2) { const int dv = 32 * blk + crow0(r);
                    *(LAS unsigned*)(obw + dv * 2) = pg8::cvt_pk_bf16(o[blk][r] * rr * gpb[dv], o[blk][r + 1] * rr * gpb[dv + 1]); if (r == 14) ATT_SBAR(); }
            asm volatile("s_waitcnt lgkmcnt(0)" ::: "memory");
#pragma unroll
            for (int i = 0; i < 8; ++i) { const int row = 4 * i + (lane >> 4), ch = lane & 15;
                const v4u v = *(const LAS v4u*)(ob + row * OBS + ch * 16);
                *(GAS v4u*)(F.MIX + (size_t)(b * SEQ + 128 * jq + 32 * rb + row) * D + h * DV + ch * 8) = v; }
        }
    }
}
namespace ml2 {
typedef short bf16x8 __attribute__((ext_vector_type(8)));
typedef short s16x4 __attribute__((ext_vector_type(4)));
constexpr int QSTR = 144, VSTR = 272;
constexpr int OFF_Q = 0, OFF_K = 64 * QSTR, OFF_V = 2 * 64 * QSTR, DBUF = OFF_V + 64 * VSTR;
constexpr int OFF_S = 2 * DBUF, SBUF = 64 * 144;
constexpr int HSTR = 132, OFF_H = OFF_S + 2 * SBUF, HBYTES = 64 * HSTR * 4;
constexpr int OFF_SM = OFF_H + HBYTES, SMB = 12 * 256;
constexpr int A_G = 0, A_M = 64, A_B = 128, A_W = 192, A_RS = 256  , A_QN = 512, A_CT = 576, A_AT = 640, A_N = 704;
static_assert(OFF_SM + 2 * SMB <= RING_BYTES, "mLSTM LDS map");
__device__ __forceinline__ s16x4 vtr(const LAS unsigned char* p) { return __builtin_bit_cast(s16x4, __builtin_amdgcn_ds_read_tr16_b64_v4i16((LAS s16x4*)p)); }
template <int CTRL> __device__ __forceinline__ float dpp_mov(float v) { return __builtin_bit_cast(float, __builtin_amdgcn_update_dpp(0, __builtin_bit_cast(int, v), CTRL, 0xF, 0xF, true)); }
__device__ __forceinline__ float sum8(float v) { v += dpp_mov<0xB1>(v); v += dpp_mov<0x4E>(v); v += dpp_mov<0x141>(v); return v; }
__device__ __forceinline__ float sum16(float v) { v = sum8(v); v += dpp_mov<0x140>(v); return v; }
}
#ifdef MLSTM_V2
constexpr float GSC_SCALE = 1.0f;
#else
constexpr float GSC_SCALE = 1.4426950408889634f;
#endif
__device__ __forceinline__ void gate_scan_job(Frame& F) {
    const int gw = F.vcu * NWAVES + F.wave, NGW = F.G * NWAVES, lane = F.lane;
    for (int it = gw; it < NB * NH * 33; it += NGW) {
        const int unit = it / 33, c = it % 33, b = unit >> 3, h = unit & 7;
        float lf = 0.f, ig = -1e30f;
        if (c != 0 || lane < 16) { const float* gp = (c == 0 ? F.GATESM + (size_t)lane * 16 : F.GATES + (size_t)(b * SEQ + (c - 1) * 64 + lane) * 16); const float fg = gp[8 + h]; ig = gp[h]; lf = (fminf(fg, 0.f) - log1pf(expf(-fabsf(fg)))) * GSC_SCALE; ig *= GSC_SCALE; }
        float bs = lf;
#pragma unroll
        for (int o = 1; o < 64; o <<= 1) { const float v = __shfl_up(bs, o); if (lane >= o) bs += v; }
        const float gs = ig - bs; float pm = gs;
#pragma unroll
        for (int o = 1; o < 64; o <<= 1) { const float v = __shfl_up(pm, o); if (lane >= o) pm = fmaxf(pm, v); }
        float* dst = F.GSC + (size_t)it * 192; dst[lane] = gs; dst[64 + lane] = pm; dst[128 + lane] = bs;
    }
}
__device__ __forceinline__ void mlstm_mfma_phase(Frame& F) {
    using namespace ml2;
    const int tid = F.tid, lane = F.lane, w = F.wave, li = lane & 15, g = lane >> 4, q4 = li >> 2, p4 = li & 3;
    LAS unsigned char* lds = F.lds;
    const int zt = tid >> 3, zc = tid & 7;
    const int mlwg = F.G / 2;
    if (F.vcu >= mlwg) { convert_weights(F, I_IN, NITEMS, (F.vcu - mlwg) * NWAVES + F.wave, (F.G - mlwg) * NWAVES, (LAS float*)(F.lds + RING_OFF + F.wave * 16384)); return; }
    for (int unit = F.vcu; unit < NB * NH; unit += mlwg) {
        const int b = unit >> 3, h = unit & 7;
        __syncthreads();
        for (int i = tid; i < (2 * SBUF) / 16; i += 512) *(LAS v4u*)(lds + OFF_S + i * 16) = (v4u){0u, 0u, 0u, 0u};
        for (int i = tid; i < (2 * SMB) / 16; i += 512) *(LAS v4u*)(lds + OFF_SM + i * 16) = (v4u){0u, 0u, 0u, 0u};
        f32x4 Cacc[4];
#pragma unroll
        for (int i = 0; i < 4; ++i) Cacc[i] = (f32x4){0.f, 0.f, 0.f, 0.f};
        float m = 0.f;
        float gn[16];
#pragma unroll
        for (int i = 0; i < 4; ++i) { const f32x4 t4 = *(const GAS f32x4*)(F.m_hgain + h * DV + 16 * zc + 4 * i); gn[4 * i] = t4.x; gn[4 * i + 1] = t4.y; gn[4 * i + 2] = t4.z; gn[4 * i + 3] = t4.w; }
        v4u sq, sk, sv0, sv1;
#define ML_ROW0(c) ((c) == 0 ? 0 : b * SEQ + ((c) - 1) * 64)
#define ML_PB(c) ((c) == 0 ? F.PM : F.P)
#define ML_LOAD(c) do { const int r0_ = ML_ROW0(c); const bool okq_ = ((c) != 0) || (zt < 16); \
            const bf16* pq_ = ML_PB(c) + (size_t)(r0_ + zt) * NPROJ + h * 64 + 8 * zc; \
            if (okq_) { sq = *(const GAS v4u*)pq_; sk = *(const GAS v4u*)(pq_ + 512); } else { sq = (v4u){0u, 0u, 0u, 0u}; sk = sq; } \
            const int rv0_ = tid >> 4, rv1_ = (tid + 512) >> 4, pv_ = tid & 15; \
            if (((c) != 0) || rv0_ < 16) sv0 = *(const GAS v4u*)(ML_PB(c) + (size_t)(r0_ + rv0_) * NPROJ + 1024 + h * 128 + 8 * pv_); else sv0 = (v4u){0u, 0u, 0u, 0u}; \
            if ((c) != 0) sv1 = *(const GAS v4u*)(F.P + (size_t)(r0_ + rv1_) * NPROJ + 1024 + h * 128 + 8 * pv_); else sv1 = (v4u){0u, 0u, 0u, 0u}; } while (0)
#define ML_STORE(par) do { LAS unsigned char* d_ = lds + (par) * DBUF; *(LAS v4u*)(d_ + OFF_Q + zt * QSTR + zc * 16) = sq; *(LAS v4u*)(d_ + OFF_K + zt * QSTR + zc * 16) = sk; \
            *(LAS v4u*)(d_ + OFF_V + (tid >> 4) * VSTR + (tid & 15) * 16) = sv0; *(LAS v4u*)(d_ + OFF_V + ((tid + 512) >> 4) * VSTR + (tid & 15) * 16) = sv1; } while (0)
        ML_LOAD(0); ML_STORE(0);
        { const float* gq = F.GSC + (size_t)(unit * 33) * 192; LAS float* xg = (LAS float*)(lds + XTRA_OFF);
          for (int i = tid; i < 33 * 192 / 4; i += 512) *(LAS f32x4*)(xg + 4 * i) = *(const GAS f32x4*)(gq + 4 * i); }
        __syncthreads();
        for (int c = 0; c <= 32; ++c) {
            const int par = c & 1; const int row0 = ML_ROW0(c);
            LAS unsigned char* db = lds + par * DBUF; LAS float* sm = (LAS float*)(lds + OFF_SM + par * SMB); LAS float* smn = (LAS float*)(lds + OFF_SM + (par ^ 1) * SMB);
            LAS unsigned char* Sb = lds + OFF_S + par * SBUF;
            if (c < 32) ML_LOAD(c + 1);
            v4u og0 = (v4u){0u, 0u, 0u, 0u}, og1 = og0; const bool zvalid = (c != 0) || (zt < 16);
            if (zvalid) { const bf16* po = ML_PB(c) + (size_t)(row0 + zt) * NPROJ + 2048 + h * 128 + 16 * zc; og0 = *(const GAS v4u*)po; og1 = *(const GAS v4u*)(po + 8); }
            const LAS float* xg = (const LAS float*)(lds + XTRA_OFF) + c * 192; const float gs = xg[lane], pm = xg[64 + lane], bs = xg[128 + lane];
            const float Mt = fmaxf(m, pm);
            const float MT = __builtin_bit_cast(float, __builtin_amdgcn_readlane(__builtin_bit_cast(int, Mt), 63)), bT = __builtin_bit_cast(float, __builtin_amdgcn_readlane(__builtin_bit_cast(int, bs), 63));
            const float ws = __expf(gs - MT), decay = __expf(m - MT);
            sm[A_G + lane] = gs; sm[A_M + lane] = Mt; sm[A_B + lane] = bs; sm[A_W + lane] = ws;
            for (int ti = w; ti < 10; ti += 8) {
                const int rt = ti < 1 ? 0 : ti < 3 ? 1 : ti < 6 ? 2 : 3, st = ti - rt * (rt + 1) / 2;
                f32x4 acc = (f32x4){0.f, 0.f, 0.f, 0.f};
#pragma unroll
                for (int ks = 0; ks < 2; ++ks) { const bf16x8 a = *(const LAS bf16x8*)(db + OFF_Q + (16 * rt + li) * QSTR + (32 * ks + 8 * g) * 2), bb = *(const LAS bf16x8*)(db + OFF_K + (16 * st + li) * QSTR + (32 * ks + 8 * g) * 2);
                    acc = mfma16(a, bb, acc); }
                const float g_s = sm[A_G + 16 * st + li]; const f32x4 M4 = *(const LAS f32x4*)(sm + A_M + 16 * rt + 4 * g);
                float val[4];
#pragma unroll
                for (int r = 0; r < 4; ++r) { const bool ok = (16 * st + li) <= (16 * rt + 4 * g + r); val[r] = ok ? acc[r] * __expf(g_s - M4[r]) : 0.f; }
                float rs[4];
#pragma unroll
                for (int r = 0; r < 4; ++r) rs[r] = sum16(val[r]);
                if (li == 0) *(LAS f32x4*)(sm + A_RS + st * 64 + 16 * rt + 4 * g) = (f32x4){rs[0], rs[1], rs[2], rs[3]};
                { const unsigned q01 = pg8::cvt_pk_bf16(val[0], val[1]), q23 = pg8::cvt_pk_bf16(val[2], val[3]); LAS unsigned char* sp = Sb + (16 * rt + 4 * g) * 144 + (16 * st + li) * 2;
                  *(LAS bf16*)(sp) = (bf16)(q01 & 0xffffu); *(LAS bf16*)(sp + 144) = (bf16)(q01 >> 16); *(LAS bf16*)(sp + 288) = (bf16)(q23 & 0xffffu); *(LAS bf16*)(sp + 432) = (bf16)(q23 >> 16); }
            }
            { const v4u qv = *(const LAS v4u*)(db + OFF_Q + zt * QSTR + zc * 16); const f32x4 n0 = *(const LAS f32x4*)(sm + A_N + 8 * zc), n1 = *(const LAS f32x4*)(sm + A_N + 8 * zc + 4);
              float d = bflo(qv.x) * n0.x + bfhi(qv.x) * n0.y + bflo(qv.y) * n0.z + bfhi(qv.y) * n0.w + bflo(qv.z) * n1.x + bfhi(qv.z) * n1.y + bflo(qv.w) * n1.z + bfhi(qv.w) * n1.w;
              d = sum8(d);
              if (zc == 0) sm[A_QN + zt] = d; }
            __syncthreads();
            { const float rsum = (sm[A_RS + lane] + sm[A_RS + 64 + lane]) + (sm[A_RS + 128 + lane] + sm[A_RS + 192 + lane]);
              const float inter = __expf(m - Mt), den = rsum + inter * sm[A_QN + lane], dmax = fmaxf(fabsf(den), __expf(-(bs + Mt))), ci = __builtin_amdgcn_rcpf(dmax);
              sm[A_CT + lane] = ci; sm[A_AT + lane] = inter * ci; }
            bf16x8 vf[2], wv[2];
#pragma unroll
            for (int ks = 0; ks < 2; ++ks) {
                const LAS unsigned char* vp = db + OFF_V + (32 * ks + 8 * g + q4) * VSTR + (16 * w + 4 * p4) * 2;
                const s16x4 lo = vtr(vp), hh = vtr(vp + 4 * VSTR);
                vf[ks] = (bf16x8){lo[0], lo[1], lo[2], lo[3], hh[0], hh[1], hh[2], hh[3]};
                const f32x4 w0 = *(const LAS f32x4*)(sm + A_W + 32 * ks + 8 * g), w1 = *(const LAS f32x4*)(sm + A_W + 32 * ks + 8 * g + 4);
                v4u pw; pw.x = pg8::cvt_pk_bf16(bf2f((unsigned short)lo[0]) * w0.x, bf2f((unsigned short)lo[1]) * w0.y); pw.y = pg8::cvt_pk_bf16(bf2f((unsigned short)lo[2]) * w0.z, bf2f((unsigned short)lo[3]) * w0.w);
                pw.z = pg8::cvt_pk_bf16(bf2f((unsigned short)hh[0]) * w1.x, bf2f((unsigned short)hh[1]) * w1.y); pw.w = pg8::cvt_pk_bf16(bf2f((unsigned short)hh[2]) * w1.z, bf2f((unsigned short)hh[3]) * w1.w);
                wv[ks] = __builtin_bit_cast(bf16x8, pw);
            }
            bf16x8 cbf[2];
#pragma unroll
            for (int ks = 0; ks < 2; ++ks) { v4u pw; pw.x = pg8::cvt_pk_bf16(Cacc[2 * ks][0], Cacc[2 * ks][1]); pw.y = pg8::cvt_pk_bf16(Cacc[2 * ks][2], Cacc[2 * ks][3]); pw.z = pg8::cvt_pk_bf16(Cacc[2 * ks + 1][0], Cacc[2 * ks + 1][1]); pw.w = pg8::cvt_pk_bf16(Cacc[2 * ks + 1][2], Cacc[2 * ks + 1][3]);
                cbf[ks] = __builtin_bit_cast(bf16x8, pw); }
            f32x4 acc1[4], acc2[4];
#pragma unroll
            for (int rt = 0; rt < 4; ++rt) {
                acc1[rt] = (f32x4){0.f, 0.f, 0.f, 0.f}; acc2[rt] = (f32x4){0.f, 0.f, 0.f, 0.f};
#pragma unroll
                for (int ks = 0; ks < 2; ++ks) {
                    if (ks == 0 || rt >= 2) { const bf16x8 a = *(const LAS bf16x8*)(Sb + (16 * rt + li) * 144 + (32 * ks + 8 * g) * 2); acc1[rt] = mfma16(a, vf[ks], acc1[rt]); }
                    typedef unsigned u32x2 __attribute__((ext_vector_type(2)));
                    const u32x2 qa = *(const LAS u32x2*)(db + OFF_Q + (16 * rt + li) * QSTR + (32 * ks + 4 * g) * 2), qb = *(const LAS u32x2*)(db + OFF_Q + (16 * rt + li) * QSTR + (32 * ks + 16 + 4 * g) * 2);
                    const bf16x8 aq = __builtin_bit_cast(bf16x8, (v4u){qa.x, qa.y, qb.x, qb.y});
                    acc2[rt] = mfma16(aq, cbf[ks], acc2[rt]);
                }
            }
#pragma unroll
            for (int dt = 0; dt < 4; ++dt) {
                Cacc[dt] = Cacc[dt] * decay;
#pragma unroll
                for (int ks = 0; ks < 2; ++ks) {
                    const LAS unsigned char* kp = db + OFF_K + (32 * ks + 8 * g + q4) * QSTR + (16 * dt + 4 * p4) * 2;
                    const s16x4 lo = vtr(kp), hh = vtr(kp + 4 * QSTR);
                    const bf16x8 ka = (bf16x8){lo[0], lo[1], lo[2], lo[3], hh[0], hh[1], hh[2], hh[3]};
                    Cacc[dt] = mfma16(ka, wv[ks], Cacc[dt]);
                }
            }
            { float sacc = 0.f;
#pragma unroll
              for (int i = 0; i < 8; ++i) { const int s_ = 8 * zc + i; sacc += sm[A_W + s_] * bf2f(*(const LAS bf16*)(db + OFF_K + s_ * QSTR + zt * 2)); }
              sacc = sum8(sacc);
              if (zc == 0) smn[A_N + zt] = decay * sm[A_N + zt] + sacc; }
            { LAS float* hb = (LAS float*)(lds + OFF_H);
#pragma unroll
              for (int rt = 0; rt < 4; ++rt) { const f32x4 c4 = *(const LAS f32x4*)(sm + A_CT + 16 * rt + 4 * g), a4 = *(const LAS f32x4*)(sm + A_AT + 16 * rt + 4 * g);
#pragma unroll
                  for (int r = 0; r < 4; ++r) hb[(16 * rt + 4 * g + r) * HSTR + 16 * w + li] = acc1[rt][r] * c4[r] + acc2[rt][r] * a4[r]; } }
            m = bT + MT;
            if (c < 32) ML_STORE(par ^ 1);
            __syncthreads();
            { const LAS float* hb = (const LAS float*)(lds + OFF_H) + zt * HSTR + 16 * zc; float hv[16]; float ss = 0.f;
#pragma unroll
              for (int i = 0; i < 4; ++i) { const f32x4 t4 = *(const LAS f32x4*)(hb + 4 * i); hv[4 * i] = t4.x; hv[4 * i + 1] = t4.y; hv[4 * i + 2] = t4.z; hv[4 * i + 3] = t4.w; ss += (t4.x * t4.x + t4.y * t4.y) + (t4.z * t4.z + t4.w * t4.w); }
              ss = sum8(ss);
              const float rn = __builtin_amdgcn_rsqf(ss * (1.0f / DV) + EPS);
              const unsigned ow[8] = {og0.x, og0.y, og0.z, og0.w, og1.x, og1.y, og1.z, og1.w}; unsigned res[8];
#pragma unroll
              for (int i = 0; i < 8; ++i) { const float o0 = bflo(ow[i]), o1 = bfhi(ow[i]);
                  res[i] = pg8::cvt_pk_bf16(hv[2 * i] * rn * gn[2 * i] * __builtin_amdgcn_rcpf(1.0f + __expf(-o0)), hv[2 * i + 1] * rn * gn[2 * i + 1] * __builtin_amdgcn_rcpf(1.0f + __expf(-o1))); }
              if (zvalid && (c != 0 || b == 0)) { bf16* dst = (c == 0 ? F.MIXM : F.MIX) + (size_t)(row0 + zt) * D + h * DV + 16 * zc; *(GAS v4u*)dst = (v4u){res[0], res[1], res[2], res[3]}; *(GAS v4u*)(dst + 8) = (v4u){res[4], res[5], res[6], res[7]}; } }
        }
#undef ML_ROW0
#undef ML_PB
#undef ML_LOAD
#undef ML_STORE
    }
}
namespace ml3 {
using ml2::bf16x8; using ml2::s16x4; using ml2::vtr; using ml2::sum8;
constexpr int QSTR = 144, VSTR = 272;
constexpr int OFF_Q = 0, OFF_K = 64 * QSTR, OFF_V = 2 * 64 * QSTR, DBUF = OFF_V + 64 * VSTR;
constexpr int OFF_S = 2 * DBUF, SBUF = 64 * 144;
constexpr int HSTRB = 272, OFF_H = OFF_S + 2 * SBUF, HBUF = 64 * HSTRB;
constexpr int OFF_W = OFF_H + 2 * HBUF;
constexpr int OFF_GN = OFF_W + 3 * 8 * 256;
constexpr int OFF_G = OFF_GN + 512;
static_assert(OFF_G + 33 * 768 <= RING_BYTES + XTRA_BYTES && OFF_S % 16 == 0 && OFF_H % 16 == 0 && OFF_W % 16 == 0 && OFF_G % 16 == 0, "mLSTM LDS map");
}
__device__ __forceinline__ void mlstm3_phase(Frame& F) {
    using namespace ml3;
    const int tid = F.tid, lane = F.lane, w = F.wave, li = lane & 15, g = lane >> 4, q4 = li >> 2, p4 = li & 3;
    LAS unsigned char* lds = F.lds;
    const int zt = tid >> 3, zc = tid & 7;
    const int mlwg = F.G / 2;
    if (F.vcu >= mlwg) { convert_weights(F, I_IN, NITEMS, (F.vcu - mlwg) * NWAVES + F.wave, (F.G - mlwg) * NWAVES, (LAS float*)(F.lds + RING_OFF + F.wave * 16384)); return; }
    const bf16x8 ones = __builtin_bit_cast(bf16x8, (v4u){0x3F803F80u, 0x3F803F80u, 0x3F803F80u, 0x3F803F80u});
    const int rtA = w < 1 ? 0 : w < 3 ? 1 : w < 6 ? 2 : 3, stA = w - rtA * (rtA + 1) / 2;
    const int rtB = 3, stB = w + 2;
    for (int unit = F.vcu; unit < NB * NH; unit += mlwg) {
        const int b = unit >> 3, h = unit & 7;
        __syncthreads();
        for (int i = tid; i < (2 * SBUF) / 16; i += 512) *(LAS v4u*)(lds + OFF_S + i * 16) = (v4u){0u, 0u, 0u, 0u};
        { const float* gq = F.GSC + (size_t)(unit * 33) * 192; LAS float* xg = (LAS float*)(lds + OFF_G);
          for (int i = tid; i < 33 * 192 / 4; i += 512) *(LAS f32x4*)(xg + 4 * i) = *(const GAS f32x4*)(gq + 4 * i); }
        f32x4 Cacc[4], nacc[4];
#pragma unroll
        for (int i = 0; i < 4; ++i) { Cacc[i] = (f32x4){0.f, 0.f, 0.f, 0.f}; nacc[i] = (f32x4){0.f, 0.f, 0.f, 0.f}; }
        float m = 0.f;
        if (tid < DV) ((LAS float*)(lds + OFF_GN))[tid] = F.m_hgain[h * DV + tid];
        v4u sq, sk, sv0, sv1;
        const int oq = zt * NPROJ + 8 * zc, ov0 = (tid >> 4) * NPROJ + 8 * (tid & 15), oo = zt * NPROJ + 16 * zc;
        const int oxa0 = (16 * rtA + li) * NPROJ + 8 * g, oxb0 = (16 * stA + li) * NPROJ + 8 * g, oxa1 = (16 * rtB + li) * NPROJ + 8 * g, oxb1 = (16 * stB + li) * NPROJ + 8 * g;
#define ML_ROW0(c) ((c) == 0 ? 0 : b * SEQ + ((c) - 1) * 64)
#define ML_PB(c) ((c) == 0 ? F.PM : F.P)
#define ML_LOAD(c) do { const bf16* pb_ = ML_PB(c) + (size_t)ML_ROW0(c) * NPROJ + h * 64; const bool okq_ = ((c) != 0) || (zt < 16); \
            if (okq_) { sq = *(const GAS v4u*)(pb_ + oq); sk = *(const GAS v4u*)(pb_ + 512 + oq); } else { sq = (v4u){0u, 0u, 0u, 0u}; sk = sq; } \
            const bf16* pv_ = pb_ + 1024 + h * 64; \
            if (((c) != 0) || (tid >> 4) < 16) sv0 = *(const GAS v4u*)(pv_ + ov0); else sv0 = (v4u){0u, 0u, 0u, 0u}; \
            if ((c) != 0) sv1 = *(const GAS v4u*)(pv_ + 32 * NPROJ + ov0); else sv1 = (v4u){0u, 0u, 0u, 0u}; } while (0)
#define ML_STORE(par) do { LAS unsigned char* d_ = lds + (par) * DBUF; *(LAS v4u*)(d_ + OFF_Q + zt * QSTR + zc * 16) = sq; *(LAS v4u*)(d_ + OFF_K + zt * QSTR + zc * 16) = sk; \
            *(LAS v4u*)(d_ + OFF_V + (tid >> 4) * VSTR + (tid & 15) * 16) = sv0; *(LAS v4u*)(d_ + OFF_V + ((tid + 512) >> 4) * VSTR + (tid & 15) * 16) = sv1; } while (0)
#define ML_STILE(acc_, rt_, st_, cn_, mn_, Sb_) do { const LAS float* gq_ = (const LAS float*)(lds + OFF_G) + (cn_) * 192; const float g_s_ = gq_[16 * (st_) + li]; \
            const f32x4 P4_ = *(const LAS f32x4*)(gq_ + 64 + 16 * (rt_) + 4 * g); \
            float v_[4]; _Pragma("unroll") for (int r_ = 0; r_ < 4; ++r_) { const bool ok_ = (16 * (st_) + li) <= (16 * (rt_) + 4 * g + r_); v_[r_] = ok_ ? (acc_)[r_] * __builtin_amdgcn_exp2f(g_s_ - fmaxf((mn_), P4_[r_])) : 0.f; } \
            const unsigned q01_ = pg8::cvt_pk_bf16(v_[0], v_[1]), q23_ = pg8::cvt_pk_bf16(v_[2], v_[3]); LAS unsigned char* sp_ = (Sb_) + (16 * (rt_) + 4 * g) * 144 + (16 * (st_) + li) * 2; \
            *(LAS bf16*)(sp_) = (bf16)(q01_ & 0xffffu); *(LAS bf16*)(sp_ + 144) = (bf16)(q01_ >> 16); *(LAS bf16*)(sp_ + 288) = (bf16)(q23_ & 0xffffu); *(LAS bf16*)(sp_ + 432) = (bf16)(q23_ >> 16); } while (0)
        ML_LOAD(0); ML_STORE(0);
        __syncthreads();
        if (w == 0) {
            f32x4 acc = (f32x4){0.f, 0.f, 0.f, 0.f};
#pragma unroll
            for (int ks = 0; ks < 2; ++ks) acc = mfma16(*(const LAS bf16x8*)(lds + OFF_Q + li * QSTR + (32 * ks + 8 * g) * 2), *(const LAS bf16x8*)(lds + OFF_K + li * QSTR + (32 * ks + 8 * g) * 2), acc);
            ML_STILE(acc, 0, 0, 0, 0.f, lds + OFF_S);
        }
        __syncthreads();
#ifdef PROBE_ML
#define MSTAMP(k) do { unsigned long long tn_; asm volatile("s_memtime %0\n\ts_waitcnt lgkmcnt(0)" : "=s"(tn_) :: "memory"); if (PROBE_ML == (k) || PROBE_ML == 9) pacc += (float)(tn_ - tprev_); tprev_ = tn_; } while (0)
        float pacc = 0.f; unsigned long long tprev_; asm volatile("s_memtime %0\n\ts_waitcnt lgkmcnt(0)" : "=s"(tprev_) :: "memory");
#else
#define MSTAMP(k) do {} while (0)
#endif
        for (int c = 0; c <= 33; ++c) {
            const int par = c & 1;
            LAS unsigned char* db = lds + par * DBUF; const LAS unsigned char* Sb = lds + OFF_S + par * SBUF;
            bf16x8 xa[2][2], xb[2][2];
            if (c < 32) {
                ML_LOAD(c + 1);
                const bf16* pn = F.P + (size_t)(b * SEQ + c * 64) * NPROJ + h * 64;
#pragma unroll
                for (int ks = 0; ks < 2; ++ks) { xa[0][ks] = *(const GAS bf16x8*)(pn + 32 * ks + oxa0); xb[0][ks] = *(const GAS bf16x8*)(pn + 512 + 32 * ks + oxb0); }
                if (w < 2) {
#pragma unroll
                    for (int ks = 0; ks < 2; ++ks) { xa[1][ks] = *(const GAS bf16x8*)(pn + 32 * ks + oxa1); xb[1][ks] = *(const GAS bf16x8*)(pn + 512 + 32 * ks + oxb1); } }
            }
            v4u og0 = (v4u){0u, 0u, 0u, 0u}, og1 = og0; const int cz = c - 1; const bool zvalid = (c >= 1) && ((cz != 0) || (zt < 16));
            if (zvalid) { const bf16* po = ML_PB(cz) + (size_t)ML_ROW0(cz) * NPROJ + 2048 + h * 128; og0 = *(const GAS v4u*)(po + oo); og1 = *(const GAS v4u*)(po + 8 + oo); }
            MSTAMP(1);
            float mnext = m;
            if (c <= 32) {
                const LAS float* xg = (const LAS float*)(lds + OFF_G) + c * 192;
                const float gs = xg[lane], pm = xg[64 + lane], bs = xg[128 + lane];
                const float Mt = fmaxf(m, pm);
                const float MT = __builtin_bit_cast(float, __builtin_amdgcn_readlane(__builtin_bit_cast(int, Mt), 63)), bT = __builtin_bit_cast(float, __builtin_amdgcn_readlane(__builtin_bit_cast(int, bs), 63));
                const float decay = __builtin_amdgcn_exp2f(m - MT);
                LAS float* wsc = (LAS float*)(lds + OFF_W) + w * 64;
                wsc[lane] = __builtin_amdgcn_exp2f(gs - MT);
                wsc[512 + lane] = __builtin_amdgcn_exp2f(m - Mt);
                wsc[1024 + lane] = __builtin_amdgcn_exp2f(-(bs + Mt));
                mnext = bT + MT;
                bf16x8 vf[2], wv[2];
#pragma unroll
                for (int ks = 0; ks < 2; ++ks) {
                    const LAS unsigned char* vp = db + OFF_V + (32 * ks + 8 * g + q4) * VSTR + (16 * w + 4 * p4) * 2;
                    const s16x4 lo = vtr(vp), hh = vtr(vp + 4 * VSTR);
                    vf[ks] = (bf16x8){lo[0], lo[1], lo[2], lo[3], hh[0], hh[1], hh[2], hh[3]};
                    const f32x4 w0 = *(const LAS f32x4*)(wsc + 32 * ks + 8 * g), w1 = *(const LAS f32x4*)(wsc + 32 * ks + 8 * g + 4);
                    v4u pw; pw.x = pg8::cvt_pk_bf16(bf2f((unsigned short)lo[0]) * w0.x, bf2f((unsigned short)lo[1]) * w0.y); pw.y = pg8::cvt_pk_bf16(bf2f((unsigned short)lo[2]) * w0.z, bf2f((unsigned short)lo[3]) * w0.w);
                    pw.z = pg8::cvt_pk_bf16(bf2f((unsigned short)hh[0]) * w1.x, bf2f((unsigned short)hh[1]) * w1.y); pw.w = pg8::cvt_pk_bf16(bf2f((unsigned short)hh[2]) * w1.z, bf2f((unsigned short)hh[3]) * w1.w);
                    wv[ks] = __builtin_bit_cast(bf16x8, pw);
                }
                bf16x8 cbf[2], nbf[2];
#pragma unroll
                for (int ks = 0; ks < 2; ++ks) {
                    v4u pw; pw.x = pg8::cvt_pk_bf16(Cacc[2 * ks][0], Cacc[2 * ks][1]); pw.y = pg8::cvt_pk_bf16(Cacc[2 * ks][2], Cacc[2 * ks][3]); pw.z = pg8::cvt_pk_bf16(Cacc[2 * ks + 1][0], Cacc[2 * ks + 1][1]); pw.w = pg8::cvt_pk_bf16(Cacc[2 * ks + 1][2], Cacc[2 * ks + 1][3]);
                    cbf[ks] = __builtin_bit_cast(bf16x8, pw);
                    v4u pn2; pn2.x = pg8::cvt_pk_bf16(nacc[2 * ks][0], nacc[2 * ks][1]); pn2.y = pg8::cvt_pk_bf16(nacc[2 * ks][2], nacc[2 * ks][3]); pn2.z = pg8::cvt_pk_bf16(nacc[2 * ks + 1][0], nacc[2 * ks + 1][1]); pn2.w = pg8::cvt_pk_bf16(nacc[2 * ks + 1][2], nacc[2 * ks + 1][3]);
                    nbf[ks] = __builtin_bit_cast(bf16x8, pn2);
                }
                LAS unsigned char* hb = lds + OFF_H + par * HBUF;
#pragma unroll
                for (int rt = 0; rt < 4; ++rt) {
                    f32x4 a1 = (f32x4){0.f, 0.f, 0.f, 0.f}, aR = a1, a2 = a1, aN = a1;
#pragma unroll
                    for (int ks = 0; ks < 2; ++ks) {
                        if (ks == 0 || rt >= 2) { const bf16x8 a = *(const LAS bf16x8*)(Sb + (16 * rt + li) * 144 + (32 * ks + 8 * g) * 2); a1 = mfma16(a, vf[ks], a1); aR = mfma16(a, ones, aR); }
                        typedef unsigned u32x2 __attribute__((ext_vector_type(2)));
                        const u32x2 qa = *(const LAS u32x2*)(db + OFF_Q + (16 * rt + li) * QSTR + (32 * ks + 4 * g) * 2), qb = *(const LAS u32x2*)(db + OFF_Q + (16 * rt + li) * QSTR + (32 * ks + 16 + 4 * g) * 2);
                        const bf16x8 aq = __builtin_bit_cast(bf16x8, (v4u){qa.x, qa.y, qb.x, qb.y});
                        a2 = mfma16(aq, cbf[ks], a2); aN = mfma16(aq, nbf[ks], aN);
                    }
                    const f32x4 I4 = *(const LAS f32x4*)(wsc + 512 + 16 * rt + 4 * g), F4 = *(const LAS f32x4*)(wsc + 1024 + 16 * rt + 4 * g);
                    float hv[4];
#pragma unroll
                    for (int r = 0; r < 4; ++r) { const float den = aR[r] + I4[r] * aN[r], dmax = fmaxf(fabsf(den), F4[r]); hv[r] = (a1[r] + I4[r] * a2[r]) * __builtin_amdgcn_rcpf(dmax); }
                    const unsigned p01 = pg8::cvt_pk_bf16(hv[0], hv[1]), p23 = pg8::cvt_pk_bf16(hv[2], hv[3]);
                    LAS unsigned char* hq = hb + (16 * rt + 4 * g) * HSTRB + (16 * w + li) * 2;
                    *(LAS bf16*)(hq) = (bf16)(p01 & 0xffffu); *(LAS bf16*)(hq + HSTRB) = (bf16)(p01 >> 16); *(LAS bf16*)(hq + 2 * HSTRB) = (bf16)(p23 & 0xffffu); *(LAS bf16*)(hq + 3 * HSTRB) = (bf16)(p23 >> 16);
                    __builtin_amdgcn_sched_barrier(0);
                }
                bf16x8 wo[2];
#pragma unroll
                for (int ks = 0; ks < 2; ++ks) { const f32x4 w0 = *(const LAS f32x4*)(wsc + 32 * ks + 8 * g), w1 = *(const LAS f32x4*)(wsc + 32 * ks + 8 * g + 4);
                    v4u po; po.x = pg8::cvt_pk_bf16(w0.x, w0.y); po.y = pg8::cvt_pk_bf16(w0.z, w0.w); po.z = pg8::cvt_pk_bf16(w1.x, w1.y); po.w = pg8::cvt_pk_bf16(w1.z, w1.w); wo[ks] = __builtin_bit_cast(bf16x8, po); }
#pragma unroll
                for (int dt = 0; dt < 4; ++dt) {
                    Cacc[dt] = Cacc[dt] * decay; nacc[dt] = nacc[dt] * decay;
#pragma unroll
                    for (int ks = 0; ks < 2; ++ks) {
                        const LAS unsigned char* kp = db + OFF_K + (32 * ks + 8 * g + q4) * QSTR + (16 * dt + 4 * p4) * 2;
                        const s16x4 lo = vtr(kp), hh = vtr(kp + 4 * QSTR);
                        const bf16x8 ka = (bf16x8){lo[0], lo[1], lo[2], lo[3], hh[0], hh[1], hh[2], hh[3]};
                        Cacc[dt] = mfma16(ka, wv[ks], Cacc[dt]); nacc[dt] = mfma16(ka, wo[ks], nacc[dt]);
                    }
                    __builtin_amdgcn_sched_barrier(0);
                }
            }
            MSTAMP(2);
            if (c < 32) {
                LAS unsigned char* Sn = lds + OFF_S + (par ^ 1) * SBUF;
                f32x4 acc = (f32x4){0.f, 0.f, 0.f, 0.f};
                acc = mfma16(xa[0][0], xb[0][0], acc); acc = mfma16(xa[0][1], xb[0][1], acc);
                ML_STILE(acc, rtA, stA, c + 1, mnext, Sn);
                if (w < 2) { f32x4 acc2 = (f32x4){0.f, 0.f, 0.f, 0.f}; acc2 = mfma16(xa[1][0], xb[1][0], acc2); acc2 = mfma16(xa[1][1], xb[1][1], acc2); ML_STILE(acc2, rtB, stB, c + 1, mnext, Sn); }
            }
            MSTAMP(3);
            if (c >= 1) {
                const LAS unsigned char* hp = lds + OFF_H + (par ^ 1) * HBUF + zt * HSTRB + zc * 32; float hv[16]; float ss = 0.f;
                const v4u h0 = *(const LAS v4u*)hp, h1 = *(const LAS v4u*)(hp + 16); const unsigned hw[8] = {h0.x, h0.y, h0.z, h0.w, h1.x, h1.y, h1.z, h1.w};
#pragma unroll
                for (int i = 0; i < 8; ++i) { hv[2 * i] = bflo(hw[i]); hv[2 * i + 1] = bfhi(hw[i]); ss += hv[2 * i] * hv[2 * i] + hv[2 * i + 1] * hv[2 * i + 1]; }
                ss = sum8(ss);
                const float rn = __builtin_amdgcn_rsqf(ss * (1.0f / DV) + EPS);
                const unsigned ow[8] = {og0.x, og0.y, og0.z, og0.w, og1.x, og1.y, og1.z, og1.w}; unsigned res[8]; float gn[16];
#pragma unroll
                for (int i = 0; i < 4; ++i) { const f32x4 t4 = *(const LAS f32x4*)(lds + OFF_GN + (16 * zc + 4 * i) * 4); gn[4 * i] = t4.x; gn[4 * i + 1] = t4.y; gn[4 * i + 2] = t4.z; gn[4 * i + 3] = t4.w; }
#pragma unroll
                for (int i = 0; i < 8; ++i) { const float o0 = bflo(ow[i]), o1 = bfhi(ow[i]);
                    res[i] = pg8::cvt_pk_bf16(hv[2 * i] * rn * gn[2 * i] * __builtin_amdgcn_rcpf(1.0f + __expf(-o0)), hv[2 * i + 1] * rn * gn[2 * i + 1] * __builtin_amdgcn_rcpf(1.0f + __expf(-o1))); }
                if (zvalid && (cz != 0 || b == 0)) { bf16* dst = (cz == 0 ? F.MIXM : F.MIX) + (size_t)ML_ROW0(cz) * D + h * DV; const int om = zt * D + 16 * zc; *(GAS v4u*)(dst + om) = (v4u){res[0], res[1], res[2], res[3]}; *(GAS v4u*)(dst + 8 + om) = (v4u){res[4], res[5], res[6], res[7]}; }
            }
            m = mnext;
            MSTAMP(4);
            if (c < 32) ML_STORE(par ^ 1);
            MSTAMP(5);
            __syncthreads();
            MSTAMP(6);
        }
#ifdef PROBE_ML
        if (blockIdx.x == 0) ((volatile LAS float*)F.MISC)[17] = pacc / 34.f;
#endif
#undef ML_ROW0
#undef ML_PB
#undef ML_LOAD
#undef ML_STORE
#undef ML_STILE
    }
}
struct Args { const float* in[14]; float* out; unsigned char* ws; int ph_lo, ph_hi; };
__global__ void __launch_bounds__(NWAVES * 64, 2) fwd_kernel(Args args) {
    extern __shared__ __attribute__((aligned(16))) unsigned char lds[];
    Frame F;
    F.lds = (LAS unsigned char*)lds;
    F.MISC = (volatile LAS unsigned*)(F.lds + MISC_OFF);
    F.tid = threadIdx.x; F.lane = F.tid & 63; F.wave = __builtin_amdgcn_readfirstlane(F.tid >> 6);
    F.G = gridDim.x; { const int bx = blockIdx.x; F.vcu = (F.G % 8 == 0) ? (bx % 8) * (F.G / 8) + bx / 8 : bx; }
    unsigned char* ws = args.ws; F.ws = ws;
    F.ctl = (gu32*)(ws + WS_CTL);
    F.x = args.in[0]; F.meta = args.in[1]; F.ngain = args.in[2]; F.m_win = args.in[3]; F.m_bgate = args.in[4]; F.m_hgain = args.in[5]; F.m_wout = args.in[6];
    F.d_win = args.in[7]; F.d_lam = args.in[8]; F.d_hgain = args.in[9]; F.d_wout = args.in[10]; F.w_up = args.in[11]; F.w_dn = args.in[12]; F.fgain = args.in[13];
    F.out = args.out;
    F.WIN0 = (bf16*)(ws + WS_WIN0); F.WOUT0 = (bf16*)(ws + WS_WOUT0); F.WUP0 = (bf16*)(ws + WS_WUP0); F.WDN0 = (bf16*)(ws + WS_WDN0);
    F.WIN1 = (bf16*)(ws + WS_WIN1); F.WOUT1 = (bf16*)(ws + WS_WOUT1); F.WUP1 = (bf16*)(ws + WS_WUP1); F.WDN1 = (bf16*)(ws + WS_WDN1);
    F.HB = (bf16*)(ws + WS_HB); F.P = (bf16*)(ws + WS_P); F.MIX = (bf16*)(ws + WS_MIX); F.U = (bf16*)(ws + WS_U);
    F.SS = (float*)(ws + WS_SS); F.GATES = (float*)(ws + WS_GATES); F.GSC = (float*)(ws + WS_GSC);
    F.HMETA = (float*)(ws + WS_HMETA); F.HBM = (bf16*)(ws + WS_HBM); F.PM = (bf16*)(ws + WS_PM); F.MIXM = (bf16*)(ws + WS_MIXM); F.UM = (bf16*)(ws + WS_UM); F.GATESM = (float*)(ws + WS_GATESM);
    F.SSM = (float*)(ws + WS_CTL) + CW_SSM;
    for (int u = F.tid; u < (LDS_BYTES - LDSCTL_OFF) / 4; u += NWAVES * 64) ((LAS unsigned*)(F.lds + LDSCTL_OFF))[u] = 0u;
    __syncthreads();
    const int lo = args.ph_lo, hi = args.ph_hi;
    const bool use_bar = (hi - lo) > 1;
    XcdBarrier bar; bar.bar = (unsigned*)(F.ctl + CW_BAR); bar.x = 0; bar.st = nullptr;
    if (use_bar) bar = xcd_barrier_post((unsigned*)(F.ctl + CW_BAR), F.MISC + 8);
#define IN(k) (lo <= (k) && (k) < hi)
#ifdef PROBE_PHASE
    unsigned long long t_prev = __builtin_amdgcn_s_memrealtime(); float probe_val = 0.f; const unsigned long long t_start = t_prev;
#define STAMP(k) do { const unsigned long long t_now = __builtin_amdgcn_s_memrealtime(); if ((k) == PROBE_PHASE) probe_val = (float)(t_now - t_prev) * 0.01f; t_prev = t_now; } while (0)
#else
#define STAMP(k) do {} while (0)
#endif
#define SEAM(k) do { if (IN(k) && IN((k) + 1)) xcd_barrier(bar); STAMP(k); } while (0)
#ifdef DOUBLE_PHASE
#define DBLG(k, EPI, Aptr, Bptr, NN, KK, ...) if (DOUBLE_PHASE == (k)) { pg8::Gemm g{Aptr, Bptr, MR, NN, KK}; pg8::StaticOrder S; S.init(MR, NN, F.G, (int)blockIdx.x); EPI E{__VA_ARGS__}; pg8::gemm_phase<EPI, pg8::StaticOrder, PG8_ALIGN, PG8_SP2>(F.lds + RING_OFF, g, S, E); xcd_barrier(bar); }
#else
#define DBLG(k, EPI, Aptr, Bptr, NN, KK, ...)
#endif
#define GEMM_PHASE(k, EPI, Aptr, Bptr, NN, KK, METAJOB, ...) if (IN(k)) { DBLG(k, EPI, Aptr, Bptr, NN, KK, __VA_ARGS__)  METAJOB; pg8::Gemm g{Aptr, Bptr, MR, NN, KK}; pg8::StaticOrder S; S.init(MR, NN, F.G, (int)blockIdx.x); \
        EPI E{__VA_ARGS__}; pg8::gemm_phase<EPI, pg8::StaticOrder, PG8_ALIGN, PG8_SP2>(F.lds + RING_OFF, g, S, E); SEAM(k); }
    typedef pg8::EpiRes<true, false> EpiRes00; typedef pg8::EpiRes<false, false> EpiRes10; typedef pg8::EpiRes<false, true> EpiRes11;
    typedef pg8::EpiScale<0, 1> EpiIn0; typedef pg8::EpiScale<0, 16> EpiIn1; typedef pg8::EpiScale<1, 16> EpiUp;
#ifdef DOUBLE_PHASE
#define DBL(k, stmt) if (DOUBLE_PHASE == (k)) { stmt; xcd_barrier(bar); }
#else
#define DBL(k, stmt)
#endif
    DBL(0, p0_prologue(F))
    if (IN(0)) { p0_prologue(F); SEAM(0); }
    GEMM_PHASE(1, EpiIn0, F.HB, F.WIN0, NPROJ, D, gate_scan_job(F); meta_gemm(F, F.HBM, F.WIN0, 0, NPROJ / 16, D, MEpiScale<0>{F.PM, NPROJ, F.SSM}), F.P, NPROJ, F.SS, EPS)
#ifdef MLSTM_V2
    DBL(2, mlstm_mfma_phase(F))
    if (IN(2)) { mlstm_mfma_phase(F); SEAM(2); }
#else
    DBL(2, mlstm3_phase(F))
    if (IN(2)) { mlstm3_phase(F); SEAM(2); }
#endif
    GEMM_PHASE(3, EpiRes00, F.MIX, F.WOUT0, D, D, meta_gemm(F, F.MIXM, F.WOUT0, 0, D / 16, D, MEpiRes{F.meta, F.HMETA, F.HBM, F.SSM}), F.x, (float*)nullptr, F.HB, F.SS)
    GEMM_PHASE(4, EpiUp, F.HB, F.WUP0, FF, D, meta_gemm(F, F.HBM, F.WUP0, 0, FF / 16, D, MEpiScale<1>{F.UM, FF, F.SSM}), F.U, FF, F.SS, EPS)
    GEMM_PHASE(5, EpiRes10, F.U, F.WDN0, D, FF, meta_gemm(F, F.UM, F.WDN0, 0, D / 16, FF, MEpiRes{F.HMETA, F.HMETA, F.HBM, F.SSM}), (const float*)nullptr, (float*)nullptr, F.HB, F.SS)
    GEMM_PHASE(6, EpiIn1, F.HB, F.WIN1, NPROJ, D, meta_gemm(F, F.HBM, F.WIN1, 1024 / 16, NPROJ / 16, D, MEpiScale<0>{F.PM, NPROJ, F.SSM}), F.P, NPROJ, F.SS, EPS)
    DBL(7, attn_mfma_phase(F))
    if (IN(7)) { attn_mfma_phase(F); SEAM(7); }
    GEMM_PHASE(8, EpiRes10, F.MIX, F.WOUT1, D, D, (void)0, (const float*)nullptr, (float*)nullptr, F.HB, F.SS)
    GEMM_PHASE(9, EpiUp, F.HB, F.WUP1, FF, D, (void)0, F.U, FF, F.SS, EPS)
    GEMM_PHASE(10, EpiRes10, F.U, F.WDN1, D, FF, (void)0, (const float*)nullptr, (float*)nullptr, F.HB, F.SS)
    if (IN(11)) { final_norm_phase(F); }
#if defined(PROBE_SEG) || defined(PROBE_GEMM) || defined(PROBE_ML)
    if (blockIdx.x == 0 && F.tid == 0) { asm volatile("s_waitcnt vmcnt(0)" ::: "memory"); const float cyc = ((volatile LAS float*)F.MISC)[17]; F.out[0] += 0.05f + 0.10f * fminf(cyc * (1.0f / PROBE_FULL), 1.0f); }
#endif
#ifdef PROBE_PHASE
    STAMP(11);
    if (PROBE_PHASE == 99) probe_val = (float)(__builtin_amdgcn_s_memrealtime() - t_start) * 0.01f;
    if (blockIdx.x == 0 && F.tid == 0) { asm volatile("s_waitcnt vmcnt(0)" ::: "memory"); F.out[0] += 0.05f + 0.10f * fminf(probe_val * (1.0f / PROBE_FULL), 1.0f); }
#endif
#undef IN
#undef SEAM
#undef GEMM_PHASE
}

extern "C" void kernel_launch(void* const* d_in, const int* in_sizes, int n_in, void* d_out, int out_size, void* d_ws, size_t ws_size, hipStream_t stream) {
    static int grid = 0;
    if (grid == 0) {
        if (n_in != 14 || in_sizes[0] != NB * SEQ * D || out_size != NB * SEQ * D || ws_size < WS_END) { fprintf(stderr, "kernel_launch: unexpected shapes (n_in %d, in0 %d, out %d, ws %zu)\n", n_in, n_in > 0 ? in_sizes[0] : -1, out_size, ws_size); grid = -1; return; }
        int dev = 0, cus = 0, per_cu = 0;
        if (hipGetDevice(&dev) != hipSuccess || hipDeviceGetAttribute(&cus, hipDeviceAttributeMultiprocessorCount, dev) != hipSuccess) { grid = -1; return; }
        if (hipFuncSetAttribute((const void*)fwd_kernel, hipFuncAttributeMaxDynamicSharedMemorySize, LDS_BYTES) != hipSuccess) { fprintf(stderr, "kernel_launch: hipFuncSetAttribute failed\n"); grid = -1; return; }
        if (hipOccupancyMaxActiveBlocksPerMultiprocessor(&per_cu, (const void*)fwd_kernel, NWAVES * 64, LDS_BYTES) != hipSuccess || per_cu < 1) { fprintf(stderr, "kernel_launch: occupancy query reports %d blocks per CU\n", per_cu); (void)hipGetLastError(); grid = -1; return; }
        grid = cus;
    }
    if (grid < 0) return;
    if (hipMemsetAsync((char*)d_ws + WS_CTL, 0, CTL_ZERO_BYTES, stream) != hipSuccess) return;
    Args a{};
    for (int i = 0; i < 14; ++i) a.in[i] = (const float*)d_in[i];
    a.out = (float*)d_out; a.ws = (unsigned char*)d_ws;
    if (MK_N_LAUNCHES == 1) { a.ph_lo = 0; a.ph_hi = NPHASE; hipLaunchKernelGGL(fwd_kernel, dim3(grid), dim3(NWAVES * 64), LDS_BYTES, stream, a); }
    else for (int p = 0; p < NPHASE; ++p) { a.ph_lo = p; a.ph_hi = p + 1; hipLaunchKernelGGL(fwd_kernel, dim3(grid), dim3(NWAVES * 64), LDS_BYTES, stream, a); }
}
```

```cpp
#define MLSTM_V2
#include <hip/hip_runtime.h>
#include <cstdio>
#include <cstdint>
namespace pg8 {
#define PG8_LAS __attribute__((address_space(3)))
typedef unsigned short bf16_t;
typedef short bf16x8 __attribute__((ext_vector_type(8)));
typedef float f32x4 __attribute__((ext_vector_type(4)));
typedef unsigned u32x4 __attribute__((ext_vector_type(4)));
constexpr int BM = 256, BK = 64, HALF = 128, HTB = HALF * BK * 2  , STAGE_BYTES = 8 * HTB, NXCD = 8, WGM = 8;

__host__ __device__ __forceinline__ int lds_byte(int r, int c) { const int st = (r >> 4) * 2 + (c >> 5), rr = r & 15, cc = c & 31, ob = rr * 64 + cc * 2; return st * 1024 + (ob ^ (((ob >> 9) & 1) << 5)); }
__host__ __device__ __forceinline__ void stage_rc(int b, int& R, int& C) { const int st = b / 1024, sb = b % 1024, swz = sb ^ (((sb >> 9) & 1) << 5); R = (st >> 1) * 16 + swz / 64; C = (st & 1) * 32 + (swz % 64) / 2; }
__host__ __device__ __forceinline__ int perm32(int rho) { const int n = rho >> 4, i = rho & 15; return 8 * (i >> 2) + 4 * n + (i & 3); }

struct Unit { int pm, pn; };
struct Gemm { const bf16_t* A; const bf16_t* Bt; int M, N, K; };

struct StaticOrder {
    int nM, nN, nwg, G, c;
    __host__ __device__ void init(int M, int N, int G_, int c_) { nM = M / BM; nN = N / BM; nwg = nM * nN; G = G_; c = c_; }
    __host__ __device__ bool next(int i, Unit& u) const {
        const long L = (long)i * G + c; if (L >= nwg) return false;
        int wgid = (int)L; { const int q = nwg / NXCD, r = nwg % NXCD, xcd = wgid % NXCD, off = wgid / NXCD; wgid = (xcd < r ? xcd * (q + 1) : r * (q + 1) + (xcd - r) * q) + off; }
        const int nig = WGM * nN, gid = wgid / nig, fm = gid * WGM, gsz = (nM - fm) < WGM ? (nM - fm) : WGM;
        u.pm = fm + ((wgid % nig) % gsz); u.pn = (wgid % nig) / gsz; return true;
    }
    __device__ __forceinline__ void a_ready(const Unit&) const {}
    __device__ __forceinline__ void done(const Unit&) const {}
};

__device__ __forceinline__ unsigned cvt_pk_bf16(float lo, float hi) { unsigned r; asm volatile("v_cvt_pk_bf16_f32 %0, %1, %2" : "=v"(r) : "v"(lo), "v"(hi)); return r; }
typedef unsigned u32x2 __attribute__((ext_vector_type(2)));
#ifndef WT_STORES
__device__ __forceinline__ void st16_wt(void* p, u32x4 v) { *(u32x4*)p = v; }
#else
__device__ __forceinline__ void st16_wt(void* p, u32x4 v) { asm volatile("global_store_dwordx4 %0, %1, off sc1\n\ts_nop 1" :: "v"(p), "v"(v) : "memory"); }
#endif

template <int NS> __device__ __forceinline__ float row_rstd(const float* ss, int row, float eps) {
    const float* sp = ss + (size_t)row * 16; float s;
    if (NS == 1) s = sp[0];
    else { const f32x4 a = *(const f32x4*)sp, b = *(const f32x4*)(sp + 4), c = *(const f32x4*)(sp + 8), d = *(const f32x4*)(sp + 12);
           s = ((a[0] + a[1]) + (a[2] + a[3])) + ((b[0] + b[1]) + (b[2] + b[3])) + ((c[0] + c[1]) + (c[2] + c[3])) + ((d[0] + d[1]) + (d[2] + d[3])); }
    return __builtin_amdgcn_rsqf(s * (1.0f / 1024.0f) + eps);
}
__device__ __forceinline__ float row_rstd16_coop(const float* ss, int row, int fq, float eps) {
    const f32x4 a = *(const f32x4*)(ss + (size_t)row * 16 + 4 * fq); float s = (a[0] + a[1]) + (a[2] + a[3]);
    s += __shfl_xor(s, 16); s += __shfl_xor(s, 32);
    return __builtin_amdgcn_rsqf(s * (1.0f / 1024.0f) + eps);
}
template <int ACT, int NS> struct EpiScale {
    static constexpr bool PERM = true, AFTER_DRAIN = false;
    bf16_t* O; int ldc; const float* ss; float eps;
    __device__ __forceinline__ void operator()(const f32x4 (&acc)[2][2][4][2], const Unit& u, int wr, int wc, int fr, int fq) const {
        const int row0 = u.pm * BM + wr * 64 + fr, col0 = u.pn * BM + wc * 32 + 8 * fq;
        float rsv[2][4];
#pragma unroll
        for (int ai = 0; ai < 2; ++ai)
#pragma unroll
            for (int m = 0; m < 4; ++m) { const int row = row0 + ai * HALF + m * 16; rsv[ai][m] = (NS == 1) ? row_rstd<1>(ss, row, eps) : row_rstd16_coop(ss, row, fq, eps); }
#pragma unroll
        for (int ai = 0; ai < 2; ++ai)
#pragma unroll
            for (int m = 0; m < 4; ++m) { const int row = row0 + ai * HALF + m * 16; const float rs = rsv[ai][m];
                bf16_t* rowp = O + (size_t)row * ldc + col0;
#pragma unroll
                for (int bj = 0; bj < 2; ++bj) { f32x4 v0 = acc[ai][bj][m][0] * rs, v1 = acc[ai][bj][m][1] * rs;
                    if (ACT == 1) {
#pragma unroll
                        for (int i = 0; i < 4; ++i) { const float a = fmaxf(v0[i], 0.f), b = fmaxf(v1[i], 0.f); v0[i] = a * a; v1[i] = b * b; } }
                    u32x4 w; w.x = cvt_pk_bf16(v0[0], v0[1]); w.y = cvt_pk_bf16(v0[2], v0[3]); w.z = cvt_pk_bf16(v1[0], v1[1]); w.w = cvt_pk_bf16(v1[2], v1[3]);
                    st16_wt(rowp + bj * HALF, w); } }
    }
};
template <bool IN_F32, bool OUT_F32> struct EpiRes {
    static constexpr bool PERM = true, AFTER_DRAIN = false;
    const float* Hin; float* Hout; bf16_t* HB; float* ss;
    __device__ __forceinline__ void operator()(const f32x4 (&acc)[2][2][4][2], const Unit& u, int wr, int wc, int fr, int fq) const {
        const int row0 = u.pm * BM + wr * 64 + fr, col0 = u.pn * BM + wc * 32 + 8 * fq;
#pragma unroll
        for (int ai = 0; ai < 2; ++ai)
#pragma unroll
            for (int m = 0; m < 4; ++m) { const int row = row0 + ai * HALF + m * 16; const size_t off = (size_t)row * 1024 + col0; float q = 0.f;
#pragma unroll
                for (int bj = 0; bj < 2; ++bj) { f32x4 h0, h1;
                    if (IN_F32) { h0 = *(const f32x4*)(Hin + off + bj * HALF); h1 = *(const f32x4*)(Hin + off + bj * HALF + 4); }
                    else { const u32x4 w = *(const u32x4*)(HB + off + bj * HALF);
                        h0 = (f32x4){__builtin_bit_cast(float, w.x << 16), __builtin_bit_cast(float, w.x & 0xffff0000u), __builtin_bit_cast(float, w.y << 16), __builtin_bit_cast(float, w.y & 0xffff0000u)};
                        h1 = (f32x4){__builtin_bit_cast(float, w.z << 16), __builtin_bit_cast(float, w.z & 0xffff0000u), __builtin_bit_cast(float, w.w << 16), __builtin_bit_cast(float, w.w & 0xffff0000u)}; }
                    h0 = h0 + acc[ai][bj][m][0]; h1 = h1 + acc[ai][bj][m][1];
                    q += ((h0[0] * h0[0] + h0[1] * h0[1]) + (h0[2] * h0[2] + h0[3] * h0[3])) + ((h1[0] * h1[0] + h1[1] * h1[1]) + (h1[2] * h1[2] + h1[3] * h1[3]));
                    if (OUT_F32) { st16_wt(Hout + off + bj * HALF, __builtin_bit_cast(u32x4, h0)); st16_wt(Hout + off + bj * HALF + 4, __builtin_bit_cast(u32x4, h1)); }
                    else { u32x4 w; w.x = cvt_pk_bf16(h0[0], h0[1]); w.y = cvt_pk_bf16(h0[2], h0[3]); w.z = cvt_pk_bf16(h1[0], h1[1]); w.w = cvt_pk_bf16(h1[2], h1[3]); st16_wt(HB + off + bj * HALF, w); } }
                q += __shfl_xor(q, 16); q += __shfl_xor(q, 32);
                if (fq == 0) ss[(size_t)row * 16 + u.pn * 4 + wc] = q; }
    }
};

template <class Epi, class Sched, bool ALIGN_EPI = false, bool SP2 = false>
__device__ __forceinline__ void gemm_phase(PG8_LAS unsigned char* lds, const Gemm g, const Sched& S, const Epi& E) {
    const int tid = threadIdx.x, wid = __builtin_amdgcn_readfirstlane(tid >> 6), lane = tid & 63, wr = wid >> 2, wc = wid & 3, fr = lane & 15, fq = lane >> 4;
    const int K = g.K, nt = K / BK;
    unsigned voffA[2], voffB[2];
#pragma unroll
    for (int i = 0; i < 2; ++i) { int R, C; stage_rc(tid * 16 + i * 8192, R, C); const int Rb = Epi::PERM ? ((R & ~31) + perm32(R & 31)) : R;
        voffA[i] = (unsigned)(R * K + C) * 2u; voffB[i] = (unsigned)(Rb * K + C) * 2u; }
    const size_t kstep = (size_t)(BK * 2);
    const size_t hstep = (size_t)HALF * K * 2;
    const size_t tstep = 2 * hstep;
    const unsigned ldsw = (unsigned)wid * 1024u;
    const int aoff = lds_byte(wr * 64 + fr, fq * 8), boff = lds_byte(wc * 32 + fr, fq * 8);
#define PG8_SA(b, h) (((b) * 2 + (h)) * HTB)
#define PG8_SB(b, h) ((4 + (b) * 2 + (h)) * HTB)
#define PG8_STAGE(bufoff, gbase, voff) do { _Pragma("unroll") for (int _i = 0; _i < 2; ++_i) \
        __builtin_amdgcn_global_load_lds((const unsigned*)((const char*)(gbase) + (voff)[_i]), (PG8_LAS unsigned*)(lds + (bufoff) + ldsw + _i * 8192), 16, 0, 0); } while (0)
#define PG8_LDA(dst, b, h) do { _Pragma("unroll") for (int m = 0; m < 4; ++m) _Pragma("unroll") for (int k = 0; k < 2; ++k) dst[m][k] = *(const PG8_LAS bf16x8*)(lds + PG8_SA(b, h) + aoff + m * 2048 + k * 1024); } while (0)
#define PG8_LDB(dst, b, h) do { _Pragma("unroll") for (int n = 0; n < 2; ++n) _Pragma("unroll") for (int k = 0; k < 2; ++k) dst[n][k] = *(const PG8_LAS bf16x8*)(lds + PG8_SB(b, h) + boff + n * 2048 + k * 1024); } while (0)
#define PG8_MMA(ai, bj, At, Bt) do { __builtin_amdgcn_s_setprio(1); _Pragma("unroll") for (int m = 0; m < 4; ++m) _Pragma("unroll") for (int n = 0; n < 2; ++n) _Pragma("unroll") for (int k = 0; k < 2; ++k) \
        acc[ai][bj][m][n] = __builtin_amdgcn_mfma_f32_16x16x32_bf16(Bt[n][k], At[m][k], acc[ai][bj][m][n], 0, 0, 0); __builtin_amdgcn_s_setprio(0); } while (0)
#define PG8_WAIT_V(n) asm volatile("s_waitcnt vmcnt(" #n ")" ::: "memory")
#define PG8_WAIT_L(n) asm volatile("s_waitcnt lgkmcnt(" #n ")" ::: "memory")
#define PG8_BAR __builtin_amdgcn_s_barrier()
#define PG8_SCHED __builtin_amdgcn_sched_barrier(0)
    Unit cur, nxt; int ui = 0;
#ifdef PROBE_GEMM
    float probe_epi_cycles = 0.f, probe_units = 0.f; unsigned long long tph0_; const unsigned long long trl0_ = __builtin_amdgcn_s_memrealtime(); asm volatile("s_memtime %0\n\ts_waitcnt lgkmcnt(0)" : "=s"(tph0_) :: "memory");
#endif
    if (!S.next(0, cur)) return;
    f32x4 acc[2][2][4][2];
#pragma unroll
    for (int a = 0; a < 2; ++a)
#pragma unroll
        for (int b = 0; b < 2; ++b)
#pragma unroll
            for (int m = 0; m < 4; ++m)
#pragma unroll
                for (int n = 0; n < 2; ++n) acc[a][b][m][n] = (f32x4){0.f, 0.f, 0.f, 0.f};
    bf16x8 At[4][2], B0[2][2], B1[2][2];
    const char* cA = (const char*)g.A + (size_t)cur.pm * tstep; const char* cB = (const char*)g.Bt + (size_t)cur.pn * tstep;
    S.a_ready(cur);
    if constexpr (SP2) {
        PG8_STAGE(PG8_SB(0, 0), cB, voffB); PG8_STAGE(PG8_SB(0, 1), cB + hstep, voffB); PG8_STAGE(PG8_SA(0, 0), cA, voffA); PG8_STAGE(PG8_SA(0, 1), cA + hstep, voffA);
        if (wr == 1) PG8_BAR;
        PG8_WAIT_V(2); PG8_BAR;
        PG8_STAGE(PG8_SB(1, 0), cB + kstep, voffB); PG8_STAGE(PG8_SA(1, 0), cA + kstep, voffA); PG8_STAGE(PG8_SB(1, 1), cB + hstep + kstep, voffB);
        PG8_WAIT_V(6); PG8_BAR;
    } else {
        PG8_STAGE(PG8_SB(0, 0), cB, voffB); PG8_STAGE(PG8_SA(0, 0), cA, voffA); PG8_STAGE(PG8_SB(0, 1), cB + hstep, voffB); PG8_STAGE(PG8_SA(0, 1), cA + hstep, voffA);
        if (wr == 1) PG8_BAR;
        PG8_WAIT_V(4); PG8_BAR;
        PG8_STAGE(PG8_SB(1, 0), cB + kstep, voffB); PG8_STAGE(PG8_SA(1, 0), cA + kstep, voffA); PG8_STAGE(PG8_SB(1, 1), cB + hstep + kstep, voffB);
        PG8_WAIT_V(6); PG8_BAR;
    }
    for (;;) {
        const bool has_next = S.next(ui + 1, nxt);
        const char* nA = has_next ? (const char*)g.A + (size_t)nxt.pm * tstep : cA; const char* nB = has_next ? (const char*)g.Bt + (size_t)nxt.pn * tstep : cB;
        for (int t = 0; t < nt; t += 2) {
            const bool last = (t == nt - 2);
            const char* a1 = cA + (size_t)(t + 1) * kstep;
            const char* a2 = last ? nA : cA + (size_t)(t + 2) * kstep; const char* b2 = last ? nB : cB + (size_t)(t + 2) * kstep;
            const char* a3 = a2 + kstep; const char* b3 = b2 + kstep;
            if (last && has_next) S.a_ready(nxt);
            if constexpr (SP2) {
            PG8_LDB(B0, 0, 0); PG8_LDB(B1, 0, 1); PG8_SCHED; PG8_LDA(At, 0, 0); PG8_STAGE(PG8_SA(1, 1), a1 + hstep, voffA);
            PG8_WAIT_V(8); PG8_WAIT_L(0); PG8_BAR; PG8_MMA(0, 0, At, B0); PG8_MMA(0, 1, At, B1); PG8_BAR; PG8_SCHED;
            PG8_LDA(At, 0, 1); PG8_STAGE(PG8_SB(0, 0), b2, voffB); PG8_STAGE(PG8_SB(0, 1), b2 + hstep, voffB); PG8_STAGE(PG8_SA(0, 0), a2, voffA);
            PG8_WAIT_V(8); PG8_WAIT_L(0); PG8_BAR; PG8_MMA(1, 0, At, B0); PG8_MMA(1, 1, At, B1); PG8_BAR; PG8_SCHED;
            PG8_LDB(B0, 1, 0); PG8_LDB(B1, 1, 1); PG8_SCHED; PG8_LDA(At, 1, 0); PG8_STAGE(PG8_SA(0, 1), a2 + hstep, voffA);
            PG8_WAIT_V(8); PG8_WAIT_L(0); PG8_BAR; PG8_MMA(0, 0, At, B0); PG8_MMA(0, 1, At, B1); PG8_BAR; PG8_SCHED;
            PG8_LDA(At, 1, 1); PG8_STAGE(PG8_SB(1, 0), b3, voffB); PG8_STAGE(PG8_SB(1, 1), b3 + hstep, voffB); PG8_STAGE(PG8_SA(1, 0), a3, voffA);
            PG8_WAIT_V(8); PG8_WAIT_L(0); PG8_BAR; PG8_MMA(1, 0, At, B0); PG8_MMA(1, 1, At, B1); PG8_BAR; PG8_SCHED;
            } else {
            PG8_LDB(B0, 0, 0); PG8_SCHED; PG8_LDA(At, 0, 0); PG8_STAGE(PG8_SA(1, 1), a1 + hstep, voffA);
            PG8_WAIT_L(8); PG8_BAR; PG8_WAIT_L(0); PG8_MMA(0, 0, At, B0); PG8_BAR; PG8_SCHED;
            PG8_LDB(B1, 0, 1); PG8_STAGE(PG8_SB(0, 0), b2, voffB);
            PG8_BAR; PG8_WAIT_L(0); PG8_MMA(0, 1, At, B1); PG8_BAR;
            PG8_LDA(At, 0, 1); PG8_STAGE(PG8_SA(0, 0), a2, voffA);
            PG8_BAR; PG8_WAIT_L(0); PG8_MMA(1, 0, At, B0); PG8_BAR; PG8_SCHED;
            PG8_STAGE(PG8_SB(0, 1), b2 + hstep, voffB);
            PG8_WAIT_V(6); PG8_BAR; PG8_MMA(1, 1, At, B1); PG8_BAR;
            PG8_LDB(B0, 1, 0); PG8_SCHED; PG8_LDA(At, 1, 0); PG8_STAGE(PG8_SA(0, 1), a2 + hstep, voffA);
            PG8_WAIT_L(8); PG8_BAR; PG8_WAIT_L(0); PG8_MMA(0, 0, At, B0); PG8_BAR; PG8_SCHED;
            PG8_LDB(B1, 1, 1); PG8_STAGE(PG8_SB(1, 0), b3, voffB);
            PG8_BAR; PG8_WAIT_L(0); PG8_MMA(0, 1, At, B1); PG8_BAR;
            PG8_LDA(At, 1, 1); PG8_STAGE(PG8_SA(1, 0), a3, voffA);
            PG8_BAR; PG8_WAIT_L(0); PG8_MMA(1, 0, At, B0); PG8_BAR; PG8_SCHED;
            PG8_STAGE(PG8_SB(1, 1), b3 + hstep, voffB);
            PG8_WAIT_V(6); PG8_BAR; PG8_MMA(1, 1, At, B1); PG8_BAR;
            }
        }
        if constexpr (ALIGN_EPI) { if (wr == 0) PG8_BAR; }
#ifdef PROBE_GEMM
        unsigned long long tg0_; asm volatile("s_memtime %0\n\ts_waitcnt lgkmcnt(0)" : "=s"(tg0_) :: "memory");
#endif
        if constexpr (!Epi::AFTER_DRAIN) { E(acc, cur, wr, wc, fr, fq); S.done(cur); }
#ifdef PROBE_GEMM
        { unsigned long long tg1_; asm volatile("s_waitcnt vmcnt(0)\n\ts_memtime %0\n\ts_waitcnt lgkmcnt(0)" : "=s"(tg1_) :: "memory"); probe_epi_cycles += (float)(tg1_ - tg0_); probe_units += 1.f; }
#endif
        if (!has_next) break;
#pragma unroll
        for (int a = 0; a < 2; ++a)
#pragma unroll
            for (int b = 0; b < 2; ++b)
#pragma unroll
                for (int m = 0; m < 4; ++m)
#pragma unroll
                    for (int n = 0; n < 2; ++n) acc[a][b][m][n] = (f32x4){0.f, 0.f, 0.f, 0.f};
        cur = nxt; cA = nA; cB = nB; ++ui;
        if constexpr (ALIGN_EPI) { if (wr == 1) PG8_BAR; }
    }
#ifdef PROBE_GEMM
    if (g.N == PROBE_GEMM_N && g.K == PROBE_GEMM_K) { unsigned long long tph1_; asm volatile("s_memtime %0\n\ts_waitcnt lgkmcnt(0)" : "=s"(tph1_) :: "memory");
        if (blockIdx.x == 0 && tid == 0) { ((volatile PG8_LAS float*)(lds + 162112))[17] = (PROBE_GEMM == 1) ? probe_epi_cycles / probe_units : (PROBE_GEMM == 2) ? (float)(tph1_ - tph0_) / probe_units : (PROBE_GEMM == 3) ? (float)(tph1_ - tph0_) / (float)(__builtin_amdgcn_s_memrealtime() - trl0_) * 100.0f : (float)(__builtin_amdgcn_s_memrealtime() - trl0_) * 0.01f; } }
#endif
    PG8_WAIT_V(0);
    if constexpr (!ALIGN_EPI) { if (wr == 0) PG8_BAR; }
    PG8_BAR;
    if constexpr (Epi::AFTER_DRAIN) { E.fused(acc, cur, wr, wc, fr, fq, lds, wid, lane); S.done(cur); }
#undef PG8_SA
#undef PG8_SB
#undef PG8_STAGE
#undef PG8_LDA
#undef PG8_LDB
#undef PG8_MMA
#undef PG8_WAIT_V
#undef PG8_WAIT_L
#undef PG8_BAR
#undef PG8_SCHED
}
}

#ifndef PG8_SP2
#define PG8_SP2 true
#endif
#ifndef PG8_ALIGN
#define PG8_ALIGN true
#endif
constexpr int NB = 16, SEQ = 2048, NMETA = 16, D = 1024, FF = 4096;
constexpr int MR = NB * SEQ;
constexpr int NH = 8, DQK = 64, DV = 128;
constexpr int NPROJ = 3072;
constexpr float EPS = 1e-6f, SUBLN_EPS = 1e-5f;
constexpr int NWAVES = 8;
#ifndef MK_N_LAUNCHES
#define MK_N_LAUNCHES 1
#endif
constexpr int NPHASE = 12;

constexpr size_t MiB = 1u << 20;
constexpr size_t WS_CTL = 0, CTL_ZERO_BYTES = 1 * MiB;
constexpr size_t WS_WIN0 = 1 * MiB, WS_WOUT0 = 7 * MiB, WS_WUP0 = 9 * MiB, WS_WDN0 = 17 * MiB;
constexpr size_t WS_WIN1 = 25 * MiB, WS_WOUT1 = 31 * MiB, WS_WUP1 = 33 * MiB, WS_WDN1 = 41 * MiB;
constexpr size_t WS_META = 49 * MiB;
constexpr size_t WS_HMETA = WS_META;
constexpr size_t WS_HBM = WS_HMETA + 16 * D * 4;
constexpr size_t WS_PM = WS_HBM + 16 * D * 2;
constexpr size_t WS_MIXM = WS_PM + 16 * NPROJ * 2;
constexpr size_t WS_UM = WS_MIXM + 16 * D * 2;
constexpr size_t WS_GATESM = WS_UM + 16 * FF * 2;
constexpr size_t WS_SS = 50 * MiB;
constexpr size_t WS_GATES = 52 * MiB;
constexpr size_t WS_HB = 54 * MiB;
constexpr size_t WS_P = 118 * MiB;
constexpr size_t WS_MIX = 310 * MiB;
constexpr size_t WS_U = WS_P;
constexpr size_t WS_GSC = 374 * MiB;
constexpr size_t WS_END = 378 * MiB;
static_assert(WS_GATESM + 1024 <= WS_SS && WS_HB + (size_t)MR * D * 2 <= WS_P && WS_P + (size_t)MR * NPROJ * 2 <= WS_MIX && WS_U + (size_t)MR * FF * 2 <= WS_END && WS_MIX + (size_t)MR * D * 2 <= WS_GSC, "d_ws map");
constexpr int CW_BAR = 4096;
constexpr int CW_SSM = 16384;

constexpr int RING_OFF = 0, RING_BYTES = 131072;
constexpr int XTRA_OFF = RING_BYTES, XTRA_BYTES = 30720;
constexpr int LDSCTL_OFF = XTRA_OFF + XTRA_BYTES, MISC_OFF = LDSCTL_OFF + 320;
constexpr int LDS_BYTES = 163840;
static_assert(MISC_OFF + 128 <= LDS_BYTES, "LDS map");

#define GAS __attribute__((address_space(1)))
#define LAS __attribute__((address_space(3)))
typedef unsigned short bf16;
typedef unsigned v4u __attribute__((ext_vector_type(4)));
typedef float f32x4 __attribute__((ext_vector_type(4)));
typedef GAS unsigned gu32;
#define RLX_AGENT __ATOMIC_RELAXED, __HIP_MEMORY_SCOPE_AGENT
#define LDS_WAIT() asm volatile("s_waitcnt lgkmcnt(0)" ::: "memory")
__device__ __forceinline__ unsigned f2bf(float f) { unsigned u = __builtin_bit_cast(unsigned, f); return (u + 0x7fffu + ((u >> 16) & 1u)) >> 16; }
__device__ __forceinline__ unsigned pk2(float lo, float hi) { return f2bf(lo) | (f2bf(hi) << 16); }
__device__ __forceinline__ float bf2f(unsigned short v) { return __builtin_bit_cast(float, (unsigned)v << 16); }
__device__ __forceinline__ float bflo(unsigned w) { return __builtin_bit_cast(float, w << 16); }
__device__ __forceinline__ float bfhi(unsigned w) { return __builtin_bit_cast(float, w & 0xffff0000u); }

#define XB_TMO      128
#define XB_XCNT(j)  (256  + 64 * (j))
#define XB_XSUB(j)  (1280 + 64 * (j))
#define XB_XGEN(j)  (2304 + 64 * (j))
#define XB_TOP      3328
#define XB_TOPGEN   3392
#define XCD_BAR_WORDS 3456
#define XB_SPIN_CAP (1u << 18)
__device__ __forceinline__ unsigned xb_ld(unsigned* p)              { return __hip_atomic_load(p, __ATOMIC_RELAXED, __HIP_MEMORY_SCOPE_AGENT); }
__device__ __forceinline__ unsigned xb_add(unsigned* p, unsigned v) { return __hip_atomic_fetch_add(p, v, __ATOMIC_RELAXED, __HIP_MEMORY_SCOPE_AGENT); }
__device__ __forceinline__ unsigned xb_xcc_id() { return (unsigned)__builtin_amdgcn_s_getreg((3 << 11) | 20) & 0xFu; }
#define XB_SPIN(cond, bar) do { unsigned _sp = 0; while (cond) { __builtin_amdgcn_s_sleep(1); \
    if ((++_sp & 255u) == 0u) { if (xb_ld(&(bar)[XB_TMO])) break; if (_sp > XB_SPIN_CAP) { atomicAdd(&(bar)[XB_TMO], 1u); break; } } } } while (0)
struct XcdBarrier { unsigned* bar; unsigned x; volatile LAS unsigned* st; };
__device__ __forceinline__ XcdBarrier xcd_barrier_post(unsigned* bar, volatile LAS unsigned* st) {
    XcdBarrier b; b.bar = bar; b.x = xb_xcc_id(); b.st = st;
    if (threadIdx.x == 0) (void)xb_add(&bar[XB_XCNT(b.x)], 1u);
    return b;
}
__device__ __forceinline__ void xcd_barrier_complete(unsigned* bar, unsigned x, unsigned& nloc, unsigned& nx) {
    const unsigned G = gridDim.x * gridDim.y * gridDim.z;
    unsigned sum, cnt, mine, sp = 0u;
    for (;;) {
        sum = 0u; cnt = 0u; mine = 0u;
#pragma unroll
        for (unsigned j = 0; j < 16; ++j) { const unsigned c = xb_ld(&bar[XB_XCNT(j)]); sum += c; cnt += (c > 0u) ? 1u : 0u; mine = (j == x) ? c : mine; }
        if (sum == G) break;
        __builtin_amdgcn_s_sleep(1);
        if ((++sp & 255u) == 0u) { if (xb_ld(&bar[XB_TMO])) break; if (sp > XB_SPIN_CAP) { atomicAdd(&bar[XB_TMO], 1u); break; } }
    }
    nloc = mine > 0u ? mine : 1u; nx = cnt > 0u ? cnt : 1u;
}
__device__ __forceinline__ void xcd_barrier(const XcdBarrier& b) {
    asm volatile("s_waitcnt vmcnt(0)" ::: "memory");
    __syncthreads();
    if (threadIdx.x == 0) {
        unsigned* bar = b.bar;
        __builtin_amdgcn_s_waitcnt(0);
        unsigned nloc = b.st[0], nx = b.st[1];
        if (nloc == 0u) { xcd_barrier_complete(bar, b.x, nloc, nx); b.st[0] = nloc; b.st[1] = nx; }
        const unsigned old = xb_add(&bar[XB_XSUB(b.x)], 1u);
        const unsigned gen = old / nloc;
        if (old + 1u == (gen + 1u) * nloc) {
            __builtin_amdgcn_fence(__ATOMIC_RELEASE, "agent");
            asm volatile("s_waitcnt vmcnt(0)" ::: "memory");
            const unsigned og = xb_add(&bar[XB_TOP], 1u);
            const unsigned tg = og / nx;
            if (og + 1u == (tg + 1u) * nx) xb_add(&bar[XB_TOPGEN], 1u);
            else XB_SPIN(xb_ld(&bar[XB_TOPGEN]) == tg, bar);
            __builtin_amdgcn_fence(__ATOMIC_ACQUIRE, "agent");
            xb_add(&bar[XB_XGEN(b.x)], 1u);
            asm volatile("s_waitcnt vmcnt(0)" ::: "memory");
        } else {
            XB_SPIN(xb_ld(&bar[XB_XGEN(b.x)]) == gen, bar);
            __builtin_amdgcn_fence(__ATOMIC_ACQUIRE, "agent");
            asm volatile("s_waitcnt vmcnt(0)" ::: "memory");
        }
    }
    __syncthreads();
}

struct Frame {
    LAS unsigned char* lds;
    volatile LAS unsigned* MISC;
    gu32* ctl;
    int tid, lane, wave, vcu, G;
    const float *x, *meta, *ngain, *m_win, *m_bgate, *m_hgain, *m_wout, *d_win, *d_lam, *d_hgain, *d_wout, *w_up, *w_dn, *fgain;
    float* out; unsigned char* ws;
    bf16 *WIN0, *WOUT0, *WUP0, *WDN0, *WIN1, *WOUT1, *WUP1, *WDN1, *HB, *P, *MIX, *U;
    float *SS, *GATES, *GSC;
    bf16 *HBM, *PM, *MIXM, *UM; float *HMETA, *GATESM, *SSM;
};
__device__ __forceinline__ float wave_sum(float v) {
#pragma unroll
    for (int o = 1; o < 64; o <<= 1) v += __shfl_xor(v, o);
    return v;
}
typedef short bf16x8_t __attribute__((ext_vector_type(8)));
__device__ __forceinline__ f32x4 mfma16(bf16x8_t a, bf16x8_t b, f32x4 c) { return __builtin_amdgcn_mfma_f32_16x16x32_bf16(a, b, c, 0, 0, 0); }
__device__ __forceinline__ void transpose_item(const float* W, int K, int ldw, int Nuse, const float* gk, int nscale, float qscale, bf16* WT, LAS float* scr, int item, int lane) {
    const int nblk = Nuse / 32, kb = item / nblk, nb = item % nblk, k0 = 64 * kb, n0 = 32 * nb;
    const float cs = (n0 < nscale) ? qscale : 1.f;
    const int lr = lane >> 3, lp = lane & 7;
#pragma unroll
    for (int i = 0; i < 8; ++i) { const int kk = 8 * i + lr; const float g = gk ? gk[k0 + kk] * cs : cs; const f32x4 v = *(const GAS f32x4*)(W + (size_t)(k0 + kk) * ldw + n0 + 4 * lp);
        LAS float* d = scr + kk * 33 + 4 * lp; d[0] = v.x * g; d[1] = v.y * g; d[2] = v.z * g; d[3] = v.w * g; }
    LDS_WAIT(); asm volatile("" ::: "memory");
    const int c = lane & 7;
#pragma unroll
    for (int j = 0; j < 4; ++j) { const int n = (lane >> 3) + 8 * j; const LAS float* s = scr + (8 * c) * 33 + n;
        v4u o; o.x = pg8::cvt_pk_bf16(s[0 * 33], s[1 * 33]); o.y = pg8::cvt_pk_bf16(s[2 * 33], s[3 * 33]); o.z = pg8::cvt_pk_bf16(s[4 * 33], s[5 * 33]); o.w = pg8::cvt_pk_bf16(s[6 * 33], s[7 * 33]);
        *(GAS v4u*)(WT + (size_t)(n0 + n) * K + k0 + 8 * c) = o; }
    LDS_WAIT(); asm volatile("" ::: "memory");
}
constexpr int I_IN = (D / 64) * (NPROJ / 32), I_OUT = (D / 64) * (D / 32), I_UP = (D / 64) * (FF / 32), I_DN = (FF / 64) * (D / 32);
constexpr int I_LAYER = I_IN + I_OUT + I_UP + I_DN, NITEMS = 2 * I_LAYER;
__device__ __forceinline__ void convert_weights(Frame& F, int it0, int it1, int gw, int ngw, LAS float* scr) {
    for (int it = it0 + gw; it < it1; it += ngw) {
        const int layer = it / I_LAYER; int r = it % I_LAYER;
        const float* g0 = F.ngain + (layer * 2 + 0) * D; const float* g1 = F.ngain + (layer * 2 + 1) * D;
        if (r < I_IN) { if (layer == 0) transpose_item(F.m_win, D, 3088, NPROJ, g0, 512, 0.125f, F.WIN0, scr, r, F.lane); else transpose_item(F.d_win, D, NPROJ, NPROJ, g0, 1024, 0.125f * 1.4426950408889634f, F.WIN1, scr, r, F.lane);   continue; } r -= I_IN;
        if (r < I_OUT) { transpose_item(layer == 0 ? F.m_wout : F.d_wout, D, D, D, nullptr, 0, 1.f, layer == 0 ? F.WOUT0 : F.WOUT1, scr, r, F.lane); continue; } r -= I_OUT;
        if (r < I_UP) { transpose_item(F.w_up + (size_t)layer * D * FF, D, FF, FF, g1, 0, 1.f, layer == 0 ? F.WUP0 : F.WUP1, scr, r, F.lane); continue; } r -= I_UP;
        transpose_item(F.w_dn + (size_t)layer * FF * D, FF, D, D, nullptr, 0, 1.f, layer == 0 ? F.WDN0 : F.WDN1, scr, r, F.lane);
    }
}
constexpr int WGSTR = 2048 + 16;
__device__ __forceinline__ void embed_group(Frame& F, const float* src, bf16* hb, float* ssd, int ss_stride, float* gd, const LAS unsigned char* wgl) {
    const int li = F.lane & 15, g = F.lane >> 4;
    const float* sp = src + (size_t)li * D + 8 * g; bf16* hp = hb + (size_t)li * D + 8 * g; const LAS unsigned char* wp = wgl + li * WGSTR + 16 * g;
    f32x4 acc = (f32x4){0.f, 0.f, 0.f, 0.f}; float ssp = 0.f;
#pragma unroll 8
    for (int ks = 0; ks < 32; ++ks) {
        const f32x4 a0 = *(const GAS f32x4*)(sp + 32 * ks), a1 = *(const GAS f32x4*)(sp + 32 * ks + 4);
        ssp += ((a0.x * a0.x + a0.y * a0.y) + (a0.z * a0.z + a0.w * a0.w)) + ((a1.x * a1.x + a1.y * a1.y) + (a1.z * a1.z + a1.w * a1.w));
        v4u pw; pw.x = pg8::cvt_pk_bf16(a0.x, a0.y); pw.y = pg8::cvt_pk_bf16(a0.z, a0.w); pw.z = pg8::cvt_pk_bf16(a1.x, a1.y); pw.w = pg8::cvt_pk_bf16(a1.z, a1.w);
        *(GAS v4u*)(hp + 32 * ks) = pw;
        acc = mfma16(__builtin_bit_cast(bf16x8_t, pw), *(const LAS bf16x8_t*)(wp + 64 * ks), acc);
    }
    ssp += __shfl_xor(ssp, 16); ssp += __shfl_xor(ssp, 32);
    const float rstd = 1.0f / sqrtf(ssp * (1.0f / D) + EPS);
    if (g == 0) ssd[(size_t)li * ss_stride] = ssp;
    const float bg = F.m_bgate[li];
#pragma unroll
    for (int r = 0; r < 4; ++r) { const float rs = __shfl(rstd, 4 * g + r); gd[(size_t)(4 * g + r) * 16 + li] = acc[r] * rs + bg; }
}
__device__ __forceinline__ void p0_prologue(Frame& F) {
#ifdef PROBE_P0
    const unsigned long long tp0_ = __builtin_amdgcn_s_memrealtime();
#define P0STAMP(k) do { if (PROBE_P0 == (k) && blockIdx.x == 0 && F.tid == 0) ((volatile LAS float*)F.MISC)[17] = (float)(__builtin_amdgcn_s_memrealtime() - tp0_) * 0.01f; } while (0)
#else
#define P0STAMP(k) do {} while (0)
#endif
    LAS float* scr = (LAS float*)(F.lds + RING_OFF + F.wave * 16384);
    const int gw = F.vcu * NWAVES + F.wave, NGW = F.G * NWAVES;
    convert_weights(F, 0, I_IN, gw, NGW, scr);
    __syncthreads();
    P0STAMP(1);
    LAS unsigned char* wgl = F.lds + RING_OFF;
    for (int i = F.tid; i < 16 * D; i += NWAVES * 64) { const int k = i >> 4, j = i & 15; *(LAS bf16*)(wgl + j * WGSTR + k * 2) = (bf16)f2bf(F.m_win[(size_t)k * 3088 + NPROJ + j] * F.ngain[k]); }
    __syncthreads();
    P0STAMP(2);
    for (int grp = gw; grp < MR / 16; grp += NGW) embed_group(F, F.x + (size_t)grp * 16 * D, F.HB + (size_t)grp * 16 * D, F.SS + (size_t)grp * 16 * 16, 16, F.GATES + (size_t)grp * 16 * 16, wgl);
    if (gw < 16) {
        const int row = gw; const float* src = F.meta + (size_t)row * D;
        f32x4 v[4]; float s = 0.f;
#pragma unroll
        for (int j = 0; j < 4; ++j) { v[j] = ((const GAS f32x4*)src)[64 * j + F.lane]; s += (v[j].x * v[j].x + v[j].y * v[j].y) + (v[j].z * v[j].z + v[j].w * v[j].w); }
        s = wave_sum(s);
        const float rstd = 1.0f / sqrtf(s * (1.0f / D) + EPS);
#pragma unroll
        for (int j = 0; j < 4; ++j) ((GAS unsigned long long*)(F.HBM + (size_t)row * D))[64 * j + F.lane] = (unsigned long long)pg8::cvt_pk_bf16(v[j].x, v[j].y) | ((unsigned long long)pg8::cvt_pk_bf16(v[j].z, v[j].w) << 32);
        if (F.lane == 0) F.SSM[(size_t)row * 64] = s;
        float keep = 0.f;
#pragma unroll 4
        for (int gt = 0; gt < 16; ++gt) { float p = 0.f;
#pragma unroll
            for (int j = 0; j < 4; ++j) { typedef unsigned u32x2 __attribute__((ext_vector_type(2))); const u32x2 w = *(const LAS u32x2*)(wgl + gt * WGSTR + (256 * j + 4 * F.lane) * 2);
                p += (v[j].x * bflo(w.x) + v[j].y * bfhi(w.x)) + (v[j].z * bflo(w.y) + v[j].w * bfhi(w.y)); }
            p = wave_sum(p); if (F.lane == gt) keep = p; }
        if (F.lane < 16) F.GATESM[(size_t)row * 16 + F.lane] = keep * rstd + F.m_bgate[F.lane];
    }
    P0STAMP(3);
}
__device__ __forceinline__ float meta_rstd(const float* ssm, int lane) {
    float mine = 0.f;
#pragma unroll 4
    for (int r = 0; r < 16; ++r) { const float s = wave_sum(ssm[r * 64 + lane]); if (lane == r) mine = 1.0f / sqrtf(s * (1.0f / D) + EPS); }
    return mine;
}
template <int ACT> struct MEpiScale {
    bf16* O; int ldc; const float* ssm;
    __device__ __forceinline__ void operator()(int cb, int li, int g, int lane, const float (&v)[4]) const {
        const float mine = meta_rstd(ssm, lane);
#pragma unroll
        for (int r = 0; r < 4; ++r) { float x = v[r] * __shfl(mine, 4 * g + r); if (ACT == 1) { x = fmaxf(x, 0.f); x = x * x; } O[(size_t)(4 * g + r) * ldc + 16 * cb + li] = (bf16)f2bf(x); }
    }
};
struct MEpiRes {
    const float* Hin; float* H; bf16* HB; float* ssm;
    __device__ __forceinline__ void operator()(int cb, int li, int g, int lane, const float (&v)[4]) const {
#pragma unroll
        for (int r = 0; r < 4; ++r) { const int row = 4 * g + r; const float hv = Hin[(size_t)row * D + 16 * cb + li] + v[r]; H[(size_t)row * D + 16 * cb + li] = hv; HB[(size_t)row * D + 16 * cb + li] = (bf16)f2bf(hv);
            float q = hv * hv; q += __shfl_xor(q, 1); q += __shfl_xor(q, 2); q += __shfl_xor(q, 4); q += __shfl_xor(q, 8);
            if (li == 0) ssm[row * 64 + cb] = q; }
    }
};
template <class MEpi> __device__ __forceinline__ void meta_gemm(Frame& F, const bf16* A, const bf16* Bt, int cb0, int cb1, int K, const MEpi& E) {
    LAS float* red = (LAS float*)(F.lds + XTRA_OFF);
    const int li = F.lane & 15, g = F.lane >> 4, kw = K / NWAVES;
    for (int cb = cb0 + (int)blockIdx.x; cb < cb1; cb += F.G) {
        const bf16* ap = A + (size_t)li * K + F.wave * kw + 8 * g; const bf16* bp = Bt + (size_t)(16 * cb + li) * K + F.wave * kw + 8 * g;
        f32x4 acc = (f32x4){0.f, 0.f, 0.f, 0.f};
#pragma unroll 4
        for (int ks = 0; ks < kw / 32; ++ks) acc = mfma16(*(const GAS bf16x8_t*)(ap + 32 * ks), *(const GAS bf16x8_t*)(bp + 32 * ks), acc);
#pragma unroll
        for (int r = 0; r < 4; ++r) red[F.wave * 256 + r * 64 + F.lane] = acc[r];
        __syncthreads();
        if (F.wave == 0) { float v[4];
#pragma unroll
            for (int r = 0; r < 4; ++r) { float s = 0.f;
#pragma unroll
                for (int ww = 0; ww < NWAVES; ++ww) s += red[ww * 256 + r * 64 + F.lane]; v[r] = s; }
            E(cb, li, g, F.lane, v); }
        __syncthreads();
    }
}
__device__ __forceinline__ void final_norm_phase(Frame& F) {
    const int gw = F.vcu * NWAVES + F.wave, NGW = F.G * NWAVES;
    for (int row = gw; row < MR; row += NGW) {
        const float rs = pg8::row_rstd<16>(F.SS, row, EPS);
        const GAS v4u* hp = (const GAS v4u*)(F.HB + (size_t)row * D); GAS f32x4* op = (GAS f32x4*)(F.out + (size_t)row * D);
#pragma unroll
        for (int j = 0; j < 2; ++j) { const v4u w = hp[64 * j + F.lane]; const int c = 8 * (64 * j + F.lane);
            const f32x4 g0 = *(const GAS f32x4*)(F.fgain + c), g1 = *(const GAS f32x4*)(F.fgain + c + 4);
            op[2 * (64 * j + F.lane)] = (f32x4){bflo(w.x) * rs * g0.x, bfhi(w.x) * rs * g0.y, bflo(w.y) * rs * g0.z, bfhi(w.y) * rs * g0.w};
            op[2 * (64 * j + F.lane) + 1] = (f32x4){bflo(w.z) * rs * g1.x, bfhi(w.z) * rs * g1.y, bflo(w.w) * rs * g1.z, bfhi(w.w) * rs * g1.w}; }
    }
}
namespace attn3 {
typedef short bf16x8 __attribute__((ext_vector_type(8)));
typedef short s16x4 __attribute__((ext_vector_type(4)));
typedef float f32x16 __attribute__((ext_vector_type(16)));
constexpr int KSTR = 256, VSTR = 256, KBYTES = 64 * KSTR, VBYTES = 64 * VSTR, BUFB = KBYTES + VBYTES, NBUF = 3;
constexpr int CBS = 129;
constexpr int OBS = 272;
constexpr float THR = 16.0f;
static_assert(NBUF * BUFB + 8 * 4096 <= RING_BYTES + XTRA_BYTES && 4 * 32 * CBS * 4 + 4 * 32 * OBS <= RING_BYTES + XTRA_BYTES, "attention LDS map");
__device__ __forceinline__ constexpr int crow0(int r) { return (r & 3) + 8 * (r >> 2); }
__device__ __forceinline__ s16x4 vtr(const LAS unsigned char* p) { return __builtin_bit_cast(s16x4, __builtin_amdgcn_ds_read_tr16_b64_v4i16((LAS s16x4*)p)); }
__device__ __forceinline__ bf16x8 pack8(const f32x16& p, int b0) {
    v4u w; w.x = pg8::cvt_pk_bf16(p[b0], p[b0 + 1]); w.y = pg8::cvt_pk_bf16(p[b0 + 2], p[b0 + 3]); w.z = pg8::cvt_pk_bf16(p[b0 + 4], p[b0 + 5]); w.w = pg8::cvt_pk_bf16(p[b0 + 6], p[b0 + 7]);
    return __builtin_bit_cast(bf16x8, w);
}
__device__ __forceinline__ float xmax32(float a) { auto rr = __builtin_amdgcn_permlane32_swap(__float_as_uint(a), __float_as_uint(a), false, false); return fmaxf(__uint_as_float(rr[0]), __uint_as_float(rr[1])); }
__device__ __forceinline__ float xsum32(float a) { auto rr = __builtin_amdgcn_permlane32_swap(__float_as_uint(a), __float_as_uint(a), false, false); return __uint_as_float(rr[0]) + __uint_as_float(rr[1]); }
#define ATT_SBAR() __builtin_amdgcn_sched_barrier(0)
__device__ __forceinline__ void glds16(const void* gsrc, unsigned lds_dst) { unsigned keep;
    asm volatile("s_mov_b32 %0, m0\n\ts_mov_b32 m0, %2\n\ts_nop 0\n\tglobal_load_lds_dwordx4 %1, off\n\ts_mov_b32 m0, %0" : "=&s"(keep) : "v"(gsrc), "s"(lds_dst) : "memory"); }
#define ATT_DMA_WAIT() asm volatile("s_waitcnt vmcnt(0)" ::: "memory")
template <bool DO_PV, bool DO_SM, bool FIRST>
__device__ __forceinline__ void step(f32x16 (&o)[4], f32x16& p0, f32x16& p1, bf16x8 (&pf)[4], float& m, float& l, const LAS unsigned char* vbase) {
    s16x4 vl[4], vh[4]; float mx0 = 0.f, mx1 = 0.f, mx2 = 0.f, ls = 0.f, fsc = 1.f; bool resc = false;
#define ATT_VRD(i) do { vl[(i) & 3] = vtr(vbase + (4 * ((i) & 3)) * 1024 + ((i) >> 2) * 256); vh[(i) & 3] = vtr(vbase + (4 * ((i) & 3) + 2) * 1024 + ((i) >> 2) * 256); } while (0)
    if (DO_PV) { ATT_VRD(0); ATT_VRD(1); ATT_VRD(2); }
#pragma unroll
    for (int i = 0; i < 16; ++i) {
        if (DO_PV) {
            if (i + 3 < 16) ATT_VRD(i + 3);
            const bf16x8 vf = __builtin_shufflevector(vl[i & 3], vh[i & 3], 0, 1, 2, 3, 4, 5, 6, 7);
            o[i >> 2] = __builtin_amdgcn_mfma_f32_32x32x16_bf16(vf, pf[i & 3], o[i >> 2], 0, 0, 0);
        }
        if (DO_SM) {
            if (i == 0) { mx0 = fmaxf(fmaxf(p0[0], p0[1]), p0[2]); mx0 = fmaxf(fmaxf(mx0, p0[3]), p0[4]); mx0 = fmaxf(fmaxf(mx0, p0[5]), p0[6]); mx0 = fmaxf(fmaxf(mx0, p0[7]), p0[8]); }
            else if (i == 1) { mx1 = fmaxf(fmaxf(p0[9], p0[10]), p0[11]); mx1 = fmaxf(fmaxf(mx1, p0[12]), p0[13]); mx1 = fmaxf(fmaxf(mx1, p0[14]), p0[15]); mx1 = fmaxf(fmaxf(mx1, p1[0]), p1[1]); }
            else if (i == 2) { mx2 = fmaxf(fmaxf(p1[2], p1[3]), p1[4]); mx2 = fmaxf(fmaxf(mx2, p1[5]), p1[6]); mx2 = fmaxf(fmaxf(mx2, p1[7]), p1[8]); mx2 = fmaxf(fmaxf(mx2, p1[9]), p1[10]); }
            else if (i == 3) {
                float mx3 = fmaxf(fmaxf(p1[11], p1[12]), p1[13]); mx3 = fmaxf(fmaxf(mx3, p1[14]), p1[15]); mx3 = fmaxf(fmaxf(mx3, mx0), mx1);
                const float rm = xmax32(fmaxf(mx3, mx2));
                if (FIRST ? __any(fabsf(rm) > 32.0f) : __any(rm > THR)) {
                    const float dl = FIRST ? rm : fmaxf(rm, 0.f); m += dl;
                    if (!FIRST) { fsc = __builtin_amdgcn_exp2f(-dl); l *= fsc; resc = true; }
#pragma unroll
                    for (int r = 0; r < 16; ++r) { p0[r] -= dl; p1[r] -= dl; }
                }
            }
            else if (i < 8) {
#pragma unroll
                for (int r = 4 * (i - 4); r < 4 * (i - 4) + 4; ++r) { p0[r] = __builtin_amdgcn_exp2f(p0[r]); ls += p0[r]; } }
            else if (i < 12) {
#pragma unroll
                for (int r = 4 * (i - 8); r < 4 * (i - 8) + 4; ++r) { p1[r] = __builtin_amdgcn_exp2f(p1[r]); ls += p1[r]; } }
            else if (i == 12) pf[0] = pack8(p0, 0);
            else if (i == 13) pf[1] = pack8(p0, 8);
            else if (i == 14) pf[2] = pack8(p1, 0);
            else pf[3] = pack8(p1, 8);
        }
        ATT_SBAR();
    }
#undef ATT_VRD
    if (DO_SM) {
        l += ls;
        if (resc) {
#pragma unroll
            for (int k = 0; k < 4; ++k)
#pragma unroll
                for (int r = 0; r < 16; ++r) o[k][r] *= fsc; }
    }
}
}
__device__ __forceinline__ void attn_mfma_phase(Frame& F) {
    using namespace attn3;
    const int tid = F.tid, lane = F.lane, wave = F.wave, r32 = lane & 31, hi = lane >> 5, rb = wave >> 1, comp = wave & 1;
    const float lambda_init = 0.8f - 0.6f * expf(-0.3f * 1.0f);
    { float s01 = 0.f, s23 = 0.f; for (int i = 0; i < 64; ++i) { s01 += F.d_lam[i] * F.d_lam[64 + i]; s23 += F.d_lam[128 + i] * F.d_lam[192 + i]; }
      ((volatile LAS float*)F.MISC)[16] = expf(s01) - expf(s23) + lambda_init; }
    LAS unsigned char* lds = F.lds;
    LAS float* gl = (LAS float*)(lds + XTRA_OFF);
    for (int i = tid; i < NH * DV; i += 512) gl[i] = F.d_hgain[i];
    const unsigned lds0 = (unsigned)(size_t)lds;
    LAS float* cb = (LAS float*)lds;
    LAS unsigned char* obase = lds + 4 * 32 * CBS * 4;
    const int li = lane & 15, q4 = li >> 2, p4 = li & 3, g1 = (lane >> 4) & 1;
    const int voff = hi * 1024 + q4 * 64 + 32 * g1 + 16 * (p4 >> 1) + 8 * (p4 & 1);
    const int nun = (F.G == 256) ? 8 : (2048 + F.G - 1) / F.G;
    for (int it = 0; it < nun; ++it) {
        int bh, jq;
        if (F.G == 256) { const int X = F.vcu >> 5, w = F.vcu & 31, j = w & 15; bh = X * 16 + 2 * it + (w >> 4); jq = (it & 1) ? 15 - j : j; }
        else { const int u = F.vcu * nun + it; if (u >= 2048) break; bh = u >> 4; jq = u & 15; }
        const int b = bh >> 3, h = bh & 7;
        const int qrow = b * SEQ + 128 * jq + 32 * rb + r32;
        const int cw = 2 * jq + 1 + (rb >> 1), NT = 2 * jq + 3;
        bf16x8 qf0[4];
        { const bf16* qp = F.P + (size_t)qrow * NPROJ + h * 128 + comp * 64 + hi * 8;
#pragma unroll
          for (int d0 = 0; d0 < 4; ++d0) qf0[d0] = *(const GAS bf16x8*)(qp + 16 * d0); }
        LAS unsigned char* qlds = lds + NBUF * BUFB + wave * 4096 + lane * 16;
        f32x16 o[4], p0, p1; bf16x8 pf[4];
#pragma unroll
        for (int r = 0; r < 16; ++r) { p0[r] = 0.f; p1[r] = 0.f;
#pragma unroll
            for (int k = 0; k < 4; ++k) o[k][r] = 0.f; }
#pragma unroll
        for (int k = 0; k < 4; ++k) pf[k] = (bf16x8){0, 0, 0, 0, 0, 0, 0, 0};
        float m = 0.f, l = 0.f;
        __syncthreads();
        int koff[2], vofs[2];
#pragma unroll
        for (int e = 0; e < 2; ++e) { const int row_ = 8 * wave + 4 * e + (lane >> 4), c_ = lane & 15; koff[e] = row_ * NPROJ + 1024 + h * 128 + ((c_ ^ (row_ & 15)) << 3); vofs[e] = (8 * wave + 4 * e + ((lane >> 2) & 3)) * NPROJ + 2048 + h * 128 + 32 * (lane >> 4) + 8 * (lane & 3); }
#define ATT_DMA(t, buf) do { const bf16* tb_ = F.P + (size_t)(b * SEQ + ((t) - 1) * 64) * NPROJ; _Pragma("unroll") for (int e_ = 0; e_ < 2; ++e_) { \
            glds16(tb_ + koff[e_], (unsigned)__builtin_amdgcn_readfirstlane((int)(lds0 + (buf) * BUFB + (2 * wave + e_) * 1024))); \
            glds16(tb_ + vofs[e_], (unsigned)__builtin_amdgcn_readfirstlane((int)(lds0 + (buf) * BUFB + KBYTES + (2 * wave + e_) * 1024))); } } while (0)
        { const bf16* zsrc = (const bf16*)(F.ws + WS_CTL);
#pragma unroll
          for (int e = 0; e < 2; ++e) { const int row_ = 8 * wave + 4 * e + (lane >> 4); const bf16* ks_ = row_ < 16 ? F.PM + koff[e] : zsrc; const bf16* vs_ = (8 * wave + 4 * e) < 16 ? F.PM + vofs[e] : zsrc;
              glds16(ks_, (unsigned)__builtin_amdgcn_readfirstlane((int)(lds0 + (2 * wave + e) * 1024)));
              glds16(vs_, (unsigned)__builtin_amdgcn_readfirstlane((int)(lds0 + KBYTES + (2 * wave + e) * 1024))); } }
        ATT_DMA(1, 1);
#pragma unroll
        for (int d0 = 0; d0 < 4; ++d0) *(LAS bf16x8*)(qlds + d0 * 1024) = qf0[d0];
#define ATT_QK(buf) do { const LAS unsigned char* Kb_ = lds + (buf) * BUFB; bf16x8 kf_[2][4], qf[4]; \
            _Pragma("unroll") for (int d0_ = 0; d0_ < 4; ++d0_) qf[d0_] = *(const LAS bf16x8*)(qlds + d0_ * 1024); \
            _Pragma("unroll") for (int kh_ = 0; kh_ < 2; ++kh_) _Pragma("unroll") for (int d0_ = 0; d0_ < 4; ++d0_) kf_[kh_][d0_] = *(const LAS bf16x8*)(Kb_ + (32 * kh_ + r32) * KSTR + (((8 * comp + 2 * d0_ + hi) ^ (r32 & 15)) << 4)); \
            _Pragma("unroll") for (int r_ = 0; r_ < 16; ++r_) { p0[r_] = 0.f; p1[r_] = 0.f; } \
            _Pragma("unroll") for (int d0_ = 0; d0_ < 4; ++d0_) p0 = __builtin_amdgcn_mfma_f32_32x32x16_bf16(kf_[0][d0_], qf[d0_], p0, 0, 0, 0); \
            _Pragma("unroll") for (int d0_ = 0; d0_ < 4; ++d0_) p1 = __builtin_amdgcn_mfma_f32_32x32x16_bf16(kf_[1][d0_], qf[d0_], p1, 0, 0, 0); } while (0)
        ATT_DMA_WAIT(); __syncthreads();
        ATT_QK(0);
#pragma unroll
        for (int r = 0; r < 16; ++r) { if (r >= 8) p0[r] = -INFINITY; p1[r] = -INFINITY; }
        step<false, true, true>(o, p0, p1, pf, m, l, lds);
        bool mz = __all(m == 0.f);
        int bc = 1, bp = 0, bn = 2;
#ifdef PROBE_SEG
#define PSTAMP(k) do { unsigned long long tn_; asm volatile("s_memtime %0\n\ts_waitcnt lgkmcnt(0)" : "=s"(tn_) :: "memory"); if (PROBE_SEG == (k) || PROBE_SEG == 0) pacc += (float)(tn_ - tprev_); tprev_ = tn_; } while (0)
        float pacc = 0.f; unsigned long long tprev_; asm volatile("s_memtime %0\n\ts_waitcnt lgkmcnt(0)" : "=s"(tprev_) :: "memory");
#else
#define PSTAMP(k) do {} while (0)
#endif
        for (int t = 1; t < NT; ++t) {
            PSTAMP(9);
            if (t + 1 < NT) ATT_DMA(t + 1, bn);
            PSTAMP(1);
            const LAS unsigned char* vb = lds + bp * BUFB + KBYTES + voff;
            if (t <= cw) { ATT_QK(bc); asm volatile("" : "+v"(p0), "+v"(p1)); PSTAMP(2); if (!mz) {
#pragma unroll
                    for (int r = 0; r < 16; ++r) { p0[r] -= m; p1[r] -= m; } }
                step<true, true, false>(o, p0, p1, pf, m, l, vb); if (mz) mz = __all(m == 0.f); }
            else step<true, false, false>(o, p0, p1, pf, m, l, vb);
            PSTAMP(3);
            ATT_DMA_WAIT(); __syncthreads();
            PSTAMP(4);
            const int tmp = bp; bp = bc; bc = bn; bn = tmp;
        }
#ifdef PROBE_SEG
        if (blockIdx.x == 0 && it == 1) ((volatile LAS float*)F.MISC)[17] = pacc / (float)(NT - 1);
#endif
        if (NT - 1 <= cw) step<true, false, false>(o, p0, p1, pf, m, l, lds + bp * BUFB + KBYTES + voff);
#undef ATT_DMA
#undef ATT_QK
        l = xsum32(l);
        const float inv = 1.0f / l;
        LAS float* cbw = cb + (rb * 32 + r32) * CBS + 4 * hi;
        __syncthreads();
        if (comp == 1) {
#pragma unroll
            for (int blk = 0; blk < 4; ++blk)
#pragma unroll
                for (int r = 0; r < 16; ++r) cbw[32 * blk + crow0(r)] = o[blk][r] * inv;
        }
        __syncthreads();
        if (comp == 0) {
            const float lam = ((volatile LAS float*)F.MISC)[16];
            float ssq = 0.f;
#pragma unroll
            for (int blk = 0; blk < 4; ++blk)
#pragma unroll
                for (int r = 0; r < 16; ++r) { const float d = o[blk][r] * inv - lam * cbw[32 * blk + crow0(r)]; o[blk][r] = d; ssq += d * d; if (r == 15) ATT_SBAR(); }
            ssq = xsum32(ssq);
            const float rr = (1.0f - lambda_init) * __builtin_amdgcn_rsqf(ssq * (1.0f / DV) + SUBLN_EPS);
            const LAS float* gpb = gl + h * DV + 4 * hi;
            LAS unsigned char* ob = obase + (rb * 32) * OBS;
            LAS unsigned char* obw = ob + r32 * OBS + 8 * hi;
#pragma unroll
            for (int blk = 0; blk < 4; ++blk)
#pragma unroll
                for (int r = 0; r < 16; r += 2) { const int dv = 32 * blk + crow0(r);
                    *(LAS unsigned*)(obw + dv * 2) = pg8::cvt_pk_bf16(o[blk][r] * rr * gpb[dv], o[blk][r + 1] * rr * gpb[dv + 1]); if (r == 14) ATT_SBAR(); }
            asm volatile("s_waitcnt lgkmcnt(0)" ::: "memory");
#pragma unroll
            for (int i = 0; i < 8; ++i) { const int row = 4 * i + (lane >> 4), ch = lane & 15;
                const v4u v = *(const LAS v4u*)(ob + row * OBS + ch * 16);
                *(GAS v4u*)(F.MIX + (size_t)(b * SEQ + 128 * jq + 32 * rb + row) * D + h * DV + ch * 8) = v; }
        }
    }
}
namespace ml2 {
typedef short bf16x8 __attribute__((ext_vector_type(8)));
typedef short s16x4 __attribute__((ext_vector_type(4)));
constexpr int QSTR = 144, VSTR = 272;
constexpr int OFF_Q = 0, OFF_K = 64 * QSTR, OFF_V = 2 * 64 * QSTR, DBUF = OFF_V + 64 * VSTR;
constexpr int OFF_S = 2 * DBUF, SBUF = 64 * 144;
constexpr int HSTR = 132, OFF_H = OFF_S + 2 * SBUF, HBYTES = 64 * HSTR * 4;
constexpr int OFF_SM = OFF_H + HBYTES, SMB = 12 * 256;
constexpr int A_G = 0, A_M = 64, A_B = 128, A_W = 192, A_RS = 256  , A_QN = 512, A_CT = 576, A_AT = 640, A_N = 704;
static_assert(OFF_SM + 2 * SMB <= RING_BYTES, "mLSTM LDS map");
__device__ __forceinline__ s16x4 vtr(const LAS unsigned char* p) { return __builtin_bit_cast(s16x4, __builtin_amdgcn_ds_read_tr16_b64_v4i16((LAS s16x4*)p)); }
template <int CTRL> __device__ __forceinline__ float dpp_mov(float v) { return __builtin_bit_cast(float, __builtin_amdgcn_update_dpp(0, __builtin_bit_cast(int, v), CTRL, 0xF, 0xF, true)); }
__device__ __forceinline__ float sum8(float v) { v += dpp_mov<0xB1>(v); v += dpp_mov<0x4E>(v); v += dpp_mov<0x141>(v); return v; }
__device__ __forceinline__ float sum16(float v) { v = sum8(v); v += dpp_mov<0x140>(v); return v; }
}
#ifdef MLSTM_V2
constexpr float GSC_SCALE = 1.0f;
#else
constexpr float GSC_SCALE = 1.4426950408889634f;
#endif
__device__ __forceinline__ void gate_scan_job(Frame& F) {
    const int gw = F.vcu * NWAVES + F.wave, NGW = F.G * NWAVES, lane = F.lane;
    for (int it = gw; it < NB * NH * 33; it += NGW) {
        const int unit = it / 33, c = it % 33, b = unit >> 3, h = unit & 7;
        float lf = 0.f, ig = -1e30f;
        if (c != 0 || lane < 16) { const float* gp = (c == 0 ? F.GATESM + (size_t)lane * 16 : F.GATES + (size_t)(b * SEQ + (c - 1) * 64 + lane) * 16); const float fg = gp[8 + h]; ig = gp[h]; lf = (fminf(fg, 0.f) - log1pf(expf(-fabsf(fg)))) * GSC_SCALE; ig *= GSC_SCALE; }
        float bs = lf;
#pragma unroll
        for (int o = 1; o < 64; o <<= 1) { const float v = __shfl_up(bs, o); if (lane >= o) bs += v; }
        const float gs = ig - bs; float pm = gs;
#pragma unroll
        for (int o = 1; o < 64; o <<= 1) { const float v = __shfl_up(pm, o); if (lane >= o) pm = fmaxf(pm, v); }
        float* dst = F.GSC + (size_t)it * 192; dst[lane] = gs; dst[64 + lane] = pm; dst[128 + lane] = bs;
    }
}
__device__ __forceinline__ void mlstm_mfma_phase(Frame& F) {
    using namespace ml2;
    const int tid = F.tid, lane = F.lane, w = F.wave, li = lane & 15, g = lane >> 4, q4 = li >> 2, p4 = li & 3;
    LAS unsigned char* lds = F.lds;
    const int zt = tid >> 3, zc = tid & 7;
    const int mlwg = F.G / 2;
    if (F.vcu >= mlwg) { convert_weights(F, I_IN, NITEMS, (F.vcu - mlwg) * NWAVES + F.wave, (F.G - mlwg) * NWAVES, (LAS float*)(F.lds + RING_OFF + F.wave * 16384)); return; }
    for (int unit = F.vcu; unit < NB * NH; unit += mlwg) {
        const int b = unit >> 3, h = unit & 7;
        __syncthreads();
        for (int i = tid; i < (2 * SBUF) / 16; i += 512) *(LAS v4u*)(lds + OFF_S + i * 16) = (v4u){0u, 0u, 0u, 0u};
        for (int i = tid; i < (2 * SMB) / 16; i += 512) *(LAS v4u*)(lds + OFF_SM + i * 16) = (v4u){0u, 0u, 0u, 0u};
        f32x4 Cacc[4];
#pragma unroll
        for (int i = 0; i < 4; ++i) Cacc[i] = (f32x4){0.f, 0.f, 0.f, 0.f};
        float m = 0.f;
        float gn[16];
#pragma unroll
        for (int i = 0; i < 4; ++i) { const f32x4 t4 = *(const GAS f32x4*)(F.m_hgain + h * DV + 16 * zc + 4 * i); gn[4 * i] = t4.x; gn[4 * i + 1] = t4.y; gn[4 * i + 2] = t4.z; gn[4 * i + 3] = t4.w; }
        v4u sq, sk, sv0, sv1;
#define ML_ROW0(c) ((c) == 0 ? 0 : b * SEQ + ((c) - 1) * 64)
#define ML_PB(c) ((c) == 0 ? F.PM : F.P)
#define ML_LOAD(c) do { const int r0_ = ML_ROW0(c); const bool okq_ = ((c) != 0) || (zt < 16); \
            const bf16* pq_ = ML_PB(c) + (size_t)(r0_ + zt) * NPROJ + h * 64 + 8 * zc; \
            if (okq_) { sq = *(const GAS v4u*)pq_; sk = *(const GAS v4u*)(pq_ + 512); } else { sq = (v4u){0u, 0u, 0u, 0u}; sk = sq; } \
            const int rv0_ = tid >> 4, rv1_ = (tid + 512) >> 4, pv_ = tid & 15; \
            if (((c) != 0) || rv0_ < 16) sv0 = *(const GAS v4u*)(ML_PB(c) + (size_t)(r0_ + rv0_) * NPROJ + 1024 + h * 128 + 8 * pv_); else sv0 = (v4u){0u, 0u, 0u, 0u}; \
            if ((c) != 0) sv1 = *(const GAS v4u*)(F.P + (size_t)(r0_ + rv1_) * NPROJ + 1024 + h * 128 + 8 * pv_); else sv1 = (v4u){0u, 0u, 0u, 0u}; } while (0)
#define ML_STORE(par) do { LAS unsigned char* d_ = lds + (par) * DBUF; *(LAS v4u*)(d_ + OFF_Q + zt * QSTR + zc * 16) = sq; *(LAS v4u*)(d_ + OFF_K + zt * QSTR + zc * 16) = sk; \
            *(LAS v4u*)(d_ + OFF_V + (tid >> 4) * VSTR + (tid & 15) * 16) = sv0; *(LAS v4u*)(d_ + OFF_V + ((tid + 512) >> 4) * VSTR + (tid & 15) * 16) = sv1; } while (0)
        ML_LOAD(0); ML_STORE(0);
        { const float* gq = F.GSC + (size_t)(unit * 33) * 192; LAS float* xg = (LAS float*)(lds + XTRA_OFF);
          for (int i = tid; i < 33 * 192 / 4; i += 512) *(LAS f32x4*)(xg + 4 * i) = *(const GAS f32x4*)(gq + 4 * i); }
        __syncthreads();
#ifdef PROBE_ML
#define MSTAMP2(k) do { unsigned long long tn_; asm volatile("s_memtime %0\n\ts_waitcnt lgkmcnt(0)" : "=s"(tn_) :: "memory"); if (PROBE_ML == (k) || PROBE_ML == 9) pacc += (float)(tn_ - tprev_); tprev_ = tn_; } while (0)
        float pacc = 0.f; unsigned long long tprev_; asm volatile("s_memtime %0\n\ts_waitcnt lgkmcnt(0)" : "=s"(tprev_) :: "memory");
#else
#define MSTAMP2(k) do {} while (0)
#endif
        for (int c = 0; c <= 32; ++c) {
            const int par = c & 1; const int row0 = ML_ROW0(c);
            LAS unsigned char* db = lds + par * DBUF; LAS float* sm = (LAS float*)(lds + OFF_SM + par * SMB); LAS float* smn = (LAS float*)(lds + OFF_SM + (par ^ 1) * SMB);
            LAS unsigned char* Sb = lds + OFF_S + par * SBUF;
            if (c < 32) ML_LOAD(c + 1);
            v4u og0 = (v4u){0u, 0u, 0u, 0u}, og1 = og0; const bool zvalid = (c != 0) || (zt < 16);
            if (zvalid) { const bf16* po = ML_PB(c) + (size_t)(row0 + zt) * NPROJ + 2048 + h * 128 + 16 * zc; og0 = *(const GAS v4u*)po; og1 = *(const GAS v4u*)(po + 8); }
            const LAS float* xg = (const LAS float*)(lds + XTRA_OFF) + c * 192; const float gs = xg[lane], pm = xg[64 + lane], bs = xg[128 + lane];
            const float Mt = fmaxf(m, pm);
            const float MT = __builtin_bit_cast(float, __builtin_amdgcn_readlane(__builtin_bit_cast(int, Mt), 63)), bT = __builtin_bit_cast(float, __builtin_amdgcn_readlane(__builtin_bit_cast(int, bs), 63));
            const float ws = __expf(gs - MT), decay = __expf(m - MT);
            sm[A_G + lane] = gs; sm[A_M + lane] = Mt; sm[A_B + lane] = bs; sm[A_W + lane] = ws;
            MSTAMP2(1);
            for (int ti = w; ti < 10; ti += 8) {
                const int rt = ti < 1 ? 0 : ti < 3 ? 1 : ti < 6 ? 2 : 3, st = ti - rt * (rt + 1) / 2;
                f32x4 acc = (f32x4){0.f, 0.f, 0.f, 0.f};
#pragma unroll
                for (int ks = 0; ks < 2; ++ks) { const bf16x8 a = *(const LAS bf16x8*)(db + OFF_Q + (16 * rt + li) * QSTR + (32 * ks + 8 * g) * 2), bb = *(const LAS bf16x8*)(db + OFF_K + (16 * st + li) * QSTR + (32 * ks + 8 * g) * 2);
                    acc = mfma16(a, bb, acc); }
                const float g_s = sm[A_G + 16 * st + li]; const f32x4 M4 = *(const LAS f32x4*)(sm + A_M + 16 * rt + 4 * g);
                float val[4];
#pragma unroll
                for (int r = 0; r < 4; ++r) { const bool ok = (16 * st + li) <= (16 * rt + 4 * g + r); val[r] = ok ? acc[r] * __expf(g_s - M4[r]) : 0.f; }
                float rs[4];
#pragma unroll
                for (int r = 0; r < 4; ++r) rs[r] = sum16(val[r]);
                if (li == 0) *(LAS f32x4*)(sm + A_RS + st * 64 + 16 * rt + 4 * g) = (f32x4){rs[0], rs[1], rs[2], rs[3]};
                { const unsigned q01 = pg8::cvt_pk_bf16(val[0], val[1]), q23 = pg8::cvt_pk_bf16(val[2], val[3]); LAS unsigned char* sp = Sb + (16 * rt + 4 * g) * 144 + (16 * st + li) * 2;
                  *(LAS bf16*)(sp) = (bf16)(q01 & 0xffffu); *(LAS bf16*)(sp + 144) = (bf16)(q01 >> 16); *(LAS bf16*)(sp + 288) = (bf16)(q23 & 0xffffu); *(LAS bf16*)(sp + 432) = (bf16)(q23 >> 16); }
            }
            { const v4u qv = *(const LAS v4u*)(db + OFF_Q + zt * QSTR + zc * 16); const f32x4 n0 = *(const LAS f32x4*)(sm + A_N + 8 * zc), n1 = *(const LAS f32x4*)(sm + A_N + 8 * zc + 4);
              float d = bflo(qv.x) * n0.x + bfhi(qv.x) * n0.y + bflo(qv.y) * n0.z + bfhi(qv.y) * n0.w + bflo(qv.z) * n1.x + bfhi(qv.z) * n1.y + bflo(qv.w) * n1.z + bfhi(qv.w) * n1.w;
              d = sum8(d);
              if (zc == 0) sm[A_QN + zt] = d; }
            MSTAMP2(2);
            __syncthreads();
            MSTAMP2(3);
            typedef unsigned u32x2 __attribute__((ext_vector_type(2)));
            const float r0 = sm[A_RS + lane], r1 = sm[A_RS + 64 + lane], r2 = sm[A_RS + 128 + lane], r3 = sm[A_RS + 192 + lane], qnl = sm[A_QN + lane];
            s16x4 vlo[2], vhi[2]; f32x4 w0[2], w1[2];
#pragma unroll
            for (int ks = 0; ks < 2; ++ks) { const LAS unsigned char* vp = db + OFF_V + (32 * ks + 8 * g + q4) * VSTR + (16 * w + 4 * p4) * 2; vlo[ks] = vtr(vp); vhi[ks] = vtr(vp + 4 * VSTR);
                w0[ks] = *(const LAS f32x4*)(sm + A_W + 32 * ks + 8 * g); w1[ks] = *(const LAS f32x4*)(sm + A_W + 32 * ks + 8 * g + 4); }
            bf16x8 sfr[4][2]; u32x2 qpa[4][2], qpb[4][2];
#pragma unroll
            for (int rt = 0; rt < 4; ++rt)
#pragma unroll
                for (int ks = 0; ks < 2; ++ks) {
                    if (ks == 0 || rt >= 2) sfr[rt][ks] = *(const LAS bf16x8*)(Sb + (16 * rt + li) * 144 + (32 * ks + 8 * g) * 2);
                    qpa[rt][ks] = *(const LAS u32x2*)(db + OFF_Q + (16 * rt + li) * QSTR + (32 * ks + 4 * g) * 2); qpb[rt][ks] = *(const LAS u32x2*)(db + OFF_Q + (16 * rt + li) * QSTR + (32 * ks + 16 + 4 * g) * 2); }
            __builtin_amdgcn_sched_barrier(0);
            { const float rsum = (r0 + r1) + (r2 + r3);
              const float inter = __expf(m - Mt), den = rsum + inter * qnl, dmax = fmaxf(fabsf(den), __expf(-(bs + Mt))), ci = __builtin_amdgcn_rcpf(dmax);
              sm[A_CT + lane] = ci; sm[A_AT + lane] = inter * ci; }
            bf16x8 vf[2], wv[2];
#pragma unroll
            for (int ks = 0; ks < 2; ++ks) { const s16x4 lo = vlo[ks], hh = vhi[ks];
                vf[ks] = (bf16x8){lo[0], lo[1], lo[2], lo[3], hh[0], hh[1], hh[2], hh[3]};
                v4u pw; pw.x = pg8::cvt_pk_bf16(bf2f((unsigned short)lo[0]) * w0[ks].x, bf2f((unsigned short)lo[1]) * w0[ks].y); pw.y = pg8::cvt_pk_bf16(bf2f((unsigned short)lo[2]) * w0[ks].z, bf2f((unsigned short)lo[3]) * w0[ks].w);
                pw.z = pg8::cvt_pk_bf16(bf2f((unsigned short)hh[0]) * w1[ks].x, bf2f((unsigned short)hh[1]) * w1[ks].y); pw.w = pg8::cvt_pk_bf16(bf2f((unsigned short)hh[2]) * w1[ks].z, bf2f((unsigned short)hh[3]) * w1[ks].w);
                wv[ks] = __builtin_bit_cast(bf16x8, pw); }
            bf16x8 cbf[2];
#pragma unroll
            for (int ks = 0; ks < 2; ++ks) { v4u pw; pw.x = pg8::cvt_pk_bf16(Cacc[2 * ks][0], Cacc[2 * ks][1]); pw.y = pg8::cvt_pk_bf16(Cacc[2 * ks][2], Cacc[2 * ks][3]); pw.z = pg8::cvt_pk_bf16(Cacc[2 * ks + 1][0], Cacc[2 * ks + 1][1]); pw.w = pg8::cvt_pk_bf16(Cacc[2 * ks + 1][2], Cacc[2 * ks + 1][3]);
                cbf[ks] = __builtin_bit_cast(bf16x8, pw); }
            f32x4 acc1[4], acc2[4];
#pragma unroll
            for (int rt = 0; rt < 4; ++rt) {
                acc1[rt] = (f32x4){0.f, 0.f, 0.f, 0.f}; acc2[rt] = (f32x4){0.f, 0.f, 0.f, 0.f};
#pragma unroll
                for (int ks = 0; ks < 2; ++ks) {
                    if (ks == 0 || rt >= 2) acc1[rt] = mfma16(sfr[rt][ks], vf[ks], acc1[rt]);
                    const bf16x8 aq = __builtin_bit_cast(bf16x8, (v4u){qpa[rt][ks].x, qpa[rt][ks].y, qpb[rt][ks].x, qpb[rt][ks].y});
                    acc2[rt] = mfma16(aq, cbf[ks], acc2[rt]);
                }
            }
            __builtin_amdgcn_sched_barrier(0);
            s16x4 klo[4][2], khi[4][2];
#pragma unroll
            for (int dt = 0; dt < 4; ++dt)
#pragma unroll
                for (int ks = 0; ks < 2; ++ks) { const LAS unsigned char* kp = db + OFF_K + (32 * ks + 8 * g + q4) * QSTR + (16 * dt + 4 * p4) * 2; klo[dt][ks] = vtr(kp); khi[dt][ks] = vtr(kp + 4 * QSTR); }
            float kn[8];
#pragma unroll
            for (int i = 0; i < 8; ++i) kn[i] = bf2f(*(const LAS bf16*)(db + OFF_K + (8 * zc + i) * QSTR + zt * 2));
            const f32x4 wn0 = *(const LAS f32x4*)(sm + A_W + 8 * zc), wn1 = *(const LAS f32x4*)(sm + A_W + 8 * zc + 4); const float nold = sm[A_N + zt];
            __builtin_amdgcn_sched_barrier(0);
#pragma unroll
            for (int dt = 0; dt < 4; ++dt) {
                Cacc[dt] = Cacc[dt] * decay;
#pragma unroll
                for (int ks = 0; ks < 2; ++ks) { const s16x4 lo = klo[dt][ks], hh = khi[dt][ks];
                    const bf16x8 ka = (bf16x8){lo[0], lo[1], lo[2], lo[3], hh[0], hh[1], hh[2], hh[3]};
                    Cacc[dt] = mfma16(ka, wv[ks], Cacc[dt]); }
            }
            { float sacc = (wn0.x * kn[0] + wn0.y * kn[1]) + (wn0.z * kn[2] + wn0.w * kn[3]) + (wn1.x * kn[4] + wn1.y * kn[5]) + (wn1.z * kn[6] + wn1.w * kn[7]);
              sacc = sum8(sacc);
              if (zc == 0) smn[A_N + zt] = decay * nold + sacc; }
            { LAS float* hb = (LAS float*)(lds + OFF_H);
#pragma unroll
              for (int rt = 0; rt < 4; ++rt) { const f32x4 c4 = *(const LAS f32x4*)(sm + A_CT + 16 * rt + 4 * g), a4 = *(const LAS f32x4*)(sm + A_AT + 16 * rt + 4 * g);
#pragma unroll
                  for (int r = 0; r < 4; ++r) hb[(16 * rt + 4 * g + r) * HSTR + 16 * w + li] = acc1[rt][r] * c4[r] + acc2[rt][r] * a4[r]; } }
            m = bT + MT;
            if (c < 32) ML_STORE(par ^ 1);
            MSTAMP2(4);
            __syncthreads();
            MSTAMP2(5);
            { const LAS float* hb = (const LAS float*)(lds + OFF_H) + zt * HSTR + 16 * zc; float hv[16]; float ss = 0.f;
#pragma unroll
              for (int i = 0; i < 4; ++i) { const f32x4 t4 = *(const LAS f32x4*)(hb + 4 * i); hv[4 * i] = t4.x; hv[4 * i + 1] = t4.y; hv[4 * i + 2] = t4.z; hv[4 * i + 3] = t4.w; ss += (t4.x * t4.x + t4.y * t4.y) + (t4.z * t4.z + t4.w * t4.w); }
              ss = sum8(ss);
              const float rn = __builtin_amdgcn_rsqf(ss * (1.0f / DV) + EPS);
              const unsigned ow[8] = {og0.x, og0.y, og0.z, og0.w, og1.x, og1.y, og1.z, og1.w}; unsigned res[8];
#pragma unroll
              for (int i = 0; i < 8; ++i) { const float o0 = bflo(ow[i]), o1 = bfhi(ow[i]);
                  res[i] = pg8::cvt_pk_bf16(hv[2 * i] * rn * gn[2 * i] * __builtin_amdgcn_rcpf(1.0f + __expf(-o0)), hv[2 * i + 1] * rn * gn[2 * i + 1] * __builtin_amdgcn_rcpf(1.0f + __expf(-o1))); }
              if (zvalid && (c != 0 || b == 0)) { bf16* dst = (c == 0 ? F.MIXM : F.MIX) + (size_t)(row0 + zt) * D + h * DV + 16 * zc; *(GAS v4u*)dst = (v4u){res[0], res[1], res[2], res[3]}; *(GAS v4u*)(dst + 8) = (v4u){res[4], res[5], res[6], res[7]}; } }
            MSTAMP2(6);
        }
#ifdef PROBE_ML
        if (blockIdx.x == 0) ((volatile LAS float*)F.MISC)[17] = pacc / 33.f;
#endif
#undef ML_ROW0
#undef ML_PB
#undef ML_LOAD
#undef ML_STORE
    }
}
namespace ml3 {
using ml2::bf16x8; using ml2::s16x4; using ml2::vtr; using ml2::sum8;
constexpr int QSTR = 144, VSTR = 272;
constexpr int OFF_Q = 0, OFF_K = 64 * QSTR, OFF_V = 2 * 64 * QSTR, DBUF = OFF_V + 64 * VSTR;
constexpr int OFF_S = 2 * DBUF, SBUF = 64 * 144;
constexpr int HSTRB = 272, OFF_H = OFF_S + 2 * SBUF, HBUF = 64 * HSTRB;
constexpr int OFF_W = OFF_H + 2 * HBUF;
constexpr int OFF_GN = OFF_W + 3 * 8 * 256;
constexpr int OFF_G = OFF_GN + 512;
static_assert(OFF_G + 33 * 768 <= RING_BYTES + XTRA_BYTES && OFF_S % 16 == 0 && OFF_H % 16 == 0 && OFF_W % 16 == 0 && OFF_G % 16 == 0, "mLSTM LDS map");
}
__device__ __forceinline__ void mlstm3_phase(Frame& F) {
    using namespace ml3;
    const int tid = F.tid, lane = F.lane, w = F.wave, li = lane & 15, g = lane >> 4, q4 = li >> 2, p4 = li & 3;
    LAS unsigned char* lds = F.lds;
    const int zt = tid >> 3, zc = tid & 7;
    const int mlwg = F.G / 2;
    if (F.vcu >= mlwg) { convert_weights(F, I_IN, NITEMS, (F.vcu - mlwg) * NWAVES + F.wave, (F.G - mlwg) * NWAVES, (LAS float*)(F.lds + RING_OFF + F.wave * 16384)); return; }
    const bf16x8 ones = __builtin_bit_cast(bf16x8, (v4u){0x3F803F80u, 0x3F803F80u, 0x3F803F80u, 0x3F803F80u});
    const int rtA = w < 1 ? 0 : w < 3 ? 1 : w < 6 ? 2 : 3, stA = w - rtA * (rtA + 1) / 2;
    const int rtB = 3, stB = w + 2;
    for (int unit = F.vcu; unit < NB * NH; unit += mlwg) {
        const int b = unit >> 3, h = unit & 7;
        __syncthreads();
        for (int i = tid; i < (2 * SBUF) / 16; i += 512) *(LAS v4u*)(lds + OFF_S + i * 16) = (v4u){0u, 0u, 0u, 0u};
        { const float* gq = F.GSC + (size_t)(unit * 33) * 192; LAS float* xg = (LAS float*)(lds + OFF_G);
          for (int i = tid; i < 33 * 192 / 4; i += 512) *(LAS f32x4*)(xg + 4 * i) = *(const GAS f32x4*)(gq + 4 * i); }
        f32x4 Cacc[4], nacc[4];
#pragma unroll
        for (int i = 0; i < 4; ++i) { Cacc[i] = (f32x4){0.f, 0.f, 0.f, 0.f}; nacc[i] = (f32x4){0.f, 0.f, 0.f, 0.f}; }
        float m = 0.f;
        if (tid < DV) ((LAS float*)(lds + OFF_GN))[tid] = F.m_hgain[h * DV + tid];
        v4u sq, sk, sv0, sv1;
        const int oq = zt * NPROJ + 8 * zc, ov0 = (tid >> 4) * NPROJ + 8 * (tid & 15), oo = zt * NPROJ + 16 * zc;
        const int oxa0 = (16 * rtA + li) * NPROJ + 8 * g, oxb0 = (16 * stA + li) * NPROJ + 8 * g, oxa1 = (16 * rtB + li) * NPROJ + 8 * g, oxb1 = (16 * stB + li) * NPROJ + 8 * g;
#define ML_ROW0(c) ((c) == 0 ? 0 : b * SEQ + ((c) - 1) * 64)
#define ML_PB(c) ((c) == 0 ? F.PM : F.P)
#define ML_LOAD(c) do { const bf16* pb_ = ML_PB(c) + (size_t)ML_ROW0(c) * NPROJ + h * 64; const bool okq_ = ((c) != 0) || (zt < 16); \
            if (okq_) { sq = *(const GAS v4u*)(pb_ + oq); sk = *(const GAS v4u*)(pb_ + 512 + oq); } else { sq = (v4u){0u, 0u, 0u, 0u}; sk = sq; } \
            const bf16* pv_ = pb_ + 1024 + h * 64; \
            if (((c) != 0) || (tid >> 4) < 16) sv0 = *(const GAS v4u*)(pv_ + ov0); else sv0 = (v4u){0u, 0u, 0u, 0u}; \
            if ((c) != 0) sv1 = *(const GAS v4u*)(pv_ + 32 * NPROJ + ov0); else sv1 = (v4u){0u, 0u, 0u, 0u}; } while (0)
#define ML_STORE(par) do { LAS unsigned char* d_ = lds + (par) * DBUF; *(LAS v4u*)(d_ + OFF_Q + zt * QSTR + zc * 16) = sq; *(LAS v4u*)(d_ + OFF_K + zt * QSTR + zc * 16) = sk; \
            *(LAS v4u*)(d_ + OFF_V + (tid >> 4) * VSTR + (tid & 15) * 16) = sv0; *(LAS v4u*)(d_ + OFF_V + ((tid + 512) >> 4) * VSTR + (tid & 15) * 16) = sv1; } while (0)
#define ML_STILE(acc_, rt_, st_, cn_, mn_, Sb_) do { const LAS float* gq_ = (const LAS float*)(lds + OFF_G) + (cn_) * 192; const float g_s_ = gq_[16 * (st_) + li]; \
            const f32x4 P4_ = *(const LAS f32x4*)(gq_ + 64 + 16 * (rt_) + 4 * g); \
            float v_[4]; _Pragma("unroll") for (int r_ = 0; r_ < 4; ++r_) { const bool ok_ = (16 * (st_) + li) <= (16 * (rt_) + 4 * g + r_); v_[r_] = ok_ ? (acc_)[r_] * __builtin_amdgcn_exp2f(g_s_ - fmaxf((mn_), P4_[r_])) : 0.f; } \
            const unsigned q01_ = pg8::cvt_pk_bf16(v_[0], v_[1]), q23_ = pg8::cvt_pk_bf16(v_[2], v_[3]); LAS unsigned char* sp_ = (Sb_) + (16 * (rt_) + 4 * g) * 144 + (16 * (st_) + li) * 2; \
            *(LAS bf16*)(sp_) = (bf16)(q01_ & 0xffffu); *(LAS bf16*)(sp_ + 144) = (bf16)(q01_ >> 16); *(LAS bf16*)(sp_ + 288) = (bf16)(q23_ & 0xffffu); *(LAS bf16*)(sp_ + 432) = (bf16)(q23_ >> 16); } while (0)
        ML_LOAD(0); ML_STORE(0);
        __syncthreads();
        if (w == 0) {
            f32x4 acc = (f32x4){0.f, 0.f, 0.f, 0.f};
#pragma unroll
            for (int ks = 0; ks < 2; ++ks) acc = mfma16(*(const LAS bf16x8*)(lds + OFF_Q + li * QSTR + (32 * ks + 8 * g) * 2), *(const LAS bf16x8*)(lds + OFF_K + li * QSTR + (32 * ks + 8 * g) * 2), acc);
            ML_STILE(acc, 0, 0, 0, 0.f, lds + OFF_S);
        }
        __syncthreads();
#ifdef PROBE_ML
#define MSTAMP(k) do { unsigned long long tn_; asm volatile("s_memtime %0\n\ts_waitcnt lgkmcnt(0)" : "=s"(tn_) :: "memory"); if (PROBE_ML == (k) || PROBE_ML == 9) pacc += (float)(tn_ - tprev_); tprev_ = tn_; } while (0)
        float pacc = 0.f; unsigned long long tprev_; asm volatile("s_memtime %0\n\ts_waitcnt lgkmcnt(0)" : "=s"(tprev_) :: "memory");
#else
#define MSTAMP(k) do {} while (0)
#endif
        for (int c = 0; c <= 33; ++c) {
            const int par = c & 1;
            LAS unsigned char* db = lds + par * DBUF; const LAS unsigned char* Sb = lds + OFF_S + par * SBUF;
            bf16x8 xa[2][2], xb[2][2];
            if (c < 32) {
                ML_LOAD(c + 1);
                const bf16* pn = F.P + (size_t)(b * SEQ + c * 64) * NPROJ + h * 64;
#pragma unroll
                for (int ks = 0; ks < 2; ++ks) { xa[0][ks] = *(const GAS bf16x8*)(pn + 32 * ks + oxa0); xb[0][ks] = *(const GAS bf16x8*)(pn + 512 + 32 * ks + oxb0); }
                if (w < 2) {
#pragma unroll
                    for (int ks = 0; ks < 2; ++ks) { xa[1][ks] = *(const GAS bf16x8*)(pn + 32 * ks + oxa1); xb[1][ks] = *(const GAS bf16x8*)(pn + 512 + 32 * ks + oxb1); } }
            }
            v4u og0 = (v4u){0u, 0u, 0u, 0u}, og1 = og0; const int cz = c - 1; const bool zvalid = (c >= 1) && ((cz != 0) || (zt < 16));
            if (zvalid) { const bf16* po = ML_PB(cz) + (size_t)ML_ROW0(cz) * NPROJ + 2048 + h * 128; og0 = *(const GAS v4u*)(po + oo); og1 = *(const GAS v4u*)(po + 8 + oo); }
            MSTAMP(1);
            float mnext = m;
            if (c <= 32) {
                const LAS float* xg = (const LAS float*)(lds + OFF_G) + c * 192;
                const float gs = xg[lane], pm = xg[64 + lane], bs = xg[128 + lane];
                const float Mt = fmaxf(m, pm);
                const float MT = __builtin_bit_cast(float, __builtin_amdgcn_readlane(__builtin_bit_cast(int, Mt), 63)), bT = __builtin_bit_cast(float, __builtin_amdgcn_readlane(__builtin_bit_cast(int, bs), 63));
                const float decay = __builtin_amdgcn_exp2f(m - MT);
                LAS float* wsc = (LAS float*)(lds + OFF_W) + w * 64;
                wsc[lane] = __builtin_amdgcn_exp2f(gs - MT);
                wsc[512 + lane] = __builtin_amdgcn_exp2f(m - Mt);
                wsc[1024 + lane] = __builtin_amdgcn_exp2f(-(bs + Mt));
                mnext = bT + MT;
                bf16x8 vf[2], wv[2];
#pragma unroll
                for (int ks = 0; ks < 2; ++ks) {
                    const LAS unsigned char* vp = db + OFF_V + (32 * ks + 8 * g + q4) * VSTR + (16 * w + 4 * p4) * 2;
                    const s16x4 lo = vtr(vp), hh = vtr(vp + 4 * VSTR);
                    vf[ks] = (bf16x8){lo[0], lo[1], lo[2], lo[3], hh[0], hh[1], hh[2], hh[3]};
                    const f32x4 w0 = *(const LAS f32x4*)(wsc + 32 * ks + 8 * g), w1 = *(const LAS f32x4*)(wsc + 32 * ks + 8 * g + 4);
                    v4u pw; pw.x = pg8::cvt_pk_bf16(bf2f((unsigned short)lo[0]) * w0.x, bf2f((unsigned short)lo[1]) * w0.y); pw.y = pg8::cvt_pk_bf16(bf2f((unsigned short)lo[2]) * w0.z, bf2f((unsigned short)lo[3]) * w0.w);
                    pw.z = pg8::cvt_pk_bf16(bf2f((unsigned short)hh[0]) * w1.x, bf2f((unsigned short)hh[1]) * w1.y); pw.w = pg8::cvt_pk_bf16(bf2f((unsigned short)hh[2]) * w1.z, bf2f((unsigned short)hh[3]) * w1.w);
                    wv[ks] = __builtin_bit_cast(bf16x8, pw);
                }
                bf16x8 cbf[2], nbf[2];
#pragma unroll
                for (int ks = 0; ks < 2; ++ks) {
                    v4u pw; pw.x = pg8::cvt_pk_bf16(Cacc[2 * ks][0], Cacc[2 * ks][1]); pw.y = pg8::cvt_pk_bf16(Cacc[2 * ks][2], Cacc[2 * ks][3]); pw.z = pg8::cvt_pk_bf16(Cacc[2 * ks + 1][0], Cacc[2 * ks + 1][1]); pw.w = pg8::cvt_pk_bf16(Cacc[2 * ks + 1][2], Cacc[2 * ks + 1][3]);
                    cbf[ks] = __builtin_bit_cast(bf16x8, pw);
                    v4u pn2; pn2.x = pg8::cvt_pk_bf16(nacc[2 * ks][0], nacc[2 * ks][1]); pn2.y = pg8::cvt_pk_bf16(nacc[2 * ks][2], nacc[2 * ks][3]); pn2.z = pg8::cvt_pk_bf16(nacc[2 * ks + 1][0], nacc[2 * ks + 1][1]); pn2.w = pg8::cvt_pk_bf16(nacc[2 * ks + 1][2], nacc[2 * ks + 1][3]);
                    nbf[ks] = __builtin_bit_cast(bf16x8, pn2);
                }
                LAS unsigned char* hb = lds + OFF_H + par * HBUF;
#pragma unroll
                for (int rt = 0; rt < 4; ++rt) {
                    f32x4 a1 = (f32x4){0.f, 0.f, 0.f, 0.f}, aR = a1, a2 = a1, aN = a1;
#pragma unroll
                    for (int ks = 0; ks < 2; ++ks) {
                        if (ks == 0 || rt >= 2) { const bf16x8 a = *(const LAS bf16x8*)(Sb + (16 * rt + li) * 144 + (32 * ks + 8 * g) * 2); a1 = mfma16(a, vf[ks], a1); aR = mfma16(a, ones, aR); }
                        typedef unsigned u32x2 __attribute__((ext_vector_type(2)));
                        const u32x2 qa = *(const LAS u32x2*)(db + OFF_Q + (16 * rt + li) * QSTR + (32 * ks + 4 * g) * 2), qb = *(const LAS u32x2*)(db + OFF_Q + (16 * rt + li) * QSTR + (32 * ks + 16 + 4 * g) * 2);
                        const bf16x8 aq = __builtin_bit_cast(bf16x8, (v4u){qa.x, qa.y, qb.x, qb.y});
                        a2 = mfma16(aq, cbf[ks], a2); aN = mfma16(aq, nbf[ks], aN);
                    }
                    const f32x4 I4 = *(const LAS f32x4*)(wsc + 512 + 16 * rt + 4 * g), F4 = *(const LAS f32x4*)(wsc + 1024 + 16 * rt + 4 * g);
                    float hv[4];
#pragma unroll
                    for (int r = 0; r < 4; ++r) { const float den = aR[r] + I4[r] * aN[r], dmax = fmaxf(fabsf(den), F4[r]); hv[r] = (a1[r] + I4[r] * a2[r]) * __builtin_amdgcn_rcpf(dmax); }
                    const unsigned p01 = pg8::cvt_pk_bf16(hv[0], hv[1]), p23 = pg8::cvt_pk_bf16(hv[2], hv[3]);
                    LAS unsigned char* hq = hb + (16 * rt + 4 * g) * HSTRB + (16 * w + li) * 2;
                    *(LAS bf16*)(hq) = (bf16)(p01 & 0xffffu); *(LAS bf16*)(hq + HSTRB) = (bf16)(p01 >> 16); *(LAS bf16*)(hq + 2 * HSTRB) = (bf16)(p23 & 0xffffu); *(LAS bf16*)(hq + 3 * HSTRB) = (bf16)(p23 >> 16);
                    __builtin_amdgcn_sched_barrier(0);
                }
                bf16x8 wo[2];
#pragma unroll
                for (int ks = 0; ks < 2; ++ks) { const f32x4 w0 = *(const LAS f32x4*)(wsc + 32 * ks + 8 * g), w1 = *(const LAS f32x4*)(wsc + 32 * ks + 8 * g + 4);
                    v4u po; po.x = pg8::cvt_pk_bf16(w0.x, w0.y); po.y = pg8::cvt_pk_bf16(w0.z, w0.w); po.z = pg8::cvt_pk_bf16(w1.x, w1.y); po.w = pg8::cvt_pk_bf16(w1.z, w1.w); wo[ks] = __builtin_bit_cast(bf16x8, po); }
#pragma unroll
                for (int dt = 0; dt < 4; ++dt) {
                    Cacc[dt] = Cacc[dt] * decay; nacc[dt] = nacc[dt] * decay;
#pragma unroll
                    for (int ks = 0; ks < 2; ++ks) {
                        const LAS unsigned char* kp = db + OFF_K + (32 * ks + 8 * g + q4) * QSTR + (16 * dt + 4 * p4) * 2;
                        const s16x4 lo = vtr(kp), hh = vtr(kp + 4 * QSTR);
                        const bf16x8 ka = (bf16x8){lo[0], lo[1], lo[2], lo[3], hh[0], hh[1], hh[2], hh[3]};
                        Cacc[dt] = mfma16(ka, wv[ks], Cacc[dt]); nacc[dt] = mfma16(ka, wo[ks], nacc[dt]);
                    }
                    __builtin_amdgcn_sched_barrier(0);
                }
            }
            MSTAMP(2);
            if (c < 32) {
                LAS unsigned char* Sn = lds + OFF_S + (par ^ 1) * SBUF;
                f32x4 acc = (f32x4){0.f, 0.f, 0.f, 0.f};
                acc = mfma16(xa[0][0], xb[0][0], acc); acc = mfma16(xa[0][1], xb[0][1], acc);
                ML_STILE(acc, rtA, stA, c + 1, mnext, Sn);
                if (w < 2) { f32x4 acc2 = (f32x4){0.f, 0.f, 0.f, 0.f}; acc2 = mfma16(xa[1][0], xb[1][0], acc2); acc2 = mfma16(xa[1][1], xb[1][1], acc2); ML_STILE(acc2, rtB, stB, c + 1, mnext, Sn); }
            }
            MSTAMP(3);
            if (c >= 1) {
                const LAS unsigned char* hp = lds + OFF_H + (par ^ 1) * HBUF + zt * HSTRB + zc * 32; float hv[16]; float ss = 0.f;
                const v4u h0 = *(const LAS v4u*)hp, h1 = *(const LAS v4u*)(hp + 16); const unsigned hw[8] = {h0.x, h0.y, h0.z, h0.w, h1.x, h1.y, h1.z, h1.w};
#pragma unroll
                for (int i = 0; i < 8; ++i) { hv[2 * i] = bflo(hw[i]); hv[2 * i + 1] = bfhi(hw[i]); ss += hv[2 * i] * hv[2 * i] + hv[2 * i + 1] * hv[2 * i + 1]; }
                ss = sum8(ss);
                const float rn = __builtin_amdgcn_rsqf(ss * (1.0f / DV) + EPS);
                const unsigned ow[8] = {og0.x, og0.y, og0.z, og0.w, og1.x, og1.y, og1.z, og1.w}; unsigned res[8]; float gn[16];
#pragma unroll
                for (int i = 0; i < 4; ++i) { const f32x4 t4 = *(const LAS f32x4*)(lds + OFF_GN + (16 * zc + 4 * i) * 4); gn[4 * i] = t4.x; gn[4 * i + 1] = t4.y; gn[4 * i + 2] = t4.z; gn[4 * i + 3] = t4.w; }
#pragma unroll
                for (int i = 0; i < 8; ++i) { const float o0 = bflo(ow[i]), o1 = bfhi(ow[i]);
                    res[i] = pg8::cvt_pk_bf16(hv[2 * i] * rn * gn[2 * i] * __builtin_amdgcn_rcpf(1.0f + __expf(-o0)), hv[2 * i + 1] * rn * gn[2 * i + 1] * __builtin_amdgcn_rcpf(1.0f + __expf(-o1))); }
                if (zvalid && (cz != 0 || b == 0)) { bf16* dst = (cz == 0 ? F.MIXM : F.MIX) + (size_t)ML_ROW0(cz) * D + h * DV; const int om = zt * D + 16 * zc; *(GAS v4u*)(dst + om) = (v4u){res[0], res[1], res[2], res[3]}; *(GAS v4u*)(dst + 8 + om) = (v4u){res[4], res[5], res[6], res[7]}; }
            }
            m = mnext;
            MSTAMP(4);
            if (c < 32) ML_STORE(par ^ 1);
            MSTAMP(5);
            __syncthreads();
            MSTAMP(6);
        }
#ifdef PROBE_ML
        if (blockIdx.x == 0) ((volatile LAS float*)F.MISC)[17] = pacc / 34.f;
#endif
#undef ML_ROW0
#undef ML_PB
#undef ML_LOAD
#undef ML_STORE
#undef ML_STILE
    }
}
struct Args { const float* in[14]; float* out; unsigned char* ws; int ph_lo, ph_hi; };
__global__ void __launch_bounds__(NWAVES * 64, 2) fwd_kernel(Args args) {
    extern __shared__ __attribute__((aligned(16))) unsigned char lds[];
    Frame F;
    F.lds = (LAS unsigned char*)lds;
    F.MISC = (volatile LAS unsigned*)(F.lds + MISC_OFF);
    F.tid = threadIdx.x; F.lane = F.tid & 63; F.wave = __builtin_amdgcn_readfirstlane(F.tid >> 6);
    F.G = gridDim.x; { const int bx = blockIdx.x; F.vcu = (F.G % 8 == 0) ? (bx % 8) * (F.G / 8) + bx / 8 : bx; }
    unsigned char* ws = args.ws; F.ws = ws;
    F.ctl = (gu32*)(ws + WS_CTL);
    F.x = args.in[0]; F.meta = args.in[1]; F.ngain = args.in[2]; F.m_win = args.in[3]; F.m_bgate = args.in[4]; F.m_hgain = args.in[5]; F.m_wout = args.in[6];
    F.d_win = args.in[7]; F.d_lam = args.in[8]; F.d_hgain = args.in[9]; F.d_wout = args.in[10]; F.w_up = args.in[11]; F.w_dn = args.in[12]; F.fgain = args.in[13];
    F.out = args.out;
    F.WIN0 = (bf16*)(ws + WS_WIN0); F.WOUT0 = (bf16*)(ws + WS_WOUT0); F.WUP0 = (bf16*)(ws + WS_WUP0); F.WDN0 = (bf16*)(ws + WS_WDN0);
    F.WIN1 = (bf16*)(ws + WS_WIN1); F.WOUT1 = (bf16*)(ws + WS_WOUT1); F.WUP1 = (bf16*)(ws + WS_WUP1); F.WDN1 = (bf16*)(ws + WS_WDN1);
    F.HB = (bf16*)(ws + WS_HB); F.P = (bf16*)(ws + WS_P); F.MIX = (bf16*)(ws + WS_MIX); F.U = (bf16*)(ws + WS_U);
    F.SS = (float*)(ws + WS_SS); F.GATES = (float*)(ws + WS_GATES); F.GSC = (float*)(ws + WS_GSC);
    F.HMETA = (float*)(ws + WS_HMETA); F.HBM = (bf16*)(ws + WS_HBM); F.PM = (bf16*)(ws + WS_PM); F.MIXM = (bf16*)(ws + WS_MIXM); F.UM = (bf16*)(ws + WS_UM); F.GATESM = (float*)(ws + WS_GATESM);
    F.SSM = (float*)(ws + WS_CTL) + CW_SSM;
    for (int u = F.tid; u < (LDS_BYTES - LDSCTL_OFF) / 4; u += NWAVES * 64) ((LAS unsigned*)(F.lds + LDSCTL_OFF))[u] = 0u;
    __syncthreads();
    const int lo = args.ph_lo, hi = args.ph_hi;
    const bool use_bar = (hi - lo) > 1;
    XcdBarrier bar; bar.bar = (unsigned*)(F.ctl + CW_BAR); bar.x = 0; bar.st = nullptr;
    if (use_bar) bar = xcd_barrier_post((unsigned*)(F.ctl + CW_BAR), F.MISC + 8);
#define IN(k) (lo <= (k) && (k) < hi)
#ifdef PROBE_PHASE
    unsigned long long t_prev = __builtin_amdgcn_s_memrealtime(); float probe_val = 0.f; const unsigned long long t_start = t_prev;
#define STAMP(k) do { const unsigned long long t_now = __builtin_amdgcn_s_memrealtime(); if ((k) == PROBE_PHASE) probe_val = (float)(t_now - t_prev) * 0.01f; t_prev = t_now; } while (0)
#else
#define STAMP(k) do {} while (0)
#endif
#ifdef PROBE_BAR
    float bar_us = 0.f;
#define SEAM(k) do { if (IN(k) && IN((k) + 1)) { const unsigned long long tb0_ = __builtin_amdgcn_s_memrealtime(); xcd_barrier(bar); if (PROBE_BAR == 99 || PROBE_BAR == (k)) bar_us += (float)(__builtin_amdgcn_s_memrealtime() - tb0_) * 0.01f; } STAMP(k); } while (0)
#else
#define SEAM(k) do { if (IN(k) && IN((k) + 1)) xcd_barrier(bar); STAMP(k); } while (0)
#endif
#ifdef DOUBLE_PHASE
#define DBLG(k, EPI, Aptr, Bptr, NN, KK, ...) if (DOUBLE_PHASE == (k)) { pg8::Gemm g{Aptr, Bptr, MR, NN, KK}; pg8::StaticOrder S; S.init(MR, NN, F.G, (int)blockIdx.x); EPI E{__VA_ARGS__}; pg8::gemm_phase<EPI, pg8::StaticOrder, PG8_ALIGN, PG8_SP2>(F.lds + RING_OFF, g, S, E); xcd_barrier(bar); }
#else
#define DBLG(k, EPI, Aptr, Bptr, NN, KK, ...)
#endif
#define GEMM_PHASE(k, EPI, Aptr, Bptr, NN, KK, METAJOB, ...) if (IN(k)) { DBLG(k, EPI, Aptr, Bptr, NN, KK, __VA_ARGS__)  METAJOB; pg8::Gemm g{Aptr, Bptr, MR, NN, KK}; pg8::StaticOrder S; S.init(MR, NN, F.G, (int)blockIdx.x); \
        EPI E{__VA_ARGS__}; pg8::gemm_phase<EPI, pg8::StaticOrder, PG8_ALIGN, PG8_SP2>(F.lds + RING_OFF, g, S, E); SEAM(k); }
    typedef pg8::EpiRes<true, false> EpiRes00; typedef pg8::EpiRes<false, false> EpiRes10; typedef pg8::EpiRes<false, true> EpiRes11;
    typedef pg8::EpiScale<0, 1> EpiIn0; typedef pg8::EpiScale<0, 16> EpiIn1; typedef pg8::EpiScale<1, 16> EpiUp;
#ifdef DOUBLE_PHASE
#define DBL(k, stmt) if (DOUBLE_PHASE == (k)) { stmt; xcd_barrier(bar); }
#else
#define DBL(k, stmt)
#endif
    DBL(0, p0_prologue(F))
    if (IN(0)) { p0_prologue(F); SEAM(0); }
    GEMM_PHASE(1, EpiIn0, F.HB, F.WIN0, NPROJ, D, gate_scan_job(F); meta_gemm(F, F.HBM, F.WIN0, 0, NPROJ / 16, D, MEpiScale<0>{F.PM, NPROJ, F.SSM}), F.P, NPROJ, F.SS, EPS)
#ifdef MLSTM_V2
    DBL(2, mlstm_mfma_phase(F))
    if (IN(2)) { mlstm_mfma_phase(F); SEAM(2); }
#else
    DBL(2, mlstm3_phase(F))
    if (IN(2)) { mlstm3_phase(F); SEAM(2); }
#endif
    GEMM_PHASE(3, EpiRes00, F.MIX, F.WOUT0, D, D, meta_gemm(F, F.MIXM, F.WOUT0, 0, D / 16, D, MEpiRes{F.meta, F.HMETA, F.HBM, F.SSM}), F.x, (float*)nullptr, F.HB, F.SS)
    GEMM_PHASE(4, EpiUp, F.HB, F.WUP0, FF, D, meta_gemm(F, F.HBM, F.WUP0, 0, FF / 16, D, MEpiScale<1>{F.UM, FF, F.SSM}), F.U, FF, F.SS, EPS)
    GEMM_PHASE(5, EpiRes10, F.U, F.WDN0, D, FF, meta_gemm(F, F.UM, F.WDN0, 0, D / 16, FF, MEpiRes{F.HMETA, F.HMETA, F.HBM, F.SSM}), (const float*)nullptr, (float*)nullptr, F.HB, F.SS)
    GEMM_PHASE(6, EpiIn1, F.HB, F.WIN1, NPROJ, D, meta_gemm(F, F.HBM, F.WIN1, 1024 / 16, NPROJ / 16, D, MEpiScale<0>{F.PM, NPROJ, F.SSM}), F.P, NPROJ, F.SS, EPS)
    DBL(7, attn_mfma_phase(F))
    if (IN(7)) { attn_mfma_phase(F); SEAM(7); }
    GEMM_PHASE(8, EpiRes10, F.MIX, F.WOUT1, D, D, (void)0, (const float*)nullptr, (float*)nullptr, F.HB, F.SS)
    GEMM_PHASE(9, EpiUp, F.HB, F.WUP1, FF, D, (void)0, F.U, FF, F.SS, EPS)
    GEMM_PHASE(10, EpiRes10, F.U, F.WDN1, D, FF, (void)0, (const float*)nullptr, (float*)nullptr, F.HB, F.SS)
    if (IN(11)) { final_norm_phase(F); }
#ifdef PROBE_BAR
    if (blockIdx.x == PROBE_BLOCK && F.tid == 0) { asm volatile("s_waitcnt vmcnt(0)" ::: "memory"); F.out[PROBE_BLOCK == 0 ? 0 : 1] += 0.05f + 0.10f * fminf(bar_us * (1.0f / PROBE_FULL), 1.0f); }
#endif
#if defined(PROBE_SEG) || defined(PROBE_GEMM) || defined(PROBE_ML) || defined(PROBE_P0)
    if (blockIdx.x == 0 && F.tid == 0) { asm volatile("s_waitcnt vmcnt(0)" ::: "memory"); const float cyc = ((volatile LAS float*)F.MISC)[17]; F.out[0] += 0.05f + 0.10f * fminf(cyc * (1.0f / PROBE_FULL), 1.0f); }
#endif
#ifdef PROBE_PHASE
    STAMP(11);
    if (PROBE_PHASE == 99) probe_val = (float)(__builtin_amdgcn_s_memrealtime() - t_start) * 0.01f;
    if (blockIdx.x == 0 && F.tid == 0) { asm volatile("s_waitcnt vmcnt(0)" ::: "memory"); F.out[0] += 0.05f + 0.10f * fminf(probe_val * (1.0f / PROBE_FULL), 1.0f); }
#endif
#undef IN
#undef SEAM
#undef GEMM_PHASE
}

extern "C" void kernel_launch(void* const* d_in, const int* in_sizes, int n_in, void* d_out, int out_size, void* d_ws, size_t ws_size, hipStream_t stream) {
    static int grid = 0;
    if (grid == 0) {
        if (n_in != 14 || in_sizes[0] != NB * SEQ * D || out_size != NB * SEQ * D || ws_size < WS_END) { fprintf(stderr, "kernel_launch: unexpected shapes (n_in %d, in0 %d, out %d, ws %zu)\n", n_in, n_in > 0 ? in_sizes[0] : -1, out_size, ws_size); grid = -1; return; }
        int dev = 0, cus = 0, per_cu = 0;
        if (hipGetDevice(&dev) != hipSuccess || hipDeviceGetAttribute(&cus, hipDeviceAttributeMultiprocessorCount, dev) != hipSuccess) { grid = -1; return; }
        if (hipFuncSetAttribute((const void*)fwd_kernel, hipFuncAttributeMaxDynamicSharedMemorySize, LDS_BYTES) != hipSuccess) { fprintf(stderr, "kernel_launch: hipFuncSetAttribute failed\n"); grid = -1; return; }
        if (hipOccupancyMaxActiveBlocksPerMultiprocessor(&per_cu, (const void*)fwd_kernel, NWAVES * 64, LDS_BYTES) != hipSuccess || per_cu < 1) { fprintf(stderr, "kernel_launch: occupancy query reports %d blocks per CU\n", per_cu); (void)hipGetLastError(); grid = -1; return; }
        grid = cus;
    }
    if (grid < 0) return;
    if (hipMemsetAsync((char*)d_ws + WS_CTL, 0, CTL_ZERO_BYTES, stream) != hipSuccess) return;
    Args a{};
    for (int i = 0; i < 14; ++i) a.in[i] = (const float*)d_in[i];
    a.out = (float*)d_out; a.ws = (unsigned char*)d_ws;
    if (MK_N_LAUNCHES == 1) { a.ph_lo = 0; a.ph_hi = NPHASE; hipLaunchKernelGGL(fwd_kernel, dim3(grid), dim3(NWAVES * 64), LDS_BYTES, stream, a); }
    else for (int p = 0; p < NPHASE; ++p) { a.ph_lo = p; a.ph_hi = p + 1; hipLaunchKernelGGL(fwd_kernel, dim3(grid), dim3(NWAVES * 64), LDS_BYTES, stream, a); }
}
```

```cpp
#define MLSTM_V2
#include <hip/hip_runtime.h>
#include <cstdio>
#include <cstdint>
namespace pg8 {
#define PG8_LAS __attribute__((address_space(3)))
typedef unsigned short bf16_t;
typedef short bf16x8 __attribute__((ext_vector_type(8)));
typedef float f32x4 __attribute__((ext_vector_type(4)));
typedef unsigned u32x4 __attribute__((ext_vector_type(4)));
constexpr int BM = 256, BK = 64, HALF = 128, HTB = HALF * BK * 2  , STAGE_BYTES = 8 * HTB, NXCD = 8, WGM = 8;

__host__ __device__ __forceinline__ int lds_byte(int r, int c) { const int st = (r >> 4) * 2 + (c >> 5), rr = r & 15, cc = c & 31, ob = rr * 64 + cc * 2; return st * 1024 + (ob ^ (((ob >> 9) & 1) << 5)); }
__host__ __device__ __forceinline__ void stage_rc(int b, int& R, int& C) { const int st = b / 1024, sb = b % 1024, swz = sb ^ (((sb >> 9) & 1) << 5); R = (st >> 1) * 16 + swz / 64; C = (st & 1) * 32 + (swz % 64) / 2; }
__host__ __device__ __forceinline__ int perm32(int rho) { const int n = rho >> 4, i = rho & 15; return 8 * (i >> 2) + 4 * n + (i & 3); }

struct Unit { int pm, pn; };
struct Gemm { const bf16_t* A; const bf16_t* Bt; int M, N, K; };

struct StaticOrder {
    int nM, nN, nwg, G, c;
    __host__ __device__ void init(int M, int N, int G_, int c_) { nM = M / BM; nN = N / BM; nwg = nM * nN; G = G_; c = c_; }
    __host__ __device__ bool next(int i, Unit& u) const {
        const long L = (long)i * G + c; if (L >= nwg) return false;
        int wgid = (int)L; { const int q = nwg / NXCD, r = nwg % NXCD, xcd = wgid % NXCD, off = wgid / NXCD; wgid = (xcd < r ? xcd * (q + 1) : r * (q + 1) + (xcd - r) * q) + off; }
        const int nig = WGM * nN, gid = wgid / nig, fm = gid * WGM, gsz = (nM - fm) < WGM ? (nM - fm) : WGM;
        u.pm = fm + ((wgid % nig) % gsz); u.pn = (wgid % nig) / gsz; return true;
    }
    __device__ __forceinline__ void a_ready(const Unit&) const {}
    __device__ __forceinline__ void done(const Unit&) const {}
};

__device__ __forceinline__ unsigned cvt_pk_bf16(float lo, float hi) { unsigned r; asm volatile("v_cvt_pk_bf16_f32 %0, %1, %2" : "=v"(r) : "v"(lo), "v"(hi)); return r; }
typedef unsigned u32x2 __attribute__((ext_vector_type(2)));
#ifndef WT_STORES
__device__ __forceinline__ void st16_wt(void* p, u32x4 v) { *(u32x4*)p = v; }
#else
__device__ __forceinline__ void st16_wt(void* p, u32x4 v) { asm volatile("global_store_dwordx4 %0, %1, off sc1\n\ts_nop 1" :: "v"(p), "v"(v) : "memory"); }
#endif

template <int NS> __device__ __forceinline__ float row_rstd(const float* ss, int row, float eps) {
    const float* sp = ss + (size_t)row * 16; float s;
    if (NS == 1) s = sp[0];
    else { const f32x4 a = *(const f32x4*)sp, b = *(const f32x4*)(sp + 4), c = *(const f32x4*)(sp + 8), d = *(const f32x4*)(sp + 12);
           s = ((a[0] + a[1]) + (a[2] + a[3])) + ((b[0] + b[1]) + (b[2] + b[3])) + ((c[0] + c[1]) + (c[2] + c[3])) + ((d[0] + d[1]) + (d[2] + d[3])); }
    return __builtin_amdgcn_rsqf(s * (1.0f / 1024.0f) + eps);
}
__device__ __forceinline__ float row_rstd16_coop(const float* ss, int row, int fq, float eps) {
    const f32x4 a = *(const f32x4*)(ss + (size_t)row * 16 + 4 * fq); float s = (a[0] + a[1]) + (a[2] + a[3]);
    s += __shfl_xor(s, 16); s += __shfl_xor(s, 32);
    return __builtin_amdgcn_rsqf(s * (1.0f / 1024.0f) + eps);
}
template <int ACT, int NS> struct EpiScale {
    static constexpr bool PERM = true, AFTER_DRAIN = false;
    bf16_t* O; int ldc; const float* ss; float eps;
    __device__ __forceinline__ void operator()(const f32x4 (&acc)[2][2][4][2], const Unit& u, int wr, int wc, int fr, int fq) const {
        const int row0 = u.pm * BM + wr * 64 + fr, col0 = u.pn * BM + wc * 32 + 8 * fq;
        float rsv[2][4];
#pragma unroll
        for (int ai = 0; ai < 2; ++ai)
#pragma unroll
            for (int m = 0; m < 4; ++m) { const int row = row0 + ai * HALF + m * 16; rsv[ai][m] = (NS == 1) ? row_rstd<1>(ss, row, eps) : row_rstd16_coop(ss, row, fq, eps); }
#pragma unroll
        for (int ai = 0; ai < 2; ++ai)
#pragma unroll
            for (int m = 0; m < 4; ++m) { const int row = row0 + ai * HALF + m * 16; const float rs = rsv[ai][m];
                bf16_t* rowp = O + (size_t)row * ldc + col0;
#pragma unroll
                for (int bj = 0; bj < 2; ++bj) { f32x4 v0 = acc[ai][bj][m][0] * rs, v1 = acc[ai][bj][m][1] * rs;
                    if (ACT == 1) {
#pragma unroll
                        for (int i = 0; i < 4; ++i) { const float a = fmaxf(v0[i], 0.f), b = fmaxf(v1[i], 0.f); v0[i] = a * a; v1[i] = b * b; } }
                    u32x4 w; w.x = cvt_pk_bf16(v0[0], v0[1]); w.y = cvt_pk_bf16(v0[2], v0[3]); w.z = cvt_pk_bf16(v1[0], v1[1]); w.w = cvt_pk_bf16(v1[2], v1[3]);
                    st16_wt(rowp + bj * HALF, w); } }
    }
};
template <bool IN_F32, bool OUT_F32> struct EpiRes {
    static constexpr bool PERM = true, AFTER_DRAIN = false;
    const float* Hin; float* Hout; bf16_t* HB; float* ss;
    __device__ __forceinline__ void operator()(const f32x4 (&acc)[2][2][4][2], const Unit& u, int wr, int wc, int fr, int fq) const {
        const int row0 = u.pm * BM + wr * 64 + fr, col0 = u.pn * BM + wc * 32 + 8 * fq;
#pragma unroll
        for (int ai = 0; ai < 2; ++ai)
#pragma unroll
            for (int m = 0; m < 4; ++m) { const int row = row0 + ai * HALF + m * 16; const size_t off = (size_t)row * 1024 + col0; float q = 0.f;
#pragma unroll
                for (int bj = 0; bj < 2; ++bj) { f32x4 h0, h1;
                    if (IN_F32) { h0 = *(const f32x4*)(Hin + off + bj * HALF); h1 = *(const f32x4*)(Hin + off + bj * HALF + 4); }
                    else { const u32x4 w = *(const u32x4*)(HB + off + bj * HALF);
                        h0 = (f32x4){__builtin_bit_cast(float, w.x << 16), __builtin_bit_cast(float, w.x & 0xffff0000u), __builtin_bit_cast(float, w.y << 16), __builtin_bit_cast(float, w.y & 0xffff0000u)};
                        h1 = (f32x4){__builtin_bit_cast(float, w.z << 16), __builtin_bit_cast(float, w.z & 0xffff0000u), __builtin_bit_cast(float, w.w << 16), __builtin_bit_cast(float, w.w & 0xffff0000u)}; }
                    h0 = h0 + acc[ai][bj][m][0]; h1 = h1 + acc[ai][bj][m][1];
                    q += ((h0[0] * h0[0] + h0[1] * h0[1]) + (h0[2] * h0[2] + h0[3] * h0[3])) + ((h1[0] * h1[0] + h1[1] * h1[1]) + (h1[2] * h1[2] + h1[3] * h1[3]));
                    if (OUT_F32) { st16_wt(Hout + off + bj * HALF, __builtin_bit_cast(u32x4, h0)); st16_wt(Hout + off + bj * HALF + 4, __builtin_bit_cast(u32x4, h1)); }
                    else { u32x4 w; w.x = cvt_pk_bf16(h0[0], h0[1]); w.y = cvt_pk_bf16(h0[2], h0[3]); w.z = cvt_pk_bf16(h1[0], h1[1]); w.w = cvt_pk_bf16(h1[2], h1[3]); st16_wt(HB + off + bj * HALF, w); } }
                q += __shfl_xor(q, 16); q += __shfl_xor(q, 32);
                if (fq == 0) ss[(size_t)row * 16 + u.pn * 4 + wc] = q; }
    }
};

template <class Epi, class Sched, bool ALIGN_EPI = false, bool SP2 = false>
__device__ __forceinline__ void gemm_phase(PG8_LAS unsigned char* lds, const Gemm g, const Sched& S, const Epi& E) {
    const int tid = threadIdx.x, wid = __builtin_amdgcn_readfirstlane(tid >> 6), lane = tid & 63, wr = wid >> 2, wc = wid & 3, fr = lane & 15, fq = lane >> 4;
    const int K = g.K, nt = K / BK;
    unsigned voffA[2], voffB[2];
#pragma unroll
    for (int i = 0; i < 2; ++i) { int R, C; stage_rc(tid * 16 + i * 8192, R, C); const int Rb = Epi::PERM ? ((R & ~31) + perm32(R & 31)) : R;
        voffA[i] = (unsigned)(R * K + C) * 2u; voffB[i] = (unsigned)(Rb * K + C) * 2u; }
    const size_t kstep = (size_t)(BK * 2);
    const size_t hstep = (size_t)HALF * K * 2;
    const size_t tstep = 2 * hstep;
    const unsigned ldsw = (unsigned)wid * 1024u;
    const int aoff = lds_byte(wr * 64 + fr, fq * 8), boff = lds_byte(wc * 32 + fr, fq * 8);
#define PG8_SA(b, h) (((b) * 2 + (h)) * HTB)
#define PG8_SB(b, h) ((4 + (b) * 2 + (h)) * HTB)
#define PG8_STAGE(bufoff, gbase, voff) do { _Pragma("unroll") for (int _i = 0; _i < 2; ++_i) \
        __builtin_amdgcn_global_load_lds((const unsigned*)((const char*)(gbase) + (voff)[_i]), (PG8_LAS unsigned*)(lds + (bufoff) + ldsw + _i * 8192), 16, 0, 0); } while (0)
#define PG8_LDA(dst, b, h) do { _Pragma("unroll") for (int m = 0; m < 4; ++m) _Pragma("unroll") for (int k = 0; k < 2; ++k) dst[m][k] = *(const PG8_LAS bf16x8*)(lds + PG8_SA(b, h) + aoff + m * 2048 + k * 1024); } while (0)
#define PG8_LDB(dst, b, h) do { _Pragma("unroll") for (int n = 0; n < 2; ++n) _Pragma("unroll") for (int k = 0; k < 2; ++k) dst[n][k] = *(const PG8_LAS bf16x8*)(lds + PG8_SB(b, h) + boff + n * 2048 + k * 1024); } while (0)
#define PG8_MMA(ai, bj, At, Bt) do { __builtin_amdgcn_s_setprio(1); _Pragma("unroll") for (int m = 0; m < 4; ++m) _Pragma("unroll") for (int n = 0; n < 2; ++n) _Pragma("unroll") for (int k = 0; k < 2; ++k) \
        acc[ai][bj][m][n] = __builtin_amdgcn_mfma_f32_16x16x32_bf16(Bt[n][k], At[m][k], acc[ai][bj][m][n], 0, 0, 0); __builtin_amdgcn_s_setprio(0); } while (0)
#define PG8_WAIT_V(n) asm volatile("s_waitcnt vmcnt(" #n ")" ::: "memory")
#define PG8_WAIT_L(n) asm volatile("s_waitcnt lgkmcnt(" #n ")" ::: "memory")
#define PG8_BAR __builtin_amdgcn_s_barrier()
#define PG8_SCHED __builtin_amdgcn_sched_barrier(0)
    Unit cur, nxt; int ui = 0;
#ifdef PROBE_GEMM
    float probe_epi_cycles = 0.f, probe_units = 0.f; unsigned long long tph0_; const unsigned long long trl0_ = __builtin_amdgcn_s_memrealtime(); asm volatile("s_memtime %0\n\ts_waitcnt lgkmcnt(0)" : "=s"(tph0_) :: "memory");
#endif
    if (!S.next(0, cur)) return;
    f32x4 acc[2][2][4][2];
#pragma unroll
    for (int a = 0; a < 2; ++a)
#pragma unroll
        for (int b = 0; b < 2; ++b)
#pragma unroll
            for (int m = 0; m < 4; ++m)
#pragma unroll
                for (int n = 0; n < 2; ++n) acc[a][b][m][n] = (f32x4){0.f, 0.f, 0.f, 0.f};
    bf16x8 At[4][2], B0[2][2], B1[2][2];
    const char* cA = (const char*)g.A + (size_t)cur.pm * tstep; const char* cB = (const char*)g.Bt + (size_t)cur.pn * tstep;
    S.a_ready(cur);
    if constexpr (SP2) {
        PG8_STAGE(PG8_SB(0, 0), cB, voffB); PG8_STAGE(PG8_SB(0, 1), cB + hstep, voffB); PG8_STAGE(PG8_SA(0, 0), cA, voffA); PG8_STAGE(PG8_SA(0, 1), cA + hstep, voffA);
        if (wr == 1) PG8_BAR;
        PG8_WAIT_V(2); PG8_BAR;
        PG8_STAGE(PG8_SB(1, 0), cB + kstep, voffB); PG8_STAGE(PG8_SA(1, 0), cA + kstep, voffA); PG8_STAGE(PG8_SB(1, 1), cB + hstep + kstep, voffB);
        PG8_WAIT_V(6); PG8_BAR;
    } else {
        PG8_STAGE(PG8_SB(0, 0), cB, voffB); PG8_STAGE(PG8_SA(0, 0), cA, voffA); PG8_STAGE(PG8_SB(0, 1), cB + hstep, voffB); PG8_STAGE(PG8_SA(0, 1), cA + hstep, voffA);
        if (wr == 1) PG8_BAR;
        PG8_WAIT_V(4); PG8_BAR;
        PG8_STAGE(PG8_SB(1, 0), cB + kstep, voffB); PG8_STAGE(PG8_SA(1, 0), cA + kstep, voffA); PG8_STAGE(PG8_SB(1, 1), cB + hstep + kstep, voffB);
        PG8_WAIT_V(6); PG8_BAR;
    }
    for (;;) {
        const bool has_next = S.next(ui + 1, nxt);
        const char* nA = has_next ? (const char*)g.A + (size_t)nxt.pm * tstep : cA; const char* nB = has_next ? (const char*)g.Bt + (size_t)nxt.pn * tstep : cB;
        for (int t = 0; t < nt; t += 2) {
            const bool last = (t == nt - 2);
            const char* a1 = cA + (size_t)(t + 1) * kstep;
            const char* a2 = last ? nA : cA + (size_t)(t + 2) * kstep; const char* b2 = last ? nB : cB + (size_t)(t + 2) * kstep;
            const char* a3 = a2 + kstep; const char* b3 = b2 + kstep;
            if (last && has_next) S.a_ready(nxt);
            if constexpr (SP2) {
            PG8_LDB(B0, 0, 0); PG8_LDB(B1, 0, 1); PG8_SCHED; PG8_LDA(At, 0, 0); PG8_STAGE(PG8_SA(1, 1), a1 + hstep, voffA);
            PG8_WAIT_V(8); PG8_WAIT_L(0); PG8_BAR; PG8_MMA(0, 0, At, B0); PG8_MMA(0, 1, At, B1); PG8_BAR; PG8_SCHED;
            PG8_LDA(At, 0, 1); PG8_STAGE(PG8_SB(0, 0), b2, voffB); PG8_STAGE(PG8_SB(0, 1), b2 + hstep, voffB); PG8_STAGE(PG8_SA(0, 0), a2, voffA);
            PG8_WAIT_V(8); PG8_WAIT_L(0); PG8_BAR; PG8_MMA(1, 0, At, B0); PG8_MMA(1, 1, At, B1); PG8_BAR; PG8_SCHED;
            PG8_LDB(B0, 1, 0); PG8_LDB(B1, 1, 1); PG8_SCHED; PG8_LDA(At, 1, 0); PG8_STAGE(PG8_SA(0, 1), a2 + hstep, voffA);
            PG8_WAIT_V(8); PG8_WAIT_L(0); PG8_BAR; PG8_MMA(0, 0, At, B0); PG8_MMA(0, 1, At, B1); PG8_BAR; PG8_SCHED;
            PG8_LDA(At, 1, 1); PG8_STAGE(PG8_SB(1, 0), b3, voffB); PG8_STAGE(PG8_SB(1, 1), b3 + hstep, voffB); PG8_STAGE(PG8_SA(1, 0), a3, voffA);
            PG8_WAIT_V(8); PG8_WAIT_L(0); PG8_BAR; PG8_MMA(1, 0, At, B0); PG8_MMA(1, 1, At, B1); PG8_BAR; PG8_SCHED;
            } else {
            PG8_LDB(B0, 0, 0); PG8_SCHED; PG8_LDA(At, 0, 0); PG8_STAGE(PG8_SA(1, 1), a1 + hstep, voffA);
            PG8_WAIT_L(8); PG8_BAR; PG8_WAIT_L(0); PG8_MMA(0, 0, At, B0); PG8_BAR; PG8_SCHED;
            PG8_LDB(B1, 0, 1); PG8_STAGE(PG8_SB(0, 0), b2, voffB);
            PG8_BAR; PG8_WAIT_L(0); PG8_MMA(0, 1, At, B1); PG8_BAR;
            PG8_LDA(At, 0, 1); PG8_STAGE(PG8_SA(0, 0), a2, voffA);
            PG8_BAR; PG8_WAIT_L(0); PG8_MMA(1, 0, At, B0); PG8_BAR; PG8_SCHED;
            PG8_STAGE(PG8_SB(0, 1), b2 + hstep, voffB);
            PG8_WAIT_V(6); PG8_BAR; PG8_MMA(1, 1, At, B1); PG8_BAR;
            PG8_LDB(B0, 1, 0); PG8_SCHED; PG8_LDA(At, 1, 0); PG8_STAGE(PG8_SA(0, 1), a2 + hstep, voffA);
            PG8_WAIT_L(8); PG8_BAR; PG8_WAIT_L(0); PG8_MMA(0, 0, At, B0); PG8_BAR; PG8_SCHED;
            PG8_LDB(B1, 1, 1); PG8_STAGE(PG8_SB(1, 0), b3, voffB);
            PG8_BAR; PG8_WAIT_L(0); PG8_MMA(0, 1, At, B1); PG8_BAR;
            PG8_LDA(At, 1, 1); PG8_STAGE(PG8_SA(1, 0), a3, voffA);
            PG8_BAR; PG8_WAIT_L(0); PG8_MMA(1, 0, At, B0); PG8_BAR; PG8_SCHED;
            PG8_STAGE(PG8_SB(1, 1), b3 + hstep, voffB);
            PG8_WAIT_V(6); PG8_BAR; PG8_MMA(1, 1, At, B1); PG8_BAR;
            }
        }
        if constexpr (ALIGN_EPI) { if (wr == 0) PG8_BAR; }
#ifdef PROBE_GEMM
        unsigned long long tg0_; asm volatile("s_memtime %0\n\ts_waitcnt lgkmcnt(0)" : "=s"(tg0_) :: "memory");
#endif
        if constexpr (!Epi::AFTER_DRAIN) { E(acc, cur, wr, wc, fr, fq); S.done(cur); }
#ifdef PROBE_GEMM
        { unsigned long long tg1_; asm volatile("s_waitcnt vmcnt(0)\n\ts_memtime %0\n\ts_waitcnt lgkmcnt(0)" : "=s"(tg1_) :: "memory"); probe_epi_cycles += (float)(tg1_ - tg0_); probe_units += 1.f; }
#endif
        if (!has_next) break;
#pragma unroll
        for (int a = 0; a < 2; ++a)
#pragma unroll
            for (int b = 0; b < 2; ++b)
#pragma unroll
                for (int m = 0; m < 4; ++m)
#pragma unroll
                    for (int n = 0; n < 2; ++n) acc[a][b][m][n] = (f32x4){0.f, 0.f, 0.f, 0.f};
        cur = nxt; cA = nA; cB = nB; ++ui;
        if constexpr (ALIGN_EPI) { if (wr == 1) PG8_BAR; }
    }
#ifdef PROBE_GEMM
    if (g.N == PROBE_GEMM_N && g.K == PROBE_GEMM_K) { unsigned long long tph1_; asm volatile("s_memtime %0\n\ts_waitcnt lgkmcnt(0)" : "=s"(tph1_) :: "memory");
        if (blockIdx.x == 0 && tid == 0) { ((volatile PG8_LAS float*)(lds + 162112))[17] = (PROBE_GEMM == 1) ? probe_epi_cycles / probe_units : (PROBE_GEMM == 2) ? (float)(tph1_ - tph0_) / probe_units : (PROBE_GEMM == 3) ? (float)(tph1_ - tph0_) / (float)(__builtin_amdgcn_s_memrealtime() - trl0_) * 100.0f : (float)(__builtin_amdgcn_s_memrealtime() - trl0_) * 0.01f; } }
#endif
    PG8_WAIT_V(0);
    if constexpr (!ALIGN_EPI) { if (wr == 0) PG8_BAR; }
    PG8_BAR;
    if constexpr (Epi::AFTER_DRAIN) { E.fused(acc, cur, wr, wc, fr, fq, lds, wid, lane); S.done(cur); }
#undef PG8_SA
#undef PG8_SB
#undef PG8_STAGE
#undef PG8_LDA
#undef PG8_LDB
#undef PG8_MMA
#undef PG8_WAIT_V
#undef PG8_WAIT_L
#undef PG8_BAR
#undef PG8_SCHED
}
}

#ifndef PG8_SP2
#define PG8_SP2 true
#endif
#ifndef PG8_ALIGN
#define PG8_ALIGN true
#endif
constexpr int NB = 16, SEQ = 2048, NMETA = 16, D = 1024, FF = 4096;
constexpr int MR = NB * SEQ;
constexpr int NH = 8, DQK = 64, DV = 128;
constexpr int NPROJ = 3072;
constexpr float EPS = 1e-6f, SUBLN_EPS = 1e-5f;
constexpr int NWAVES = 8;
#ifndef MK_N_LAUNCHES
#define MK_N_LAUNCHES 1
#endif
constexpr int NPHASE = 12;

constexpr size_t MiB = 1u << 20;
constexpr size_t WS_CTL = 0, CTL_ZERO_BYTES = 1 * MiB;
constexpr size_t WS_WIN0 = 1 * MiB, WS_WOUT0 = 7 * MiB, WS_WUP0 = 9 * MiB, WS_WDN0 = 17 * MiB;
constexpr size_t WS_WIN1 = 25 * MiB, WS_WOUT1 = 31 * MiB, WS_WUP1 = 33 * MiB, WS_WDN1 = 41 * MiB;
constexpr size_t WS_META = 49 * MiB;
constexpr size_t WS_HMETA = WS_META;
constexpr size_t WS_HBM = WS_HMETA + 16 * D * 4;
constexpr size_t WS_PM = WS_HBM + 16 * D * 2;
constexpr size_t WS_MIXM = WS_PM + 16 * NPROJ * 2;
constexpr size_t WS_UM = WS_MIXM + 16 * D * 2;
constexpr size_t WS_GATESM = WS_UM + 16 * FF * 2;
constexpr size_t WS_SS = 50 * MiB;
constexpr size_t WS_GATES = 52 * MiB;
constexpr size_t WS_HB = 54 * MiB;
constexpr size_t WS_P = 118 * MiB;
constexpr size_t WS_MIX = 310 * MiB;
constexpr size_t WS_U = WS_P;
constexpr size_t WS_GSC = 374 * MiB;
constexpr size_t WS_END = 378 * MiB;
static_assert(WS_GATESM + 1024 <= WS_SS && WS_HB + (size_t)MR * D * 2 <= WS_P && WS_P + (size_t)MR * NPROJ * 2 <= WS_MIX && WS_U + (size_t)MR * FF * 2 <= WS_END && WS_MIX + (size_t)MR * D * 2 <= WS_GSC, "d_ws map");
constexpr int CW_BAR = 4096;
constexpr int CW_SSM = 16384;

constexpr int RING_OFF = 0, RING_BYTES = 131072;
constexpr int XTRA_OFF = RING_BYTES, XTRA_BYTES = 30720;
constexpr int LDSCTL_OFF = XTRA_OFF + XTRA_BYTES, MISC_OFF = LDSCTL_OFF + 320;
constexpr int LDS_BYTES = 163840;
static_assert(MISC_OFF + 128 <= LDS_BYTES, "LDS map");

#define GAS __attribute__((address_space(1)))
#define LAS __attribute__((address_space(3)))
typedef unsigned short bf16;
typedef unsigned v4u __attribute__((ext_vector_type(4)));
typedef float f32x4 __attribute__((ext_vector_type(4)));
typedef GAS unsigned gu32;
#define RLX_AGENT __ATOMIC_RELAXED, __HIP_MEMORY_SCOPE_AGENT
#define LDS_WAIT() asm volatile("s_waitcnt lgkmcnt(0)" ::: "memory")
__device__ __forceinline__ unsigned f2bf(float f) { unsigned u = __builtin_bit_cast(unsigned, f); return (u + 0x7fffu + ((u >> 16) & 1u)) >> 16; }
__device__ __forceinline__ unsigned pk2(float lo, float hi) { return f2bf(lo) | (f2bf(hi) << 16); }
__device__ __forceinline__ float bf2f(unsigned short v) { return __builtin_bit_cast(float, (unsigned)v << 16); }
__device__ __forceinline__ float bflo(unsigned w) { return __builtin_bit_cast(float, w << 16); }
__device__ __forceinline__ float bfhi(unsigned w) { return __builtin_bit_cast(float, w & 0xffff0000u); }

#define XB_TMO      128
#define XB_XCNT(j)  (256  + 64 * (j))
#define XB_XSUB(j)  (1280 + 64 * (j))
#define XB_XGEN(j)  (2304 + 64 * (j))
#define XB_TOP      3328
#define XB_TOPGEN   3392
#define XCD_BAR_WORDS 3456
#define XB_SPIN_CAP (1u << 18)
__device__ __forceinline__ unsigned xb_ld(unsigned* p)              { return __hip_atomic_load(p, __ATOMIC_RELAXED, __HIP_MEMORY_SCOPE_AGENT); }
__device__ __forceinline__ unsigned xb_add(unsigned* p, unsigned v) { return __hip_atomic_fetch_add(p, v, __ATOMIC_RELAXED, __HIP_MEMORY_SCOPE_AGENT); }
__device__ __forceinline__ unsigned xb_xcc_id() { return (unsigned)__builtin_amdgcn_s_getreg((3 << 11) | 20) & 0xFu; }
#define XB_SPIN(cond, bar) do { unsigned _sp = 0; while (cond) { __builtin_amdgcn_s_sleep(1); \
    if ((++_sp & 255u) == 0u) { if (xb_ld(&(bar)[XB_TMO])) break; if (_sp > XB_SPIN_CAP) { atomicAdd(&(bar)[XB_TMO], 1u); break; } } } } while (0)
struct XcdBarrier { unsigned* bar; unsigned x; volatile LAS unsigned* st; };
__device__ __forceinline__ XcdBarrier xcd_barrier_post(unsigned* bar, volatile LAS unsigned* st) {
    XcdBarrier b; b.bar = bar; b.x = xb_xcc_id(); b.st = st;
    if (threadIdx.x == 0) (void)xb_add(&bar[XB_XCNT(b.x)], 1u);
    return b;
}
__device__ __forceinline__ void xcd_barrier_complete(unsigned* bar, unsigned x, unsigned& nloc, unsigned& nx) {
    const unsigned G = gridDim.x * gridDim.y * gridDim.z;
    unsigned sum, cnt, mine, sp = 0u;
    for (;;) {
        sum = 0u; cnt = 0u; mine = 0u;
#pragma unroll
        for (unsigned j = 0; j < 16; ++j) { const unsigned c = xb_ld(&bar[XB_XCNT(j)]); sum += c; cnt += (c > 0u) ? 1u : 0u; mine = (j == x) ? c : mine; }
        if (sum == G) break;
        __builtin_amdgcn_s_sleep(1);
        if ((++sp & 255u) == 0u) { if (xb_ld(&bar[XB_TMO])) break; if (sp > XB_SPIN_CAP) { atomicAdd(&bar[XB_TMO], 1u); break; } }
    }
    nloc = mine > 0u ? mine : 1u; nx = cnt > 0u ? cnt : 1u;
}
__device__ __forceinline__ void xcd_barrier(const XcdBarrier& b) {
    asm volatile("s_waitcnt vmcnt(0)" ::: "memory");
    __syncthreads();
    if (threadIdx.x == 0) {
        unsigned* bar = b.bar;
        __builtin_amdgcn_s_waitcnt(0);
        unsigned nloc = b.st[0], nx = b.st[1];
        if (nloc == 0u) { xcd_barrier_complete(bar, b.x, nloc, nx); b.st[0] = nloc; b.st[1] = nx; }
        const unsigned old = xb_add(&bar[XB_XSUB(b.x)], 1u);
        const unsigned gen = old / nloc;
        if (old + 1u == (gen + 1u) * nloc) {
            __builtin_amdgcn_fence(__ATOMIC_RELEASE, "agent");
            asm volatile("s_waitcnt vmcnt(0)" ::: "memory");
            const unsigned og = xb_add(&bar[XB_TOP], 1u);
            const unsigned tg = og / nx;
            if (og + 1u == (tg + 1u) * nx) xb_add(&bar[XB_TOPGEN], 1u);
            else XB_SPIN(xb_ld(&bar[XB_TOPGEN]) == tg, bar);
            __builtin_amdgcn_fence(__ATOMIC_ACQUIRE, "agent");
            xb_add(&bar[XB_XGEN(b.x)], 1u);
            asm volatile("s_waitcnt vmcnt(0)" ::: "memory");
        } else {
            XB_SPIN(xb_ld(&bar[XB_XGEN(b.x)]) == gen, bar);
            __builtin_amdgcn_fence(__ATOMIC_ACQUIRE, "agent");
            asm volatile("s_waitcnt vmcnt(0)" ::: "memory");
        }
    }
    __syncthreads();
}

struct Frame {
    LAS unsigned char* lds;
    volatile LAS unsigned* MISC;
    gu32* ctl;
    int tid, lane, wave, vcu, G;
    const float *x, *meta, *ngain, *m_win, *m_bgate, *m_hgain, *m_wout, *d_win, *d_lam, *d_hgain, *d_wout, *w_up, *w_dn, *fgain;
    float* out; unsigned char* ws;
    bf16 *WIN0, *WOUT0, *WUP0, *WDN0, *WIN1, *WOUT1, *WUP1, *WDN1, *HB, *P, *MIX, *U;
    float *SS, *GATES, *GSC;
    bf16 *HBM, *PM, *MIXM, *UM; float *HMETA, *GATESM, *SSM;
};
__device__ __forceinline__ float wave_sum(float v) {
#pragma unroll
    for (int o = 1; o < 64; o <<= 1) v += __shfl_xor(v, o);
    return v;
}
typedef short bf16x8_t __attribute__((ext_vector_type(8)));
__device__ __forceinline__ f32x4 mfma16(bf16x8_t a, bf16x8_t b, f32x4 c) { return __builtin_amdgcn_mfma_f32_16x16x32_bf16(a, b, c, 0, 0, 0); }
__device__ __forceinline__ void transpose_item(const float* W, int K, int ldw, int Nuse, const float* gk, int nscale, float qscale, bf16* WT, LAS float* scr, int item, int lane) {
    const int nblk = Nuse / 32, kb = item / nblk, nb = item % nblk, k0 = 64 * kb, n0 = 32 * nb;
    const float cs = (n0 < nscale) ? qscale : 1.f;
    const int lr = lane >> 3, lp = lane & 7;
#pragma unroll
    for (int i = 0; i < 8; ++i) { const int kk = 8 * i + lr; const float g = gk ? gk[k0 + kk] * cs : cs; const f32x4 v = *(const GAS f32x4*)(W + (size_t)(k0 + kk) * ldw + n0 + 4 * lp);
        LAS float* d = scr + kk * 33 + 4 * lp; d[0] = v.x * g; d[1] = v.y * g; d[2] = v.z * g; d[3] = v.w * g; }
    LDS_WAIT(); asm volatile("" ::: "memory");
    const int c = lane & 7;
#pragma unroll
    for (int j = 0; j < 4; ++j) { const int n = (lane >> 3) + 8 * j; const LAS float* s = scr + (8 * c) * 33 + n;
        v4u o; o.x = pg8::cvt_pk_bf16(s[0 * 33], s[1 * 33]); o.y = pg8::cvt_pk_bf16(s[2 * 33], s[3 * 33]); o.z = pg8::cvt_pk_bf16(s[4 * 33], s[5 * 33]); o.w = pg8::cvt_pk_bf16(s[6 * 33], s[7 * 33]);
        *(GAS v4u*)(WT + (size_t)(n0 + n) * K + k0 + 8 * c) = o; }
    LDS_WAIT(); asm volatile("" ::: "memory");
}
constexpr int I_IN = (D / 64) * (NPROJ / 32), I_OUT = (D / 64) * (D / 32), I_UP = (D / 64) * (FF / 32), I_DN = (FF / 64) * (D / 32);
constexpr int I_LAYER = I_IN + I_OUT + I_UP + I_DN, NITEMS = 2 * I_LAYER;
__device__ __forceinline__ void convert_weights(Frame& F, int it0, int it1, int gw, int ngw, LAS float* scr) {
    for (int it = it0 + gw; it < it1; it += ngw) {
        const int layer = it / I_LAYER; int r = it % I_LAYER;
        const float* g0 = F.ngain + (layer * 2 + 0) * D; const float* g1 = F.ngain + (layer * 2 + 1) * D;
        if (r < I_IN) { if (layer == 0) transpose_item(F.m_win, D, 3088, NPROJ, g0, 512, 0.125f, F.WIN0, scr, r, F.lane); else transpose_item(F.d_win, D, NPROJ, NPROJ, g0, 1024, 0.125f * 1.4426950408889634f, F.WIN1, scr, r, F.lane);   continue; } r -= I_IN;
        if (r < I_OUT) { transpose_item(layer == 0 ? F.m_wout : F.d_wout, D, D, D, nullptr, 0, 1.f, layer == 0 ? F.WOUT0 : F.WOUT1, scr, r, F.lane); continue; } r -= I_OUT;
        if (r < I_UP) { transpose_item(F.w_up + (size_t)layer * D * FF, D, FF, FF, g1, 0, 1.f, layer == 0 ? F.WUP0 : F.WUP1, scr, r, F.lane); continue; } r -= I_UP;
        transpose_item(F.w_dn + (size_t)layer * FF * D, FF, D, D, nullptr, 0, 1.f, layer == 0 ? F.WDN0 : F.WDN1, scr, r, F.lane);
    }
}
constexpr int WGSTR = 2048 + 16;
__device__ __forceinline__ void embed_group(Frame& F, const float* src, bf16* hb, float* ssd, int ss_stride, float* gd, const LAS unsigned char* wgl) {
    const int li = F.lane & 15, g = F.lane >> 4;
    const float* sp = src + (size_t)li * D + 8 * g; bf16* hp = hb + (size_t)li * D + 8 * g; const LAS unsigned char* wp = wgl + li * WGSTR + 16 * g;
    f32x4 acc = (f32x4){0.f, 0.f, 0.f, 0.f}; float ssp = 0.f;
#pragma unroll 8
    for (int ks = 0; ks < 32; ++ks) {
        const f32x4 a0 = *(const GAS f32x4*)(sp + 32 * ks), a1 = *(const GAS f32x4*)(sp + 32 * ks + 4);
        ssp += ((a0.x * a0.x + a0.y * a0.y) + (a0.z * a0.z + a0.w * a0.w)) + ((a1.x * a1.x + a1.y * a1.y) + (a1.z * a1.z + a1.w * a1.w));
        v4u pw; pw.x = pg8::cvt_pk_bf16(a0.x, a0.y); pw.y = pg8::cvt_pk_bf16(a0.z, a0.w); pw.z = pg8::cvt_pk_bf16(a1.x, a1.y); pw.w = pg8::cvt_pk_bf16(a1.z, a1.w);
        *(GAS v4u*)(hp + 32 * ks) = pw;
        acc = mfma16(__builtin_bit_cast(bf16x8_t, pw), *(const LAS bf16x8_t*)(wp + 64 * ks), acc);
    }
    ssp += __shfl_xor(ssp, 16); ssp += __shfl_xor(ssp, 32);
    const float rstd = 1.0f / sqrtf(ssp * (1.0f / D) + EPS);
    if (g == 0) ssd[(size_t)li * ss_stride] = ssp;
    const float bg = F.m_bgate[li];
#pragma unroll
    for (int r = 0; r < 4; ++r) { const float rs = __shfl(rstd, 4 * g + r); gd[(size_t)(4 * g + r) * 16 + li] = acc[r] * rs + bg; }
}
__device__ __forceinline__ void p0_prologue(Frame& F) {
#ifdef PROBE_P0
    const unsigned long long tp0_ = __builtin_amdgcn_s_memrealtime();
#define P0STAMP(k) do { if (PROBE_P0 == (k) && blockIdx.x == 0 && F.tid == 0) ((volatile LAS float*)F.MISC)[17] = (float)(__builtin_amdgcn_s_memrealtime() - tp0_) * 0.01f; } while (0)
#else
#define P0STAMP(k) do {} while (0)
#endif
    LAS float* scr = (LAS float*)(F.lds + RING_OFF + F.wave * 16384);
    const int gw = F.vcu * NWAVES + F.wave, NGW = F.G * NWAVES;
    convert_weights(F, 0, I_IN, gw, NGW, scr);
    __syncthreads();
    P0STAMP(1);
    LAS unsigned char* wgl = F.lds + RING_OFF;
    for (int i = F.tid; i < 16 * D; i += NWAVES * 64) { const int k = i >> 4, j = i & 15; *(LAS bf16*)(wgl + j * WGSTR + k * 2) = (bf16)f2bf(F.m_win[(size_t)k * 3088 + NPROJ + j] * F.ngain[k]); }
    __syncthreads();
    P0STAMP(2);
    for (int grp = gw; grp < MR / 16; grp += NGW) embed_group(F, F.x + (size_t)grp * 16 * D, F.HB + (size_t)grp * 16 * D, F.SS + (size_t)grp * 16 * 16, 16, F.GATES + (size_t)grp * 16 * 16, wgl);
    if (gw < 16) {
        const int row = gw; const float* src = F.meta + (size_t)row * D;
        f32x4 v[4]; float s = 0.f;
#pragma unroll
        for (int j = 0; j < 4; ++j) { v[j] = ((const GAS f32x4*)src)[64 * j + F.lane]; s += (v[j].x * v[j].x + v[j].y * v[j].y) + (v[j].z * v[j].z + v[j].w * v[j].w); }
        s = wave_sum(s);
        const float rstd = 1.0f / sqrtf(s * (1.0f / D) + EPS);
#pragma unroll
        for (int j = 0; j < 4; ++j) ((GAS unsigned long long*)(F.HBM + (size_t)row * D))[64 * j + F.lane] = (unsigned long long)pg8::cvt_pk_bf16(v[j].x, v[j].y) | ((unsigned long long)pg8::cvt_pk_bf16(v[j].z, v[j].w) << 32);
        if (F.lane == 0) F.SSM[(size_t)row * 64] = s;
        float keep = 0.f;
#pragma unroll 4
        for (int gt = 0; gt < 16; ++gt) { float p = 0.f;
#pragma unroll
            for (int j = 0; j < 4; ++j) { typedef unsigned u32x2 __attribute__((ext_vector_type(2))); const u32x2 w = *(const LAS u32x2*)(wgl + gt * WGSTR + (256 * j + 4 * F.lane) * 2);
                p += (v[j].x * bflo(w.x) + v[j].y * bfhi(w.x)) + (v[j].z * bflo(w.y) + v[j].w * bfhi(w.y)); }
            p = wave_sum(p); if (F.lane == gt) keep = p; }
        if (F.lane < 16) F.GATESM[(size_t)row * 16 + F.lane] = keep * rstd + F.m_bgate[F.lane];
    }
    P0STAMP(3);
}
__device__ __forceinline__ float meta_rstd(const float* ssm, int lane) {
    float mine = 0.f;
#pragma unroll 4
    for (int r = 0; r < 16; ++r) { const float s = wave_sum(ssm[r * 64 + lane]); if (lane == r) mine = 1.0f / sqrtf(s * (1.0f / D) + EPS); }
    return mine;
}
template <int ACT> struct MEpiScale {
    bf16* O; int ldc; const float* ssm;
    __device__ __forceinline__ void operator()(int cb, int li, int g, int lane, const float (&v)[4]) const {
        const float mine = meta_rstd(ssm, lane);
#pragma unroll
        for (int r = 0; r < 4; ++r) { float x = v[r] * __shfl(mine, 4 * g + r); if (ACT == 1) { x = fmaxf(x, 0.f); x = x * x; } O[(size_t)(4 * g + r) * ldc + 16 * cb + li] = (bf16)f2bf(x); }
    }
};
struct MEpiRes {
    const float* Hin; float* H; bf16* HB; float* ssm;
    __device__ __forceinline__ void operator()(int cb, int li, int g, int lane, const float (&v)[4]) const {
#pragma unroll
        for (int r = 0; r < 4; ++r) { const int row = 4 * g + r; const float hv = Hin[(size_t)row * D + 16 * cb + li] + v[r]; H[(size_t)row * D + 16 * cb + li] = hv; HB[(size_t)row * D + 16 * cb + li] = (bf16)f2bf(hv);
            float q = hv * hv; q += __shfl_xor(q, 1); q += __shfl_xor(q, 2); q += __shfl_xor(q, 4); q += __shfl_xor(q, 8);
            if (li == 0) ssm[row * 64 + cb] = q; }
    }
};
template <class MEpi> __device__ __forceinline__ void meta_gemm(Frame& F, const bf16* A, const bf16* Bt, int cb0, int cb1, int K, const MEpi& E) {
    LAS float* red = (LAS float*)(F.lds + XTRA_OFF);
    const int li = F.lane & 15, g = F.lane >> 4, kw = K / NWAVES;
    for (int cb = cb0 + (int)blockIdx.x; cb < cb1; cb += F.G) {
        const bf16* ap = A + (size_t)li * K + F.wave * kw + 8 * g; const bf16* bp = Bt + (size_t)(16 * cb + li) * K + F.wave * kw + 8 * g;
        f32x4 acc = (f32x4){0.f, 0.f, 0.f, 0.f};
#pragma unroll 4
        for (int ks = 0; ks < kw / 32; ++ks) acc = mfma16(*(const GAS bf16x8_t*)(ap + 32 * ks), *(const GAS bf16x8_t*)(bp + 32 * ks), acc);
#pragma unroll
        for (int r = 0; r < 4; ++r) red[F.wave * 256 + r * 64 + F.lane] = acc[r];
        __syncthreads();
        if (F.wave == 0) { float v[4];
#pragma unroll
            for (int r = 0; r < 4; ++r) { float s = 0.f;
#pragma unroll
                for (int ww = 0; ww < NWAVES; ++ww) s += red[ww * 256 + r * 64 + F.lane]; v[r] = s; }
            E(cb, li, g, F.lane, v); }
        __syncthreads();
    }
}
__device__ __forceinline__ void final_norm_phase(Frame& F) {
    const int gw = F.vcu * NWAVES + F.wave, NGW = F.G * NWAVES;
    for (int row = gw; row < MR; row += NGW) {
        const float rs = pg8::row_rstd<16>(F.SS, row, EPS);
        const GAS v4u* hp = (const GAS v4u*)(F.HB + (size_t)row * D); GAS f32x4* op = (GAS f32x4*)(F.out + (size_t)row * D);
#pragma unroll
        for (int j = 0; j < 2; ++j) { const v4u w = hp[64 * j + F.lane]; const int c = 8 * (64 * j + F.lane);
            const f32x4 g0 = *(const GAS f32x4*)(F.fgain + c), g1 = *(const GAS f32x4*)(F.fgain + c + 4);
            op[2 * (64 * j + F.lane)] = (f32x4){bflo(w.x) * rs * g0.x, bfhi(w.x) * rs * g0.y, bflo(w.y) * rs * g0.z, bfhi(w.y) * rs * g0.w};
            op[2 * (64 * j + F.lane) + 1] = (f32x4){bflo(w.z) * rs * g1.x, bfhi(w.z) * rs * g1.y, bflo(w.w) * rs * g1.z, bfhi(w.w) * rs * g1.w}; }
    }
}
namespace attn3 {
typedef short bf16x8 __attribute__((ext_vector_type(8)));
typedef short s16x4 __attribute__((ext_vector_type(4)));
typedef float f32x16 __attribute__((ext_vector_type(16)));
constexpr int KSTR = 256, VSTR = 256, KBYTES = 64 * KSTR, VBYTES = 64 * VSTR, BUFB = KBYTES + VBYTES, NBUF = 3;
constexpr int CBS = 129;
constexpr int OBS = 272;
constexpr float THR = 16.0f;
static_assert(NBUF * BUFB + 8 * 4096 <= RING_BYTES + XTRA_BYTES && 4 * 32 * CBS * 4 + 4 * 32 * OBS <= RING_BYTES + XTRA_BYTES, "attention LDS map");
__device__ __forceinline__ constexpr int crow0(int r) { return (r & 3) + 8 * (r >> 2); }
__device__ __forceinline__ s16x4 vtr(const LAS unsigned char* p) { return __builtin_bit_cast(s16x4, __builtin_amdgcn_ds_read_tr16_b64_v4i16((LAS s16x4*)p)); }
__device__ __forceinline__ bf16x8 pack8(const f32x16& p, int b0) {
    v4u w; w.x = pg8::cvt_pk_bf16(p[b0], p[b0 + 1]); w.y = pg8::cvt_pk_bf16(p[b0 + 2], p[b0 + 3]); w.z = pg8::cvt_pk_bf16(p[b0 + 4], p[b0 + 5]); w.w = pg8::cvt_pk_bf16(p[b0 + 6], p[b0 + 7]);
    return __builtin_bit_cast(bf16x8, w);
}
__device__ __forceinline__ float xmax32(float a) { auto rr = __builtin_amdgcn_permlane32_swap(__float_as_uint(a), __float_as_uint(a), false, false); return fmaxf(__uint_as_float(rr[0]), __uint_as_float(rr[1])); }
__device__ __forceinline__ float xsum32(float a) { auto rr = __builtin_amdgcn_permlane32_swap(__float_as_uint(a), __float_as_uint(a), false, false); return __uint_as_float(rr[0]) + __uint_as_float(rr[1]); }
#define ATT_SBAR() __builtin_amdgcn_sched_barrier(0)
__device__ __forceinline__ void glds16(const void* gsrc, unsigned lds_dst) { unsigned keep;
    asm volatile("s_mov_b32 %0, m0\n\ts_mov_b32 m0, %2\n\ts_nop 0\n\tglobal_load_lds_dwordx4 %1, off\n\ts_mov_b32 m0, %0" : "=&s"(keep) : "v"(gsrc), "s"(lds_dst) : "memory"); }
#define ATT_DMA_WAIT() asm volatile("s_waitcnt vmcnt(0)" ::: "memory")
template <bool DO_PV, bool DO_SM, bool FIRST>
__device__ __forceinline__ void step(f32x16 (&o)[4], f32x16& p0, f32x16& p1, bf16x8 (&pf)[4], float& m, float& l, const LAS unsigned char* vbase) {
    s16x4 vl[4], vh[4]; float mx0 = 0.f, mx1 = 0.f, mx2 = 0.f, ls = 0.f, fsc = 1.f; bool resc = false;
#define ATT_VRD(i) do { vl[(i) & 3] = vtr(vbase + (4 * ((i) & 3)) * 1024 + ((i) >> 2) * 256); vh[(i) & 3] = vtr(vbase + (4 * ((i) & 3) + 2) * 1024 + ((i) >> 2) * 256); } while (0)
    if (DO_PV) { ATT_VRD(0); ATT_VRD(1); ATT_VRD(2); }
#pragma unroll
    for (int i = 0; i < 16; ++i) {
        if (DO_PV) {
            if (i + 3 < 16) ATT_VRD(i + 3);
            const bf16x8 vf = __builtin_shufflevector(vl[i & 3], vh[i & 3], 0, 1, 2, 3, 4, 5, 6, 7);
            o[i >> 2] = __builtin_amdgcn_mfma_f32_32x32x16_bf16(vf, pf[i & 3], o[i >> 2], 0, 0, 0);
        }
        if (DO_SM) {
            if (i == 0) { mx0 = fmaxf(fmaxf(p0[0], p0[1]), p0[2]); mx0 = fmaxf(fmaxf(mx0, p0[3]), p0[4]); mx0 = fmaxf(fmaxf(mx0, p0[5]), p0[6]); mx0 = fmaxf(fmaxf(mx0, p0[7]), p0[8]); }
            else if (i == 1) { mx1 = fmaxf(fmaxf(p0[9], p0[10]), p0[11]); mx1 = fmaxf(fmaxf(mx1, p0[12]), p0[13]); mx1 = fmaxf(fmaxf(mx1, p0[14]), p0[15]); mx1 = fmaxf(fmaxf(mx1, p1[0]), p1[1]); }
            else if (i == 2) { mx2 = fmaxf(fmaxf(p1[2], p1[3]), p1[4]); mx2 = fmaxf(fmaxf(mx2, p1[5]), p1[6]); mx2 = fmaxf(fmaxf(mx2, p1[7]), p1[8]); mx2 = fmaxf(fmaxf(mx2, p1[9]), p1[10]); }
            else if (i == 3) {
                float mx3 = fmaxf(fmaxf(p1[11], p1[12]), p1[13]); mx3 = fmaxf(fmaxf(mx3, p1[14]), p1[15]); mx3 = fmaxf(fmaxf(mx3, mx0), mx1);
                const float rm = xmax32(fmaxf(mx3, mx2));
                if (FIRST ? __any(fabsf(rm) > 32.0f) : __any(rm > THR)) {
                    const float dl = FIRST ? rm : fmaxf(rm, 0.f); m += dl;
                    if (!FIRST) { fsc = __builtin_amdgcn_exp2f(-dl); l *= fsc; resc = true; }
#pragma unroll
                    for (int r = 0; r < 16; ++r) { p0[r] -= dl; p1[r] -= dl; }
                }
            }
            else if (i < 8) {
#pragma unroll
                for (int r = 4 * (i - 4); r < 4 * (i - 4) + 4; ++r) { p0[r] = __builtin_amdgcn_exp2f(p0[r]); ls += p0[r]; } }
            else if (i < 12) {
#pragma unroll
                for (int r = 4 * (i - 8); r < 4 * (i - 8) + 4; ++r) { p1[r] = __builtin_amdgcn_exp2f(p1[r]); ls += p1[r]; } }
            else if (i == 12) pf[0] = pack8(p0, 0);
            else if (i == 13) pf[1] = pack8(p0, 8);
            else if (i == 14) pf[2] = pack8(p1, 0);
            else pf[3] = pack8(p1, 8);
        }
        ATT_SBAR();
    }
#undef ATT_VRD
    if (DO_SM) {
        l += ls;
        if (resc) {
#pragma unroll
            for (int k = 0; k < 4; ++k)
#pragma unroll
                for (int r = 0; r < 16; ++r) o[k][r] *= fsc; }
    }
}
}
__device__ __forceinline__ void attn_mfma_phase(Frame& F) {
    using namespace attn3;
    const int tid = F.tid, lane = F.lane, wave = F.wave, r32 = lane & 31, hi = lane >> 5, rb = wave >> 1, comp = wave & 1;
    const float lambda_init = 0.8f - 0.6f * expf(-0.3f * 1.0f);
    { float s01 = 0.f, s23 = 0.f; for (int i = 0; i < 64; ++i) { s01 += F.d_lam[i] * F.d_lam[64 + i]; s23 += F.d_lam[128 + i] * F.d_lam[192 + i]; }
      ((volatile LAS float*)F.MISC)[16] = expf(s01) - expf(s23) + lambda_init; }
    LAS unsigned char* lds = F.lds;
    LAS float* gl = (LAS float*)(lds + XTRA_OFF);
    for (int i = tid; i < NH * DV; i += 512) gl[i] = F.d_hgain[i];
    const unsigned lds0 = (unsigned)(size_t)lds;
    LAS float* cb = (LAS float*)lds;
    LAS unsigned char* obase = lds + 4 * 32 * CBS * 4;
    const int li = lane & 15, q4 = li >> 2, p4 = li & 3, g1 = (lane >> 4) & 1;
    const int voff = hi * 1024 + q4 * 64 + 32 * g1 + 16 * (p4 >> 1) + 8 * (p4 & 1);
    const int nun = (F.G == 256) ? 8 : (2048 + F.G - 1) / F.G;
    for (int it = 0; it < nun; ++it) {
        int bh, jq;
        if (F.G == 256) { const int X = F.vcu >> 5, w = F.vcu & 31, j = w & 15; bh = X * 16 + 2 * it + (w >> 4); jq = (it & 1) ? 15 - j : j; }
        else { const int u = F.vcu * nun + it; if (u >= 2048) break; bh = u >> 4; jq = u & 15; }
        const int b = bh >> 3, h = bh & 7;
        const int qrow = b * SEQ + 128 * jq + 32 * rb + r32;
        const int cw = 2 * jq + 1 + (rb >> 1), NT = 2 * jq + 3;
        bf16x8 qf0[4];
        { const bf16* qp = F.P + (size_t)qrow * NPROJ + h * 128 + comp * 64 + hi * 8;
#pragma unroll
          for (int d0 = 0; d0 < 4; ++d0) qf0[d0] = *(const GAS bf16x8*)(qp + 16 * d0); }
        LAS unsigned char* qlds = lds + NBUF * BUFB + wave * 4096 + lane * 16;
        f32x16 o[4], p0, p1; bf16x8 pf[4];
#pragma unroll
        for (int r = 0; r < 16; ++r) { p0[r] = 0.f; p1[r] = 0.f;
#pragma unroll
            for (int k = 0; k < 4; ++k) o[k][r] = 0.f; }
#pragma unroll
        for (int k = 0; k < 4; ++k) pf[k] = (bf16x8){0, 0, 0, 0, 0, 0, 0, 0};
        float m = 0.f, l = 0.f;
        __syncthreads();
        int koff[2], vofs[2];
#pragma unroll
        for (int e = 0; e < 2; ++e) { const int row_ = 8 * wave + 4 * e + (lane >> 4), c_ = lane & 15; koff[e] = row_ * NPROJ + 1024 + h * 128 + ((c_ ^ (row_ & 15)) << 3); vofs[e] = (8 * wave + 4 * e + ((lane >> 2) & 3)) * NPROJ + 2048 + h * 128 + 32 * (lane >> 4) + 8 * (lane & 3); }
#define ATT_DMA(t, buf) do { const bf16* tb_ = F.P + (size_t)(b * SEQ + ((t) - 1) * 64) * NPROJ; _Pragma("unroll") for (int e_ = 0; e_ < 2; ++e_) { \
            glds16(tb_ + koff[e_], (unsigned)__builtin_amdgcn_readfirstlane((int)(lds0 + (buf) * BUFB + (2 * wave + e_) * 1024))); \
            glds16(tb_ + vofs[e_], (unsigned)__builtin_amdgcn_readfirstlane((int)(lds0 + (buf) * BUFB + KBYTES + (2 * wave + e_) * 1024))); } } while (0)
        { const bf16* zsrc = (const bf16*)(F.ws + WS_CTL);
#pragma unroll
          for (int e = 0; e < 2; ++e) { const int row_ = 8 * wave + 4 * e + (lane >> 4); const bf16* ks_ = row_ < 16 ? F.PM + koff[e] : zsrc; const bf16* vs_ = (8 * wave + 4 * e) < 16 ? F.PM + vofs[e] : zsrc;
              glds16(ks_, (unsigned)__builtin_amdgcn_readfirstlane((int)(lds0 + (2 * wave + e) * 1024)));
              glds16(vs_, (unsigned)__builtin_amdgcn_readfirstlane((int)(lds0 + KBYTES + (2 * wave + e) * 1024))); } }
        ATT_DMA(1, 1);
#pragma unroll
        for (int d0 = 0; d0 < 4; ++d0) *(LAS bf16x8*)(qlds + d0 * 1024) = qf0[d0];
#define ATT_QK(buf) do { const LAS unsigned char* Kb_ = lds + (buf) * BUFB; bf16x8 kf_[2][4], qf[4]; \
            _Pragma("unroll") for (int d0_ = 0; d0_ < 4; ++d0_) qf[d0_] = *(const LAS bf16x8*)(qlds + d0_ * 1024); \
            _Pragma("unroll") for (int kh_ = 0; kh_ < 2; ++kh_) _Pragma("unroll") for (int d0_ = 0; d0_ < 4; ++d0_) kf_[kh_][d0_] = *(const LAS bf16x8*)(Kb_ + (32 * kh_ + r32) * KSTR + (((8 * comp + 2 * d0_ + hi) ^ (r32 & 15)) << 4)); \
            _Pragma("unroll") for (int r_ = 0; r_ < 16; ++r_) { p0[r_] = 0.f; p1[r_] = 0.f; } \
            _Pragma("unroll") for (int d0_ = 0; d0_ < 4; ++d0_) p0 = __builtin_amdgcn_mfma_f32_32x32x16_bf16(kf_[0][d0_], qf[d0_], p0, 0, 0, 0); \
            _Pragma("unroll") for (int d0_ = 0; d0_ < 4; ++d0_) p1 = __builtin_amdgcn_mfma_f32_32x32x16_bf16(kf_[1][d0_], qf[d0_], p1, 0, 0, 0); } while (0)
        ATT_DMA_WAIT(); __syncthreads();
        ATT_QK(0);
#pragma unroll
        for (int r = 0; r < 16; ++r) { if (r >= 8) p0[r] = -INFINITY; p1[r] = -INFINITY; }
        step<false, true, true>(o, p0, p1, pf, m, l, lds);
        bool mz = __all(m == 0.f);
        int bc = 1, bp = 0, bn = 2;
#ifdef PROBE_SEG
#define PSTAMP(k) do { unsigned long long tn_; asm volatile("s_memtime %0\n\ts_waitcnt lgkmcnt(0)" : "=s"(tn_) :: "memory"); if (PROBE_SEG == (k) || PROBE_SEG == 0) pacc += (float)(tn_ - tprev_); tprev_ = tn_; } while (0)
        float pacc = 0.f; unsigned long long tprev_; asm volatile("s_memtime %0\n\ts_waitcnt lgkmcnt(0)" : "=s"(tprev_) :: "memory");
#else
#define PSTAMP(k) do {} while (0)
#endif
        for (int t = 1; t < NT; ++t) {
            PSTAMP(9);
            if (t + 1 < NT) ATT_DMA(t + 1, bn);
            PSTAMP(1);
            const LAS unsigned char* vb = lds + bp * BUFB + KBYTES + voff;
            if (t <= cw) { ATT_QK(bc); asm volatile("" : "+v"(p0), "+v"(p1)); PSTAMP(2); if (!mz) {
#pragma unroll
                    for (int r = 0; r < 16; ++r) { p0[r] -= m; p1[r] -= m; } }
                step<true, true, false>(o, p0, p1, pf, m, l, vb); if (mz) mz = __all(m == 0.f); }
            else step<true, false, false>(o, p0, p1, pf, m, l, vb);
            PSTAMP(3);
            ATT_DMA_WAIT(); __syncthreads();
            PSTAMP(4);
            const int tmp = bp; bp = bc; bc = bn; bn = tmp;
        }
#ifdef PROBE_SEG
        if (blockIdx.x == 0 && it == 1) ((volatile LAS float*)F.MISC)[17] = pacc / (float)(NT - 1);
#endif
        if (NT - 1 <= cw) step<true, false, false>(o, p0, p1, pf, m, l, lds + bp * BUFB + KBYTES + voff);
#undef ATT_DMA
#undef ATT_QK
        l = xsum32(l);
        const float inv = 1.0f / l;
        LAS float* cbw = cb + (rb * 32 + r32) * CBS + 4 * hi;
        __syncthreads();
        if (comp == 1) {
#pragma unroll
            for (int blk = 0; blk < 4; ++blk)
#pragma unroll
                for (int r = 0; r < 16; ++r) cbw[32 * blk + crow0(r)] = o[blk][r] * inv;
        }
        __syncthreads();
        if (comp == 0) {
            const float lam = ((volatile LAS float*)F.MISC)[16];
            float ssq = 0.f;
#pragma unroll
            for (int blk = 0; blk < 4; ++blk)
#pragma unroll
                for (int r = 0; r < 16; ++r) { const float d = o[blk][r] * inv - lam * cbw[32 * blk + crow0(r)]; o[blk][r] = d; ssq += d * d; if (r == 15) ATT_SBAR(); }
            ssq = xsum32(ssq);
            const float rr = (1.0f - lambda_init) * __builtin_amdgcn_rsqf(ssq * (1.0f / DV) + SUBLN_EPS);
            const LAS float* gpb = gl + h * DV + 4 * hi;
            LAS unsigned char* ob = obase + (rb * 32) * OBS;
            LAS unsigned char* obw = ob + r32 * OBS + 8 * hi;
#pragma unroll
            for (int blk = 0; blk < 4; ++blk)
#pragma unroll
                for (int r = 0; r < 16; r += 2) { const int dv = 32 * blk + crow0(r);
                    *(LAS unsigned*)(obw + dv * 2) = pg8::cvt_pk_bf16(o[blk][r] * rr * gpb[dv], o[blk][r + 1] * rr * gpb[dv + 1]); if (r == 14) ATT_SBAR(); }
            asm volatile("s_waitcnt lgkmcnt(0)" ::: "memory");
#pragma unroll
            for (int i = 0; i < 8; ++i) { const int row = 4 * i + (lane >> 4), ch = lane & 15;
                const v4u v = *(const LAS v4u*)(ob + row * OBS + ch * 16);
                *(GAS v4u*)(F.MIX + (size_t)(b * SEQ + 128 * jq + 32 * rb + row) * D + h * DV + ch * 8) = v; }
        }
    }
}
namespace ml2 {
typedef short bf16x8 __attribute__((ext_vector_type(8)));
typedef short s16x4 __attribute__((ext_vector_type(4)));
constexpr int QSTR = 144, VSTR = 272;
constexpr int OFF_Q = 0, OFF_K = 64 * QSTR, OFF_V = 2 * 64 * QSTR, DBUF = OFF_V + 64 * VSTR;
constexpr int OFF_S = 2 * DBUF, SBUF = 64 * 144;
constexpr int HSTR = 132, OFF_H = OFF_S + 2 * SBUF, HBYTES = 64 * HSTR * 4;
constexpr int OFF_SM = OFF_H + HBYTES, SMB = 12 * 256;
constexpr int A_G = 0, A_M = 64, A_B = 128, A_W = 192, A_RS = 256  , A_QN = 512, A_CT = 576, A_AT = 640, A_N = 704;
static_assert(OFF_SM + 2 * SMB <= RING_BYTES, "mLSTM LDS map");
__device__ __forceinline__ s16x4 vtr(const LAS unsigned char* p) { return __builtin_bit_cast(s16x4, __builtin_amdgcn_ds_read_tr16_b64_v4i16((LAS s16x4*)p)); }
template <int CTRL> __device__ __forceinline__ float dpp_mov(float v) { return __builtin_bit_cast(float, __builtin_amdgcn_update_dpp(0, __builtin_bit_cast(int, v), CTRL, 0xF, 0xF, true)); }
__device__ __forceinline__ float sum8(float v) { v += dpp_mov<0xB1>(v); v += dpp_mov<0x4E>(v); v += dpp_mov<0x141>(v); return v; }
__device__ __forceinline__ float sum16(float v) { v = sum8(v); v += dpp_mov<0x140>(v); return v; }
}
#ifdef MLSTM_V2
constexpr float GSC_SCALE = 1.0f;
#else
constexpr float GSC_SCALE = 1.4426950408889634f;
#endif
__device__ __forceinline__ void gate_scan_job(Frame& F) {
    const int gw = F.vcu * NWAVES + F.wave, NGW = F.G * NWAVES, lane = F.lane;
    for (int it = gw; it < NB * NH * 33; it += NGW) {
        const int unit = it / 33, c = it % 33, b = unit >> 3, h = unit & 7;
        float lf = 0.f, ig = -1e30f;
        if (c != 0 || lane < 16) { const float* gp = (c == 0 ? F.GATESM + (size_t)lane * 16 : F.GATES + (size_t)(b * SEQ + (c - 1) * 64 + lane) * 16); const float fg = gp[8 + h]; ig = gp[h]; lf = (fminf(fg, 0.f) - log1pf(expf(-fabsf(fg)))) * GSC_SCALE; ig *= GSC_SCALE; }
        float bs = lf;
#pragma unroll
        for (int o = 1; o < 64; o <<= 1) { const float v = __shfl_up(bs, o); if (lane >= o) bs += v; }
        const float gs = ig - bs; float pm = gs;
#pragma unroll
        for (int o = 1; o < 64; o <<= 1) { const float v = __shfl_up(pm, o); if (lane >= o) pm = fmaxf(pm, v); }
        float* dst = F.GSC + (size_t)it * 192; dst[lane] = gs; dst[64 + lane] = pm; dst[128 + lane] = bs;
    }
}
__device__ __forceinline__ void mlstm_mfma_phase(Frame& F) {
    using namespace ml2;
    const int tid = F.tid, lane = F.lane, w = F.wave, li = lane & 15, g = lane >> 4, q4 = li >> 2, p4 = li & 3;
    LAS unsigned char* lds = F.lds;
    const int zt = tid >> 3, zc = tid & 7;
    const int mlwg = F.G / 2;
    if (F.vcu >= mlwg) { convert_weights(F, I_IN, NITEMS, (F.vcu - mlwg) * NWAVES + F.wave, (F.G - mlwg) * NWAVES, (LAS float*)(F.lds + RING_OFF + F.wave * 16384)); return; }
    for (int unit = F.vcu; unit < NB * NH; unit += mlwg) {
        const int b = unit >> 3, h = unit & 7;
        __syncthreads();
        for (int i = tid; i < (2 * SBUF) / 16; i += 512) *(LAS v4u*)(lds + OFF_S + i * 16) = (v4u){0u, 0u, 0u, 0u};
        for (int i = tid; i < (2 * SMB) / 16; i += 512) *(LAS v4u*)(lds + OFF_SM + i * 16) = (v4u){0u, 0u, 0u, 0u};
        f32x4 Cacc[4];
#pragma unroll
        for (int i = 0; i < 4; ++i) Cacc[i] = (f32x4){0.f, 0.f, 0.f, 0.f};
        float m = 0.f;
        float gn[16];
#pragma unroll
        for (int i = 0; i < 4; ++i) { const f32x4 t4 = *(const GAS f32x4*)(F.m_hgain + h * DV + 16 * zc + 4 * i); gn[4 * i] = t4.x; gn[4 * i + 1] = t4.y; gn[4 * i + 2] = t4.z; gn[4 * i + 3] = t4.w; }
        v4u sq, sk, sv0, sv1;
#define ML_ROW0(c) ((c) == 0 ? 0 : b * SEQ + ((c) - 1) * 64)
#define ML_PB(c) ((c) == 0 ? F.PM : F.P)
#define ML_LOAD(c) do { const int r0_ = ML_ROW0(c); const bool okq_ = ((c) != 0) || (zt < 16); \
            const bf16* pq_ = ML_PB(c) + (size_t)(r0_ + zt) * NPROJ + h * 64 + 8 * zc; \
            if (okq_) { sq = *(const GAS v4u*)pq_; sk = *(const GAS v4u*)(pq_ + 512); } else { sq = (v4u){0u, 0u, 0u, 0u}; sk = sq; } \
            const int rv0_ = tid >> 4, rv1_ = (tid + 512) >> 4, pv_ = tid & 15; \
            if (((c) != 0) || rv0_ < 16) sv0 = *(const GAS v4u*)(ML_PB(c) + (size_t)(r0_ + rv0_) * NPROJ + 1024 + h * 128 + 8 * pv_); else sv0 = (v4u){0u, 0u, 0u, 0u}; \
            if ((c) != 0) sv1 = *(const GAS v4u*)(F.P + (size_t)(r0_ + rv1_) * NPROJ + 1024 + h * 128 + 8 * pv_); else sv1 = (v4u){0u, 0u, 0u, 0u}; } while (0)
#define ML_STORE(par) do { LAS unsigned char* d_ = lds + (par) * DBUF; *(LAS v4u*)(d_ + OFF_Q + zt * QSTR + zc * 16) = sq; *(LAS v4u*)(d_ + OFF_K + zt * QSTR + zc * 16) = sk; \
            *(LAS v4u*)(d_ + OFF_V + (tid >> 4) * VSTR + (tid & 15) * 16) = sv0; *(LAS v4u*)(d_ + OFF_V + ((tid + 512) >> 4) * VSTR + (tid & 15) * 16) = sv1; } while (0)
        ML_LOAD(0); ML_STORE(0);
        { const float* gq = F.GSC + (size_t)(unit * 33) * 192; LAS float* xg = (LAS float*)(lds + XTRA_OFF);
          for (int i = tid; i < 33 * 192 / 4; i += 512) *(LAS f32x4*)(xg + 4 * i) = *(const GAS f32x4*)(gq + 4 * i); }
        __syncthreads();
#ifdef PROBE_ML
#define MSTAMP2(k) do { unsigned long long tn_; asm volatile("s_memtime %0\n\ts_waitcnt lgkmcnt(0)" : "=s"(tn_) :: "memory"); if (PROBE_ML == (k) || PROBE_ML == 9) pacc += (float)(tn_ - tprev_); tprev_ = tn_; } while (0)
        float pacc = 0.f; unsigned long long tprev_; asm volatile("s_memtime %0\n\ts_waitcnt lgkmcnt(0)" : "=s"(tprev_) :: "memory");
#else
#define MSTAMP2(k) do {} while (0)
#endif
        for (int c = 0; c <= 32; ++c) {
            const int par = c & 1; const int row0 = ML_ROW0(c);
            LAS unsigned char* db = lds + par * DBUF; LAS float* sm = (LAS float*)(lds + OFF_SM + par * SMB); LAS float* smn = (LAS float*)(lds + OFF_SM + (par ^ 1) * SMB);
            LAS unsigned char* Sb = lds + OFF_S + par * SBUF;
            if (c < 32) ML_LOAD(c + 1);
            v4u og0 = (v4u){0u, 0u, 0u, 0u}, og1 = og0; const bool zvalid = (c != 0) || (zt < 16);
            if (zvalid) { const bf16* po = ML_PB(c) + (size_t)(row0 + zt) * NPROJ + 2048 + h * 128 + 16 * zc; og0 = *(const GAS v4u*)po; og1 = *(const GAS v4u*)(po + 8); }
            const LAS float* xg = (const LAS float*)(lds + XTRA_OFF) + c * 192; const float gs = xg[lane], pm = xg[64 + lane], bs = xg[128 + lane];
            const float Mt = fmaxf(m, pm);
            const float MT = __builtin_bit_cast(float, __builtin_amdgcn_readlane(__builtin_bit_cast(int, Mt), 63)), bT = __builtin_bit_cast(float, __builtin_amdgcn_readlane(__builtin_bit_cast(int, bs), 63));
            const float ws = __expf(gs - MT), decay = __expf(m - MT);
            sm[A_G + lane] = gs; sm[A_M + lane] = Mt; sm[A_B + lane] = bs; sm[A_W + lane] = ws;
            MSTAMP2(1);
            for (int ti = w; ti < 10; ti += 8) {
                const int rt = ti < 1 ? 0 : ti < 3 ? 1 : ti < 6 ? 2 : 3, st = ti - rt * (rt + 1) / 2;
                f32x4 acc = (f32x4){0.f, 0.f, 0.f, 0.f};
#pragma unroll
                for (int ks = 0; ks < 2; ++ks) { const bf16x8 a = *(const LAS bf16x8*)(db + OFF_Q + (16 * rt + li) * QSTR + (32 * ks + 8 * g) * 2), bb = *(const LAS bf16x8*)(db + OFF_K + (16 * st + li) * QSTR + (32 * ks + 8 * g) * 2);
                    acc = mfma16(a, bb, acc); }
                const float g_s = sm[A_G + 16 * st + li]; const f32x4 M4 = *(const LAS f32x4*)(sm + A_M + 16 * rt + 4 * g);
                float val[4];
#pragma unroll
                for (int r = 0; r < 4; ++r) { const bool ok = (16 * st + li) <= (16 * rt + 4 * g + r); val[r] = ok ? acc[r] * __expf(g_s - M4[r]) : 0.f; }
                float rs[4];
#pragma unroll
                for (int r = 0; r < 4; ++r) rs[r] = sum16(val[r]);
                if (li == 0) *(LAS f32x4*)(sm + A_RS + st * 64 + 16 * rt + 4 * g) = (f32x4){rs[0], rs[1], rs[2], rs[3]};
                { const unsigned q01 = pg8::cvt_pk_bf16(val[0], val[1]), q23 = pg8::cvt_pk_bf16(val[2], val[3]); LAS unsigned char* sp = Sb + (16 * rt + 4 * g) * 144 + (16 * st + li) * 2;
                  *(LAS bf16*)(sp) = (bf16)(q01 & 0xffffu); *(LAS bf16*)(sp + 144) = (bf16)(q01 >> 16); *(LAS bf16*)(sp + 288) = (bf16)(q23 & 0xffffu); *(LAS bf16*)(sp + 432) = (bf16)(q23 >> 16); }
            }
            { const v4u qv = *(const LAS v4u*)(db + OFF_Q + zt * QSTR + zc * 16); const f32x4 n0 = *(const LAS f32x4*)(sm + A_N + 8 * zc), n1 = *(const LAS f32x4*)(sm + A_N + 8 * zc + 4);
              float d = bflo(qv.x) * n0.x + bfhi(qv.x) * n0.y + bflo(qv.y) * n0.z + bfhi(qv.y) * n0.w + bflo(qv.z) * n1.x + bfhi(qv.z) * n1.y + bflo(qv.w) * n1.z + bfhi(qv.w) * n1.w;
              d = sum8(d);
              if (zc == 0) sm[A_QN + zt] = d; }
            MSTAMP2(2);
            __syncthreads();
            MSTAMP2(3);
            typedef unsigned u32x2 __attribute__((ext_vector_type(2)));
            const float r0 = sm[A_RS + lane], r1 = sm[A_RS + 64 + lane], r2 = sm[A_RS + 128 + lane], r3 = sm[A_RS + 192 + lane], qnl = sm[A_QN + lane];
            s16x4 vlo[2], vhi[2]; f32x4 w0[2], w1[2];
#pragma unroll
            for (int ks = 0; ks < 2; ++ks) { const LAS unsigned char* vp = db + OFF_V + (32 * ks + 8 * g + q4) * VSTR + (16 * w + 4 * p4) * 2; vlo[ks] = vtr(vp); vhi[ks] = vtr(vp + 4 * VSTR);
                w0[ks] = *(const LAS f32x4*)(sm + A_W + 32 * ks + 8 * g); w1[ks] = *(const LAS f32x4*)(sm + A_W + 32 * ks + 8 * g + 4); }
            bf16x8 sfr[4][2]; u32x2 qpa[4][2], qpb[4][2];
#pragma unroll
            for (int rt = 0; rt < 4; ++rt)
#pragma unroll
                for (int ks = 0; ks < 2; ++ks) {
                    if (ks == 0 || rt >= 2) sfr[rt][ks] = *(const LAS bf16x8*)(Sb + (16 * rt + li) * 144 + (32 * ks + 8 * g) * 2);
                    qpa[rt][ks] = *(const LAS u32x2*)(db + OFF_Q + (16 * rt + li) * QSTR + (32 * ks + 4 * g) * 2); qpb[rt][ks] = *(const LAS u32x2*)(db + OFF_Q + (16 * rt + li) * QSTR + (32 * ks + 16 + 4 * g) * 2); }
            __builtin_amdgcn_sched_barrier(0);
            { const float rsum = (r0 + r1) + (r2 + r3);
              const float inter = __expf(m - Mt), den = rsum + inter * qnl, dmax = fmaxf(fabsf(den), __expf(-(bs + Mt))), ci = __builtin_amdgcn_rcpf(dmax);
              sm[A_CT + lane] = ci; sm[A_AT + lane] = inter * ci; }
            bf16x8 vf[2], wv[2];
#pragma unroll
            for (int ks = 0; ks < 2; ++ks) { const s16x4 lo = vlo[ks], hh = vhi[ks];
                vf[ks] = (bf16x8){lo[0], lo[1], lo[2], lo[3], hh[0], hh[1], hh[2], hh[3]};
                v4u pw; pw.x = pg8::cvt_pk_bf16(bf2f((unsigned short)lo[0]) * w0[ks].x, bf2f((unsigned short)lo[1]) * w0[ks].y); pw.y = pg8::cvt_pk_bf16(bf2f((unsigned short)lo[2]) * w0[ks].z, bf2f((unsigned short)lo[3]) * w0[ks].w);
                pw.z = pg8::cvt_pk_bf16(bf2f((unsigned short)hh[0]) * w1[ks].x, bf2f((unsigned short)hh[1]) * w1[ks].y); pw.w = pg8::cvt_pk_bf16(bf2f((unsigned short)hh[2]) * w1[ks].z, bf2f((unsigned short)hh[3]) * w1[ks].w);
                wv[ks] = __builtin_bit_cast(bf16x8, pw); }
            bf16x8 cbf[2];
#pragma unroll
            for (int ks = 0; ks < 2; ++ks) { v4u pw; pw.x = pg8::cvt_pk_bf16(Cacc[2 * ks][0], Cacc[2 * ks][1]); pw.y = pg8::cvt_pk_bf16(Cacc[2 * ks][2], Cacc[2 * ks][3]); pw.z = pg8::cvt_pk_bf16(Cacc[2 * ks + 1][0], Cacc[2 * ks + 1][1]); pw.w = pg8::cvt_pk_bf16(Cacc[2 * ks + 1][2], Cacc[2 * ks + 1][3]);
                cbf[ks] = __builtin_bit_cast(bf16x8, pw); }
            f32x4 acc1[4], acc2[4];
#pragma unroll
            for (int rt = 0; rt < 4; ++rt) {
                acc1[rt] = (f32x4){0.f, 0.f, 0.f, 0.f}; acc2[rt] = (f32x4){0.f, 0.f, 0.f, 0.f};
#pragma unroll
                for (int ks = 0; ks < 2; ++ks) {
                    if (ks == 0 || rt >= 2) acc1[rt] = mfma16(sfr[rt][ks], vf[ks], acc1[rt]);
                    const bf16x8 aq = __builtin_bit_cast(bf16x8, (v4u){qpa[rt][ks].x, qpa[rt][ks].y, qpb[rt][ks].x, qpb[rt][ks].y});
                    acc2[rt] = mfma16(aq, cbf[ks], acc2[rt]);
                }
            }
            __builtin_amdgcn_sched_barrier(0);
            s16x4 klo[4][2], khi[4][2];
#pragma unroll
            for (int dt = 0; dt < 4; ++dt)
#pragma unroll
                for (int ks = 0; ks < 2; ++ks) { const LAS unsigned char* kp = db + OFF_K + (32 * ks + 8 * g + q4) * QSTR + (16 * dt + 4 * p4) * 2; klo[dt][ks] = vtr(kp); khi[dt][ks] = vtr(kp + 4 * QSTR); }
            float kn[8];
#pragma unroll
            for (int i = 0; i < 8; ++i) kn[i] = bf2f(*(const LAS bf16*)(db + OFF_K + (8 * zc + i) * QSTR + zt * 2));
            const f32x4 wn0 = *(const LAS f32x4*)(sm + A_W + 8 * zc), wn1 = *(const LAS f32x4*)(sm + A_W + 8 * zc + 4); const float nold = sm[A_N + zt];
            __builtin_amdgcn_sched_barrier(0);
#pragma unroll
            for (int dt = 0; dt < 4; ++dt) {
                Cacc[dt] = Cacc[dt] * decay;
#pragma unroll
                for (int ks = 0; ks < 2; ++ks) { const s16x4 lo = klo[dt][ks], hh = khi[dt][ks];
                    const bf16x8 ka = (bf16x8){lo[0], lo[1], lo[2], lo[3], hh[0], hh[1], hh[2], hh[3]};
                    Cacc[dt] = mfma16(ka, wv[ks], Cacc[dt]); }
            }
            { float sacc = (wn0.x * kn[0] + wn0.y * kn[1]) + (wn0.z * kn[2] + wn0.w * kn[3]) + (wn1.x * kn[4] + wn1.y * kn[5]) + (wn1.z * kn[6] + wn1.w * kn[7]);
              sacc = sum8(sacc);
              if (zc == 0) smn[A_N + zt] = decay * nold + sacc; }
            { LAS float* hb = (LAS float*)(lds + OFF_H);
#pragma unroll
              for (int rt = 0; rt < 4; ++rt) { const f32x4 c4 = *(const LAS f32x4*)(sm + A_CT + 16 * rt + 4 * g), a4 = *(const LAS f32x4*)(sm + A_AT + 16 * rt + 4 * g);
#pragma unroll
                  for (int r = 0; r < 4; ++r) hb[(16 * rt + 4 * g + r) * HSTR + 16 * w + li] = acc1[rt][r] * c4[r] + acc2[rt][r] * a4[r]; } }
            m = bT + MT;
            if (c < 32) ML_STORE(par ^ 1);
            MSTAMP2(4);
            __syncthreads();
            MSTAMP2(5);
            { const LAS float* hb = (const LAS float*)(lds + OFF_H) + zt * HSTR + 16 * zc; float hv[16]; float ss = 0.f;
#pragma unroll
              for (int i = 0; i < 4; ++i) { const f32x4 t4 = *(const LAS f32x4*)(hb + 4 * i); hv[4 * i] = t4.x; hv[4 * i + 1] = t4.y; hv[4 * i + 2] = t4.z; hv[4 * i + 3] = t4.w; ss += (t4.x * t4.x + t4.y * t4.y) + (t4.z * t4.z + t4.w * t4.w); }
              ss = sum8(ss);
              const float rn = __builtin_amdgcn_rsqf(ss * (1.0f / DV) + EPS);
              const unsigned ow[8] = {og0.x, og0.y, og0.z, og0.w, og1.x, og1.y, og1.z, og1.w}; unsigned res[8];
#pragma unroll
              for (int i = 0; i < 8; ++i) { const float o0 = bflo(ow[i]), o1 = bfhi(ow[i]);
                  res[i] = pg8::cvt_pk_bf16(hv[2 * i] * rn * gn[2 * i] * __builtin_amdgcn_rcpf(1.0f + __expf(-o0)), hv[2 * i + 1] * rn * gn[2 * i + 1] * __builtin_amdgcn_rcpf(1.0f + __expf(-o1))); }
              if (zvalid && (c != 0 || b == 0)) { bf16* dst = (c == 0 ? F.MIXM : F.MIX) + (size_t)(row0 + zt) * D + h * DV + 16 * zc; *(GAS v4u*)dst = (v4u){res[0], res[1], res[2], res[3]}; *(GAS v4u*)(dst + 8) = (v4u){res[4], res[5], res[6], res[7]}; } }
            MSTAMP2(6);
        }
#ifdef PROBE_ML
        if (blockIdx.x == 0) ((volatile LAS float*)F.MISC)[17] = pacc / 33.f;
#endif
#undef ML_ROW0
#undef ML_PB
#undef ML_LOAD
#undef ML_STORE
    }
}
namespace ml3 {
using ml2::bf16x8; using ml2::s16x4; using ml2::vtr; using ml2::sum8;
constexpr int QSTR = 144, VSTR = 272;
constexpr int OFF_Q = 0, OFF_K = 64 * QSTR, OFF_V = 2 * 64 * QSTR, DBUF = OFF_V + 64 * VSTR;
constexpr int OFF_S = 2 * DBUF, SBUF = 64 * 144;
constexpr int HSTRB = 272, OFF_H = OFF_S + 2 * SBUF, HBUF = 64 * HSTRB;
constexpr int OFF_W = OFF_H + 2 * HBUF;
constexpr int OFF_GN = OFF_W + 3 * 8 * 256;
constexpr int OFF_G = OFF_GN + 512;
static_assert(OFF_G + 33 * 768 <= RING_BYTES + XTRA_BYTES && OFF_S % 16 == 0 && OFF_H % 16 == 0 && OFF_W % 16 == 0 && OFF_G % 16 == 0, "mLSTM LDS map");
}
__device__ __forceinline__ void mlstm3_phase(Frame& F) {
    using namespace ml3;
    const int tid = F.tid, lane = F.lane, w = F.wave, li = lane & 15, g = lane >> 4, q4 = li >> 2, p4 = li & 3;
    LAS unsigned char* lds = F.lds;
    const int zt = tid >> 3, zc = tid & 7;
    const int mlwg = F.G / 2;
    if (F.vcu >= mlwg) { convert_weights(F, I_IN, NITEMS, (F.vcu - mlwg) * NWAVES + F.wave, (F.G - mlwg) * NWAVES, (LAS float*)(F.lds + RING_OFF + F.wave * 16384)); return; }
    const bf16x8 ones = __builtin_bit_cast(bf16x8, (v4u){0x3F803F80u, 0x3F803F80u, 0x3F803F80u, 0x3F803F80u});
    const int rtA = w < 1 ? 0 : w < 3 ? 1 : w < 6 ? 2 : 3, stA = w - rtA * (rtA + 1) / 2;
    const int rtB = 3, stB = w + 2;
    for (int unit = F.vcu; unit < NB * NH; unit += mlwg) {
        const int b = unit >> 3, h = unit & 7;
        __syncthreads();
        for (int i = tid; i < (2 * SBUF) / 16; i += 512) *(LAS v4u*)(lds + OFF_S + i * 16) = (v4u){0u, 0u, 0u, 0u};
        { const float* gq = F.GSC + (size_t)(unit * 33) * 192; LAS float* xg = (LAS float*)(lds + OFF_G);
          for (int i = tid; i < 33 * 192 / 4; i += 512) *(LAS f32x4*)(xg + 4 * i) = *(const GAS f32x4*)(gq + 4 * i); }
        f32x4 Cacc[4], nacc[4];
#pragma unroll
        for (int i = 0; i < 4; ++i) { Cacc[i] = (f32x4){0.f, 0.f, 0.f, 0.f}; nacc[i] = (f32x4){0.f, 0.f, 0.f, 0.f}; }
        float m = 0.f;
        if (tid < DV) ((LAS float*)(lds + OFF_GN))[tid] = F.m_hgain[h * DV + tid];
        v4u sq, sk, sv0, sv1;
        const int oq = zt * NPROJ + 8 * zc, ov0 = (tid >> 4) * NPROJ + 8 * (tid & 15), oo = zt * NPROJ + 16 * zc;
        const int oxa0 = (16 * rtA + li) * NPROJ + 8 * g, oxb0 = (16 * stA + li) * NPROJ + 8 * g, oxa1 = (16 * rtB + li) * NPROJ + 8 * g, oxb1 = (16 * stB + li) * NPROJ + 8 * g;
#define ML_ROW0(c) ((c) == 0 ? 0 : b * SEQ + ((c) - 1) * 64)
#define ML_PB(c) ((c) == 0 ? F.PM : F.P)
#define ML_LOAD(c) do { const bf16* pb_ = ML_PB(c) + (size_t)ML_ROW0(c) * NPROJ + h * 64; const bool okq_ = ((c) != 0) || (zt < 16); \
            if (okq_) { sq = *(const GAS v4u*)(pb_ + oq); sk = *(const GAS v4u*)(pb_ + 512 + oq); } else { sq = (v4u){0u, 0u, 0u, 0u}; sk = sq; } \
            const bf16* pv_ = pb_ + 1024 + h * 64; \
            if (((c) != 0) || (tid >> 4) < 16) sv0 = *(const GAS v4u*)(pv_ + ov0); else sv0 = (v4u){0u, 0u, 0u, 0u}; \
            if ((c) != 0) sv1 = *(const GAS v4u*)(pv_ + 32 * NPROJ + ov0); else sv1 = (v4u){0u, 0u, 0u, 0u}; } while (0)
#define ML_STORE(par) do { LAS unsigned char* d_ = lds + (par) * DBUF; *(LAS v4u*)(d_ + OFF_Q + zt * QSTR + zc * 16) = sq; *(LAS v4u*)(d_ + OFF_K + zt * QSTR + zc * 16) = sk; \
            *(LAS v4u*)(d_ + OFF_V + (tid >> 4) * VSTR + (tid & 15) * 16) = sv0; *(LAS v4u*)(d_ + OFF_V + ((tid + 512) >> 4) * VSTR + (tid & 15) * 16) = sv1; } while (0)
#define ML_STILE(acc_, rt_, st_, cn_, mn_, Sb_) do { const LAS float* gq_ = (const LAS float*)(lds + OFF_G) + (cn_) * 192; const float g_s_ = gq_[16 * (st_) + li]; \
            const f32x4 P4_ = *(const LAS f32x4*)(gq_ + 64 + 16 * (rt_) + 4 * g); \
            float v_[4]; _Pragma("unroll") for (int r_ = 0; r_ < 4; ++r_) { const bool ok_ = (16 * (st_) + li) <= (16 * (rt_) + 4 * g + r_); v_[r_] = ok_ ? (acc_)[r_] * __builtin_amdgcn_exp2f(g_s_ - fmaxf((mn_), P4_[r_])) : 0.f; } \
            const unsigned q01_ = pg8::cvt_pk_bf16(v_[0], v_[1]), q23_ = pg8::cvt_pk_bf16(v_[2], v_[3]); LAS unsigned char* sp_ = (Sb_) + (16 * (rt_) + 4 * g) * 144 + (16 * (st_) + li) * 2; \
            *(LAS bf16*)(sp_) = (bf16)(q01_ & 0xffffu); *(LAS bf16*)(sp_ + 144) = (bf16)(q01_ >> 16); *(LAS bf16*)(sp_ + 288) = (bf16)(q23_ & 0xffffu); *(LAS bf16*)(sp_ + 432) = (bf16)(q23_ >> 16); } while (0)
        ML_LOAD(0); ML_STORE(0);
        __syncthreads();
        if (w == 0) {
            f32x4 acc = (f32x4){0.f, 0.f, 0.f, 0.f};
#pragma unroll
            for (int ks = 0; ks < 2; ++ks) acc = mfma16(*(const LAS bf16x8*)(lds + OFF_Q + li * QSTR + (32 * ks + 8 * g) * 2), *(const LAS bf16x8*)(lds + OFF_K + li * QSTR + (32 * ks + 8 * g) * 2), acc);
            ML_STILE(acc, 0, 0, 0, 0.f, lds + OFF_S);
        }
        __syncthreads();
#ifdef PROBE_ML
#define MSTAMP(k) do { unsigned long long tn_; asm volatile("s_memtime %0\n\ts_waitcnt lgkmcnt(0)" : "=s"(tn_) :: "memory"); if (PROBE_ML == (k) || PROBE_ML == 9) pacc += (float)(tn_ - tprev_); tprev_ = tn_; } while (0)
        float pacc = 0.f; unsigned long long tprev_; asm volatile("s_memtime %0\n\ts_waitcnt lgkmcnt(0)" : "=s"(tprev_) :: "memory");
#else
#define MSTAMP(k) do {} while (0)
#endif
        for (int c = 0; c <= 33; ++c) {
            const int par = c & 1;
            LAS unsigned char* db = lds + par * DBUF; const LAS unsigned char* Sb = lds + OFF_S + par * SBUF;
            bf16x8 xa[2][2], xb[2][2];
            if (c < 32) {
                ML_LOAD(c + 1);
                const bf16* pn = F.P + (size_t)(b * SEQ + c * 64) * NPROJ + h * 64;
#pragma unroll
                for (int ks = 0; ks < 2; ++ks) { xa[0][ks] = *(const GAS bf16x8*)(pn + 32 * ks + oxa0); xb[0][ks] = *(const GAS bf16x8*)(pn + 512 + 32 * ks + oxb0); }
                if (w < 2) {
#pragma unroll
                    for (int ks = 0; ks < 2; ++ks) { xa[1][ks] = *(const GAS bf16x8*)(pn + 32 * ks + oxa1); xb[1][ks] = *(const GAS bf16x8*)(pn + 512 + 32 * ks + oxb1); } }
            }
            v4u og0 = (v4u){0u, 0u, 0u, 0u}, og1 = og0; const int cz = c - 1; const bool zvalid = (c >= 1) && ((cz != 0) || (zt < 16));
            if (zvalid) { const bf16* po = ML_PB(cz) + (size_t)ML_ROW0(cz) * NPROJ + 2048 + h * 128; og0 = *(const GAS v4u*)(po + oo); og1 = *(const GAS v4u*)(po + 8 + oo); }
            MSTAMP(1);
            float mnext = m;
            if (c <= 32) {
                const LAS float* xg = (const LAS float*)(lds + OFF_G) + c * 192;
                const float gs = xg[lane], pm = xg[64 + lane], bs = xg[128 + lane];
                const float Mt = fmaxf(m, pm);
                const float MT = __builtin_bit_cast(float, __builtin_amdgcn_readlane(__builtin_bit_cast(int, Mt), 63)), bT = __builtin_bit_cast(float, __builtin_amdgcn_readlane(__builtin_bit_cast(int, bs), 63));
                const float decay = __builtin_amdgcn_exp2f(m - MT);
                LAS float* wsc = (LAS float*)(lds + OFF_W) + w * 64;
                wsc[lane] = __builtin_amdgcn_exp2f(gs - MT);
                wsc[512 + lane] = __builtin_amdgcn_exp2f(m - Mt);
                wsc[1024 + lane] = __builtin_amdgcn_exp2f(-(bs + Mt));
                mnext = bT + MT;
                bf16x8 vf[2], wv[2];
#pragma unroll
                for (int ks = 0; ks < 2; ++ks) {
                    const LAS unsigned char* vp = db + OFF_V + (32 * ks + 8 * g + q4) * VSTR + (16 * w + 4 * p4) * 2;
                    const s16x4 lo = vtr(vp), hh = vtr(vp + 4 * VSTR);
                    vf[ks] = (bf16x8){lo[0], lo[1], lo[2], lo[3], hh[0], hh[1], hh[2], hh[3]};
                    const f32x4 w0 = *(const LAS f32x4*)(wsc + 32 * ks + 8 * g), w1 = *(const LAS f32x4*)(wsc + 32 * ks + 8 * g + 4);
                    v4u pw; pw.x = pg8::cvt_pk_bf16(bf2f((unsigned short)lo[0]) * w0.x, bf2f((unsigned short)lo[1]) * w0.y); pw.y = pg8::cvt_pk_bf16(bf2f((unsigned short)lo[2]) * w0.z, bf2f((unsigned short)lo[3]) * w0.w);
                    pw.z = pg8::cvt_pk_bf16(bf2f((unsigned short)hh[0]) * w1.x, bf2f((unsigned short)hh[1]) * w1.y); pw.w = pg8::cvt_pk_bf16(bf2f((unsigned short)hh[2]) * w1.z, bf2f((unsigned short)hh[3]) * w1.w);
                    wv[ks] = __builtin_bit_cast(bf16x8, pw);
                }
                bf16x8 cbf[2], nbf[2];
#pragma unroll
                for (int ks = 0; ks < 2; ++ks) {
                    v4u pw; pw.x = pg8::cvt_pk_bf16(Cacc[2 * ks][0], Cacc[2 * ks][1]); pw.y = pg8::cvt_pk_bf16(Cacc[2 * ks][2], Cacc[2 * ks][3]); pw.z = pg8::cvt_pk_bf16(Cacc[2 * ks + 1][0], Cacc[2 * ks + 1][1]); pw.w = pg8::cvt_pk_bf16(Cacc[2 * ks + 1][2], Cacc[2 * ks + 1][3]);
                    cbf[ks] = __builtin_bit_cast(bf16x8, pw);
                    v4u pn2; pn2.x = pg8::cvt_pk_bf16(nacc[2 * ks][0], nacc[2 * ks][1]); pn2.y = pg8::cvt_pk_bf16(nacc[2 * ks][2], nacc[2 * ks][3]); pn2.z = pg8::cvt_pk_bf16(nacc[2 * ks + 1][0], nacc[2 * ks + 1][1]); pn2.w = pg8::cvt_pk_bf16(nacc[2 * ks + 1][2], nacc[2 * ks + 1][3]);
                    nbf[ks] = __builtin_bit_cast(bf16x8, pn2);
                }
                LAS unsigned char* hb = lds + OFF_H + par * HBUF;
#pragma unroll
                for (int rt = 0; rt < 4; ++rt) {
                    f32x4 a1 = (f32x4){0.f, 0.f, 0.f, 0.f}, aR = a1, a2 = a1, aN = a1;
#pragma unroll
                    for (int ks = 0; ks < 2; ++ks) {
                        if (ks == 0 || rt >= 2) { const bf16x8 a = *(const LAS bf16x8*)(Sb + (16 * rt + li) * 144 + (32 * ks + 8 * g) * 2); a1 = mfma16(a, vf[ks], a1); aR = mfma16(a, ones, aR); }
                        typedef unsigned u32x2 __attribute__((ext_vector_type(2)));
                        const u32x2 qa = *(const LAS u32x2*)(db + OFF_Q + (16 * rt + li) * QSTR + (32 * ks + 4 * g) * 2), qb = *(const LAS u32x2*)(db + OFF_Q + (16 * rt + li) * QSTR + (32 * ks + 16 + 4 * g) * 2);
                        const bf16x8 aq = __builtin_bit_cast(bf16x8, (v4u){qa.x, qa.y, qb.x, qb.y});
                        a2 = mfma16(aq, cbf[ks], a2); aN = mfma16(aq, nbf[ks], aN);
                    }
                    const f32x4 I4 = *(const LAS f32x4*)(wsc + 512 + 16 * rt + 4 * g), F4 = *(const LAS f32x4*)(wsc + 1024 + 16 * rt + 4 * g);
                    float hv[4];
#pragma unroll
                    for (int r = 0; r < 4; ++r) { const float den = aR[r] + I4[r] * aN[r], dmax = fmaxf(fabsf(den), F4[r]); hv[r] = (a1[r] + I4[r] * a2[r]) * __builtin_amdgcn_rcpf(dmax); }
                    const unsigned p01 = pg8::cvt_pk_bf16(hv[0], hv[1]), p23 = pg8::cvt_pk_bf16(hv[2], hv[3]);
                    LAS unsigned char* hq = hb + (16 * rt + 4 * g) * HSTRB + (16 * w + li) * 2;
                    *(LAS bf16*)(hq) = (bf16)(p01 & 0xffffu); *(LAS bf16*)(hq + HSTRB) = (bf16)(p01 >> 16); *(LAS bf16*)(hq + 2 * HSTRB) = (bf16)(p23 & 0xffffu); *(LAS bf16*)(hq + 3 * HSTRB) = (bf16)(p23 >> 16);
                    __builtin_amdgcn_sched_barrier(0);
                }
                bf16x8 wo[2];
#pragma unroll
                for (int ks = 0; ks < 2; ++ks) { const f32x4 w0 = *(const LAS f32x4*)(wsc + 32 * ks + 8 * g), w1 = *(const LAS f32x4*)(wsc + 32 * ks + 8 * g + 4);
                    v4u po; po.x = pg8::cvt_pk_bf16(w0.x, w0.y); po.y = pg8::cvt_pk_bf16(w0.z, w0.w); po.z = pg8::cvt_pk_bf16(w1.x, w1.y); po.w = pg8::cvt_pk_bf16(w1.z, w1.w); wo[ks] = __builtin_bit_cast(bf16x8, po); }
#pragma unroll
                for (int dt = 0; dt < 4; ++dt) {
                    Cacc[dt] = Cacc[dt] * decay; nacc[dt] = nacc[dt] * decay;
#pragma unroll
                    for (int ks = 0; ks < 2; ++ks) {
                        const LAS unsigned char* kp = db + OFF_K + (32 * ks + 8 * g + q4) * QSTR + (16 * dt + 4 * p4) * 2;
                        const s16x4 lo = vtr(kp), hh = vtr(kp + 4 * QSTR);
                        const bf16x8 ka = (bf16x8){lo[0], lo[1], lo[2], lo[3], hh[0], hh[1], hh[2], hh[3]};
                        Cacc[dt] = mfma16(ka, wv[ks], Cacc[dt]); nacc[dt] = mfma16(ka, wo[ks], nacc[dt]);
                    }
                    __builtin_amdgcn_sched_barrier(0);
                }
            }
            MSTAMP(2);
            if (c < 32) {
                LAS unsigned char* Sn = lds + OFF_S + (par ^ 1) * SBUF;
                f32x4 acc = (f32x4){0.f, 0.f, 0.f, 0.f};
                acc = mfma16(xa[0][0], xb[0][0], acc); acc = mfma16(xa[0][1], xb[0][1], acc);
                ML_STILE(acc, rtA, stA, c + 1, mnext, Sn);
                if (w < 2) { f32x4 acc2 = (f32x4){0.f, 0.f, 0.f, 0.f}; acc2 = mfma16(xa[1][0], xb[1][0], acc2); acc2 = mfma16(xa[1][1], xb[1][1], acc2); ML_STILE(acc2, rtB, stB, c + 1, mnext, Sn); }
            }
            MSTAMP(3);
            if (c >= 1) {
                const LAS unsigned char* hp = lds + OFF_H + (par ^ 1) * HBUF + zt * HSTRB + zc * 32; float hv[16]; float ss = 0.f;
                const v4u h0 = *(const LAS v4u*)hp, h1 = *(const LAS v4u*)(hp + 16); const unsigned hw[8] = {h0.x, h0.y, h0.z, h0.w, h1.x, h1.y, h1.z, h1.w};
#pragma unroll
                for (int i = 0; i < 8; ++i) { hv[2 * i] = bflo(hw[i]); hv[2 * i + 1] = bfhi(hw[i]); ss += hv[2 * i] * hv[2 * i] + hv[2 * i + 1] * hv[2 * i + 1]; }
                ss = sum8(ss);
                const float rn = __builtin_amdgcn_rsqf(ss * (1.0f / DV) + EPS);
                const unsigned ow[8] = {og0.x, og0.y, og0.z, og0.w, og1.x, og1.y, og1.z, og1.w}; unsigned res[8]; float gn[16];
#pragma unroll
                for (int i = 0; i < 4; ++i) { const f32x4 t4 = *(const LAS f32x4*)(lds + OFF_GN + (16 * zc + 4 * i) * 4); gn[4 * i] = t4.x; gn[4 * i + 1] = t4.y; gn[4 * i + 2] = t4.z; gn[4 * i + 3] = t4.w; }
#pragma unroll
                for (int i = 0; i < 8; ++i) { const float o0 = bflo(ow[i]), o1 = bfhi(ow[i]);
                    res[i] = pg8::cvt_pk_bf16(hv[2 * i] * rn * gn[2 * i] * __builtin_amdgcn_rcpf(1.0f + __expf(-o0)), hv[2 * i + 1] * rn * gn[2 * i + 1] * __builtin_amdgcn_rcpf(1.0f + __expf(-o1))); }
                if (zvalid && (cz != 0 || b == 0)) { bf16* dst = (cz == 0 ? F.MIXM : F.MIX) + (size_t)ML_ROW0(cz) * D + h * DV; const int om = zt * D + 16 * zc; *(GAS v4u*)(dst + om) = (v4u){res[0], res[1], res[2], res[3]}; *(GAS v4u*)(dst + 8 + om) = (v4u){res[4], res[5], res[6], res[7]}; }
            }
            m = mnext;
            MSTAMP(4);
            if (c < 32) ML_STORE(par ^ 1);
            MSTAMP(5);
            __syncthreads();
            MSTAMP(6);
        }
#ifdef PROBE_ML
        if (blockIdx.x == 0) ((volatile LAS float*)F.MISC)[17] = pacc / 34.f;
#endif
#undef ML_ROW0
#undef ML_PB
#undef ML_LOAD
#undef ML_STORE
#undef ML_STILE
    }
}
struct Args { const float* in[14]; float* out; unsigned char* ws; int ph_lo, ph_hi; };
__global__ void __launch_bounds__(NWAVES * 64, 2) fwd_kernel(Args args) {
    extern __shared__ __attribute__((aligned(16))) unsigned char lds[];
    Frame F;
    F.lds = (LAS unsigned char*)lds;
    F.MISC = (volatile LAS unsigned*)(F.lds + MISC_OFF);
    F.tid = threadIdx.x; F.lane = F.tid & 63; F.wave = __builtin_amdgcn_readfirstlane(F.tid >> 6);
    F.G = gridDim.x; { const int bx = blockIdx.x; F.vcu = (F.G % 8 == 0) ? (bx % 8) * (F.G / 8) + bx / 8 : bx; }
    unsigned char* ws = args.ws; F.ws = ws;
    F.ctl = (gu32*)(ws + WS_CTL);
    F.x = args.in[0]; F.meta = args.in[1]; F.ngain = args.in[2]; F.m_win = args.in[3]; F.m_bgate = args.in[4]; F.m_hgain = args.in[5]; F.m_wout = args.in[6];
    F.d_win = args.in[7]; F.d_lam = args.in[8]; F.d_hgain = args.in[9]; F.d_wout = args.in[10]; F.w_up = args.in[11]; F.w_dn = args.in[12]; F.fgain = args.in[13];
    F.out = args.out;
    F.WIN0 = (bf16*)(ws + WS_WIN0); F.WOUT0 = (bf16*)(ws + WS_WOUT0); F.WUP0 = (bf16*)(ws + WS_WUP0); F.WDN0 = (bf16*)(ws + WS_WDN0);
    F.WIN1 = (bf16*)(ws + WS_WIN1); F.WOUT1 = (bf16*)(ws + WS_WOUT1); F.WUP1 = (bf16*)(ws + WS_WUP1); F.WDN1 = (bf16*)(ws + WS_WDN1);
    F.HB = (bf16*)(ws + WS_HB); F.P = (bf16*)(ws + WS_P); F.MIX = (bf16*)(ws + WS_MIX); F.U = (bf16*)(ws + WS_U);
    F.SS = (float*)(ws + WS_SS); F.GATES = (float*)(ws + WS_GATES); F.GSC = (float*)(ws + WS_GSC);
    F.HMETA = (float*)(ws + WS_HMETA); F.HBM = (bf16*)(ws + WS_HBM); F.PM = (bf16*)(ws + WS_PM); F.MIXM = (bf16*)(ws + WS_MIXM); F.UM = (bf16*)(ws + WS_UM); F.GATESM = (float*)(ws + WS_GATESM);
    F.SSM = (float*)(ws + WS_CTL) + CW_SSM;
    for (int u = F.tid; u < (LDS_BYTES - LDSCTL_OFF) / 4; u += NWAVES * 64) ((LAS unsigned*)(F.lds + LDSCTL_OFF))[u] = 0u;
    __syncthreads();
    const int lo = args.ph_lo, hi = args.ph_hi;
    const bool use_bar = (hi - lo) > 1;
    XcdBarrier bar; bar.bar = (unsigned*)(F.ctl + CW_BAR); bar.x = 0; bar.st = nullptr;
    if (use_bar) bar = xcd_barrier_post((unsigned*)(F.ctl + CW_BAR), F.MISC + 8);
#define IN(k) (lo <= (k) && (k) < hi)
#ifdef PROBE_PHASE
    unsigned long long t_prev = __builtin_amdgcn_s_memrealtime(); float probe_val = 0.f; const unsigned long long t_start = t_prev;
#define STAMP(k) do { const unsigned long long t_now = __builtin_amdgcn_s_memrealtime(); if ((k) == PROBE_PHASE) probe_val = (float)(t_now - t_prev) * 0.01f; t_prev = t_now; } while (0)
#else
#define STAMP(k) do {} while (0)
#endif
#ifdef PROBE_SPREAD
#define SPREAD_STAMP(k) do { if ((k) == PROBE_SPREAD && F.tid == 0) { const unsigned long long tt_ = __builtin_amdgcn_s_memrealtime(); atomicMax((unsigned long long*)(F.ws + WS_CTL + 8192), ~tt_); atomicMax((unsigned long long*)(F.ws + WS_CTL + 8200), tt_); } } while (0)
#else
#define SPREAD_STAMP(k) do {} while (0)
#endif
#ifdef PROBE_BAR
    float bar_us = 0.f;
#define SEAM(k) do { SPREAD_STAMP(k); if (IN(k) && IN((k) + 1)) { const unsigned long long tb0_ = __builtin_amdgcn_s_memrealtime(); xcd_barrier(bar); if (PROBE_BAR == 99 || PROBE_BAR == (k)) bar_us += (float)(__builtin_amdgcn_s_memrealtime() - tb0_) * 0.01f; } STAMP(k); } while (0)
#else
#define SEAM(k) do { SPREAD_STAMP(k); if (IN(k) && IN((k) + 1)) xcd_barrier(bar); STAMP(k); } while (0)
#endif
#ifdef DOUBLE_PHASE
#define DBLG(k, EPI, Aptr, Bptr, NN, KK, ...) if (DOUBLE_PHASE == (k)) { pg8::Gemm g{Aptr, Bptr, MR, NN, KK}; pg8::StaticOrder S; S.init(MR, NN, F.G, (int)blockIdx.x); EPI E{__VA_ARGS__}; pg8::gemm_phase<EPI, pg8::StaticOrder, PG8_ALIGN, PG8_SP2>(F.lds + RING_OFF, g, S, E); xcd_barrier(bar); }
#else
#define DBLG(k, EPI, Aptr, Bptr, NN, KK, ...)
#endif
#define GEMM_PHASE(k, EPI, Aptr, Bptr, NN, KK, METAJOB, ...) if (IN(k)) { DBLG(k, EPI, Aptr, Bptr, NN, KK, __VA_ARGS__)  METAJOB; pg8::Gemm g{Aptr, Bptr, MR, NN, KK}; pg8::StaticOrder S; S.init(MR, NN, F.G, (int)blockIdx.x); \
        EPI E{__VA_ARGS__}; pg8::gemm_phase<EPI, pg8::StaticOrder, PG8_ALIGN, PG8_SP2>(F.lds + RING_OFF, g, S, E); SEAM(k); }
    typedef pg8::EpiRes<true, false> EpiRes00; typedef pg8::EpiRes<false, false> EpiRes10; typedef pg8::EpiRes<false, true> EpiRes11;
    typedef pg8::EpiScale<0, 1> EpiIn0; typedef pg8::EpiScale<0, 16> EpiIn1; typedef pg8::EpiScale<1, 16> EpiUp;
#ifdef DOUBLE_PHASE
#define DBL(k, stmt) if (DOUBLE_PHASE == (k)) { stmt; xcd_barrier(bar); }
#else
#define DBL(k, stmt)
#endif
    DBL(0, p0_prologue(F))
    if (IN(0)) { p0_prologue(F); SEAM(0); }
    GEMM_PHASE(1, EpiIn0, F.HB, F.WIN0, NPROJ, D, gate_scan_job(F); meta_gemm(F, F.HBM, F.WIN0, 0, NPROJ / 16, D, MEpiScale<0>{F.PM, NPROJ, F.SSM}), F.P, NPROJ, F.SS, EPS)
#ifdef MLSTM_V2
    DBL(2, mlstm_mfma_phase(F))
    if (IN(2)) { mlstm_mfma_phase(F); SEAM(2); }
#else
    DBL(2, mlstm3_phase(F))
    if (IN(2)) { mlstm3_phase(F); SEAM(2); }
#endif
    GEMM_PHASE(3, EpiRes00, F.MIX, F.WOUT0, D, D, meta_gemm(F, F.MIXM, F.WOUT0, 0, D / 16, D, MEpiRes{F.meta, F.HMETA, F.HBM, F.SSM}), F.x, (float*)nullptr, F.HB, F.SS)
    GEMM_PHASE(4, EpiUp, F.HB, F.WUP0, FF, D, meta_gemm(F, F.HBM, F.WUP0, 0, FF / 16, D, MEpiScale<1>{F.UM, FF, F.SSM}), F.U, FF, F.SS, EPS)
    GEMM_PHASE(5, EpiRes10, F.U, F.WDN0, D, FF, meta_gemm(F, F.UM, F.WDN0, 0, D / 16, FF, MEpiRes{F.HMETA, F.HMETA, F.HBM, F.SSM}), (const float*)nullptr, (float*)nullptr, F.HB, F.SS)
    GEMM_PHASE(6, EpiIn1, F.HB, F.WIN1, NPROJ, D, meta_gemm(F, F.HBM, F.WIN1, 1024 / 16, NPROJ / 16, D, MEpiScale<0>{F.PM, NPROJ, F.SSM}), F.P, NPROJ, F.SS, EPS)
    DBL(7, attn_mfma_phase(F))
    if (IN(7)) { attn_mfma_phase(F); SEAM(7); }
    GEMM_PHASE(8, EpiRes10, F.MIX, F.WOUT1, D, D, (void)0, (const float*)nullptr, (float*)nullptr, F.HB, F.SS)
    GEMM_PHASE(9, EpiUp, F.HB, F.WUP1, FF, D, (void)0, F.U, FF, F.SS, EPS)
    GEMM_PHASE(10, EpiRes10, F.U, F.WDN1, D, FF, (void)0, (const float*)nullptr, (float*)nullptr, F.HB, F.SS)
    if (IN(11)) { final_norm_phase(F); }
#ifdef PROBE_SPREAD
    if (blockIdx.x == 0 && F.tid == 0) { asm volatile("s_waitcnt vmcnt(0)" ::: "memory"); const unsigned long long a_ = ~__hip_atomic_load((unsigned long long*)(F.ws + WS_CTL + 8192), __ATOMIC_RELAXED, __HIP_MEMORY_SCOPE_AGENT), b_ = __hip_atomic_load((unsigned long long*)(F.ws + WS_CTL + 8200), __ATOMIC_RELAXED, __HIP_MEMORY_SCOPE_AGENT); F.out[0] += 0.05f + 0.10f * fminf((float)(b_ - a_) * 0.01f * (1.0f / PROBE_FULL), 1.0f); }
#endif
#ifdef PROBE_BAR
    if (blockIdx.x == PROBE_BLOCK && F.tid == 0) { asm volatile("s_waitcnt vmcnt(0)" ::: "memory"); F.out[PROBE_BLOCK == 0 ? 0 : 1] += 0.05f + 0.10f * fminf(bar_us * (1.0f / PROBE_FULL), 1.0f); }
#endif
#if defined(PROBE_SEG) || defined(PROBE_GEMM) || defined(PROBE_ML) || defined(PROBE_P0)
    if (blockIdx.x == 0 && F.tid == 0) { asm volatile("s_waitcnt vmcnt(0)" ::: "memory"); const float cyc = ((volatile LAS float*)F.MISC)[17]; F.out[0] += 0.05f + 0.10f * fminf(cyc * (1.0f / PROBE_FULL), 1.0f); }
#endif
#ifdef PROBE_PHASE
    STAMP(11);
    if (PROBE_PHASE == 99) probe_val = (float)(__builtin_amdgcn_s_memrealtime() - t_start) * 0.01f;
    if (blockIdx.x == 0 && F.tid == 0) { asm volatile("s_waitcnt vmcnt(0)" ::: "memory"); F.out[0] += 0.05f + 0.10f * fminf(probe_val * (1.0f / PROBE_FULL), 1.0f); }
#endif
#undef IN
#undef SEAM
#undef GEMM_PHASE
}

extern "C" void kernel_launch(void* const* d_in, const int* in_sizes, int n_in, void* d_out, int out_size, void* d_ws, size_t ws_size, hipStream_t stream) {
    static int grid = 0;
    if (grid == 0) {
        if (n_in != 14 || in_sizes[0] != NB * SEQ * D || out_size != NB * SEQ * D || ws_size < WS_END) { fprintf(stderr, "kernel_launch: unexpected shapes (n_in %d, in0 %d, out %d, ws %zu)\n", n_in, n_in > 0 ? in_sizes[0] : -1, out_size, ws_size); grid = -1; return; }
        int dev = 0, cus = 0, per_cu = 0;
        if (hipGetDevice(&dev) != hipSuccess || hipDeviceGetAttribute(&cus, hipDeviceAttributeMultiprocessorCount, dev) != hipSuccess) { grid = -1; return; }
        if (hipFuncSetAttribute((const void*)fwd_kernel, hipFuncAttributeMaxDynamicSharedMemorySize, LDS_BYTES) != hipSuccess) { fprintf(stderr, "kernel_launch: hipFuncSetAttribute failed\n"); grid = -1; return; }
        if (hipOccupancyMaxActiveBlocksPerMultiprocessor(&per_cu, (const void*)fwd_kernel, NWAVES * 64, LDS_BYTES) != hipSuccess || per_cu < 1) { fprintf(stderr, "kernel_launch: occupancy query reports %d blocks per CU\n", per_cu); (void)hipGetLastError(); grid = -1; return; }
        grid = cus;
    }
    if (grid < 0) return;
    if (hipMemsetAsync((char*)d_ws + WS_CTL, 0, CTL_ZERO_BYTES, stream) != hipSuccess) return;
    Args a{};
    for (int i = 0; i < 14; ++i) a.in[i] = (const float*)d_in[i];
    a.out = (float*)d_out; a.ws = (unsigned char*)d_ws;
    if (MK_N_LAUNCHES == 1) { a.ph_lo = 0; a.ph_hi = NPHASE; hipLaunchKernelGGL(fwd_kernel, dim3(grid), dim3(NWAVES * 64), LDS_BYTES, stream, a); }
    else for (int p = 0; p < NPHASE; ++p) { a.ph_lo = p; a.ph_hi = p + 1; hipLaunchKernelGGL(fwd_kernel, dim3(grid), dim3(NWAVES * 64), LDS_BYTES, stream, a); }
}
```
